# Optimizing an MI355X kernel written in HIP

```python
import jax, jax.numpy as jnp
from jax import lax
import numpy as np

D_MODEL = 2048
BATCH = 1
SEQ = 16384
DEPTH = 1

MEM_LEN = 256
GLA_HEADS = 4
GLA_DK = 256
GLA_DV = 512
GLA_GATE_RANK = 16
GLA_GATE_TEMP = 16.0
GLA_CHUNK = 64
CONV_DIM = D_MODEL
CONV_WIDTH = 3
XATTN_HEADS = 4
XATTN_HEAD_DIM = 128
N_EXPERTS = 32
TOP_K = 4
D_FF = D_MODEL
SWIGLU_LIMIT = 7.0
SWIGLU_ALPHA = 1.702
MOE_BLOCK = 128
NORM_EPS = 1e-5

GLA_QK_DIM = GLA_HEADS * GLA_DK
GLA_V_DIM = GLA_HEADS * GLA_DV
XATTN_DIM = XATTN_HEADS * XATTN_HEAD_DIM
IN_SPLIT_SIZES = (GLA_QK_DIM, GLA_QK_DIM, GLA_V_DIM, GLA_V_DIM, GLA_GATE_RANK, CONV_DIM, CONV_DIM, CONV_DIM, D_MODEL, D_MODEL)
IN_PROJ_DIM = sum(IN_SPLIT_SIZES)

kernel_name = 'hybrid_gla_shortconv_xattn_moe'


def rms_norm(t, g):
    t32 = t.astype(jnp.float32)
    y = t32 * lax.rsqrt(jnp.mean(t32 * t32, axis=-1, keepdims=True) + NORM_EPS)
    return (y * g.astype(jnp.float32)).astype(t.dtype)


def gla_chunked(q, k, v, log_a):
    Bsz, S, H, DK = q.shape
    DV = v.shape[-1]
    nc = S // GLA_CHUNK

    def to_chunks(t):
        return t.reshape(Bsz, nc, GLA_CHUNK, H, t.shape[-1]).transpose(1, 0, 3, 2, 4)

    qc, kc, vc = to_chunks(q), to_chunks(k), to_chunks(v)
    bc = lax.cumsum(to_chunks(log_a.astype(jnp.float32)), axis=3)
    causal = jnp.tril(jnp.ones((GLA_CHUNK, GLA_CHUNK), bool))[:, :, None]

    def step(state, inp):
        qi, ki, vi, bi = inp
        o_inter = jnp.einsum('bhck,bhkv->bhcv', qi * jnp.exp(bi), state)
        diff = bi[:, :, :, None, :] - bi[:, :, None, :, :]
        decay = jnp.where(causal, jnp.exp(jnp.minimum(diff, 0.0)), 0.0)
        scores = jnp.einsum('bhik,bhjk,bhijk->bhij', qi, ki, decay)
        o_intra = jnp.einsum('bhij,bhjv->bhiv', scores, vi)
        b_last = bi[:, :, -1:, :]
        new_state = jnp.exp(b_last[:, :, 0, :, None]) * state + jnp.einsum('bhck,bhcv->bhkv', ki * jnp.exp(b_last - bi), vi)
        return new_state, o_inter + o_intra

    state0 = jnp.zeros((Bsz, H, DK, DV), jnp.float32)
    _, o = lax.scan(step, state0, (qc, kc, vc, bc))
    return o.transpose(1, 0, 3, 2, 4).reshape(Bsz, S, H, DV)


def token_mixers(h, w_in, gla_gate_w, gla_gate_b, gla_norm_g, gla_out_w, conv_w, conv_b, conv_out_w, mix_out_w):
    Bsz, S, _ = h.shape
    split_points = np.cumsum(IN_SPLIT_SIZES)[:-1].tolist()
    proj = h @ w_in
    q, k, v, r, a_low, cb, cc, ch, ga, gb = jnp.split(proj, split_points, axis=-1)

    log_a = jax.nn.log_sigmoid((a_low @ gla_gate_w + gla_gate_b).astype(jnp.float32)) / GLA_GATE_TEMP
    o = gla_chunked(q.reshape(Bsz, S, GLA_HEADS, GLA_DK) * (GLA_DK ** -0.5),
                    k.reshape(Bsz, S, GLA_HEADS, GLA_DK),
                    v.reshape(Bsz, S, GLA_HEADS, GLA_DV),
                    log_a.reshape(Bsz, S, GLA_HEADS, GLA_DK))
    o = rms_norm(o, gla_norm_g).reshape(Bsz, S, GLA_V_DIM).astype(h.dtype)
    y_a = (o * jax.nn.silu(r)) @ gla_out_w

    u = cc * ch
    uc = lax.conv_general_dilated(u, conv_w.astype(u.dtype)[:, None, :], window_strides=(1,),
                                  padding=[(CONV_WIDTH - 1, 0)], dimension_numbers=('NWC', 'WIO', 'NWC'),
                                  feature_group_count=CONV_DIM) + conv_b
    y_b = (cb * uc) @ conv_out_w

    merged = jax.nn.sigmoid(ga) * y_a + jax.nn.sigmoid(gb) * y_b
    return merged @ mix_out_w


def memory_cross_attention(h, mem_n, q_w, k_w, v_w, o_w):
    Bsz, S, _ = h.shape
    M = mem_n.shape[1]
    q = (h @ q_w).reshape(Bsz, S, XATTN_HEADS, XATTN_HEAD_DIM)
    k = (mem_n @ k_w).reshape(Bsz, M, XATTN_HEADS, XATTN_HEAD_DIM)
    v = (mem_n @ v_w).reshape(Bsz, M, XATTN_HEADS, XATTN_HEAD_DIM)
    s = jnp.einsum('bshd,bmhd->bhsm', q, k).astype(jnp.float32) * (XATTN_HEAD_DIM ** -0.5)
    p = jax.nn.softmax(s, axis=-1).astype(v.dtype)
    o = jnp.einsum('bhsm,bmhd->bshd', p, v).reshape(Bsz, S, XATTN_DIM)
    return o @ o_w


def moe_ffn(h, router_w, router_b, gu_w, gu_b, down_w, down_b):
    Bsz, S, D = h.shape
    T = Bsz * S
    xt = h.reshape(T, D)
    logits = (xt @ router_w + router_b).astype(jnp.float32)
    top_val, top_idx = lax.top_k(logits, TOP_K)
    gates = jax.nn.softmax(top_val, axis=-1)
    A = T * TOP_K
    flat_e = top_idx.reshape(A)
    flat_tok = jnp.repeat(jnp.arange(T, dtype=jnp.int32), TOP_K)
    flat_w = gates.reshape(A)
    order = jnp.argsort(flat_e)
    sorted_e = flat_e[order]
    counts = jnp.bincount(flat_e, length=N_EXPERTS)
    group_start = jnp.cumsum(counts) - counts
    padded = (counts + MOE_BLOCK - 1) // MOE_BLOCK * MOE_BLOCK
    padded_end = jnp.cumsum(padded)
    padded_start = padded_end - padded
    dest = padded_start[sorted_e] + jnp.arange(A) - group_start[sorted_e]
    n_blocks = -(-A // MOE_BLOCK) + N_EXPERTS
    P = n_blocks * MOE_BLOCK
    row_tok = jnp.full((P,), T, jnp.int32).at[dest].set(flat_tok[order])
    row_w = jnp.zeros((P,), jnp.float32).at[dest].set(flat_w[order])
    block_e = jnp.minimum(jnp.searchsorted(padded_end, jnp.arange(n_blocks) * MOE_BLOCK, side='right'), N_EXPERTS - 1)
    x_pad = jnp.concatenate([xt, jnp.zeros((1, D), xt.dtype)], axis=0)

    def expert_block(args):
        tok, e = args
        xb = x_pad[tok]
        gu = xb @ gu_w[e] + gu_b[e]
        gate = jnp.minimum(gu[:, :D_FF], SWIGLU_LIMIT)
        up = jnp.clip(gu[:, D_FF:], -SWIGLU_LIMIT, SWIGLU_LIMIT)
        act = (up + 1.0) * gate * jax.nn.sigmoid(SWIGLU_ALPHA * gate)
        return act @ down_w[e] + down_b[e]

    ys = lax.map(expert_block, (row_tok.reshape(n_blocks, MOE_BLOCK), block_e))
    out = jax.ops.segment_sum(ys.reshape(P, D) * row_w[:, None], row_tok, num_segments=T + 1)[:T]
    return out.reshape(Bsz, S, D).astype(h.dtype)


def setup_inputs(seed: int = 0) -> dict:
    key = jax.random.key(seed)
    ks = jax.random.split(key, 32)
    n = lambda i, shape, scale: jax.random.normal(ks[i], shape, jnp.float32) * scale
    gain = lambda i, shape: 1.0 + 0.02 * jax.random.normal(ks[i], shape, jnp.float32)
    L, D = DEPTH, D_MODEL
    return {
        'x': n(0, (BATCH, SEQ, D), 1.0),
        'mem': n(1, (BATCH, MEM_LEN, D), 1.0),
        'norm_mix_g': gain(2, (L, D)),
        'w_in': n(3, (L, D, IN_PROJ_DIM), D ** -0.5),
        'gla_gate_w': n(4, (L, GLA_GATE_RANK, GLA_QK_DIM), GLA_GATE_RANK ** -0.5),
        'gla_gate_b': n(5, (L, GLA_QK_DIM), 0.1),
        'gla_norm_g': gain(6, (L, GLA_DV)),
        'gla_out_w': n(7, (L, GLA_V_DIM, D), GLA_V_DIM ** -0.5),
        'conv_w': n(8, (L, CONV_WIDTH, CONV_DIM), CONV_WIDTH ** -0.5),
        'conv_b': n(9, (L, CONV_DIM), 0.02),
        'conv_out_w': n(10, (L, CONV_DIM, D), CONV_DIM ** -0.5),
        'mix_out_w': n(11, (L, D, D), D ** -0.5),
        'norm_xattn_g': gain(12, (L, D)),
        'norm_mem_g': gain(13, (L, D)),
        'xq_w': n(14, (L, D, XATTN_DIM), D ** -0.5),
        'xk_w': n(15, (L, D, XATTN_DIM), D ** -0.5),
        'xv_w': n(16, (L, D, XATTN_DIM), D ** -0.5),
        'xo_w': n(17, (L, XATTN_DIM, D), XATTN_DIM ** -0.5),
        'norm_moe_g': gain(18, (L, D)),
        'router_w': n(19, (L, D, N_EXPERTS), D ** -0.5),
        'router_b': n(20, (L, N_EXPERTS), 0.01),
        'expert_gu_w': n(21, (L, N_EXPERTS, D, 2 * D_FF), D ** -0.5),
        'expert_gu_b': n(22, (L, N_EXPERTS, 2 * D_FF), 0.01),
        'expert_down_w': n(23, (L, N_EXPERTS, D_FF, D), D_FF ** -0.5),
        'expert_down_b': n(24, (L, N_EXPERTS, D), 0.01),
        'norm_final_g': gain(25, (D,)),
    }


def reference(x, mem, norm_mix_g, w_in, gla_gate_w, gla_gate_b, gla_norm_g, gla_out_w, conv_w, conv_b,
              conv_out_w, mix_out_w, norm_xattn_g, norm_mem_g, xq_w, xk_w, xv_w, xo_w, norm_moe_g,
              router_w, router_b, expert_gu_w, expert_gu_b, expert_down_w, expert_down_b, norm_final_g):
    for l in range(DEPTH):
        x = x + token_mixers(rms_norm(x, norm_mix_g[l]), w_in[l], gla_gate_w[l], gla_gate_b[l], gla_norm_g[l],
                             gla_out_w[l], conv_w[l], conv_b[l], conv_out_w[l], mix_out_w[l])
        mem_n = rms_norm(mem, norm_mem_g[l])
        x = x + memory_cross_attention(rms_norm(x, norm_xattn_g[l]), mem_n, xq_w[l], xk_w[l], xv_w[l], xo_w[l])
        x = x + moe_ffn(rms_norm(x, norm_moe_g[l]), router_w[l], router_b[l], expert_gu_w[l], expert_gu_b[l],
                        expert_down_w[l], expert_down_b[l])
    return rms_norm(x, norm_final_g)
```

```cpp
#include <hip/hip_runtime.h>
#include <cstdio>
#include <cstdint>

#ifndef MK_ONE_LAUNCH
#define MK_ONE_LAUNCH 0
#endif
#ifndef OPT_GEMM
#define OPT_GEMM 0
#endif
#ifndef OPT_GLA
#define OPT_GLA 0
#endif
#ifndef OPT_ATT
#define OPT_ATT 0
#endif

#define GAS __attribute__((address_space(1)))
#define LAS __attribute__((address_space(3)))
typedef unsigned short bf16;
typedef short bf16x8 __attribute__((ext_vector_type(8)));
typedef short bf16x4 __attribute__((ext_vector_type(4)));
typedef float f32x4 __attribute__((ext_vector_type(4)));
typedef float f32x2 __attribute__((ext_vector_type(2)));
typedef unsigned u32x4 __attribute__((ext_vector_type(4)));
typedef unsigned u32x2 __attribute__((ext_vector_type(2)));
#define RLX_AGENT __ATOMIC_RELAXED, __HIP_MEMORY_SCOPE_AGENT
#define LDS_WAIT() asm volatile("s_waitcnt lgkmcnt(0)" ::: "memory")
#define VM_WAIT() asm volatile("s_waitcnt vmcnt(0)" ::: "memory")

constexpr int T = 16384, D = 2048, MEM = 256;
constexpr int GH = 4, DK = 256, DV = 512, QK = GH * DK  , VD = GH * DV  ;
constexpr int CH = 64, NCH = T / CH  , NG = 16, GC = NCH / NG  , GT = GC * CH  ;
constexpr int XH = 4, XD = 128, XA = XH * XD  ;
constexpr int NE = 32, TOPK = 4, FF = 2048;
constexpr int NIN_SRC = 16400, NIN = 17408;
constexpr float EPS = 1e-5f;
constexpr int PROWS = T * TOPK + NE * 256;
constexpr int MAXTILES = PROWS / 256;

constexpr int SRC_ALOW = 6144, SRC_CB = 6160, SRC_CC = 8208, SRC_CHH = 10256, SRC_GA = 12304, SRC_GB = 14352;
constexpr int TN_Q = 0, TN_K = 4, TN_V = 8, TN_R = 16, TN_LA = 24, TN_CB = 28, TN_U = 36, TN_GA = 52, TN_GB = 60, TN_END = 68;

constexpr size_t MiB = 1u << 20;
constexpr size_t WS_CTL = 0, CTL_ZERO_BYTES = 1 * MiB;
constexpr size_t WS_WIN = 1 * MiB;
constexpr size_t WS_WGO = WS_WIN + 68 * MiB;
constexpr size_t WS_WCO = WS_WGO + 8 * MiB;
constexpr size_t WS_WMX = WS_WCO + 8 * MiB;
constexpr size_t WS_WXQ = WS_WMX + 8 * MiB;
constexpr size_t WS_WXKV = WS_WXQ + 2 * MiB;
constexpr size_t WS_WXO = WS_WXKV + 4 * MiB;
constexpr size_t WS_WR = WS_WXO + 2 * MiB;
constexpr size_t WS_WGU = WS_WR + 1 * MiB;
constexpr size_t WS_WDN = WS_WGU + 512 * MiB;
constexpr size_t WS_XN = WS_WDN + 256 * MiB;
constexpr size_t WS_Q = WS_XN + 64 * MiB;
constexpr size_t WS_K = WS_Q + 32 * MiB;
constexpr size_t WS_V = WS_K + 32 * MiB;
constexpr size_t WS_SR = WS_V + 64 * MiB;
constexpr size_t WS_LA = WS_SR + 64 * MiB;
constexpr size_t WS_CB = WS_LA + 64 * MiB;
constexpr size_t WS_U = WS_CB + 64 * MiB;
constexpr size_t WS_SGA = WS_U + 64 * MiB;
constexpr size_t WS_SGB = WS_SGA + 64 * MiB;
constexpr size_t WS_QT = WS_SGB + 64 * MiB;
constexpr size_t WS_KH = WS_QT + 32 * MiB;
constexpr size_t WS_KHT = WS_KH + 32 * MiB;
constexpr size_t WS_QG = WS_KHT + 32 * MiB;
constexpr size_t WS_VT = WS_QG + 32 * MiB;
constexpr size_t WS_DL = WS_VT + 64 * MiB;
constexpr size_t WS_DG = WS_DL + 1 * MiB;
constexpr size_t WS_Z = WS_DG + 1 * MiB;
constexpr size_t WS_OL = WS_Z + 64 * MiB;
constexpr size_t WS_SLOC = WS_OL + 64 * MiB;
constexpr size_t WS_SG0 = WS_SLOC + 32 * MiB;
constexpr size_t WS_O32 = WS_SG0 + 16 * MiB;
constexpr size_t WS_OA = WS_O32 + 128 * MiB;
constexpr size_t WS_T1 = WS_OA + 64 * MiB;
constexpr size_t WS_MG = WS_T1 + 128 * MiB;
constexpr size_t WS_X1 = WS_MG + 64 * MiB;
constexpr size_t WS_X1B = WS_X1 + 128 * MiB;
constexpr size_t WS_QX = WS_X1B + 64 * MiB;
constexpr size_t WS_OX = WS_QX + 16 * MiB;
constexpr size_t WS_MEMN = WS_OX + 16 * MiB;
constexpr size_t WS_KM = WS_MEMN + 1 * MiB;
constexpr size_t WS_VMT = WS_KM + 1 * MiB;
constexpr size_t WS_H3 = WS_VMT + 1 * MiB;
constexpr size_t WS_TKE = WS_H3 + 65 * MiB;
constexpr size_t WS_TKP = WS_TKE + 1 * MiB;
constexpr size_t WS_TKW = WS_TKP + 1 * MiB;
constexpr size_t WS_ROWTOK = WS_TKW + 1 * MiB;
constexpr size_t WS_TILE = WS_ROWTOK + 1 * MiB;
constexpr size_t WS_ACT = WS_TILE + 1 * MiB;
constexpr size_t WS_YS = WS_ACT + 288 * MiB;
constexpr size_t WS_END = WS_YS + 288 * MiB;
constexpr int CW_BAR = 4096;
constexpr int CW_CNT = 16384;
constexpr int CW_SS1 = 65536;
static_assert((CW_SS1 + T) * 4 <= (int)CTL_ZERO_BYTES, "ctl");

constexpr int NWAVES = 8, NTHR = 512;
constexpr int LDS_BYTES = 147456;
constexpr int MISC_OFF = 135168;

__device__ __forceinline__ float bf2f(unsigned short b) { return __uint_as_float(((unsigned)b) << 16); }
__device__ __forceinline__ unsigned f2bf(float f) { unsigned u = __float_as_uint(f); return (u + 0x7fffu + ((u >> 16) & 1u)) >> 16; }
__device__ __forceinline__ unsigned pk2(float lo, float hi) { return f2bf(lo) | (f2bf(hi) << 16); }
__device__ __forceinline__ float wave_sum(float v) {
#pragma unroll
    for (int o = 1; o < 64; o <<= 1) v += __shfl_xor(v, o);
    return v;
}
__device__ __forceinline__ float wave_max(float v) {
#pragma unroll
    for (int o = 1; o < 64; o <<= 1) v = fmaxf(v, __shfl_xor(v, o));
    return v;
}
__device__ __forceinline__ float sigmoidf_(float x) { return 1.0f / (1.0f + __expf(-x)); }
__device__ __forceinline__ float logsigmoidf_(float z) { return z < 0.f ? z - log1pf(__expf(z)) : -log1pf(__expf(-z)); }
__device__ __forceinline__ u32x4 pack8(f32x4 a, f32x4 b) { u32x4 w; w.x = pk2(a[0], a[1]); w.y = pk2(a[2], a[3]); w.z = pk2(b[0], b[1]); w.w = pk2(b[2], b[3]); return w; }
__device__ __forceinline__ void unpack8(u32x4 w, f32x4& a, f32x4& b) {
    a[0] = __uint_as_float(w.x << 16); a[1] = __uint_as_float(w.x & 0xffff0000u); a[2] = __uint_as_float(w.y << 16); a[3] = __uint_as_float(w.y & 0xffff0000u);
    b[0] = __uint_as_float(w.z << 16); b[1] = __uint_as_float(w.z & 0xffff0000u); b[2] = __uint_as_float(w.w << 16); b[3] = __uint_as_float(w.w & 0xffff0000u);
}
__device__ __forceinline__ int ld_agent_i(const int* p) { return (int)__hip_atomic_load((const unsigned*)p, RLX_AGENT); }

#define XB_TMO      128
#define XB_XCNT(j)  (256  + 64 * (j))
#define XB_XSUB(j)  (1280 + 64 * (j))
#define XB_XGEN(j)  (2304 + 64 * (j))
#define XB_TOP      3328
#define XB_TOPGEN   3392
#define XCD_BAR_WORDS 3456
#define XB_SPIN_CAP (1u << 22)
__device__ __forceinline__ unsigned xb_ld(unsigned* p)              { return __hip_atomic_load(p, __ATOMIC_RELAXED, __HIP_MEMORY_SCOPE_AGENT); }
__device__ __forceinline__ unsigned xb_add(unsigned* p, unsigned v) { return __hip_atomic_fetch_add(p, v, __ATOMIC_RELAXED, __HIP_MEMORY_SCOPE_AGENT); }
__device__ __forceinline__ unsigned xb_xcc_id() { return (unsigned)__builtin_amdgcn_s_getreg((3 << 11) | 20) & 0xFu; }
#define XB_SPIN(cond, bar) do { unsigned _sp = 0; while (cond) { __builtin_amdgcn_s_sleep(1); \
    if ((++_sp & 255u) == 0u) { if (xb_ld(&(bar)[XB_TMO])) break; if (_sp > XB_SPIN_CAP) { atomicAdd(&(bar)[XB_TMO], 1u); break; } } } } while (0)
struct XcdBarrier { unsigned* bar; unsigned x; volatile LAS unsigned* st; };
__device__ __forceinline__ XcdBarrier xcd_barrier_post(unsigned* bar, volatile LAS unsigned* st) {
    XcdBarrier b; b.bar = bar; b.x = xb_xcc_id(); b.st = st;
    if (threadIdx.x == 0) (void)xb_add(&bar[XB_XCNT(b.x)], 1u);
    return b;
}
__device__ __forceinline__ void xcd_barrier_complete(unsigned* bar, unsigned x, unsigned& nloc, unsigned& nx) {
    const unsigned G = gridDim.x * gridDim.y * gridDim.z;
    unsigned sum, cnt, mine, sp = 0u;
    for (;;) {
        sum = 0u; cnt = 0u; mine = 0u;
#pragma unroll
        for (unsigned j = 0; j < 16; ++j) { const unsigned c = xb_ld(&bar[XB_XCNT(j)]); sum += c; cnt += (c > 0u) ? 1u : 0u; mine = (j == x) ? c : mine; }
        if (sum == G) break;
        __builtin_amdgcn_s_sleep(1);
        if ((++sp & 255u) == 0u) { if (xb_ld(&bar[XB_TMO])) break; if (sp > XB_SPIN_CAP) { atomicAdd(&bar[XB_TMO], 1u); break; } }
    }
    nloc = mine > 0u ? mine : 1u; nx = cnt > 0u ? cnt : 1u;
}
__device__ __forceinline__ void xcd_barrier(const XcdBarrier& b) {
    asm volatile("s_waitcnt vmcnt(0)" ::: "memory");
    __syncthreads();
    if (threadIdx.x == 0) {
        unsigned* bar = b.bar;
        __builtin_amdgcn_s_waitcnt(0);
        unsigned nloc = b.st[0], nx = b.st[1];
        if (nloc == 0u) { xcd_barrier_complete(bar, b.x, nloc, nx); b.st[0] = nloc; b.st[1] = nx; }
        const unsigned old = xb_add(&bar[XB_XSUB(b.x)], 1u);
        const unsigned gen = old / nloc;
        if (old + 1u == (gen + 1u) * nloc) {
            __builtin_amdgcn_fence(__ATOMIC_RELEASE, "agent");
            asm volatile("s_waitcnt vmcnt(0)" ::: "memory");
            const unsigned og = xb_add(&bar[XB_TOP], 1u);
            const unsigned tg = og / nx;
            if (og + 1u == (tg + 1u) * nx) xb_add(&bar[XB_TOPGEN], 1u);
            else XB_SPIN(xb_ld(&bar[XB_TOPGEN]) == tg, bar);
            __builtin_amdgcn_fence(__ATOMIC_ACQUIRE, "agent");
            xb_add(&bar[XB_XGEN(b.x)], 1u);
            asm volatile("s_waitcnt vmcnt(0)" ::: "memory");
        } else {
            XB_SPIN(xb_ld(&bar[XB_XGEN(b.x)]) == gen, bar);
            __builtin_amdgcn_fence(__ATOMIC_ACQUIRE, "agent");
            asm volatile("s_waitcnt vmcnt(0)" ::: "memory");
        }
    }
    __syncthreads();
}

struct Args { const float* in[26]; float* out; unsigned char* ws; int ph_lo, ph_hi; };
struct Frame {
    LAS unsigned char* lds; unsigned char* ws; unsigned* ctl;
    int tid, lane, wave, G, bid;
    const float* const* in;
    float* out;
};
#define WSP(type, off) ((type*)(F.ws + (off)))
enum { I_X = 0, I_MEM, I_NMIXG, I_WIN, I_GGW, I_GGB, I_GNG, I_GOW, I_CW, I_CBIAS, I_COW, I_MXW, I_NXG, I_NMG, I_XQ, I_XK, I_XV, I_XO, I_NMOEG, I_RW, I_RB, I_GUW, I_GUB, I_DNW, I_DNB, I_NFG };

constexpr int BM = 256, BK = 64, HALF = 128, HTB = HALF * BK * 2, NXCD = 8, WGM = 8;
__device__ __forceinline__ int lds_byte(int r, int c) { const int st = (r >> 4) * 2 + (c >> 5), rr = r & 15, cc = c & 31, ob = rr * 64 + cc * 2; return st * 1024 + (ob ^ (((ob >> 9) & 1) << 5)); }
__device__ __forceinline__ void stage_rc(int b, int& R, int& C) { const int st = b / 1024, sb = b % 1024, swz = sb ^ (((sb >> 9) & 1) << 5); R = (st >> 1) * 16 + swz / 64; C = (st & 1) * 32 + (swz % 64) / 2; }
__device__ __forceinline__ int perm32(int rho) { const int n = rho >> 4, i = rho & 15; return 8 * (i >> 2) + 4 * n + (i & 3); }

struct Unit { int pm, pn, e; };
__device__ __forceinline__ bool static_next(int i, int G, int c, int nM, int nN, Unit& u) {
    const int nwg = nM * nN; const long L = (long)i * G + c; if (L >= nwg) return false;
    int wgid = (int)L; { const int q = nwg / NXCD, r = nwg % NXCD, xcd = wgid % NXCD, off = wgid / NXCD; wgid = (xcd < r ? xcd * (q + 1) : r * (q + 1) + (xcd - r) * q) + off; }
    const int nig = WGM * nN, gid = wgid / nig, fm = gid * WGM, gsz = (nM - fm) < WGM ? (nM - fm) : WGM;
    u.pm = fm + ((wgid % nig) % gsz); u.pn = (wgid % nig) / gsz; u.e = 0; return true;
}
struct DenseSched {
    const char* A; const char* Bt; int K, nM, nN, G, c;
    __device__ __forceinline__ void init(const void* A_, const void* Bt_, int M, int N, int K_, int G_, int c_) { A = (const char*)A_; Bt = (const char*)Bt_; K = K_; nM = M / BM; nN = N / BM; G = G_; c = c_; }
    __device__ __forceinline__ bool next(int i, Unit& u) const { return static_next(i, G, c, nM, nN, u); }
    __device__ __forceinline__ const char* a_base() const { return A; }
    __device__ __forceinline__ const char* b_base(const Unit& u) const { return Bt + (size_t)u.pn * BM * K * 2; }
    __device__ __forceinline__ unsigned a_src_row(const Unit& u, int r) const { return (unsigned)(u.pm * BM + r); }
};
struct GroupSched {
    const char* A; const char* Bt; int K, N, nM, nN, G, c; const int* tile_e; const int* row_tok;
    __device__ __forceinline__ void init(const void* A_, const void* Bt_, int ntiles, int N_, int K_, int G_, int c_, const int* te, const int* rt) { A = (const char*)A_; Bt = (const char*)Bt_; K = K_; N = N_; nM = ntiles; nN = N_ / BM; G = G_; c = c_; tile_e = te; row_tok = rt; }
    __device__ __forceinline__ bool next(int i, Unit& u) const { if (!static_next(i, G, c, nM, nN, u)) return false; u.e = __builtin_amdgcn_readfirstlane(ld_agent_i(tile_e + u.pm)); return true; }
    __device__ __forceinline__ const char* a_base() const { return A; }
    __device__ __forceinline__ const char* b_base(const Unit& u) const { return Bt + ((size_t)u.e * N + (size_t)u.pn * BM) * K * 2; }
    __device__ __forceinline__ unsigned a_src_row(const Unit& u, int r) const { return row_tok ? (unsigned)ld_agent_i(row_tok + u.pm * BM + r) : (unsigned)(u.pm * BM + r); }
};

template <class Epi, class Sched>
__device__ __forceinline__ void gemm_ref(LAS unsigned char* lds, const Sched& S, const Epi& E) {
    const int tid = threadIdx.x, tx = tid & 15, ty = tid >> 4, K = S.K;
    LAS float* As = (LAS float*)lds; LAS float* Bs = As + 16 * 260;
    const int lr = tid >> 1, kh = tid & 1;
    for (int i = 0;; ++i) {
        Unit u; if (!S.next(i, u)) break;
        float acc[8][16];
#pragma unroll
        for (int j = 0; j < 8; ++j)
#pragma unroll
            for (int q = 0; q < 16; ++q) acc[j][q] = 0.f;
        const char* Ab = S.a_base() + ((size_t)S.a_src_row(u, lr) * K + 8 * kh) * 2;
        const char* Bb = S.b_base(u) + ((size_t)lr * K + 8 * kh) * 2;
        for (int k0 = 0; k0 < K; k0 += 16) {
            const bf16x8 av = *(const bf16x8*)(Ab + (size_t)k0 * 2), bv = *(const bf16x8*)(Bb + (size_t)k0 * 2);
            __syncthreads();
#pragma unroll
            for (int j = 0; j < 8; ++j) { As[(8 * kh + j) * 260 + lr] = bf2f((unsigned short)av[j]); Bs[(8 * kh + j) * 260 + lr] = bf2f((unsigned short)bv[j]); }
            __syncthreads();
#pragma unroll 4
            for (int kk = 0; kk < 16; ++kk) {
                float a[8], b[16];
#pragma unroll
                for (int j = 0; j < 8; ++j) a[j] = As[kk * 260 + ty + 32 * j];
                const f32x4 b0 = *(const LAS f32x4*)(Bs + kk * 260 + 8 * tx), b1 = *(const LAS f32x4*)(Bs + kk * 260 + 8 * tx + 4);
                const f32x4 b2 = *(const LAS f32x4*)(Bs + kk * 260 + 128 + 8 * tx), b3 = *(const LAS f32x4*)(Bs + kk * 260 + 128 + 8 * tx + 4);
#pragma unroll
                for (int q = 0; q < 4; ++q) { b[q] = b0[q]; b[4 + q] = b1[q]; b[8 + q] = b2[q]; b[12 + q] = b3[q]; }
#pragma unroll
                for (int j = 0; j < 8; ++j)
#pragma unroll
                    for (int q = 0; q < 16; ++q) acc[j][q] += a[j] * b[q];
            }
        }
#pragma unroll 8
        for (int j = 0; j < 8; ++j) {
            const f32x4 a0 = {acc[j][0], acc[j][1], acc[j][2], acc[j][3]}, a1 = {acc[j][4], acc[j][5], acc[j][6], acc[j][7]};
            const f32x4 b0 = {acc[j][8], acc[j][9], acc[j][10], acc[j][11]}, b1 = {acc[j][12], acc[j][13], acc[j][14], acc[j][15]};
            E.template row8<false>(u.pm * BM + ty + 32 * j, u, 8 * tx, a0, a1, b0, b1);
        }
    }
    __syncthreads();
}

template <class Epi, class Sched>
__device__ __forceinline__ void gemm_mfma(LAS unsigned char* lds, const Sched& S, const Epi& E) {
    const int tid = threadIdx.x, wid = __builtin_amdgcn_readfirstlane(tid >> 6), lane = tid & 63, wr = wid >> 2, wc = wid & 3, fr = lane & 15, fq = lane >> 4;
    const int K = S.K, nt = K / BK;
    int Rr[2], Cc[2]; unsigned voffB[2];
#pragma unroll
    for (int i = 0; i < 2; ++i) { stage_rc(tid * 16 + i * 8192, Rr[i], Cc[i]); const int Rb = (Rr[i] & ~31) + perm32(Rr[i] & 31); voffB[i] = (unsigned)(Rb * K + Cc[i]) * 2u; }
    const size_t kstep = (size_t)(BK * 2);
    const size_t hstep = (size_t)HALF * K * 2;
    const unsigned ldsw = (unsigned)wid * 1024u;
    const int aoff = lds_byte(wr * 64 + fr, fq * 8), boff = lds_byte(wc * 32 + fr, fq * 8);
#define PG8_SA(b, h) (((b) * 2 + (h)) * HTB)
#define PG8_SB(b, h) ((4 + (b) * 2 + (h)) * HTB)
#define PG8_STAGE(bufoff, gbase, voff) do { _Pragma("unroll") for (int _i = 0; _i < 2; ++_i) \
        __builtin_amdgcn_global_load_lds((const unsigned*)((const char*)(gbase) + (voff)[_i]), (LAS unsigned*)(lds + (bufoff) + ldsw + _i * 8192), 16, 0, 0); } while (0)
#define PG8_LDA(dst, b, h) do { _Pragma("unroll") for (int m = 0; m < 4; ++m) _Pragma("unroll") for (int k = 0; k < 2; ++k) dst[m][k] = *(const LAS bf16x8*)(lds + PG8_SA(b, h) + aoff + m * 2048 + k * 1024); } while (0)
#define PG8_LDB(dst, b, h) do { _Pragma("unroll") for (int n = 0; n < 2; ++n) _Pragma("unroll") for (int k = 0; k < 2; ++k) dst[n][k] = *(const LAS bf16x8*)(lds + PG8_SB(b, h) + boff + n * 2048 + k * 1024); } while (0)
#define PG8_MMA(ai, bj, At, Bt) do { __builtin_amdgcn_s_setprio(1); _Pragma("unroll") for (int m = 0; m < 4; ++m) _Pragma("unroll") for (int n = 0; n < 2; ++n) _Pragma("unroll") for (int k = 0; k < 2; ++k) \
        acc[ai][bj][m][n] = __builtin_amdgcn_mfma_f32_16x16x32_bf16(Bt[n][k], At[m][k], acc[ai][bj][m][n], 0, 0, 0); __builtin_amdgcn_s_setprio(0); } while (0)
#define PG8_WAIT_V(n) asm volatile("s_waitcnt vmcnt(" #n ")" ::: "memory")
#define PG8_WAIT_L(n) asm volatile("s_waitcnt lgkmcnt(" #n ")" ::: "memory")
#define PG8_BAR __builtin_amdgcn_s_barrier()
#define PG8_SCHED __builtin_amdgcn_sched_barrier(0)
#define PG8_AOFF(dst, uu) do { _Pragma("unroll") for (int _h = 0; _h < 2; ++_h) _Pragma("unroll") for (int _i = 0; _i < 2; ++_i) dst[_h][_i] = (S.a_src_row(uu, _h * HALF + Rr[_i]) * (unsigned)K + (unsigned)Cc[_i]) * 2u; } while (0)
    Unit cur, nxt; int ui = 0;
    if (!S.next(0, cur)) return;
    f32x4 acc[2][2][4][2];
#pragma unroll
    for (int a = 0; a < 2; ++a)
#pragma unroll
        for (int b = 0; b < 2; ++b)
#pragma unroll
            for (int m = 0; m < 4; ++m)
#pragma unroll
                for (int n = 0; n < 2; ++n) acc[a][b][m][n] = (f32x4){0.f, 0.f, 0.f, 0.f};
    bf16x8 At[4][2], B0[2][2], B1[2][2];
    unsigned coff[2][2], noff[2][2];
    PG8_AOFF(coff, cur);
    const char* cA = S.a_base(); const char* cB = S.b_base(cur);
    PG8_STAGE(PG8_SB(0, 0), cB, voffB); PG8_STAGE(PG8_SB(0, 1), cB + hstep, voffB); PG8_STAGE(PG8_SA(0, 0), cA, coff[0]); PG8_STAGE(PG8_SA(0, 1), cA, coff[1]);
    if (wr == 1) PG8_BAR;
    PG8_WAIT_V(2); PG8_BAR;
    PG8_STAGE(PG8_SB(1, 0), cB + kstep, voffB); PG8_STAGE(PG8_SA(1, 0), cA + kstep, coff[0]); PG8_STAGE(PG8_SB(1, 1), cB + hstep + kstep, voffB);
    PG8_WAIT_V(6); PG8_BAR;
    for (;;) {
        const bool has_next = S.next(ui + 1, nxt);
        const char* nB = cB;
#pragma unroll
        for (int _h = 0; _h < 2; ++_h)
#pragma unroll
            for (int _i = 0; _i < 2; ++_i) noff[_h][_i] = coff[_h][_i];
        if (has_next) { nB = S.b_base(nxt); PG8_AOFF(noff, nxt); }
        for (int t = 0; t < nt; t += 2) {
            const bool last = (t == nt - 2);
            const char* a1 = cA + (size_t)(t + 1) * kstep;
            const char* a2 = last ? cA : cA + (size_t)(t + 2) * kstep; const char* b2 = last ? nB : cB + (size_t)(t + 2) * kstep;
            const char* a3 = a2 + kstep; const char* b3 = b2 + kstep;
            unsigned o2[2][2];
#pragma unroll
            for (int _h = 0; _h < 2; ++_h)
#pragma unroll
                for (int _i = 0; _i < 2; ++_i) o2[_h][_i] = last ? noff[_h][_i] : coff[_h][_i];
            PG8_LDB(B0, 0, 0); PG8_LDB(B1, 0, 1); PG8_SCHED; PG8_LDA(At, 0, 0); PG8_STAGE(PG8_SA(1, 1), a1, coff[1]);
            PG8_WAIT_V(8); PG8_WAIT_L(0); PG8_BAR; PG8_MMA(0, 0, At, B0); PG8_MMA(0, 1, At, B1); PG8_BAR; PG8_SCHED;
            PG8_LDA(At, 0, 1); PG8_STAGE(PG8_SB(0, 0), b2, voffB); PG8_STAGE(PG8_SB(0, 1), b2 + hstep, voffB); PG8_STAGE(PG8_SA(0, 0), a2, o2[0]);
            PG8_WAIT_V(8); PG8_WAIT_L(0); PG8_BAR; PG8_MMA(1, 0, At, B0); PG8_MMA(1, 1, At, B1); PG8_BAR; PG8_SCHED;
            PG8_LDB(B0, 1, 0); PG8_LDB(B1, 1, 1); PG8_SCHED; PG8_LDA(At, 1, 0); PG8_STAGE(PG8_SA(0, 1), a2, o2[1]);
            PG8_WAIT_V(8); PG8_WAIT_L(0); PG8_BAR; PG8_MMA(0, 0, At, B0); PG8_MMA(0, 1, At, B1); PG8_BAR; PG8_SCHED;
            PG8_LDA(At, 1, 1); PG8_STAGE(PG8_SB(1, 0), b3, voffB); PG8_STAGE(PG8_SB(1, 1), b3 + hstep, voffB); PG8_STAGE(PG8_SA(1, 0), a3, o2[0]);
            PG8_WAIT_V(8); PG8_WAIT_L(0); PG8_BAR; PG8_MMA(1, 0, At, B0); PG8_MMA(1, 1, At, B1); PG8_BAR; PG8_SCHED;
        }
        if (wr == 0) PG8_BAR;
#pragma unroll 2
        for (int ai = 0; ai < 2; ++ai)
#pragma unroll 4
            for (int m = 0; m < 4; ++m)
                E.template row8<true>(cur.pm * BM + ai * HALF + wr * 64 + m * 16 + fr, cur, wc * 32 + 8 * fq, acc[ai][0][m][0], acc[ai][0][m][1], acc[ai][1][m][0], acc[ai][1][m][1]);
        if (!has_next) break;
#pragma unroll
        for (int a = 0; a < 2; ++a)
#pragma unroll
            for (int b = 0; b < 2; ++b)
#pragma unroll
                for (int m = 0; m < 4; ++m)
#pragma unroll
                    for (int n = 0; n < 2; ++n) acc[a][b][m][n] = (f32x4){0.f, 0.f, 0.f, 0.f};
        cur = nxt; cB = nB;
#pragma unroll
        for (int _h = 0; _h < 2; ++_h)
#pragma unroll
            for (int _i = 0; _i < 2; ++_i) coff[_h][_i] = noff[_h][_i];
        ++ui;
        if (wr == 1) PG8_BAR;
    }
    PG8_WAIT_V(0);
    PG8_BAR;
#undef PG8_SA
#undef PG8_SB
#undef PG8_STAGE
#undef PG8_LDA
#undef PG8_LDB
#undef PG8_MMA
#undef PG8_WAIT_V
#undef PG8_WAIT_L
#undef PG8_BAR
#undef PG8_SCHED
#undef PG8_AOFF
}
template <class Epi, class Sched>
__device__ __forceinline__ void gemm_any(LAS unsigned char* lds, const Sched& S, const Epi& E) {
#if OPT_GEMM
    gemm_mfma<Epi, Sched>(lds, S, E);
#else
    gemm_ref<Epi, Sched>(lds, S, E);
#endif
}

__device__ __forceinline__ void st_bf8(bf16* p, f32x4 a, f32x4 b) { *(u32x4*)p = pack8(a, b); }
__device__ __forceinline__ void ld_bf8(const bf16* p, f32x4& a, f32x4& b) { unpack8(*(const u32x4*)p, a, b); }

struct EpiInProj {
    bf16 *Q, *Kk, *V, *SR, *CB, *U, *SGA, *SGB; float* LA; const float* gate_b;
    template <bool MF> __device__ __forceinline__ void row8(int row, const Unit& u, int c0, f32x4 a0, f32x4 a1, f32x4 b0, f32x4 b1) const {
        const int pn = u.pn;
        if (pn >= TN_LA && pn < TN_CB) {
            const int col = (pn - TN_LA) * 256 + c0; float* p = LA + (size_t)row * QK + col; const float* gb = gate_b + col;
            const f32x4 g0 = *(const f32x4*)gb, g1 = *(const f32x4*)(gb + 4), g2 = *(const f32x4*)(gb + 128), g3 = *(const f32x4*)(gb + 132);
#pragma unroll
            for (int j = 0; j < 4; ++j) { a0[j] = logsigmoidf_(a0[j] + g0[j]) * 0.0625f; a1[j] = logsigmoidf_(a1[j] + g1[j]) * 0.0625f; b0[j] = logsigmoidf_(b0[j] + g2[j]) * 0.0625f; b1[j] = logsigmoidf_(b1[j] + g3[j]) * 0.0625f; }
            *(f32x4*)p = a0; *(f32x4*)(p + 4) = a1; *(f32x4*)(p + 128) = b0; *(f32x4*)(p + 132) = b1; return; }
        if (pn >= TN_U && pn < TN_GA) { st_bf8(U + (size_t)row * D + (pn - TN_U) * 128 + c0, a0 * b0, a1 * b1); return; }
        bf16* base; int ld, ct, mode = 0; float sc = 1.0f;
        if (pn < TN_K) { base = Q; ld = QK; ct = pn - TN_Q; sc = 0.0625f; }
        else if (pn < TN_V) { base = Kk; ld = QK; ct = pn - TN_K; }
        else if (pn < TN_R) { base = V; ld = VD; ct = pn - TN_V; }
        else if (pn < TN_LA) { base = SR; ld = VD; ct = pn - TN_R; mode = 1; }
        else if (pn < TN_U) { base = CB; ld = D; ct = pn - TN_CB; }
        else if (pn < TN_GB) { base = SGA; ld = D; ct = pn - TN_GA; mode = 2; }
        else { base = SGB; ld = D; ct = pn - TN_GB; mode = 2; }
        if (mode) {
#pragma unroll
            for (int j = 0; j < 4; ++j) { const float s0 = sigmoidf_(a0[j]), s1 = sigmoidf_(a1[j]), s2 = sigmoidf_(b0[j]), s3 = sigmoidf_(b1[j]);
                a0[j] = (mode == 1) ? a0[j] * s0 : s0; a1[j] = (mode == 1) ? a1[j] * s1 : s1; b0[j] = (mode == 1) ? b0[j] * s2 : s2; b1[j] = (mode == 1) ? b1[j] * s3 : s3; }
        } else { a0 *= sc; a1 *= sc; b0 *= sc; b1 *= sc; }
        bf16* p = base + (size_t)row * ld + ct * 256 + c0; st_bf8(p, a0, a1); st_bf8(p + 128, b0, b1);
    }
};
struct EpiGateA {
    float* T1; const bf16* SGA;
    template <bool MF> __device__ __forceinline__ void row8(int row, const Unit& u, int c0, f32x4 a0, f32x4 a1, f32x4 b0, f32x4 b1) const {
        const size_t o = (size_t)row * D + u.pn * 256 + c0; f32x4 g0, g1, g2, g3; ld_bf8(SGA + o, g0, g1); ld_bf8(SGA + o + 128, g2, g3);
        *(f32x4*)(T1 + o) = a0 * g0; *(f32x4*)(T1 + o + 4) = a1 * g1; *(f32x4*)(T1 + o + 128) = b0 * g2; *(f32x4*)(T1 + o + 132) = b1 * g3;
    }
};
struct EpiGateB {
    const float* T1; const bf16* SGB; bf16* MG;
    template <bool MF> __device__ __forceinline__ void row8(int row, const Unit& u, int c0, f32x4 a0, f32x4 a1, f32x4 b0, f32x4 b1) const {
        const size_t o = (size_t)row * D + u.pn * 256 + c0; f32x4 g0, g1, g2, g3; ld_bf8(SGB + o, g0, g1); ld_bf8(SGB + o + 128, g2, g3);
        const f32x4 t0 = *(const f32x4*)(T1 + o), t1 = *(const f32x4*)(T1 + o + 4), t2 = *(const f32x4*)(T1 + o + 128), t3 = *(const f32x4*)(T1 + o + 132);
        st_bf8(MG + o, t0 + a0 * g0, t1 + a1 * g1); st_bf8(MG + o + 128, t2 + b0 * g2, t3 + b1 * g3);
    }
};
struct EpiResid1 {
    const float* X; float* X1; bf16* X1B; float* SS1;
    template <bool MF> __device__ __forceinline__ void row8(int row, const Unit& u, int c0, f32x4 a0, f32x4 a1, f32x4 b0, f32x4 b1) const {
        const size_t o = (size_t)row * D + u.pn * 256 + c0;
        a0 += *(const f32x4*)(X + o); a1 += *(const f32x4*)(X + o + 4); b0 += *(const f32x4*)(X + o + 128); b1 += *(const f32x4*)(X + o + 132);
        *(f32x4*)(X1 + o) = a0; *(f32x4*)(X1 + o + 4) = a1; *(f32x4*)(X1 + o + 128) = b0; *(f32x4*)(X1 + o + 132) = b1;
        st_bf8(X1B + o, a0, a1); st_bf8(X1B + o + 128, b0, b1);
        float s = 0.f;
#pragma unroll
        for (int j = 0; j < 4; ++j) s += a0[j] * a0[j] + a1[j] * a1[j] + b0[j] * b0[j] + b1[j] * b1[j];
        if (MF) { s += __shfl_xor(s, 16); s += __shfl_xor(s, 32); if ((threadIdx.x & 63) < 16) atomicAdd(SS1 + row, s); }
        else atomicAdd(SS1 + row, s);
    }
};
struct EpiXQ {
    bf16* QX; const float* SS1;
    template <bool MF> __device__ __forceinline__ void row8(int row, const Unit& u, int c0, f32x4 a0, f32x4 a1, f32x4 b0, f32x4 b1) const {
        const float r = rsqrtf(SS1[row] * (1.0f / D) + EPS); bf16* p = QX + (size_t)row * XA + u.pn * 256 + c0;
        st_bf8(p, a0 * r, a1 * r); st_bf8(p + 128, b0 * r, b1 * r);
    }
};
struct EpiResid2 {
    float* X1;
    template <bool MF> __device__ __forceinline__ void row8(int row, const Unit& u, int c0, f32x4 a0, f32x4 a1, f32x4 b0, f32x4 b1) const {
        float* p = X1 + (size_t)row * D + u.pn * 256 + c0;
        *(f32x4*)p = *(const f32x4*)p + a0; *(f32x4*)(p + 4) = *(const f32x4*)(p + 4) + a1; *(f32x4*)(p + 128) = *(const f32x4*)(p + 128) + b0; *(f32x4*)(p + 132) = *(const f32x4*)(p + 132) + b1;
    }
};
struct EpiGU {
    bf16* ACT; const float* gub;
    template <bool MF> __device__ __forceinline__ void row8(int row, const Unit& u, int c0, f32x4 a0, f32x4 a1, f32x4 b0, f32x4 b1) const {
        const int f = u.pn * 128 + c0; const float* bg = gub + (size_t)u.e * (2 * FF) + f;
        const f32x4 g0 = *(const f32x4*)bg, g1 = *(const f32x4*)(bg + 4), u0 = *(const f32x4*)(bg + FF), u1 = *(const f32x4*)(bg + FF + 4);
        f32x4 r0, r1;
#pragma unroll
        for (int j = 0; j < 4; ++j) {
            float g = fminf(a0[j] + g0[j], 7.0f), up = fminf(fmaxf(b0[j] + u0[j], -7.0f), 7.0f); r0[j] = (up + 1.0f) * g * sigmoidf_(1.702f * g);
            g = fminf(a1[j] + g1[j], 7.0f); up = fminf(fmaxf(b1[j] + u1[j], -7.0f), 7.0f); r1[j] = (up + 1.0f) * g * sigmoidf_(1.702f * g);
        }
        st_bf8(ACT + (size_t)row * FF + f, r0, r1);
    }
};
struct EpiDown {
    bf16* YS; const float* dnb;
    template <bool MF> __device__ __forceinline__ void row8(int row, const Unit& u, int c0, f32x4 a0, f32x4 a1, f32x4 b0, f32x4 b1) const {
        const int col = u.pn * 256 + c0; const float* bb = dnb + (size_t)u.e * D + col; bf16* p = YS + (size_t)row * D + col;
        st_bf8(p, a0 + *(const f32x4*)bb, a1 + *(const f32x4*)(bb + 4)); st_bf8(p + 128, b0 + *(const f32x4*)(bb + 128), b1 + *(const f32x4*)(bb + 132));
    }
};

__device__ __forceinline__ void tr_item(const float* W, int ldw, int K, int srccol0, bf16* WT, int dstrow0, const float* ksc, LAS float* scr, int kb, int lane) {
    const int k0 = 64 * kb;
#pragma unroll 8
    for (int i = 0; i < 32; ++i) { const int kk = 2 * i + (lane >> 5); float v = W[(size_t)(k0 + kk) * ldw + srccol0 + (lane & 31)]; if (ksc) v *= ksc[k0 + kk]; scr[kk * 33 + (lane & 31)] = v; }
    LDS_WAIT(); asm volatile("" ::: "memory");
    const int c = lane & 7;
#pragma unroll
    for (int j = 0; j < 4; ++j) { const int n = (lane >> 3) + 8 * j; const LAS float* s = scr + (8 * c) * 33 + n;
        u32x4 o; o.x = pk2(s[0 * 33], s[1 * 33]); o.y = pk2(s[2 * 33], s[3 * 33]); o.z = pk2(s[4 * 33], s[5 * 33]); o.w = pk2(s[6 * 33], s[7 * 33]);
        *(u32x4*)(WT + (size_t)(dstrow0 + n) * K + k0 + 8 * c) = o; }
    LDS_WAIT(); asm volatile("" ::: "memory");
}
__device__ __forceinline__ void fold_item(const float* Win, const float* GW, bf16* WT, int n0, LAS float* scr, int kb, int lane) {
    const int k0 = 64 * kb, nn = lane & 31;
    float gw[16];
#pragma unroll
    for (int r = 0; r < 16; ++r) gw[r] = GW[r * QK + n0 + nn];
#pragma unroll 4
    for (int i = 0; i < 32; ++i) { const int kk = 2 * i + (lane >> 5); const float* wr = Win + (size_t)(k0 + kk) * NIN_SRC + SRC_ALOW; float v = 0.f;
#pragma unroll
        for (int r = 0; r < 16; ++r) v += wr[r] * gw[r];
        scr[kk * 33 + nn] = v; }
    LDS_WAIT(); asm volatile("" ::: "memory");
    const int c = lane & 7;
#pragma unroll
    for (int j = 0; j < 4; ++j) { const int n = (lane >> 3) + 8 * j; const LAS float* s = scr + (8 * c) * 33 + n;
        u32x4 o; o.x = pk2(s[0 * 33], s[1 * 33]); o.y = pk2(s[2 * 33], s[3 * 33]); o.z = pk2(s[4 * 33], s[5 * 33]); o.w = pk2(s[6 * 33], s[7 * 33]);
        *(u32x4*)(WT + (size_t)(TN_LA * 256 + n0 + n) * D + k0 + 8 * c) = o; }
    LDS_WAIT(); asm volatile("" ::: "memory");
}
__device__ __forceinline__ void rms_row_to_bf16(const float* xrow, const float* g, bf16* orow, int lane) {
    f32x4 v[8]; float s = 0.f;
#pragma unroll
    for (int j = 0; j < 8; ++j) { v[j] = *(const f32x4*)(xrow + 4 * lane + 256 * j); s += (v[j][0] * v[j][0] + v[j][1] * v[j][1]) + (v[j][2] * v[j][2] + v[j][3] * v[j][3]); }
    const float r = rsqrtf(wave_sum(s) * (1.0f / D) + EPS);
#pragma unroll
    for (int j = 0; j < 8; ++j) { const f32x4 gg = *(const f32x4*)(g + 4 * lane + 256 * j); u32x2 o; o.x = pk2(v[j][0] * r * gg[0], v[j][1] * r * gg[1]); o.y = pk2(v[j][2] * r * gg[2], v[j][3] * r * gg[3]); *(u32x2*)(orow + 4 * lane + 256 * j) = o; }
}
__device__ __forceinline__ void p0_prologue(Frame& F) {
    LAS float* scr = (LAS float*)(F.lds + F.wave * 16384);
    const int gw = F.bid * NWAVES + F.wave, NGW = F.G * NWAVES, lane = F.lane;
    const float* Win = F.in[I_WIN];
    bf16* WIN = WSP(bf16, WS_WIN);
    for (int it = gw; it < 544 * 32; it += NGW) {
        const int nb = it % 544, kb = it / 544, n0 = 32 * nb;
        if (n0 >= TN_LA * 256 && n0 < TN_CB * 256) { fold_item(Win, F.in[I_GGW], WIN, n0 - TN_LA * 256, scr, kb, lane); continue; }
        int src;
        if (n0 < TN_LA * 256) src = n0;
        else if (n0 < TN_U * 256) src = SRC_CB + (n0 - TN_CB * 256);
        else if (n0 < TN_GA * 256) { const int rel = n0 - TN_U * 256, p = rel >> 8, w = rel & 255; src = (w < 128) ? SRC_CC + 128 * p + w : SRC_CHH + 128 * p + (w - 128); }
        else if (n0 < TN_GB * 256) src = SRC_GA + (n0 - TN_GA * 256);
        else src = SRC_GB + (n0 - TN_GB * 256);
        tr_item(Win, NIN_SRC, D, src, WIN, n0, nullptr, scr, kb, lane);
    }
    for (int it = gw; it < 3 * 2048; it += NGW) { const int w = it / 2048, r = it % 2048, nb = r % 64, kb = r / 64;
        const float* W = F.in[w == 0 ? I_GOW : (w == 1 ? I_COW : I_MXW)]; bf16* WT = WSP(bf16, w == 0 ? WS_WGO : (w == 1 ? WS_WCO : WS_WMX));
        tr_item(W, D, D, 32 * nb, WT, 32 * nb, nullptr, scr, kb, lane); }
    for (int it = gw; it < 3 * 512; it += NGW) { const int w = it / 512, r = it % 512, nb = r % 16, kb = r / 16;
        if (w == 0) tr_item(F.in[I_XQ], XA, D, 32 * nb, WSP(bf16, WS_WXQ), 32 * nb, F.in[I_NXG], scr, kb, lane);
        else tr_item(F.in[w == 1 ? I_XK : I_XV], XA, D, 32 * nb, WSP(bf16, WS_WXKV), (w - 1) * XA + 32 * nb, nullptr, scr, kb, lane); }
    for (int it = gw; it < 512; it += NGW) { const int nb = it % 64, kb = it / 64; tr_item(F.in[I_XO], D, XA, 32 * nb, WSP(bf16, WS_WXO), 32 * nb, nullptr, scr, kb, lane); }
    for (int it = gw; it < NE * 4096; it += NGW) { const int e = it / 4096, r = it % 4096, nb = r % 128, kb = r / 128, n0 = 32 * nb, p = n0 >> 8, w = n0 & 255;
        const int src = (w < 128) ? 128 * p + w : FF + 128 * p + (w - 128);
        tr_item(F.in[I_GUW] + (size_t)e * D * (2 * FF), 2 * FF, D, src, WSP(bf16, WS_WGU) + (size_t)e * (2 * FF) * D, n0, nullptr, scr, kb, lane); }
    for (int it = gw; it < NE * 2048; it += NGW) { const int e = it / 2048, r = it % 2048, nb = r % 64, kb = r / 64;
        tr_item(F.in[I_DNW] + (size_t)e * FF * D, D, FF, 32 * nb, WSP(bf16, WS_WDN) + (size_t)e * D * FF, 32 * nb, nullptr, scr, kb, lane); }
    { const float* rw = F.in[I_RW]; const float* g = F.in[I_NMOEG]; float* WR = WSP(float, WS_WR);
      for (int i = F.bid * NTHR + F.tid; i < NE * D; i += F.G * NTHR) { const int e = i / D, k = i % D; WR[i] = rw[k * NE + e] * g[k]; } }
    for (int m = gw; m < T; m += NGW) rms_row_to_bf16(F.in[I_X] + (size_t)m * D, F.in[I_NMIXG], WSP(bf16, WS_XN) + (size_t)m * D, lane);
    for (int m = gw; m < MEM; m += NGW) rms_row_to_bf16(F.in[I_MEM] + (size_t)m * D, F.in[I_NMG], WSP(bf16, WS_MEMN) + (size_t)m * D, lane);
    { u32x4* z = (u32x4*)(WSP(bf16, WS_H3) + (size_t)T * D); for (int i = F.bid * NTHR + F.tid; i < 256; i += F.G * NTHR) z[i] = (u32x4){0u, 0u, 0u, 0u}; }
}

__device__ __forceinline__ void p_memkv(Frame& F) {
    const bf16* A = WSP(bf16, WS_MEMN); const bf16* B = WSP(bf16, WS_WXKV); bf16* KM = WSP(bf16, WS_KM); bf16* VMT = WSP(bf16, WS_VMT);
    for (int o = F.bid * NTHR + F.tid; o < MEM * 2 * XA; o += F.G * NTHR) {
        const int m = o & 255, n = o >> 8;
        const bf16* a = A + (size_t)m * D; const bf16* b = B + (size_t)n * D; float s = 0.f;
        for (int k = 0; k < D; k += 8) { f32x4 a0, a1, b0, b1; ld_bf8(a + k, a0, a1); ld_bf8(b + k, b0, b1);
#pragma unroll
            for (int j = 0; j < 4; ++j) s += a0[j] * b0[j] + a1[j] * b1[j]; }
        if (n < XA) KM[(size_t)m * XA + n] = (bf16)f2bf(s); else VMT[(size_t)(n - XA) * MEM + m] = (bf16)f2bf(s);
    }
}

__device__ __forceinline__ void p_conv(Frame& F) {
    const bf16* U = WSP(bf16, WS_U); const bf16* CB = WSP(bf16, WS_CB); bf16* Z = WSP(bf16, WS_Z);
    const float* cw = F.in[I_CW]; const float* cb = F.in[I_CBIAS];
    for (int task = F.bid * NTHR + F.tid; task < (T / 64) * (D / 8); task += F.G * NTHR) {
        const int cg = task & 255, tb = task >> 8, c = 8 * cg, t0 = 64 * tb;
        f32x4 w0a = *(const f32x4*)(cw + c), w0b = *(const f32x4*)(cw + c + 4), w1a = *(const f32x4*)(cw + D + c), w1b = *(const f32x4*)(cw + D + c + 4);
        f32x4 w2a = *(const f32x4*)(cw + 2 * D + c), w2b = *(const f32x4*)(cw + 2 * D + c + 4), ba = *(const f32x4*)(cb + c), bb = *(const f32x4*)(cb + c + 4);
        f32x4 p2a = {0.f, 0.f, 0.f, 0.f}, p2b = p2a, p1a = p2a, p1b = p2a;
        if (t0 >= 2) { ld_bf8(U + (size_t)(t0 - 2) * D + c, p2a, p2b); ld_bf8(U + (size_t)(t0 - 1) * D + c, p1a, p1b); }
        for (int t = t0; t < t0 + 64; ++t) {
            f32x4 ua, ub, ca, cbv; ld_bf8(U + (size_t)t * D + c, ua, ub); ld_bf8(CB + (size_t)t * D + c, ca, cbv);
            const f32x4 ya = ca * (w0a * p2a + w1a * p1a + w2a * ua + ba), yb = cbv * (w0b * p2b + w1b * p1b + w2b * ub + bb);
            st_bf8(Z + (size_t)t * D + c, ya, yb);
            p2a = p1a; p2b = p1b; p1a = ua; p1b = ub;
        }
    }
}
__device__ __forceinline__ void p_glaprep(Frame& F) {
    const bf16* Q = WSP(bf16, WS_Q); const bf16* Kk = WSP(bf16, WS_K); const bf16* V = WSP(bf16, WS_V); const float* LA = WSP(float, WS_LA);
    bf16* QT = WSP(bf16, WS_QT); bf16* KH = WSP(bf16, WS_KH); bf16* KHT = WSP(bf16, WS_KHT); bf16* QG = WSP(bf16, WS_QG); bf16* VT = WSP(bf16, WS_VT);
    float* DL = WSP(float, WS_DL); float* DG = WSP(float, WS_DG);
    LAS float* part = (LAS float*)F.lds;
    const int col = F.tid & 63, sub = F.tid >> 6;
    for (int unit = F.bid; unit < NG * 16; unit += F.G) {
        const int g = unit >> 4, cs = unit & 15, gc = cs * 64 + col, h = gc >> 8, kc = gc & 255;
        float carry = 0.f;
        for (int c = 0; c < GC; ++c) {
            const int chunk = g * GC + c, t0 = chunk * CH + 8 * sub;
            float la[8], qv[8], kv[8];
#pragma unroll
            for (int j = 0; j < 8; ++j) { la[j] = LA[(size_t)(t0 + j) * QK + gc]; qv[j] = bf2f(Q[(size_t)(t0 + j) * QK + gc]); kv[j] = bf2f(Kk[(size_t)(t0 + j) * QK + gc]); }
#pragma unroll
            for (int j = 1; j < 8; ++j) la[j] += la[j - 1];
            __syncthreads();
            part[sub * 64 + col] = la[7];
            __syncthreads();
            float off = 0.f, tot = 0.f;
#pragma unroll
            for (int s = 0; s < 8; ++s) { const float p = part[s * 64 + col]; off += (s < sub) ? p : 0.f; tot += p; }
            unsigned kt[4];
#pragma unroll
            for (int j = 0; j < 8; ++j) { const float b = off + la[j], eb = __expf(b), enb = __expf(-b), eg = __expf(carry + b);
                QT[(size_t)(t0 + j) * QK + gc] = (bf16)f2bf(qv[j] * eb); const unsigned khv = f2bf(kv[j] * enb); KH[(size_t)(t0 + j) * QK + gc] = (bf16)khv;
                QG[(size_t)(t0 + j) * QK + gc] = (bf16)f2bf(qv[j] * eg);
                if (j & 1) kt[j >> 1] |= khv << 16; else kt[j >> 1] = khv; }
            *(u32x4*)(KHT + ((size_t)(chunk * GH + h) * DK + kc) * CH + 8 * sub) = (u32x4){kt[0], kt[1], kt[2], kt[3]};
            if (sub == 0) DL[(size_t)chunk * QK + gc] = __expf(tot);
            carry += tot;
        }
        if (sub == 0) DG[(size_t)g * QK + gc] = __expf(carry);
    }
    for (int unit = F.bid; unit < NCH * (VD / 64); unit += F.G) {
        const int chunk = unit >> 5, vs = unit & 31, vc = vs * 64 + col, t0 = chunk * CH + 8 * sub;
        unsigned w[4];
#pragma unroll
        for (int j = 0; j < 8; ++j) { const unsigned x = V[(size_t)(t0 + j) * VD + vc]; if (j & 1) w[j >> 1] |= x << 16; else w[j >> 1] = x; }
        *(u32x4*)(VT + ((size_t)chunk * VD + vc) * CH + 8 * sub) = (u32x4){w[0], w[1], w[2], w[3]};
    }
}

__device__ __forceinline__ void p_gla_ref(Frame& F) {
    const bf16* Q = WSP(bf16, WS_Q); const bf16* Kk = WSP(bf16, WS_K); const bf16* V = WSP(bf16, WS_V); const float* LA = WSP(float, WS_LA); float* O32 = WSP(float, WS_O32);
    LAS float* red = (LAS float*)F.lds;
    const int k = F.tid & 255, vh = F.tid >> 8;
    for (int unit = F.bid; unit < GH * 64; unit += F.G) {
        const int h = unit >> 6, vb = unit & 63, vcol = h * DV + vb * 8 + vh * 4;
        float s0 = 0.f, s1 = 0.f, s2 = 0.f, s3 = 0.f;
        for (int tb = 0; tb < T; tb += 8) {
            LAS float* rb = red + ((tb >> 3) & 1) * 256;
#pragma unroll
            for (int j = 0; j < 8; ++j) {
                const int t = tb + j; const float a = __expf(LA[(size_t)t * QK + h * DK + k]), kk = bf2f(Kk[(size_t)t * QK + h * DK + k]), qq = bf2f(Q[(size_t)t * QK + h * DK + k]);
                const u32x2 vv = *(const u32x2*)(V + (size_t)t * VD + vcol);
                const float v0 = __uint_as_float(vv.x << 16), v1 = __uint_as_float(vv.x & 0xffff0000u), v2 = __uint_as_float(vv.y << 16), v3 = __uint_as_float(vv.y & 0xffff0000u);
                s0 = a * s0 + kk * v0; s1 = a * s1 + kk * v1; s2 = a * s2 + kk * v2; s3 = a * s3 + kk * v3;
                const float p0 = wave_sum(qq * s0), p1 = wave_sum(qq * s1), p2 = wave_sum(qq * s2), p3 = wave_sum(qq * s3);
                if (F.lane == 0) *(LAS f32x4*)(rb + (j * 8 + F.wave) * 4) = (f32x4){p0, p1, p2, p3};
            }
            __syncthreads();
            if (F.tid < 64) { const int j = F.tid >> 3, vhh = (F.tid >> 2) & 1, q = F.tid & 3; float s = 0.f;
#pragma unroll
                for (int w = 0; w < 4; ++w) s += rb[(j * 8 + vhh * 4 + w) * 4 + q];
                O32[(size_t)(tb + j) * VD + h * DV + vb * 8 + vhh * 4 + q] = s; }
        }
        __syncthreads();
    }
}
__device__ __forceinline__ void p_gla_norm_ref(Frame& F) {
    const float* O32 = WSP(float, WS_O32); const bf16* SR = WSP(bf16, WS_SR); bf16* OA = WSP(bf16, WS_OA); const float* g = F.in[I_GNG];
    const int gw = F.bid * NWAVES + F.wave, NGW = F.G * NWAVES;
    for (int it = gw; it < T * GH; it += NGW) {
        const size_t o = (size_t)it * DV + 8 * F.lane;
        const f32x4 a = *(const f32x4*)(O32 + o), b = *(const f32x4*)(O32 + o + 4);
        float s = 0.f;
#pragma unroll
        for (int j = 0; j < 4; ++j) s += a[j] * a[j] + b[j] * b[j];
        const float r = rsqrtf(wave_sum(s) * (1.0f / DV) + EPS);
        f32x4 s0, s1; ld_bf8(SR + o, s0, s1);
        const f32x4 g0 = *(const f32x4*)(g + 8 * F.lane), g1 = *(const f32x4*)(g + 8 * F.lane + 4);
        st_bf8(OA + o, a * r * g0 * s0, b * r * g1 * s1);
    }
}

__device__ __forceinline__ void p_attn_ref(Frame& F) {
    const bf16* QX = WSP(bf16, WS_QX); const bf16* KM = WSP(bf16, WS_KM); const bf16* VMT = WSP(bf16, WS_VMT); bf16* OX = WSP(bf16, WS_OX);
    LAS float* pbuf = (LAS float*)F.lds + F.wave * 256;
    const int gw = F.bid * NWAVES + F.wave, NGW = F.G * NWAVES, lane = F.lane;
    for (int it = gw; it < T * XH; it += NGW) {
        const int t = it >> 2, h = it & 3; const bf16* q = QX + (size_t)t * XA + h * XD;
        float s[4] = {0.f, 0.f, 0.f, 0.f};
        for (int d = 0; d < XD; d += 8) { f32x4 q0, q1; ld_bf8(q + d, q0, q1);
#pragma unroll
            for (int c = 0; c < 4; ++c) { f32x4 k0, k1; ld_bf8(KM + (size_t)(lane + 64 * c) * XA + h * XD + d, k0, k1);
#pragma unroll
                for (int j = 0; j < 4; ++j) s[c] += q0[j] * k0[j] + q1[j] * k1[j]; } }
        const float sc = 0.08838834764831845f;
        float mx = fmaxf(fmaxf(s[0], s[1]), fmaxf(s[2], s[3])) * sc; mx = wave_max(mx);
        float e[4], sum = 0.f;
#pragma unroll
        for (int c = 0; c < 4; ++c) { e[c] = __expf(s[c] * sc - mx); sum += e[c]; }
        sum = wave_sum(sum); const float inv = 1.0f / sum;
#pragma unroll
        for (int c = 0; c < 4; ++c) pbuf[lane + 64 * c] = bf2f((unsigned short)f2bf(e[c] * inv));
        LDS_WAIT(); asm volatile("" ::: "memory");
        float o0 = 0.f, o1 = 0.f; const bf16* v0 = VMT + (size_t)(h * XD + 2 * lane) * MEM; const bf16* v1 = v0 + MEM;
        for (int m = 0; m < MEM; m += 8) { f32x4 a0, a1, b0, b1; ld_bf8(v0 + m, a0, a1); ld_bf8(v1 + m, b0, b1); const f32x4 p0 = *(const LAS f32x4*)(pbuf + m), p1 = *(const LAS f32x4*)(pbuf + m + 4);
#pragma unroll
            for (int j = 0; j < 4; ++j) { o0 += p0[j] * a0[j] + p1[j] * a1[j]; o1 += p0[j] * b0[j] + p1[j] * b1[j]; } }
        *(unsigned*)(OX + (size_t)t * XA + h * XD + 2 * lane) = pk2(o0, o1);
        LDS_WAIT(); asm volatile("" ::: "memory");
    }
}

typedef float f32x16 __attribute__((ext_vector_type(16)));
__device__ __forceinline__ void p_router(Frame& F) {
    const float* X2 = WSP(float, WS_X1); bf16* H3 = WSP(bf16, WS_H3); const float* WR = WSP(float, WS_WR); const float* g = F.in[I_NMOEG]; const float* rb = F.in[I_RB];
    int* TKE = WSP(int, WS_TKE); int* TKP = WSP(int, WS_TKP); float* TKW = WSP(float, WS_TKW); unsigned* cnt = F.ctl + CW_CNT;
    LAS unsigned* lcnt = (LAS unsigned*)F.lds;
    LAS int* le = (LAS int*)(F.lds + 256);
    LAS int* lp = (LAS int*)(F.lds + 256 + 1024);
    LAS float* P = (LAS float*)(F.lds + 4096);
    LAS float* SSQ = (LAS float*)(F.lds + 4096 + 8 * 32 * 33 * 4);
    const int lane = F.lane, th = F.wave & 1, kq = F.wave >> 1, li = lane & 31, hh = lane >> 5;
    for (int blk = F.bid; blk < T / 64; blk += F.G) {
        __syncthreads();
        if (F.tid < 64) lcnt[F.tid] = 0u;
        const float* xr = X2 + (size_t)(blk * 64 + th * 32 + li) * D + kq * 512 + 4 * hh;
        const float* wr = WR + (size_t)li * D + kq * 512 + 4 * hh;
        f32x16 acc;
#pragma unroll
        for (int r = 0; r < 16; ++r) acc[r] = 0.f;
        float ss = 0.f;
#pragma unroll 4
        for (int q = 0; q < 64; ++q) {
            const f32x4 a = *(const f32x4*)(xr + 8 * q), b = *(const f32x4*)(wr + 8 * q);
            ss += (a[0] * a[0] + a[1] * a[1]) + (a[2] * a[2] + a[3] * a[3]);
#pragma unroll
            for (int s = 0; s < 4; ++s) acc = __builtin_amdgcn_mfma_f32_32x32x2f32(a[s], b[s], acc, 0, 0, 0);
        }
        ss += __shfl_xor(ss, 32);
#pragma unroll
        for (int r = 0; r < 16; ++r) P[(F.wave * 32 + (r & 3) + 8 * (r >> 2) + 4 * hh) * 33 + li] = acc[r];
        if (lane < 32) SSQ[F.wave * 32 + lane] = ss;
        __syncthreads();
        if (F.tid < 64) {
            const int tl = F.tid, th2 = tl >> 5, ti = tl & 31, t = blk * 64 + tl;
            float ssq = 0.f;
#pragma unroll
            for (int k4 = 0; k4 < 4; ++k4) ssq += SSQ[(k4 * 2 + th2) * 32 + ti];
            const float r = rsqrtf(ssq * (1.0f / D) + EPS);
            float v0 = -3.0e38f, v1 = -3.0e38f, v2 = -3.0e38f, v3 = -3.0e38f; int i0 = 0, i1 = 0, i2 = 0, i3 = 0;
            for (int e = 0; e < NE; ++e) {
                float x = 0.f;
#pragma unroll
                for (int k4 = 0; k4 < 4; ++k4) x += P[((k4 * 2 + th2) * 32 + ti) * 33 + e];
                x = x * r + rb[e];
                if (x > v3) {
                    if (x > v2) { v3 = v2; i3 = i2;
                        if (x > v1) { v2 = v1; i2 = i1;
                            if (x > v0) { v1 = v0; i1 = i0; v0 = x; i0 = e; } else { v1 = x; i1 = e; } }
                        else { v2 = x; i2 = e; } }
                    else { v3 = x; i3 = e; } }
            }
            const float e1 = __expf(v1 - v0), e2 = __expf(v2 - v0), e3 = __expf(v3 - v0), inv = 1.0f / (1.0f + e1 + e2 + e3);
            const unsigned p0 = __hip_atomic_fetch_add(lcnt + i0, 1u, __ATOMIC_RELAXED, __HIP_MEMORY_SCOPE_WORKGROUP);
            const unsigned p1 = __hip_atomic_fetch_add(lcnt + i1, 1u, __ATOMIC_RELAXED, __HIP_MEMORY_SCOPE_WORKGROUP);
            const unsigned p2 = __hip_atomic_fetch_add(lcnt + i2, 1u, __ATOMIC_RELAXED, __HIP_MEMORY_SCOPE_WORKGROUP);
            const unsigned p3 = __hip_atomic_fetch_add(lcnt + i3, 1u, __ATOMIC_RELAXED, __HIP_MEMORY_SCOPE_WORKGROUP);
            le[tl * 4 + 0] = i0; le[tl * 4 + 1] = i1; le[tl * 4 + 2] = i2; le[tl * 4 + 3] = i3;
            lp[tl * 4 + 0] = (int)p0; lp[tl * 4 + 1] = (int)p1; lp[tl * 4 + 2] = (int)p2; lp[tl * 4 + 3] = (int)p3;
            *(int4*)(TKE + t * 4) = make_int4(i0, i1, i2, i3);
            *(f32x4*)(TKW + t * 4) = (f32x4){inv, e1 * inv, e2 * inv, e3 * inv};
        }
        __syncthreads();
        if (F.tid < NE) lcnt[32 + F.tid] = __hip_atomic_fetch_add(cnt + 64 * F.tid, lcnt[F.tid], RLX_AGENT);
        __syncthreads();
        if (F.tid < 256) { const int tl = F.tid >> 2, k = F.tid & 3; TKP[(blk * 64 + tl) * 4 + k] = lp[tl * 4 + k] + (int)lcnt[32 + le[tl * 4 + k]]; }
        for (int tt = 0; tt < 8; ++tt) { const int t = blk * 64 + F.wave * 8 + tt; rms_row_to_bf16(X2 + (size_t)t * D, g, H3 + (size_t)t * D, lane); }
    }
}
__device__ __forceinline__ void p_lists(Frame& F) {
    unsigned* cnt = F.ctl + CW_CNT; int* TKE = WSP(int, WS_TKE); int* TKP = WSP(int, WS_TKP); int* ROWTOK = WSP(int, WS_ROWTOK); int* TILE = WSP(int, WS_TILE);
    LAS int* poff = (LAS int*)F.lds;
    LAS int* lc = (LAS int*)(F.lds + 256);
    __syncthreads();
    if (F.tid < NE) lc[F.tid] = (int)__hip_atomic_load(cnt + 64 * F.tid, RLX_AGENT);
    __syncthreads();
    if (F.tid == 0) { int o = 0; for (int e = 0; e < NE; ++e) { poff[e] = o; o += (lc[e] + 255) / 256 * 256; } poff[NE] = o; }
    __syncthreads();
    for (int i = F.bid * NTHR + F.tid; i < T * TOPK; i += F.G * NTHR) { const int e = TKE[i], slot = poff[e] + TKP[i]; TKP[i] = slot; ROWTOK[slot] = i >> 2; }
    if (F.bid == 0) {
        for (int e = 0; e < NE; ++e) for (int s = poff[e] + lc[e] + F.tid; s < poff[e + 1]; s += NTHR) ROWTOK[s] = T;
        for (int e = 0; e < NE; ++e) for (int tl = poff[e] / 256 + F.tid; tl < poff[e + 1] / 256; tl += NTHR) TILE[tl] = e;
        if (F.tid == 0) TILE[512] = poff[NE] / 256;
    }
    __syncthreads();
}
__device__ __forceinline__ void p_combine(Frame& F) {
    const float* X2 = WSP(float, WS_X1); const bf16* YS = WSP(bf16, WS_YS); const int* TKP = WSP(int, WS_TKP); const float* TKW = WSP(float, WS_TKW); const float* g = F.in[I_NFG];
    const int gw = F.bid * NWAVES + F.wave, NGW = F.G * NWAVES, lane = F.lane;
    for (int t = gw; t < T; t += NGW) {
        int sl[4]; float w[4];
#pragma unroll
        for (int k = 0; k < 4; ++k) { sl[k] = TKP[t * 4 + k]; w[k] = TKW[t * 4 + k]; }
        f32x4 v[8]; float s = 0.f;
#pragma unroll
        for (int j = 0; j < 8; ++j) { v[j] = *(const f32x4*)(X2 + (size_t)t * D + 4 * lane + 256 * j);
#pragma unroll
            for (int k = 0; k < 4; ++k) { const u32x2 y = *(const u32x2*)(YS + (size_t)sl[k] * D + 4 * lane + 256 * j);
                v[j][0] += w[k] * __uint_as_float(y.x << 16); v[j][1] += w[k] * __uint_as_float(y.x & 0xffff0000u); v[j][2] += w[k] * __uint_as_float(y.y << 16); v[j][3] += w[k] * __uint_as_float(y.y & 0xffff0000u); }
            s += (v[j][0] * v[j][0] + v[j][1] * v[j][1]) + (v[j][2] * v[j][2] + v[j][3] * v[j][3]); }
        const float r = rsqrtf(wave_sum(s) * (1.0f / D) + EPS);
#pragma unroll
        for (int j = 0; j < 8; ++j) { const f32x4 gg = *(const f32x4*)(g + 4 * lane + 256 * j); *(f32x4*)(F.out + (size_t)t * D + 4 * lane + 256 * j) = v[j] * r * gg; }
    }
}

constexpr int NPHASE = 16;
__global__ void __launch_bounds__(NTHR, 2) hybrid_fwd(Args args) {
    extern __shared__ __attribute__((aligned(16))) unsigned char lds_raw[];
    Frame F;
    F.lds = (LAS unsigned char*)lds_raw; F.ws = args.ws; F.ctl = (unsigned*)(args.ws + WS_CTL);
    F.tid = threadIdx.x; F.lane = F.tid & 63; F.wave = __builtin_amdgcn_readfirstlane(F.tid >> 6); F.G = gridDim.x; F.bid = blockIdx.x;
    F.in = args.in; F.out = args.out;
    volatile LAS unsigned* MISC = (volatile LAS unsigned*)(F.lds + MISC_OFF);
    if (F.tid < 32) MISC[F.tid] = 0u;
    __syncthreads();
#if MK_ONE_LAUNCH
    XcdBarrier bar = xcd_barrier_post(F.ctl + CW_BAR, MISC + 8);
#define GRID_BAR() xcd_barrier(bar)
#else
#define GRID_BAR() do {} while (0)
#endif
    const int lo = args.ph_lo, hi = args.ph_hi;
#ifndef ONLY_PHASE
#define ONLY_PHASE -1
#endif
#define IN(k) (lo <= (k) && (k) < hi && (ONLY_PHASE < 0 || ONLY_PHASE == (k)))
#define SEAM(k) do { if (IN(k) && IN((k) + 1)) GRID_BAR(); } while (0)

    if (IN(0)) { p0_prologue(F); }
    SEAM(0);
    if (IN(1)) {
        DenseSched S; S.init(WSP(bf16, WS_XN), WSP(bf16, WS_WIN), T, NIN, D, F.G, F.bid);
        EpiInProj E{WSP(bf16, WS_Q), WSP(bf16, WS_K), WSP(bf16, WS_V), WSP(bf16, WS_SR), WSP(bf16, WS_CB), WSP(bf16, WS_U), WSP(bf16, WS_SGA), WSP(bf16, WS_SGB), WSP(float, WS_LA), F.in[I_GGB]};
        gemm_any(F.lds, S, E);
        p_memkv(F);
    }
    SEAM(1);
    if (IN(2)) { p_conv(F); p_glaprep(F); }
    SEAM(2);
    if (IN(3)) {
#if OPT_GLA
#else
        p_gla_ref(F);
#endif
    }
    SEAM(3);
    if (IN(4)) {
#if OPT_GLA
#endif
    }
    SEAM(4);
    if (IN(5)) {
#if OPT_GLA
#else
        p_gla_norm_ref(F);
#endif
    }
    SEAM(5);
    if (IN(6)) {
        { DenseSched S; S.init(WSP(bf16, WS_OA), WSP(bf16, WS_WGO), T, D, D, F.G, F.bid); EpiGateA E{WSP(float, WS_T1), WSP(bf16, WS_SGA)}; gemm_any(F.lds, S, E); }
        VM_WAIT(); __syncthreads();
        { DenseSched S; S.init(WSP(bf16, WS_Z), WSP(bf16, WS_WCO), T, D, D, F.G, F.bid); EpiGateB E{WSP(float, WS_T1), WSP(bf16, WS_SGB), WSP(bf16, WS_MG)}; gemm_any(F.lds, S, E); }
    }
    SEAM(6);
    if (IN(7)) { DenseSched S; S.init(WSP(bf16, WS_MG), WSP(bf16, WS_WMX), T, D, D, F.G, F.bid); EpiResid1 E{F.in[I_X], WSP(float, WS_X1), WSP(bf16, WS_X1B), (float*)(F.ctl + CW_SS1)}; gemm_any(F.lds, S, E); }
    SEAM(7);
    if (IN(8)) { DenseSched S; S.init(WSP(bf16, WS_X1B), WSP(bf16, WS_WXQ), T, XA, D, F.G, F.bid); EpiXQ E{WSP(bf16, WS_QX), (const float*)(F.ctl + CW_SS1)}; gemm_any(F.lds, S, E); }
    SEAM(8);
    if (IN(9)) {
#if OPT_ATT
#else
        p_attn_ref(F);
#endif
    }
    SEAM(9);
    if (IN(10)) { DenseSched S; S.init(WSP(bf16, WS_OX), WSP(bf16, WS_WXO), T, D, XA, F.G, F.bid); EpiResid2 E{WSP(float, WS_X1)}; gemm_any(F.lds, S, E); }
    SEAM(10);
    if (IN(11)) { p_router(F); }
    SEAM(11);
    if (IN(12)) { p_lists(F); }
    SEAM(12);
    if (IN(13)) { const int ntiles = __builtin_amdgcn_readfirstlane(ld_agent_i(WSP(int, WS_TILE) + 512));
        GroupSched S; S.init(WSP(bf16, WS_H3), WSP(bf16, WS_WGU), ntiles, 2 * FF, D, F.G, F.bid, WSP(int, WS_TILE), WSP(int, WS_ROWTOK)); EpiGU E{WSP(bf16, WS_ACT), F.in[I_GUB]}; gemm_any(F.lds, S, E); }
    SEAM(13);
    if (IN(14)) { const int ntiles = __builtin_amdgcn_readfirstlane(ld_agent_i(WSP(int, WS_TILE) + 512));
        GroupSched S; S.init(WSP(bf16, WS_ACT), WSP(bf16, WS_WDN), ntiles, D, FF, F.G, F.bid, WSP(int, WS_TILE), nullptr); EpiDown E{WSP(bf16, WS_YS), F.in[I_DNB]}; gemm_any(F.lds, S, E); }
    SEAM(14);
    if (IN(15)) { p_combine(F); }
#undef IN
#undef SEAM
}

extern "C" void kernel_launch(void* const* d_in, const int* in_sizes, int n_in, void* d_out, int out_size, void* d_ws, size_t ws_size, hipStream_t stream) {
    static int grid = 0;
    if (grid == 0) {
        if (n_in != 26 || out_size != T * D || ws_size < WS_END) { fprintf(stderr, "kernel_launch: unexpected problem (n_in %d, out %d, ws %zu < %zu)\n", n_in, out_size, ws_size, (size_t)WS_END); grid = -1; return; }
        int dev = 0, cus = 0, per_cu = 0;
        if (hipGetDevice(&dev) != hipSuccess || hipDeviceGetAttribute(&cus, hipDeviceAttributeMultiprocessorCount, dev) != hipSuccess) { grid = -1; return; }
        if (hipFuncSetAttribute((const void*)hybrid_fwd, hipFuncAttributeMaxDynamicSharedMemorySize, LDS_BYTES) != hipSuccess) { fprintf(stderr, "kernel_launch: hipFuncSetAttribute failed\n"); grid = -1; return; }
        if (hipOccupancyMaxActiveBlocksPerMultiprocessor(&per_cu, (const void*)hybrid_fwd, NTHR, LDS_BYTES) != hipSuccess || per_cu < 1) fprintf(stderr, "kernel_launch: occupancy query says %d\n", per_cu);
        (void)hipGetLastError();
        grid = cus;
    }
    if (grid < 0) return;
    (void)hipMemsetAsync((char*)d_ws + WS_CTL, 0, CTL_ZERO_BYTES, stream);
    Args a{};
    for (int i = 0; i < 26; ++i) a.in[i] = (const float*)d_in[i];
    a.out = (float*)d_out; a.ws = (unsigned char*)d_ws;
#if MK_ONE_LAUNCH
    a.ph_lo = 0; a.ph_hi = NPHASE;
    hipLaunchKernelGGL(hybrid_fwd, dim3(grid), dim3(NTHR), LDS_BYTES, stream, a);
#else
    for (int p = 0; p < NPHASE; ++p) { a.ph_lo = p; a.ph_hi = p + 1; hipLaunchKernelGGL(hybrid_fwd, dim3(grid), dim3(NTHR), LDS_BYTES, stream, a); }
#endif
}
```

```cpp
#include <hip/hip_runtime.h>
#include <cstdio>
#include <cstdint>

#ifndef MK_ONE_LAUNCH
#define MK_ONE_LAUNCH 1
#endif
#ifndef OPT_GEMM
#define OPT_GEMM 1
#endif
#ifndef OPT_GLA
#define OPT_GLA 0
#endif
#ifndef OPT_ATT
#define OPT_ATT 0
#endif

#define GAS __attribute__((address_space(1)))
#define LAS __attribute__((address_space(3)))
typedef unsigned short bf16;
typedef short bf16x8 __attribute__((ext_vector_type(8)));
typedef short bf16x4 __attribute__((ext_vector_type(4)));
typedef float f32x4 __attribute__((ext_vector_type(4)));
typedef float f32x2 __attribute__((ext_vector_type(2)));
typedef unsigned u32x4 __attribute__((ext_vector_type(4)));
typedef unsigned u32x2 __attribute__((ext_vector_type(2)));
#define RLX_AGENT __ATOMIC_RELAXED, __HIP_MEMORY_SCOPE_AGENT
#define LDS_WAIT() asm volatile("s_waitcnt lgkmcnt(0)" ::: "memory")
#define VM_WAIT() asm volatile("s_waitcnt vmcnt(0)" ::: "memory")

constexpr int T = 16384, D = 2048, MEM = 256;
constexpr int GH = 4, DK = 256, DV = 512, QK = GH * DK  , VD = GH * DV  ;
constexpr int CH = 64, NCH = T / CH  , NG = 16, GC = NCH / NG  , GT = GC * CH  ;
constexpr int XH = 4, XD = 128, XA = XH * XD  ;
constexpr int NE = 32, TOPK = 4, FF = 2048;
constexpr int NIN_SRC = 16400, NIN = 17408;
constexpr float EPS = 1e-5f;
constexpr int PROWS = T * TOPK + NE * 256;
constexpr int MAXTILES = PROWS / 256;

constexpr int SRC_ALOW = 6144, SRC_CB = 6160, SRC_CC = 8208, SRC_CHH = 10256, SRC_GA = 12304, SRC_GB = 14352;
constexpr int TN_Q = 0, TN_K = 4, TN_V = 8, TN_R = 16, TN_LA = 24, TN_CB = 28, TN_U = 36, TN_GA = 52, TN_GB = 60, TN_END = 68;

constexpr size_t MiB = 1u << 20;
constexpr size_t WS_CTL = 0, CTL_ZERO_BYTES = 1 * MiB;
constexpr size_t WS_WIN = 1 * MiB;
constexpr size_t WS_WGO = WS_WIN + 68 * MiB;
constexpr size_t WS_WCO = WS_WGO + 8 * MiB;
constexpr size_t WS_WMX = WS_WCO + 8 * MiB;
constexpr size_t WS_WXQ = WS_WMX + 8 * MiB;
constexpr size_t WS_WXKV = WS_WXQ + 2 * MiB;
constexpr size_t WS_WXO = WS_WXKV + 4 * MiB;
constexpr size_t WS_WR = WS_WXO + 2 * MiB;
constexpr size_t WS_WGU = WS_WR + 1 * MiB;
constexpr size_t WS_WDN = WS_WGU + 512 * MiB;
constexpr size_t WS_XN = WS_WDN + 256 * MiB;
constexpr size_t WS_Q = WS_XN + 64 * MiB;
constexpr size_t WS_K = WS_Q + 32 * MiB;
constexpr size_t WS_V = WS_K + 32 * MiB;
constexpr size_t WS_SR = WS_V + 64 * MiB;
constexpr size_t WS_LA = WS_SR + 64 * MiB;
constexpr size_t WS_CB = WS_LA + 64 * MiB;
constexpr size_t WS_U = WS_CB + 64 * MiB;
constexpr size_t WS_SGA = WS_U + 64 * MiB;
constexpr size_t WS_SGB = WS_SGA + 64 * MiB;
constexpr size_t WS_QT = WS_SGB + 64 * MiB;
constexpr size_t WS_KH = WS_QT + 32 * MiB;
constexpr size_t WS_KHT = WS_KH + 32 * MiB;
constexpr size_t WS_QG = WS_KHT + 32 * MiB;
constexpr size_t WS_VT = WS_QG + 32 * MiB;
constexpr size_t WS_DL = WS_VT + 64 * MiB;
constexpr size_t WS_DG = WS_DL + 1 * MiB;
constexpr size_t WS_Z = WS_DG + 1 * MiB;
constexpr size_t WS_OL = WS_Z + 64 * MiB;
constexpr size_t WS_SLOC = WS_OL + 64 * MiB;
constexpr size_t WS_SG0 = WS_SLOC + 32 * MiB;
constexpr size_t WS_O32 = WS_SG0 + 16 * MiB;
constexpr size_t WS_OA = WS_O32 + 128 * MiB;
constexpr size_t WS_T1 = WS_OA + 64 * MiB;
constexpr size_t WS_MG = WS_T1 + 128 * MiB;
constexpr size_t WS_X1 = WS_MG + 64 * MiB;
constexpr size_t WS_X1B = WS_X1 + 128 * MiB;
constexpr size_t WS_QX = WS_X1B + 64 * MiB;
constexpr size_t WS_OX = WS_QX + 16 * MiB;
constexpr size_t WS_MEMN = WS_OX + 16 * MiB;
constexpr size_t WS_KM = WS_MEMN + 1 * MiB;
constexpr size_t WS_VMT = WS_KM + 1 * MiB;
constexpr size_t WS_H3 = WS_VMT + 1 * MiB;
constexpr size_t WS_TKE = WS_H3 + 65 * MiB;
constexpr size_t WS_TKP = WS_TKE + 1 * MiB;
constexpr size_t WS_TKW = WS_TKP + 1 * MiB;
constexpr size_t WS_ROWTOK = WS_TKW + 1 * MiB;
constexpr size_t WS_TILE = WS_ROWTOK + 1 * MiB;
constexpr size_t WS_ACT = WS_TILE + 1 * MiB;
constexpr size_t WS_YS = WS_ACT + 288 * MiB;
constexpr size_t WS_END = WS_YS + 288 * MiB;
constexpr int CW_BAR = 4096;
constexpr int CW_CNT = 16384;
constexpr int CW_SS1 = 65536;
static_assert((CW_SS1 + T) * 4 <= (int)CTL_ZERO_BYTES, "ctl");

constexpr int NWAVES = 8, NTHR = 512;
constexpr int LDS_BYTES = 147456;
constexpr int MISC_OFF = 135168;

__device__ __forceinline__ float bf2f(unsigned short b) { return __uint_as_float(((unsigned)b) << 16); }
__device__ __forceinline__ unsigned f2bf(float f) { unsigned u = __float_as_uint(f); return (u + 0x7fffu + ((u >> 16) & 1u)) >> 16; }
__device__ __forceinline__ unsigned pk2(float lo, float hi) { return f2bf(lo) | (f2bf(hi) << 16); }
__device__ __forceinline__ float wave_sum(float v) {
#pragma unroll
    for (int o = 1; o < 64; o <<= 1) v += __shfl_xor(v, o);
    return v;
}
__device__ __forceinline__ float wave_max(float v) {
#pragma unroll
    for (int o = 1; o < 64; o <<= 1) v = fmaxf(v, __shfl_xor(v, o));
    return v;
}
__device__ __forceinline__ float sigmoidf_(float x) { return 1.0f / (1.0f + __expf(-x)); }
__device__ __forceinline__ float logsigmoidf_(float z) { return z < 0.f ? z - log1pf(__expf(z)) : -log1pf(__expf(-z)); }
__device__ __forceinline__ u32x4 pack8(f32x4 a, f32x4 b) { u32x4 w; w.x = pk2(a[0], a[1]); w.y = pk2(a[2], a[3]); w.z = pk2(b[0], b[1]); w.w = pk2(b[2], b[3]); return w; }
__device__ __forceinline__ void unpack8(u32x4 w, f32x4& a, f32x4& b) {
    a[0] = __uint_as_float(w.x << 16); a[1] = __uint_as_float(w.x & 0xffff0000u); a[2] = __uint_as_float(w.y << 16); a[3] = __uint_as_float(w.y & 0xffff0000u);
    b[0] = __uint_as_float(w.z << 16); b[1] = __uint_as_float(w.z & 0xffff0000u); b[2] = __uint_as_float(w.w << 16); b[3] = __uint_as_float(w.w & 0xffff0000u);
}
__device__ __forceinline__ int ld_agent_i(const int* p) { return (int)__hip_atomic_load((const unsigned*)p, RLX_AGENT); }

#define XB_TMO      128
#define XB_XCNT(j)  (256  + 64 * (j))
#define XB_XSUB(j)  (1280 + 64 * (j))
#define XB_XGEN(j)  (2304 + 64 * (j))
#define XB_TOP      3328
#define XB_TOPGEN   3392
#define XCD_BAR_WORDS 3456
#define XB_SPIN_CAP (1u << 22)
__device__ __forceinline__ unsigned xb_ld(unsigned* p)              { return __hip_atomic_load(p, __ATOMIC_RELAXED, __HIP_MEMORY_SCOPE_AGENT); }
__device__ __forceinline__ unsigned xb_add(unsigned* p, unsigned v) { return __hip_atomic_fetch_add(p, v, __ATOMIC_RELAXED, __HIP_MEMORY_SCOPE_AGENT); }
__device__ __forceinline__ unsigned xb_xcc_id() { return (unsigned)__builtin_amdgcn_s_getreg((3 << 11) | 20) & 0xFu; }
#define XB_SPIN(cond, bar) do { unsigned _sp = 0; while (cond) { __builtin_amdgcn_s_sleep(1); \
    if ((++_sp & 255u) == 0u) { if (xb_ld(&(bar)[XB_TMO])) break; if (_sp > XB_SPIN_CAP) { atomicAdd(&(bar)[XB_TMO], 1u); break; } } } } while (0)
struct XcdBarrier { unsigned* bar; unsigned x; volatile LAS unsigned* st; };
__device__ __forceinline__ XcdBarrier xcd_barrier_post(unsigned* bar, volatile LAS unsigned* st) {
    XcdBarrier b; b.bar = bar; b.x = xb_xcc_id(); b.st = st;
    if (threadIdx.x == 0) (void)xb_add(&bar[XB_XCNT(b.x)], 1u);
    return b;
}
__device__ __forceinline__ void xcd_barrier_complete(unsigned* bar, unsigned x, unsigned& nloc, unsigned& nx) {
    const unsigned G = gridDim.x * gridDim.y * gridDim.z;
    unsigned sum, cnt, mine, sp = 0u;
    for (;;) {
        sum = 0u; cnt = 0u; mine = 0u;
#pragma unroll
        for (unsigned j = 0; j < 16; ++j) { const unsigned c = xb_ld(&bar[XB_XCNT(j)]); sum += c; cnt += (c > 0u) ? 1u : 0u; mine = (j == x) ? c : mine; }
        if (sum == G) break;
        __builtin_amdgcn_s_sleep(1);
        if ((++sp & 255u) == 0u) { if (xb_ld(&bar[XB_TMO])) break; if (sp > XB_SPIN_CAP) { atomicAdd(&bar[XB_TMO], 1u); break; } }
    }
    nloc = mine > 0u ? mine : 1u; nx = cnt > 0u ? cnt : 1u;
}
__device__ __forceinline__ void xcd_barrier(const XcdBarrier& b) {
    asm volatile("s_waitcnt vmcnt(0)" ::: "memory");
    __syncthreads();
    if (threadIdx.x == 0) {
        unsigned* bar = b.bar;
        __builtin_amdgcn_s_waitcnt(0);
        unsigned nloc = b.st[0], nx = b.st[1];
        if (nloc == 0u) { xcd_barrier_complete(bar, b.x, nloc, nx); b.st[0] = nloc; b.st[1] = nx; }
        const unsigned old = xb_add(&bar[XB_XSUB(b.x)], 1u);
        const unsigned gen = old / nloc;
        if (old + 1u == (gen + 1u) * nloc) {
            __builtin_amdgcn_fence(__ATOMIC_RELEASE, "agent");
            asm volatile("s_waitcnt vmcnt(0)" ::: "memory");
            const unsigned og = xb_add(&bar[XB_TOP], 1u);
            const unsigned tg = og / nx;
            if (og + 1u == (tg + 1u) * nx) xb_add(&bar[XB_TOPGEN], 1u);
            else XB_SPIN(xb_ld(&bar[XB_TOPGEN]) == tg, bar);
            __builtin_amdgcn_fence(__ATOMIC_ACQUIRE, "agent");
            xb_add(&bar[XB_XGEN(b.x)], 1u);
            asm volatile("s_waitcnt vmcnt(0)" ::: "memory");
        } else {
            XB_SPIN(xb_ld(&bar[XB_XGEN(b.x)]) == gen, bar);
            __builtin_amdgcn_fence(__ATOMIC_ACQUIRE, "agent");
            asm volatile("s_waitcnt vmcnt(0)" ::: "memory");
        }
    }
    __syncthreads();
}

struct Args { const float* in[26]; float* out; unsigned char* ws; int ph_lo, ph_hi; };
struct Frame {
    LAS unsigned char* lds; unsigned char* ws; unsigned* ctl;
    int tid, lane, wave, G, bid;
    const float* const* in;
    float* out;
};
#define WSP(type, off) ((type*)(F.ws + (off)))
enum { I_X = 0, I_MEM, I_NMIXG, I_WIN, I_GGW, I_GGB, I_GNG, I_GOW, I_CW, I_CBIAS, I_COW, I_MXW, I_NXG, I_NMG, I_XQ, I_XK, I_XV, I_XO, I_NMOEG, I_RW, I_RB, I_GUW, I_GUB, I_DNW, I_DNB, I_NFG };

constexpr int BM = 256, BK = 64, HALF = 128, HTB = HALF * BK * 2, NXCD = 8, WGM = 8;
__device__ __forceinline__ int lds_byte(int r, int c) { const int st = (r >> 4) * 2 + (c >> 5), rr = r & 15, cc = c & 31, ob = rr * 64 + cc * 2; return st * 1024 + (ob ^ (((ob >> 9) & 1) << 5)); }
__device__ __forceinline__ void stage_rc(int b, int& R, int& C) { const int st = b / 1024, sb = b % 1024, swz = sb ^ (((sb >> 9) & 1) << 5); R = (st >> 1) * 16 + swz / 64; C = (st & 1) * 32 + (swz % 64) / 2; }
__device__ __forceinline__ int perm32(int rho) { const int n = rho >> 4, i = rho & 15; return 8 * (i >> 2) + 4 * n + (i & 3); }

struct Unit { int pm, pn, e; };
__device__ __forceinline__ bool static_next(int i, int G, int c, int nM, int nN, Unit& u) {
    const int nwg = nM * nN; const long L = (long)i * G + c; if (L >= nwg) return false;
    int wgid = (int)L; { const int q = nwg / NXCD, r = nwg % NXCD, xcd = wgid % NXCD, off = wgid / NXCD; wgid = (xcd < r ? xcd * (q + 1) : r * (q + 1) + (xcd - r) * q) + off; }
    const int nig = WGM * nN, gid = wgid / nig, fm = gid * WGM, gsz = (nM - fm) < WGM ? (nM - fm) : WGM;
    u.pm = fm + ((wgid % nig) % gsz); u.pn = (wgid % nig) / gsz; u.e = 0; return true;
}
struct DenseSched {
    const char* A; const char* Bt; int K, nM, nN, G, c;
    __device__ __forceinline__ void init(const void* A_, const void* Bt_, int M, int N, int K_, int G_, int c_) { A = (const char*)A_; Bt = (const char*)Bt_; K = K_; nM = M / BM; nN = N / BM; G = G_; c = c_; }
    __device__ __forceinline__ bool next(int i, Unit& u) const { return static_next(i, G, c, nM, nN, u); }
    __device__ __forceinline__ const char* a_base() const { return A; }
    __device__ __forceinline__ const char* b_base(const Unit& u) const { return Bt + (size_t)u.pn * BM * K * 2; }
    __device__ __forceinline__ unsigned a_src_row(const Unit& u, int r) const { return (unsigned)(u.pm * BM + r); }
};
struct GroupSched {
    const char* A; const char* Bt; int K, N, nM, nN, G, c; const int* tile_e; const int* row_tok;
    __device__ __forceinline__ void init(const void* A_, const void* Bt_, int ntiles, int N_, int K_, int G_, int c_, const int* te, const int* rt) { A = (const char*)A_; Bt = (const char*)Bt_; K = K_; N = N_; nM = ntiles; nN = N_ / BM; G = G_; c = c_; tile_e = te; row_tok = rt; }
    __device__ __forceinline__ bool next(int i, Unit& u) const { if (!static_next(i, G, c, nM, nN, u)) return false; u.e = __builtin_amdgcn_readfirstlane(ld_agent_i(tile_e + u.pm)); return true; }
    __device__ __forceinline__ const char* a_base() const { return A; }
    __device__ __forceinline__ const char* b_base(const Unit& u) const { return Bt + ((size_t)u.e * N + (size_t)u.pn * BM) * K * 2; }
    __device__ __forceinline__ unsigned a_src_row(const Unit& u, int r) const { return row_tok ? (unsigned)ld_agent_i(row_tok + u.pm * BM + r) : (unsigned)(u.pm * BM + r); }
};

template <class Epi, class Sched>
__device__ __forceinline__ void gemm_ref(LAS unsigned char* lds, const Sched& S, const Epi& E) {
    const int tid = threadIdx.x, tx = tid & 15, ty = tid >> 4, K = S.K;
    LAS float* As = (LAS float*)lds; LAS float* Bs = As + 16 * 260;
    const int lr = tid >> 1, kh = tid & 1;
    for (int i = 0;; ++i) {
        Unit u; if (!S.next(i, u)) break;
        float acc[8][16];
#pragma unroll
        for (int j = 0; j < 8; ++j)
#pragma unroll
            for (int q = 0; q < 16; ++q) acc[j][q] = 0.f;
        const char* Ab = S.a_base() + ((size_t)S.a_src_row(u, lr) * K + 8 * kh) * 2;
        const char* Bb = S.b_base(u) + ((size_t)lr * K + 8 * kh) * 2;
        for (int k0 = 0; k0 < K; k0 += 16) {
            const bf16x8 av = *(const bf16x8*)(Ab + (size_t)k0 * 2), bv = *(const bf16x8*)(Bb + (size_t)k0 * 2);
            __syncthreads();
#pragma unroll
            for (int j = 0; j < 8; ++j) { As[(8 * kh + j) * 260 + lr] = bf2f((unsigned short)av[j]); Bs[(8 * kh + j) * 260 + lr] = bf2f((unsigned short)bv[j]); }
            __syncthreads();
#pragma unroll 4
            for (int kk = 0; kk < 16; ++kk) {
                float a[8], b[16];
#pragma unroll
                for (int j = 0; j < 8; ++j) a[j] = As[kk * 260 + ty + 32 * j];
                const f32x4 b0 = *(const LAS f32x4*)(Bs + kk * 260 + 8 * tx), b1 = *(const LAS f32x4*)(Bs + kk * 260 + 8 * tx + 4);
                const f32x4 b2 = *(const LAS f32x4*)(Bs + kk * 260 + 128 + 8 * tx), b3 = *(const LAS f32x4*)(Bs + kk * 260 + 128 + 8 * tx + 4);
#pragma unroll
                for (int q = 0; q < 4; ++q) { b[q] = b0[q]; b[4 + q] = b1[q]; b[8 + q] = b2[q]; b[12 + q] = b3[q]; }
#pragma unroll
                for (int j = 0; j < 8; ++j)
#pragma unroll
                    for (int q = 0; q < 16; ++q) acc[j][q] += a[j] * b[q];
            }
        }
#pragma unroll 8
        for (int j = 0; j < 8; ++j) {
            const f32x4 a0 = {acc[j][0], acc[j][1], acc[j][2], acc[j][3]}, a1 = {acc[j][4], acc[j][5], acc[j][6], acc[j][7]};
            const f32x4 b0 = {acc[j][8], acc[j][9], acc[j][10], acc[j][11]}, b1 = {acc[j][12], acc[j][13], acc[j][14], acc[j][15]};
            E.template row8<false>(u.pm * BM + ty + 32 * j, u, 8 * tx, a0, a1, b0, b1);
        }
    }
    __syncthreads();
}

template <class Epi, class Sched>
__device__ __forceinline__ void gemm_mfma(LAS unsigned char* lds, const Sched& S, const Epi& E) {
    const int tid = threadIdx.x, wid = __builtin_amdgcn_readfirstlane(tid >> 6), lane = tid & 63, wr = wid >> 2, wc = wid & 3, fr = lane & 15, fq = lane >> 4;
    const int K = S.K, nt = K / BK;
    int Rr[2], Cc[2]; unsigned voffB[2];
#pragma unroll
    for (int i = 0; i < 2; ++i) { stage_rc(tid * 16 + i * 8192, Rr[i], Cc[i]); const int Rb = (Rr[i] & ~31) + perm32(Rr[i] & 31); voffB[i] = (unsigned)(Rb * K + Cc[i]) * 2u; }
    const size_t kstep = (size_t)(BK * 2);
    const size_t hstep = (size_t)HALF * K * 2;
    const unsigned ldsw = (unsigned)wid * 1024u;
    const int aoff = lds_byte(wr * 64 + fr, fq * 8), boff = lds_byte(wc * 32 + fr, fq * 8);
#define PG8_SA(b, h) (((b) * 2 + (h)) * HTB)
#define PG8_SB(b, h) ((4 + (b) * 2 + (h)) * HTB)
#define PG8_STAGE(bufoff, gbase, voff) do { _Pragma("unroll") for (int _i = 0; _i < 2; ++_i) \
        __builtin_amdgcn_global_load_lds((const unsigned*)((const char*)(gbase) + (voff)[_i]), (LAS unsigned*)(lds + (bufoff) + ldsw + _i * 8192), 16, 0, 0); } while (0)
#define PG8_LDA(dst, b, h) do { _Pragma("unroll") for (int m = 0; m < 4; ++m) _Pragma("unroll") for (int k = 0; k < 2; ++k) dst[m][k] = *(const LAS bf16x8*)(lds + PG8_SA(b, h) + aoff + m * 2048 + k * 1024); } while (0)
#define PG8_LDB(dst, b, h) do { _Pragma("unroll") for (int n = 0; n < 2; ++n) _Pragma("unroll") for (int k = 0; k < 2; ++k) dst[n][k] = *(const LAS bf16x8*)(lds + PG8_SB(b, h) + boff + n * 2048 + k * 1024); } while (0)
#define PG8_MMA(ai, bj, At, Bt) do { __builtin_amdgcn_s_setprio(1); _Pragma("unroll") for (int m = 0; m < 4; ++m) _Pragma("unroll") for (int n = 0; n < 2; ++n) _Pragma("unroll") for (int k = 0; k < 2; ++k) \
        acc[ai][bj][m][n] = __builtin_amdgcn_mfma_f32_16x16x32_bf16(Bt[n][k], At[m][k], acc[ai][bj][m][n], 0, 0, 0); __builtin_amdgcn_s_setprio(0); } while (0)
#define PG8_WAIT_V(n) asm volatile("s_waitcnt vmcnt(" #n ")" ::: "memory")
#define PG8_WAIT_L(n) asm volatile("s_waitcnt lgkmcnt(" #n ")" ::: "memory")
#define PG8_BAR __builtin_amdgcn_s_barrier()
#define PG8_SCHED __builtin_amdgcn_sched_barrier(0)
#define PG8_AOFF(dst, uu) do { _Pragma("unroll") for (int _h = 0; _h < 2; ++_h) _Pragma("unroll") for (int _i = 0; _i < 2; ++_i) dst[_h][_i] = (S.a_src_row(uu, _h * HALF + Rr[_i]) * (unsigned)K + (unsigned)Cc[_i]) * 2u; } while (0)
    Unit cur, nxt; int ui = 0;
    if (!S.next(0, cur)) return;
    f32x4 acc[2][2][4][2];
#pragma unroll
    for (int a = 0; a < 2; ++a)
#pragma unroll
        for (int b = 0; b < 2; ++b)
#pragma unroll
            for (int m = 0; m < 4; ++m)
#pragma unroll
                for (int n = 0; n < 2; ++n) acc[a][b][m][n] = (f32x4){0.f, 0.f, 0.f, 0.f};
    bf16x8 At[4][2], B0[2][2], B1[2][2];
    unsigned coff[2][2], noff[2][2];
    PG8_AOFF(coff, cur);
    const char* cA = S.a_base(); const char* cB = S.b_base(cur);
    PG8_STAGE(PG8_SB(0, 0), cB, voffB); PG8_STAGE(PG8_SB(0, 1), cB + hstep, voffB); PG8_STAGE(PG8_SA(0, 0), cA, coff[0]); PG8_STAGE(PG8_SA(0, 1), cA, coff[1]);
    if (wr == 1) PG8_BAR;
    PG8_WAIT_V(2); PG8_BAR;
    PG8_STAGE(PG8_SB(1, 0), cB + kstep, voffB); PG8_STAGE(PG8_SA(1, 0), cA + kstep, coff[0]); PG8_STAGE(PG8_SB(1, 1), cB + hstep + kstep, voffB);
    PG8_WAIT_V(6); PG8_BAR;
    for (;;) {
        const bool has_next = S.next(ui + 1, nxt);
        const char* nB = cB;
#pragma unroll
        for (int _h = 0; _h < 2; ++_h)
#pragma unroll
            for (int _i = 0; _i < 2; ++_i) noff[_h][_i] = coff[_h][_i];
        if (has_next) { nB = S.b_base(nxt); PG8_AOFF(noff, nxt); }
        for (int t = 0; t < nt; t += 2) {
            const bool last = (t == nt - 2);
            const char* a1 = cA + (size_t)(t + 1) * kstep;
            const char* a2 = last ? cA : cA + (size_t)(t + 2) * kstep; const char* b2 = last ? nB : cB + (size_t)(t + 2) * kstep;
            const char* a3 = a2 + kstep; const char* b3 = b2 + kstep;
            unsigned o2[2][2];
#pragma unroll
            for (int _h = 0; _h < 2; ++_h)
#pragma unroll
                for (int _i = 0; _i < 2; ++_i) o2[_h][_i] = last ? noff[_h][_i] : coff[_h][_i];
            PG8_LDB(B0, 0, 0); PG8_LDB(B1, 0, 1); PG8_SCHED; PG8_LDA(At, 0, 0); PG8_STAGE(PG8_SA(1, 1), a1, coff[1]);
            PG8_WAIT_V(8); PG8_WAIT_L(0); PG8_BAR; PG8_MMA(0, 0, At, B0); PG8_MMA(0, 1, At, B1); PG8_BAR; PG8_SCHED;
            PG8_LDA(At, 0, 1); PG8_STAGE(PG8_SB(0, 0), b2, voffB); PG8_STAGE(PG8_SB(0, 1), b2 + hstep, voffB); PG8_STAGE(PG8_SA(0, 0), a2, o2[0]);
            PG8_WAIT_V(8); PG8_WAIT_L(0); PG8_BAR; PG8_MMA(1, 0, At, B0); PG8_MMA(1, 1, At, B1); PG8_BAR; PG8_SCHED;
            PG8_LDB(B0, 1, 0); PG8_LDB(B1, 1, 1); PG8_SCHED; PG8_LDA(At, 1, 0); PG8_STAGE(PG8_SA(0, 1), a2, o2[1]);
            PG8_WAIT_V(8); PG8_WAIT_L(0); PG8_BAR; PG8_MMA(0, 0, At, B0); PG8_MMA(0, 1, At, B1); PG8_BAR; PG8_SCHED;
            PG8_LDA(At, 1, 1); PG8_STAGE(PG8_SB(1, 0), b3, voffB); PG8_STAGE(PG8_SB(1, 1), b3 + hstep, voffB); PG8_STAGE(PG8_SA(1, 0), a3, o2[0]);
            PG8_WAIT_V(8); PG8_WAIT_L(0); PG8_BAR; PG8_MMA(1, 0, At, B0); PG8_MMA(1, 1, At, B1); PG8_BAR; PG8_SCHED;
        }
        if (wr == 0) PG8_BAR;
#pragma unroll 2
        for (int ai = 0; ai < 2; ++ai)
#pragma unroll 4
            for (int m = 0; m < 4; ++m)
                E.template row8<true>(cur.pm * BM + ai * HALF + wr * 64 + m * 16 + fr, cur, wc * 32 + 8 * fq, acc[ai][0][m][0], acc[ai][0][m][1], acc[ai][1][m][0], acc[ai][1][m][1]);
        if (!has_next) break;
#pragma unroll
        for (int a = 0; a < 2; ++a)
#pragma unroll
            for (int b = 0; b < 2; ++b)
#pragma unroll
                for (int m = 0; m < 4; ++m)
#pragma unroll
                    for (int n = 0; n < 2; ++n) acc[a][b][m][n] = (f32x4){0.f, 0.f, 0.f, 0.f};
        cur = nxt; cB = nB;
#pragma unroll
        for (int _h = 0; _h < 2; ++_h)
#pragma unroll
            for (int _i = 0; _i < 2; ++_i) coff[_h][_i] = noff[_h][_i];
        ++ui;
        if (wr == 1) PG8_BAR;
    }
    PG8_WAIT_V(0);
    PG8_BAR;
#undef PG8_SA
#undef PG8_SB
#undef PG8_STAGE
#undef PG8_LDA
#undef PG8_LDB
#undef PG8_MMA
#undef PG8_WAIT_V
#undef PG8_WAIT_L
#undef PG8_BAR
#undef PG8_SCHED
#undef PG8_AOFF
}
template <class Epi, class Sched>
__device__ __forceinline__ void gemm_any(LAS unsigned char* lds, const Sched& S, const Epi& E) {
#if OPT_GEMM
    gemm_mfma<Epi, Sched>(lds, S, E);
#else
    gemm_ref<Epi, Sched>(lds, S, E);
#endif
}

__device__ __forceinline__ void st_bf8(bf16* p, f32x4 a, f32x4 b) { *(u32x4*)p = pack8(a, b); }
__device__ __forceinline__ void ld_bf8(const bf16* p, f32x4& a, f32x4& b) { unpack8(*(const u32x4*)p, a, b); }

struct EpiInProj {
    bf16 *Q, *Kk, *V, *SR, *CB, *U, *SGA, *SGB; float* LA; const float* gate_b;
    template <bool MF> __device__ __forceinline__ void row8(int row, const Unit& u, int c0, f32x4 a0, f32x4 a1, f32x4 b0, f32x4 b1) const {
        const int pn = u.pn;
        if (pn >= TN_LA && pn < TN_CB) {
            const int col = (pn - TN_LA) * 256 + c0; float* p = LA + (size_t)row * QK + col; const float* gb = gate_b + col;
            const f32x4 g0 = *(const f32x4*)gb, g1 = *(const f32x4*)(gb + 4), g2 = *(const f32x4*)(gb + 128), g3 = *(const f32x4*)(gb + 132);
#pragma unroll
            for (int j = 0; j < 4; ++j) { a0[j] = logsigmoidf_(a0[j] + g0[j]) * 0.0625f; a1[j] = logsigmoidf_(a1[j] + g1[j]) * 0.0625f; b0[j] = logsigmoidf_(b0[j] + g2[j]) * 0.0625f; b1[j] = logsigmoidf_(b1[j] + g3[j]) * 0.0625f; }
            *(f32x4*)p = a0; *(f32x4*)(p + 4) = a1; *(f32x4*)(p + 128) = b0; *(f32x4*)(p + 132) = b1; return; }
        if (pn >= TN_U && pn < TN_GA) { st_bf8(U + (size_t)row * D + (pn - TN_U) * 128 + c0, a0 * b0, a1 * b1); return; }
        bf16* base; int ld, ct, mode = 0; float sc = 1.0f;
        if (pn < TN_K) { base = Q; ld = QK; ct = pn - TN_Q; sc = 0.0625f; }
        else if (pn < TN_V) { base = Kk; ld = QK; ct = pn - TN_K; }
        else if (pn < TN_R) { base = V; ld = VD; ct = pn - TN_V; }
        else if (pn < TN_LA) { base = SR; ld = VD; ct = pn - TN_R; mode = 1; }
        else if (pn < TN_U) { base = CB; ld = D; ct = pn - TN_CB; }
        else if (pn < TN_GB) { base = SGA; ld = D; ct = pn - TN_GA; mode = 2; }
        else { base = SGB; ld = D; ct = pn - TN_GB; mode = 2; }
        if (mode) {
#pragma unroll
            for (int j = 0; j < 4; ++j) { const float s0 = sigmoidf_(a0[j]), s1 = sigmoidf_(a1[j]), s2 = sigmoidf_(b0[j]), s3 = sigmoidf_(b1[j]);
                a0[j] = (mode == 1) ? a0[j] * s0 : s0; a1[j] = (mode == 1) ? a1[j] * s1 : s1; b0[j] = (mode == 1) ? b0[j] * s2 : s2; b1[j] = (mode == 1) ? b1[j] * s3 : s3; }
        } else { a0 *= sc; a1 *= sc; b0 *= sc; b1 *= sc; }
        bf16* p = base + (size_t)row * ld + ct * 256 + c0; st_bf8(p, a0, a1); st_bf8(p + 128, b0, b1);
    }
};
struct EpiGateA {
    float* T1; const bf16* SGA;
    template <bool MF> __device__ __forceinline__ void row8(int row, const Unit& u, int c0, f32x4 a0, f32x4 a1, f32x4 b0, f32x4 b1) const {
        const size_t o = (size_t)row * D + u.pn * 256 + c0; f32x4 g0, g1, g2, g3; ld_bf8(SGA + o, g0, g1); ld_bf8(SGA + o + 128, g2, g3);
        *(f32x4*)(T1 + o) = a0 * g0; *(f32x4*)(T1 + o + 4) = a1 * g1; *(f32x4*)(T1 + o + 128) = b0 * g2; *(f32x4*)(T1 + o + 132) = b1 * g3;
    }
};
struct EpiGateB {
    const float* T1; const bf16* SGB; bf16* MG;
    template <bool MF> __device__ __forceinline__ void row8(int row, const Unit& u, int c0, f32x4 a0, f32x4 a1, f32x4 b0, f32x4 b1) const {
        const size_t o = (size_t)row * D + u.pn * 256 + c0; f32x4 g0, g1, g2, g3; ld_bf8(SGB + o, g0, g1); ld_bf8(SGB + o + 128, g2, g3);
        const f32x4 t0 = *(const f32x4*)(T1 + o), t1 = *(const f32x4*)(T1 + o + 4), t2 = *(const f32x4*)(T1 + o + 128), t3 = *(const f32x4*)(T1 + o + 132);
        st_bf8(MG + o, t0 + a0 * g0, t1 + a1 * g1); st_bf8(MG + o + 128, t2 + b0 * g2, t3 + b1 * g3);
    }
};
struct EpiResid1 {
    const float* X; float* X1; bf16* X1B; float* SS1;
    template <bool MF> __device__ __forceinline__ void row8(int row, const Unit& u, int c0, f32x4 a0, f32x4 a1, f32x4 b0, f32x4 b1) const {
        const size_t o = (size_t)row * D + u.pn * 256 + c0;
        a0 += *(const f32x4*)(X + o); a1 += *(const f32x4*)(X + o + 4); b0 += *(const f32x4*)(X + o + 128); b1 += *(const f32x4*)(X + o + 132);
        *(f32x4*)(X1 + o) = a0; *(f32x4*)(X1 + o + 4) = a1; *(f32x4*)(X1 + o + 128) = b0; *(f32x4*)(X1 + o + 132) = b1;
        st_bf8(X1B + o, a0, a1); st_bf8(X1B + o + 128, b0, b1);
        float s = 0.f;
#pragma unroll
        for (int j = 0; j < 4; ++j) s += a0[j] * a0[j] + a1[j] * a1[j] + b0[j] * b0[j] + b1[j] * b1[j];
        if (MF) { s += __shfl_xor(s, 16); s += __shfl_xor(s, 32); if ((threadIdx.x & 63) < 16) atomicAdd(SS1 + row, s); }
        else atomicAdd(SS1 + row, s);
    }
};
struct EpiXQ {
    bf16* QX; const float* SS1;
    template <bool MF> __device__ __forceinline__ void row8(int row, const Unit& u, int c0, f32x4 a0, f32x4 a1, f32x4 b0, f32x4 b1) const {
        const float r = rsqrtf(SS1[row] * (1.0f / D) + EPS); bf16* p = QX + (size_t)row * XA + u.pn * 256 + c0;
        st_bf8(p, a0 * r, a1 * r); st_bf8(p + 128, b0 * r, b1 * r);
    }
};
struct EpiResid2 {
    float* X1;
    template <bool MF> __device__ __forceinline__ void row8(int row, const Unit& u, int c0, f32x4 a0, f32x4 a1, f32x4 b0, f32x4 b1) const {
        float* p = X1 + (size_t)row * D + u.pn * 256 + c0;
        *(f32x4*)p = *(const f32x4*)p + a0; *(f32x4*)(p + 4) = *(const f32x4*)(p + 4) + a1; *(f32x4*)(p + 128) = *(const f32x4*)(p + 128) + b0; *(f32x4*)(p + 132) = *(const f32x4*)(p + 132) + b1;
    }
};
struct EpiGU {
    bf16* ACT; const float* gub;
    template <bool MF> __device__ __forceinline__ void row8(int row, const Unit& u, int c0, f32x4 a0, f32x4 a1, f32x4 b0, f32x4 b1) const {
        const int f = u.pn * 128 + c0; const float* bg = gub + (size_t)u.e * (2 * FF) + f;
        const f32x4 g0 = *(const f32x4*)bg, g1 = *(const f32x4*)(bg + 4), u0 = *(const f32x4*)(bg + FF), u1 = *(const f32x4*)(bg + FF + 4);
        f32x4 r0, r1;
#pragma unroll
        for (int j = 0; j < 4; ++j) {
            float g = fminf(a0[j] + g0[j], 7.0f), up = fminf(fmaxf(b0[j] + u0[j], -7.0f), 7.0f); r0[j] = (up + 1.0f) * g * sigmoidf_(1.702f * g);
            g = fminf(a1[j] + g1[j], 7.0f); up = fminf(fmaxf(b1[j] + u1[j], -7.0f), 7.0f); r1[j] = (up + 1.0f) * g * sigmoidf_(1.702f * g);
        }
        st_bf8(ACT + (size_t)row * FF + f, r0, r1);
    }
};
struct EpiDown {
    bf16* YS; const float* dnb;
    template <bool MF> __device__ __forceinline__ void row8(int row, const Unit& u, int c0, f32x4 a0, f32x4 a1, f32x4 b0, f32x4 b1) const {
        const int col = u.pn * 256 + c0; const float* bb = dnb + (size_t)u.e * D + col; bf16* p = YS + (size_t)row * D + col;
        st_bf8(p, a0 + *(const f32x4*)bb, a1 + *(const f32x4*)(bb + 4)); st_bf8(p + 128, b0 + *(const f32x4*)(bb + 128), b1 + *(const f32x4*)(bb + 132));
    }
};

__device__ __forceinline__ void tr_item(const float* W, int ldw, int K, int srccol0, bf16* WT, int dstrow0, const float* ksc, LAS float* scr, int kb, int lane) {
    const int k0 = 64 * kb;
#pragma unroll 8
    for (int i = 0; i < 32; ++i) { const int kk = 2 * i + (lane >> 5); float v = W[(size_t)(k0 + kk) * ldw + srccol0 + (lane & 31)]; if (ksc) v *= ksc[k0 + kk]; scr[kk * 33 + (lane & 31)] = v; }
    LDS_WAIT(); asm volatile("" ::: "memory");
    const int c = lane & 7;
#pragma unroll
    for (int j = 0; j < 4; ++j) { const int n = (lane >> 3) + 8 * j; const LAS float* s = scr + (8 * c) * 33 + n;
        u32x4 o; o.x = pk2(s[0 * 33], s[1 * 33]); o.y = pk2(s[2 * 33], s[3 * 33]); o.z = pk2(s[4 * 33], s[5 * 33]); o.w = pk2(s[6 * 33], s[7 * 33]);
        *(u32x4*)(WT + (size_t)(dstrow0 + n) * K + k0 + 8 * c) = o; }
    LDS_WAIT(); asm volatile("" ::: "memory");
}
__device__ __forceinline__ void fold_item(const float* Win, const float* GW, bf16* WT, int n0, LAS float* scr, int kb, int lane) {
    const int k0 = 64 * kb, nn = lane & 31;
    float gw[16];
#pragma unroll
    for (int r = 0; r < 16; ++r) gw[r] = GW[r * QK + n0 + nn];
#pragma unroll 4
    for (int i = 0; i < 32; ++i) { const int kk = 2 * i + (lane >> 5); const float* wr = Win + (size_t)(k0 + kk) * NIN_SRC + SRC_ALOW; float v = 0.f;
#pragma unroll
        for (int r = 0; r < 16; ++r) v += wr[r] * gw[r];
        scr[kk * 33 + nn] = v; }
    LDS_WAIT(); asm volatile("" ::: "memory");
    const int c = lane & 7;
#pragma unroll
    for (int j = 0; j < 4; ++j) { const int n = (lane >> 3) + 8 * j; const LAS float* s = scr + (8 * c) * 33 + n;
        u32x4 o; o.x = pk2(s[0 * 33], s[1 * 33]); o.y = pk2(s[2 * 33], s[3 * 33]); o.z = pk2(s[4 * 33], s[5 * 33]); o.w = pk2(s[6 * 33], s[7 * 33]);
        *(u32x4*)(WT + (size_t)(TN_LA * 256 + n0 + n) * D + k0 + 8 * c) = o; }
    LDS_WAIT(); asm volatile("" ::: "memory");
}
__device__ __forceinline__ void rms_row_to_bf16(const float* xrow, const float* g, bf16* orow, int lane) {
    f32x4 v[8]; float s = 0.f;
#pragma unroll
    for (int j = 0; j < 8; ++j) { v[j] = *(const f32x4*)(xrow + 4 * lane + 256 * j); s += (v[j][0] * v[j][0] + v[j][1] * v[j][1]) + (v[j][2] * v[j][2] + v[j][3] * v[j][3]); }
    const float r = rsqrtf(wave_sum(s) * (1.0f / D) + EPS);
#pragma unroll
    for (int j = 0; j < 8; ++j) { const f32x4 gg = *(const f32x4*)(g + 4 * lane + 256 * j); u32x2 o; o.x = pk2(v[j][0] * r * gg[0], v[j][1] * r * gg[1]); o.y = pk2(v[j][2] * r * gg[2], v[j][3] * r * gg[3]); *(u32x2*)(orow + 4 * lane + 256 * j) = o; }
}
__device__ __forceinline__ void p0_prologue(Frame& F) {
    LAS float* scr = (LAS float*)(F.lds + F.wave * 16384);
    const int gw = F.bid * NWAVES + F.wave, NGW = F.G * NWAVES, lane = F.lane;
    const float* Win = F.in[I_WIN];
    bf16* WIN = WSP(bf16, WS_WIN);
    for (int it = gw; it < 544 * 32; it += NGW) {
        const int nb = it % 544, kb = it / 544, n0 = 32 * nb;
        if (n0 >= TN_LA * 256 && n0 < TN_CB * 256) { fold_item(Win, F.in[I_GGW], WIN, n0 - TN_LA * 256, scr, kb, lane); continue; }
        int src;
        if (n0 < TN_LA * 256) src = n0;
        else if (n0 < TN_U * 256) src = SRC_CB + (n0 - TN_CB * 256);
        else if (n0 < TN_GA * 256) { const int rel = n0 - TN_U * 256, p = rel >> 8, w = rel & 255; src = (w < 128) ? SRC_CC + 128 * p + w : SRC_CHH + 128 * p + (w - 128); }
        else if (n0 < TN_GB * 256) src = SRC_GA + (n0 - TN_GA * 256);
        else src = SRC_GB + (n0 - TN_GB * 256);
        tr_item(Win, NIN_SRC, D, src, WIN, n0, nullptr, scr, kb, lane);
    }
    for (int it = gw; it < 3 * 2048; it += NGW) { const int w = it / 2048, r = it % 2048, nb = r % 64, kb = r / 64;
        const float* W = F.in[w == 0 ? I_GOW : (w == 1 ? I_COW : I_MXW)]; bf16* WT = WSP(bf16, w == 0 ? WS_WGO : (w == 1 ? WS_WCO : WS_WMX));
        tr_item(W, D, D, 32 * nb, WT, 32 * nb, nullptr, scr, kb, lane); }
    for (int it = gw; it < 3 * 512; it += NGW) { const int w = it / 512, r = it % 512, nb = r % 16, kb = r / 16;
        if (w == 0) tr_item(F.in[I_XQ], XA, D, 32 * nb, WSP(bf16, WS_WXQ), 32 * nb, F.in[I_NXG], scr, kb, lane);
        else tr_item(F.in[w == 1 ? I_XK : I_XV], XA, D, 32 * nb, WSP(bf16, WS_WXKV), (w - 1) * XA + 32 * nb, nullptr, scr, kb, lane); }
    for (int it = gw; it < 512; it += NGW) { const int nb = it % 64, kb = it / 64; tr_item(F.in[I_XO], D, XA, 32 * nb, WSP(bf16, WS_WXO), 32 * nb, nullptr, scr, kb, lane); }
    for (int it = gw; it < NE * 4096; it += NGW) { const int e = it / 4096, r = it % 4096, nb = r % 128, kb = r / 128, n0 = 32 * nb, p = n0 >> 8, w = n0 & 255;
        const int src = (w < 128) ? 128 * p + w : FF + 128 * p + (w - 128);
        tr_item(F.in[I_GUW] + (size_t)e * D * (2 * FF), 2 * FF, D, src, WSP(bf16, WS_WGU) + (size_t)e * (2 * FF) * D, n0, nullptr, scr, kb, lane); }
    for (int it = gw; it < NE * 2048; it += NGW) { const int e = it / 2048, r = it % 2048, nb = r % 64, kb = r / 64;
        tr_item(F.in[I_DNW] + (size_t)e * FF * D, D, FF, 32 * nb, WSP(bf16, WS_WDN) + (size_t)e * D * FF, 32 * nb, nullptr, scr, kb, lane); }
    { const float* rw = F.in[I_RW]; const float* g = F.in[I_NMOEG]; float* WR = WSP(float, WS_WR);
      for (int i = F.bid * NTHR + F.tid; i < NE * D; i += F.G * NTHR) { const int e = i / D, k = i % D; WR[i] = rw[k * NE + e] * g[k]; } }
    for (int m = gw; m < T; m += NGW) rms_row_to_bf16(F.in[I_X] + (size_t)m * D, F.in[I_NMIXG], WSP(bf16, WS_XN) + (size_t)m * D, lane);
    for (int m = gw; m < MEM; m += NGW) rms_row_to_bf16(F.in[I_MEM] + (size_t)m * D, F.in[I_NMG], WSP(bf16, WS_MEMN) + (size_t)m * D, lane);
    { u32x4* z = (u32x4*)(WSP(bf16, WS_H3) + (size_t)T * D); for (int i = F.bid * NTHR + F.tid; i < 256; i += F.G * NTHR) z[i] = (u32x4){0u, 0u, 0u, 0u}; }
}

__device__ __forceinline__ void p_memkv(Frame& F) {
    const bf16* A = WSP(bf16, WS_MEMN); const bf16* B = WSP(bf16, WS_WXKV); bf16* KM = WSP(bf16, WS_KM); bf16* VMT = WSP(bf16, WS_VMT);
    for (int o = F.bid * NTHR + F.tid; o < MEM * 2 * XA; o += F.G * NTHR) {
        const int m = o & 255, n = o >> 8;
        const bf16* a = A + (size_t)m * D; const bf16* b = B + (size_t)n * D; float s = 0.f;
        for (int k = 0; k < D; k += 8) { f32x4 a0, a1, b0, b1; ld_bf8(a + k, a0, a1); ld_bf8(b + k, b0, b1);
#pragma unroll
            for (int j = 0; j < 4; ++j) s += a0[j] * b0[j] + a1[j] * b1[j]; }
        if (n < XA) KM[(size_t)m * XA + n] = (bf16)f2bf(s); else VMT[(size_t)(n - XA) * MEM + m] = (bf16)f2bf(s);
    }
}

__device__ __forceinline__ void p_conv(Frame& F) {
    const bf16* U = WSP(bf16, WS_U); const bf16* CB = WSP(bf16, WS_CB); bf16* Z = WSP(bf16, WS_Z);
    const float* cw = F.in[I_CW]; const float* cb = F.in[I_CBIAS];
    for (int task = F.bid * NTHR + F.tid; task < (T / 64) * (D / 8); task += F.G * NTHR) {
        const int cg = task & 255, tb = task >> 8, c = 8 * cg, t0 = 64 * tb;
        f32x4 w0a = *(const f32x4*)(cw + c), w0b = *(const f32x4*)(cw + c + 4), w1a = *(const f32x4*)(cw + D + c), w1b = *(const f32x4*)(cw + D + c + 4);
        f32x4 w2a = *(const f32x4*)(cw + 2 * D + c), w2b = *(const f32x4*)(cw + 2 * D + c + 4), ba = *(const f32x4*)(cb + c), bb = *(const f32x4*)(cb + c + 4);
        f32x4 p2a = {0.f, 0.f, 0.f, 0.f}, p2b = p2a, p1a = p2a, p1b = p2a;
        if (t0 >= 2) { ld_bf8(U + (size_t)(t0 - 2) * D + c, p2a, p2b); ld_bf8(U + (size_t)(t0 - 1) * D + c, p1a, p1b); }
        for (int t = t0; t < t0 + 64; ++t) {
            f32x4 ua, ub, ca, cbv; ld_bf8(U + (size_t)t * D + c, ua, ub); ld_bf8(CB + (size_t)t * D + c, ca, cbv);
            const f32x4 ya = ca * (w0a * p2a + w1a * p1a + w2a * ua + ba), yb = cbv * (w0b * p2b + w1b * p1b + w2b * ub + bb);
            st_bf8(Z + (size_t)t * D + c, ya, yb);
            p2a = p1a; p2b = p1b; p1a = ua; p1b = ub;
        }
    }
}
__device__ __forceinline__ void p_glaprep(Frame& F) {
    const bf16* Q = WSP(bf16, WS_Q); const bf16* Kk = WSP(bf16, WS_K); const bf16* V = WSP(bf16, WS_V); const float* LA = WSP(float, WS_LA);
    bf16* QT = WSP(bf16, WS_QT); bf16* KH = WSP(bf16, WS_KH); bf16* KHT = WSP(bf16, WS_KHT); bf16* QG = WSP(bf16, WS_QG); bf16* VT = WSP(bf16, WS_VT);
    float* DL = WSP(float, WS_DL); float* DG = WSP(float, WS_DG);
    LAS float* part = (LAS float*)F.lds;
    const int col = F.tid & 63, sub = F.tid >> 6;
    for (int unit = F.bid; unit < NG * 16; unit += F.G) {
        const int g = unit >> 4, cs = unit & 15, gc = cs * 64 + col, h = gc >> 8, kc = gc & 255;
        float carry = 0.f;
        for (int c = 0; c < GC; ++c) {
            const int chunk = g * GC + c, t0 = chunk * CH + 8 * sub;
            float la[8], qv[8], kv[8];
#pragma unroll
            for (int j = 0; j < 8; ++j) { la[j] = LA[(size_t)(t0 + j) * QK + gc]; qv[j] = bf2f(Q[(size_t)(t0 + j) * QK + gc]); kv[j] = bf2f(Kk[(size_t)(t0 + j) * QK + gc]); }
#pragma unroll
            for (int j = 1; j < 8; ++j) la[j] += la[j - 1];
            __syncthreads();
            part[sub * 64 + col] = la[7];
            __syncthreads();
            float off = 0.f, tot = 0.f;
#pragma unroll
            for (int s = 0; s < 8; ++s) { const float p = part[s * 64 + col]; off += (s < sub) ? p : 0.f; tot += p; }
            unsigned kt[4];
#pragma unroll
            for (int j = 0; j < 8; ++j) { const float b = off + la[j], eb = __expf(b), enb = __expf(-b), eg = __expf(carry + b);
                QT[(size_t)(t0 + j) * QK + gc] = (bf16)f2bf(qv[j] * eb); const unsigned khv = f2bf(kv[j] * enb); KH[(size_t)(t0 + j) * QK + gc] = (bf16)khv;
                QG[(size_t)(t0 + j) * QK + gc] = (bf16)f2bf(qv[j] * eg);
                if (j & 1) kt[j >> 1] |= khv << 16; else kt[j >> 1] = khv; }
            *(u32x4*)(KHT + ((size_t)(chunk * GH + h) * DK + kc) * CH + 8 * sub) = (u32x4){kt[0], kt[1], kt[2], kt[3]};
            if (sub == 0) DL[(size_t)chunk * QK + gc] = __expf(tot);
            carry += tot;
        }
        if (sub == 0) DG[(size_t)g * QK + gc] = __expf(carry);
    }
    for (int unit = F.bid; unit < NCH * (VD / 64); unit += F.G) {
        const int chunk = unit >> 5, vs = unit & 31, vc = vs * 64 + col, t0 = chunk * CH + 8 * sub;
        unsigned w[4];
#pragma unroll
        for (int j = 0; j < 8; ++j) { const unsigned x = V[(size_t)(t0 + j) * VD + vc]; if (j & 1) w[j >> 1] |= x << 16; else w[j >> 1] = x; }
        *(u32x4*)(VT + ((size_t)chunk * VD + vc) * CH + 8 * sub) = (u32x4){w[0], w[1], w[2], w[3]};
    }
}

__device__ __forceinline__ void p_gla_ref(Frame& F) {
    const bf16* Q = WSP(bf16, WS_Q); const bf16* Kk = WSP(bf16, WS_K); const bf16* V = WSP(bf16, WS_V); const float* LA = WSP(float, WS_LA); float* O32 = WSP(float, WS_O32);
    LAS float* red = (LAS float*)F.lds;
    const int k = F.tid & 255, vh = F.tid >> 8;
    for (int unit = F.bid; unit < GH * 64; unit += F.G) {
        const int h = unit >> 6, vb = unit & 63, vcol = h * DV + vb * 8 + vh * 4;
        float s0 = 0.f, s1 = 0.f, s2 = 0.f, s3 = 0.f;
        for (int tb = 0; tb < T; tb += 8) {
            LAS float* rb = red + ((tb >> 3) & 1) * 256;
#pragma unroll
            for (int j = 0; j < 8; ++j) {
                const int t = tb + j; const float a = __expf(LA[(size_t)t * QK + h * DK + k]), kk = bf2f(Kk[(size_t)t * QK + h * DK + k]), qq = bf2f(Q[(size_t)t * QK + h * DK + k]);
                const u32x2 vv = *(const u32x2*)(V + (size_t)t * VD + vcol);
                const float v0 = __uint_as_float(vv.x << 16), v1 = __uint_as_float(vv.x & 0xffff0000u), v2 = __uint_as_float(vv.y << 16), v3 = __uint_as_float(vv.y & 0xffff0000u);
                s0 = a * s0 + kk * v0; s1 = a * s1 + kk * v1; s2 = a * s2 + kk * v2; s3 = a * s3 + kk * v3;
                const float p0 = wave_sum(qq * s0), p1 = wave_sum(qq * s1), p2 = wave_sum(qq * s2), p3 = wave_sum(qq * s3);
                if (F.lane == 0) *(LAS f32x4*)(rb + (j * 8 + F.wave) * 4) = (f32x4){p0, p1, p2, p3};
            }
            __syncthreads();
            if (F.tid < 64) { const int j = F.tid >> 3, vhh = (F.tid >> 2) & 1, q = F.tid & 3; float s = 0.f;
#pragma unroll
                for (int w = 0; w < 4; ++w) s += rb[(j * 8 + vhh * 4 + w) * 4 + q];
                O32[(size_t)(tb + j) * VD + h * DV + vb * 8 + vhh * 4 + q] = s; }
        }
        __syncthreads();
    }
}
__device__ __forceinline__ void p_gla_norm_ref(Frame& F) {
    const float* O32 = WSP(float, WS_O32); const bf16* SR = WSP(bf16, WS_SR); bf16* OA = WSP(bf16, WS_OA); const float* g = F.in[I_GNG];
    const int gw = F.bid * NWAVES + F.wave, NGW = F.G * NWAVES;
    for (int it = gw; it < T * GH; it += NGW) {
        const size_t o = (size_t)it * DV + 8 * F.lane;
        const f32x4 a = *(const f32x4*)(O32 + o), b = *(const f32x4*)(O32 + o + 4);
        float s = 0.f;
#pragma unroll
        for (int j = 0; j < 4; ++j) s += a[j] * a[j] + b[j] * b[j];
        const float r = rsqrtf(wave_sum(s) * (1.0f / DV) + EPS);
        f32x4 s0, s1; ld_bf8(SR + o, s0, s1);
        const f32x4 g0 = *(const f32x4*)(g + 8 * F.lane), g1 = *(const f32x4*)(g + 8 * F.lane + 4);
        st_bf8(OA + o, a * r * g0 * s0, b * r * g1 * s1);
    }
}

__device__ __forceinline__ void p_attn_ref(Frame& F) {
    const bf16* QX = WSP(bf16, WS_QX); const bf16* KM = WSP(bf16, WS_KM); const bf16* VMT = WSP(bf16, WS_VMT); bf16* OX = WSP(bf16, WS_OX);
    LAS float* pbuf = (LAS float*)F.lds + F.wave * 256;
    const int gw = F.bid * NWAVES + F.wave, NGW = F.G * NWAVES, lane = F.lane;
    for (int it = gw; it < T * XH; it += NGW) {
        const int t = it >> 2, h = it & 3; const bf16* q = QX + (size_t)t * XA + h * XD;
        float s[4] = {0.f, 0.f, 0.f, 0.f};
        for (int d = 0; d < XD; d += 8) { f32x4 q0, q1; ld_bf8(q + d, q0, q1);
#pragma unroll
            for (int c = 0; c < 4; ++c) { f32x4 k0, k1; ld_bf8(KM + (size_t)(lane + 64 * c) * XA + h * XD + d, k0, k1);
#pragma unroll
                for (int j = 0; j < 4; ++j) s[c] += q0[j] * k0[j] + q1[j] * k1[j]; } }
        const float sc = 0.08838834764831845f;
        float mx = fmaxf(fmaxf(s[0], s[1]), fmaxf(s[2], s[3])) * sc; mx = wave_max(mx);
        float e[4], sum = 0.f;
#pragma unroll
        for (int c = 0; c < 4; ++c) { e[c] = __expf(s[c] * sc - mx); sum += e[c]; }
        sum = wave_sum(sum); const float inv = 1.0f / sum;
#pragma unroll
        for (int c = 0; c < 4; ++c) pbuf[lane + 64 * c] = bf2f((unsigned short)f2bf(e[c] * inv));
        LDS_WAIT(); asm volatile("" ::: "memory");
        float o0 = 0.f, o1 = 0.f; const bf16* v0 = VMT + (size_t)(h * XD + 2 * lane) * MEM; const bf16* v1 = v0 + MEM;
        for (int m = 0; m < MEM; m += 8) { f32x4 a0, a1, b0, b1; ld_bf8(v0 + m, a0, a1); ld_bf8(v1 + m, b0, b1); const f32x4 p0 = *(const LAS f32x4*)(pbuf + m), p1 = *(const LAS f32x4*)(pbuf + m + 4);
#pragma unroll
            for (int j = 0; j < 4; ++j) { o0 += p0[j] * a0[j] + p1[j] * a1[j]; o1 += p0[j] * b0[j] + p1[j] * b1[j]; } }
        *(unsigned*)(OX + (size_t)t * XA + h * XD + 2 * lane) = pk2(o0, o1);
        LDS_WAIT(); asm volatile("" ::: "memory");
    }
}

typedef float f32x16 __attribute__((ext_vector_type(16)));
__device__ __forceinline__ void p_router(Frame& F) {
    const float* X2 = WSP(float, WS_X1); bf16* H3 = WSP(bf16, WS_H3); const float* WR = WSP(float, WS_WR); const float* g = F.in[I_NMOEG]; const float* rb = F.in[I_RB];
    int* TKE = WSP(int, WS_TKE); int* TKP = WSP(int, WS_TKP); float* TKW = WSP(float, WS_TKW); unsigned* cnt = F.ctl + CW_CNT;
    LAS unsigned* lcnt = (LAS unsigned*)F.lds;
    LAS int* le = (LAS int*)(F.lds + 256);
    LAS int* lp = (LAS int*)(F.lds + 256 + 1024);
    LAS float* P = (LAS float*)(F.lds + 4096);
    LAS float* SSQ = (LAS float*)(F.lds + 4096 + 8 * 32 * 33 * 4);
    const int lane = F.lane, th = F.wave & 1, kq = F.wave >> 1, li = lane & 31, hh = lane >> 5;
    for (int blk = F.bid; blk < T / 64; blk += F.G) {
        __syncthreads();
        if (F.tid < 64) lcnt[F.tid] = 0u;
        const float* xr = X2 + (size_t)(blk * 64 + th * 32 + li) * D + kq * 512 + 4 * hh;
        const float* wr = WR + (size_t)li * D + kq * 512 + 4 * hh;
        f32x16 acc;
#pragma unroll
        for (int r = 0; r < 16; ++r) acc[r] = 0.f;
        float ss = 0.f;
#pragma unroll 4
        for (int q = 0; q < 64; ++q) {
            const f32x4 a = *(const f32x4*)(xr + 8 * q), b = *(const f32x4*)(wr + 8 * q);
            ss += (a[0] * a[0] + a[1] * a[1]) + (a[2] * a[2] + a[3] * a[3]);
#pragma unroll
            for (int s = 0; s < 4; ++s) acc = __builtin_amdgcn_mfma_f32_32x32x2f32(a[s], b[s], acc, 0, 0, 0);
        }
        ss += __shfl_xor(ss, 32);
#pragma unroll
        for (int r = 0; r < 16; ++r) P[(F.wave * 32 + (r & 3) + 8 * (r >> 2) + 4 * hh) * 33 + li] = acc[r];
        if (lane < 32) SSQ[F.wave * 32 + lane] = ss;
        __syncthreads();
        if (F.tid < 64) {
            const int tl = F.tid, th2 = tl >> 5, ti = tl & 31, t = blk * 64 + tl;
            float ssq = 0.f;
#pragma unroll
            for (int k4 = 0; k4 < 4; ++k4) ssq += SSQ[(k4 * 2 + th2) * 32 + ti];
            const float r = rsqrtf(ssq * (1.0f / D) + EPS);
            float v0 = -3.0e38f, v1 = -3.0e38f, v2 = -3.0e38f, v3 = -3.0e38f; int i0 = 0, i1 = 0, i2 = 0, i3 = 0;
            for (int e = 0; e < NE; ++e) {
                float x = 0.f;
#pragma unroll
                for (int k4 = 0; k4 < 4; ++k4) x += P[((k4 * 2 + th2) * 32 + ti) * 33 + e];
                x = x * r + rb[e];
                if (x > v3) {
                    if (x > v2) { v3 = v2; i3 = i2;
                        if (x > v1) { v2 = v1; i2 = i1;
                            if (x > v0) { v1 = v0; i1 = i0; v0 = x; i0 = e; } else { v1 = x; i1 = e; } }
                        else { v2 = x; i2 = e; } }
                    else { v3 = x; i3 = e; } }
            }
            const float e1 = __expf(v1 - v0), e2 = __expf(v2 - v0), e3 = __expf(v3 - v0), inv = 1.0f / (1.0f + e1 + e2 + e3);
            const unsigned p0 = __hip_atomic_fetch_add(lcnt + i0, 1u, __ATOMIC_RELAXED, __HIP_MEMORY_SCOPE_WORKGROUP);
            const unsigned p1 = __hip_atomic_fetch_add(lcnt + i1, 1u, __ATOMIC_RELAXED, __HIP_MEMORY_SCOPE_WORKGROUP);
            const unsigned p2 = __hip_atomic_fetch_add(lcnt + i2, 1u, __ATOMIC_RELAXED, __HIP_MEMORY_SCOPE_WORKGROUP);
            const unsigned p3 = __hip_atomic_fetch_add(lcnt + i3, 1u, __ATOMIC_RELAXED, __HIP_MEMORY_SCOPE_WORKGROUP);
            le[tl * 4 + 0] = i0; le[tl * 4 + 1] = i1; le[tl * 4 + 2] = i2; le[tl * 4 + 3] = i3;
            lp[tl * 4 + 0] = (int)p0; lp[tl * 4 + 1] = (int)p1; lp[tl * 4 + 2] = (int)p2; lp[tl * 4 + 3] = (int)p3;
            *(int4*)(TKE + t * 4) = make_int4(i0, i1, i2, i3);
            *(f32x4*)(TKW + t * 4) = (f32x4){inv, e1 * inv, e2 * inv, e3 * inv};
        }
        __syncthreads();
        if (F.tid < NE) lcnt[32 + F.tid] = __hip_atomic_fetch_add(cnt + 64 * F.tid, lcnt[F.tid], RLX_AGENT);
        __syncthreads();
        if (F.tid < 256) { const int tl = F.tid >> 2, k = F.tid & 3; TKP[(blk * 64 + tl) * 4 + k] = lp[tl * 4 + k] + (int)lcnt[32 + le[tl * 4 + k]]; }
        for (int tt = 0; tt < 8; ++tt) { const int t = blk * 64 + F.wave * 8 + tt; rms_row_to_bf16(X2 + (size_t)t * D, g, H3 + (size_t)t * D, lane); }
    }
}
__device__ __forceinline__ void p_lists(Frame& F) {
    unsigned* cnt = F.ctl + CW_CNT; int* TKE = WSP(int, WS_TKE); int* TKP = WSP(int, WS_TKP); int* ROWTOK = WSP(int, WS_ROWTOK); int* TILE = WSP(int, WS_TILE);
    LAS int* poff = (LAS int*)F.lds;
    LAS int* lc = (LAS int*)(F.lds + 256);
    __syncthreads();
    if (F.tid < NE) lc[F.tid] = (int)__hip_atomic_load(cnt + 64 * F.tid, RLX_AGENT);
    __syncthreads();
    if (F.tid == 0) { int o = 0; for (int e = 0; e < NE; ++e) { poff[e] = o; o += (lc[e] + 255) / 256 * 256; } poff[NE] = o; }
    __syncthreads();
    for (int i = F.bid * NTHR + F.tid; i < T * TOPK; i += F.G * NTHR) { const int e = TKE[i], slot = poff[e] + TKP[i]; TKP[i] = slot; ROWTOK[slot] = i >> 2; }
    if (F.bid == 0) {
        for (int e = 0; e < NE; ++e) for (int s = poff[e] + lc[e] + F.tid; s < poff[e + 1]; s += NTHR) ROWTOK[s] = T;
        for (int e = 0; e < NE; ++e) for (int tl = poff[e] / 256 + F.tid; tl < poff[e + 1] / 256; tl += NTHR) TILE[tl] = e;
        if (F.tid == 0) TILE[512] = poff[NE] / 256;
    }
    __syncthreads();
}
__device__ __forceinline__ void p_combine(Frame& F) {
    const float* X2 = WSP(float, WS_X1); const bf16* YS = WSP(bf16, WS_YS); const int* TKP = WSP(int, WS_TKP); const float* TKW = WSP(float, WS_TKW); const float* g = F.in[I_NFG];
    const int gw = F.bid * NWAVES + F.wave, NGW = F.G * NWAVES, lane = F.lane;
    for (int t = gw; t < T; t += NGW) {
        int sl[4]; float w[4];
#pragma unroll
        for (int k = 0; k < 4; ++k) { sl[k] = TKP[t * 4 + k]; w[k] = TKW[t * 4 + k]; }
        f32x4 v[8]; float s = 0.f;
#pragma unroll
        for (int j = 0; j < 8; ++j) { v[j] = *(const f32x4*)(X2 + (size_t)t * D + 4 * lane + 256 * j);
#pragma unroll
            for (int k = 0; k < 4; ++k) { const u32x2 y = *(const u32x2*)(YS + (size_t)sl[k] * D + 4 * lane + 256 * j);
                v[j][0] += w[k] * __uint_as_float(y.x << 16); v[j][1] += w[k] * __uint_as_float(y.x & 0xffff0000u); v[j][2] += w[k] * __uint_as_float(y.y << 16); v[j][3] += w[k] * __uint_as_float(y.y & 0xffff0000u); }
            s += (v[j][0] * v[j][0] + v[j][1] * v[j][1]) + (v[j][2] * v[j][2] + v[j][3] * v[j][3]); }
        const float r = rsqrtf(wave_sum(s) * (1.0f / D) + EPS);
#pragma unroll
        for (int j = 0; j < 8; ++j) { const f32x4 gg = *(const f32x4*)(g + 4 * lane + 256 * j); *(f32x4*)(F.out + (size_t)t * D + 4 * lane + 256 * j) = v[j] * r * gg; }
    }
}

constexpr int NPHASE = 16;
__global__ void __launch_bounds__(NTHR, 2) hybrid_fwd(Args args) {
    extern __shared__ __attribute__((aligned(16))) unsigned char lds_raw[];
    Frame F;
    F.lds = (LAS unsigned char*)lds_raw; F.ws = args.ws; F.ctl = (unsigned*)(args.ws + WS_CTL);
    F.tid = threadIdx.x; F.lane = F.tid & 63; F.wave = __builtin_amdgcn_readfirstlane(F.tid >> 6); F.G = gridDim.x; F.bid = blockIdx.x;
    F.in = args.in; F.out = args.out;
    volatile LAS unsigned* MISC = (volatile LAS unsigned*)(F.lds + MISC_OFF);
    if (F.tid < 32) MISC[F.tid] = 0u;
    __syncthreads();
#if MK_ONE_LAUNCH
    XcdBarrier bar = xcd_barrier_post(F.ctl + CW_BAR, MISC + 8);
#define GRID_BAR() xcd_barrier(bar)
#else
#define GRID_BAR() do {} while (0)
#endif
    const int lo = args.ph_lo, hi = args.ph_hi;
#ifndef ONLY_PHASE
#define ONLY_PHASE -1
#endif
#define IN(k) (lo <= (k) && (k) < hi && (ONLY_PHASE < 0 || ONLY_PHASE == (k)))
#define SEAM(k) do { if (IN(k) && IN((k) + 1)) GRID_BAR(); } while (0)

    if (IN(0)) { p0_prologue(F); }
    SEAM(0);
    if (IN(1)) {
        DenseSched S; S.init(WSP(bf16, WS_XN), WSP(bf16, WS_WIN), T, NIN, D, F.G, F.bid);
        EpiInProj E{WSP(bf16, WS_Q), WSP(bf16, WS_K), WSP(bf16, WS_V), WSP(bf16, WS_SR), WSP(bf16, WS_CB), WSP(bf16, WS_U), WSP(bf16, WS_SGA), WSP(bf16, WS_SGB), WSP(float, WS_LA), F.in[I_GGB]};
        gemm_any(F.lds, S, E);
        p_memkv(F);
    }
    SEAM(1);
    if (IN(2)) { p_conv(F); p_glaprep(F); }
    SEAM(2);
    if (IN(3)) {
#if OPT_GLA
#else
        p_gla_ref(F);
#endif
    }
    SEAM(3);
    if (IN(4)) {
#if OPT_GLA
#endif
    }
    SEAM(4);
    if (IN(5)) {
#if OPT_GLA
#else
        p_gla_norm_ref(F);
#endif
    }
    SEAM(5);
    if (IN(6)) {
        { DenseSched S; S.init(WSP(bf16, WS_OA), WSP(bf16, WS_WGO), T, D, D, F.G, F.bid); EpiGateA E{WSP(float, WS_T1), WSP(bf16, WS_SGA)}; gemm_any(F.lds, S, E); }
        VM_WAIT(); __syncthreads();
        { DenseSched S; S.init(WSP(bf16, WS_Z), WSP(bf16, WS_WCO), T, D, D, F.G, F.bid); EpiGateB E{WSP(float, WS_T1), WSP(bf16, WS_SGB), WSP(bf16, WS_MG)}; gemm_any(F.lds, S, E); }
    }
    SEAM(6);
    if (IN(7)) { DenseSched S; S.init(WSP(bf16, WS_MG), WSP(bf16, WS_WMX), T, D, D, F.G, F.bid); EpiResid1 E{F.in[I_X], WSP(float, WS_X1), WSP(bf16, WS_X1B), (float*)(F.ctl + CW_SS1)}; gemm_any(F.lds, S, E); }
    SEAM(7);
    if (IN(8)) { DenseSched S; S.init(WSP(bf16, WS_X1B), WSP(bf16, WS_WXQ), T, XA, D, F.G, F.bid); EpiXQ E{WSP(bf16, WS_QX), (const float*)(F.ctl + CW_SS1)}; gemm_any(F.lds, S, E); }
    SEAM(8);
    if (IN(9)) {
#if OPT_ATT
#else
        p_attn_ref(F);
#endif
    }
    SEAM(9);
    if (IN(10)) { DenseSched S; S.init(WSP(bf16, WS_OX), WSP(bf16, WS_WXO), T, D, XA, F.G, F.bid); EpiResid2 E{WSP(float, WS_X1)}; gemm_any(F.lds, S, E); }
    SEAM(10);
    if (IN(11)) { p_router(F); }
    SEAM(11);
    if (IN(12)) { p_lists(F); }
    SEAM(12);
    if (IN(13)) { const int ntiles = __builtin_amdgcn_readfirstlane(ld_agent_i(WSP(int, WS_TILE) + 512));
        GroupSched S; S.init(WSP(bf16, WS_H3), WSP(bf16, WS_WGU), ntiles, 2 * FF, D, F.G, F.bid, WSP(int, WS_TILE), WSP(int, WS_ROWTOK)); EpiGU E{WSP(bf16, WS_ACT), F.in[I_GUB]}; gemm_any(F.lds, S, E); }
    SEAM(13);
    if (IN(14)) { const int ntiles = __builtin_amdgcn_readfirstlane(ld_agent_i(WSP(int, WS_TILE) + 512));
        GroupSched S; S.init(WSP(bf16, WS_ACT), WSP(bf16, WS_WDN), ntiles, D, FF, F.G, F.bid, WSP(int, WS_TILE), nullptr); EpiDown E{WSP(bf16, WS_YS), F.in[I_DNB]}; gemm_any(F.lds, S, E); }
    SEAM(14);
    if (IN(15)) { p_combine(F); }
#undef IN
#undef SEAM
}

extern "C" void kernel_launch(void* const* d_in, const int* in_sizes, int n_in, void* d_out, int out_size, void* d_ws, size_t ws_size, hipStream_t stream) {
    static int grid = 0;
    if (grid == 0) {
        if (n_in != 26 || out_size != T * D || ws_size < WS_END) { fprintf(stderr, "kernel_launch: unexpected problem (n_in %d, out %d, ws %zu < %zu)\n", n_in, out_size, ws_size, (size_t)WS_END); grid = -1; return; }
        int dev = 0, cus = 0, per_cu = 0;
        if (hipGetDevice(&dev) != hipSuccess || hipDeviceGetAttribute(&cus, hipDeviceAttributeMultiprocessorCount, dev) != hipSuccess) { grid = -1; return; }
        if (hipFuncSetAttribute((const void*)hybrid_fwd, hipFuncAttributeMaxDynamicSharedMemorySize, LDS_BYTES) != hipSuccess) { fprintf(stderr, "kernel_launch: hipFuncSetAttribute failed\n"); grid = -1; return; }
        if (hipOccupancyMaxActiveBlocksPerMultiprocessor(&per_cu, (const void*)hybrid_fwd, NTHR, LDS_BYTES) != hipSuccess || per_cu < 1) fprintf(stderr, "kernel_launch: occupancy query says %d\n", per_cu);
        (void)hipGetLastError();
        grid = cus;
    }
    if (grid < 0) return;
    (void)hipMemsetAsync((char*)d_ws + WS_CTL, 0, CTL_ZERO_BYTES, stream);
    Args a{};
    for (int i = 0; i < 26; ++i) a.in[i] = (const float*)d_in[i];
    a.out = (float*)d_out; a.ws = (unsigned char*)d_ws;
#if MK_ONE_LAUNCH
    a.ph_lo = 0; a.ph_hi = NPHASE;
    hipLaunchKernelGGL(hybrid_fwd, dim3(grid), dim3(NTHR), LDS_BYTES, stream, a);
#else
    for (int p = 0; p < NPHASE; ++p) { a.ph_lo = p; a.ph_hi = p + 1; hipLaunchKernelGGL(hybrid_fwd, dim3(grid), dim3(NTHR), LDS_BYTES, stream, a); }
#endif
}
```

```cpp
#include <hip/hip_runtime.h>
#include <cstdio>
#include <cstdint>

#ifndef MK_ONE_LAUNCH
#define MK_ONE_LAUNCH 1
#endif
#ifndef OPT_GEMM
#define OPT_GEMM 1
#endif
#ifndef OPT_GLA
#define OPT_GLA 1
#endif
#ifndef OPT_ATT
#define OPT_ATT 0
#endif

#define GAS __attribute__((address_space(1)))
#define LAS __attribute__((address_space(3)))
typedef unsigned short bf16;
typedef short bf16x8 __attribute__((ext_vector_type(8)));
typedef short bf16x4 __attribute__((ext_vector_type(4)));
typedef float f32x4 __attribute__((ext_vector_type(4)));
typedef float f32x2 __attribute__((ext_vector_type(2)));
typedef unsigned u32x4 __attribute__((ext_vector_type(4)));
typedef unsigned u32x2 __attribute__((ext_vector_type(2)));
#define RLX_AGENT __ATOMIC_RELAXED, __HIP_MEMORY_SCOPE_AGENT
#define LDS_WAIT() asm volatile("s_waitcnt lgkmcnt(0)" ::: "memory")
#define VM_WAIT() asm volatile("s_waitcnt vmcnt(0)" ::: "memory")

constexpr int T = 16384, D = 2048, MEM = 256;
constexpr int GH = 4, DK = 256, DV = 512, QK = GH * DK  , VD = GH * DV  ;
constexpr int CH = 64, NCH = T / CH  , NG = 16, GC = NCH / NG  , GT = GC * CH  ;
constexpr int XH = 4, XD = 128, XA = XH * XD  ;
constexpr int NE = 32, TOPK = 4, FF = 2048;
constexpr int NIN_SRC = 16400, NIN = 17408;
constexpr float EPS = 1e-5f;
constexpr int PROWS = T * TOPK + NE * 256;
constexpr int MAXTILES = PROWS / 256;

constexpr int SRC_ALOW = 6144, SRC_CB = 6160, SRC_CC = 8208, SRC_CHH = 10256, SRC_GA = 12304, SRC_GB = 14352;
constexpr int TN_Q = 0, TN_K = 4, TN_V = 8, TN_R = 16, TN_LA = 24, TN_CB = 28, TN_U = 36, TN_GA = 52, TN_GB = 60, TN_END = 68;

constexpr size_t MiB = 1u << 20;
constexpr size_t WS_CTL = 0, CTL_ZERO_BYTES = 1 * MiB;
constexpr size_t WS_WIN = 1 * MiB;
constexpr size_t WS_WGO = WS_WIN + 68 * MiB;
constexpr size_t WS_WCO = WS_WGO + 8 * MiB;
constexpr size_t WS_WMX = WS_WCO + 8 * MiB;
constexpr size_t WS_WXQ = WS_WMX + 8 * MiB;
constexpr size_t WS_WXKV = WS_WXQ + 2 * MiB;
constexpr size_t WS_WXO = WS_WXKV + 4 * MiB;
constexpr size_t WS_WR = WS_WXO + 2 * MiB;
constexpr size_t WS_WGU = WS_WR + 1 * MiB;
constexpr size_t WS_WDN = WS_WGU + 512 * MiB;
constexpr size_t WS_XN = WS_WDN + 256 * MiB;
constexpr size_t WS_Q = WS_XN + 64 * MiB;
constexpr size_t WS_K = WS_Q + 32 * MiB;
constexpr size_t WS_V = WS_K + 32 * MiB;
constexpr size_t WS_SR = WS_V + 64 * MiB;
constexpr size_t WS_LA = WS_SR + 64 * MiB;
constexpr size_t WS_CB = WS_LA + 64 * MiB;
constexpr size_t WS_U = WS_CB + 64 * MiB;
constexpr size_t WS_SGA = WS_U + 64 * MiB;
constexpr size_t WS_SGB = WS_SGA + 64 * MiB;
constexpr size_t WS_QT = WS_SGB + 64 * MiB;
constexpr size_t WS_KH = WS_QT + 32 * MiB;
constexpr size_t WS_KHT = WS_KH + 32 * MiB;
constexpr size_t WS_QG = WS_KHT + 32 * MiB;
constexpr size_t WS_VT = WS_QG + 32 * MiB;
constexpr size_t WS_DL = WS_VT + 64 * MiB;
constexpr size_t WS_DG = WS_DL + 1 * MiB;
constexpr size_t WS_Z = WS_DG + 1 * MiB;
constexpr size_t WS_OL = WS_Z + 64 * MiB;
constexpr size_t WS_SLOC = WS_OL + 64 * MiB;
constexpr size_t WS_SG0 = WS_SLOC + 32 * MiB;
constexpr size_t WS_O32 = WS_SG0 + 16 * MiB;
constexpr size_t WS_OA = WS_O32 + 128 * MiB;
constexpr size_t WS_T1 = WS_OA + 64 * MiB;
constexpr size_t WS_MG = WS_T1 + 128 * MiB;
constexpr size_t WS_X1 = WS_MG + 64 * MiB;
constexpr size_t WS_X1B = WS_X1 + 128 * MiB;
constexpr size_t WS_QX = WS_X1B + 64 * MiB;
constexpr size_t WS_OX = WS_QX + 16 * MiB;
constexpr size_t WS_MEMN = WS_OX + 16 * MiB;
constexpr size_t WS_KM = WS_MEMN + 1 * MiB;
constexpr size_t WS_VMT = WS_KM + 1 * MiB;
constexpr size_t WS_H3 = WS_VMT + 1 * MiB;
constexpr size_t WS_TKE = WS_H3 + 65 * MiB;
constexpr size_t WS_TKP = WS_TKE + 1 * MiB;
constexpr size_t WS_TKW = WS_TKP + 1 * MiB;
constexpr size_t WS_ROWTOK = WS_TKW + 1 * MiB;
constexpr size_t WS_TILE = WS_ROWTOK + 1 * MiB;
constexpr size_t WS_ACT = WS_TILE + 1 * MiB;
constexpr size_t WS_YS = WS_ACT + 288 * MiB;
constexpr size_t WS_END = WS_YS + 288 * MiB;
constexpr int CW_BAR = 4096;
constexpr int CW_CNT = 16384;
constexpr int CW_SS1 = 65536;
static_assert((CW_SS1 + T) * 4 <= (int)CTL_ZERO_BYTES, "ctl");

constexpr int NWAVES = 8, NTHR = 512;
constexpr int LDS_BYTES = 147456;
constexpr int MISC_OFF = 135168;

__device__ __forceinline__ float bf2f(unsigned short b) { return __uint_as_float(((unsigned)b) << 16); }
__device__ __forceinline__ unsigned f2bf(float f) { unsigned u = __float_as_uint(f); return (u + 0x7fffu + ((u >> 16) & 1u)) >> 16; }
__device__ __forceinline__ unsigned pk2(float lo, float hi) { return f2bf(lo) | (f2bf(hi) << 16); }
__device__ __forceinline__ float wave_sum(float v) {
#pragma unroll
    for (int o = 1; o < 64; o <<= 1) v += __shfl_xor(v, o);
    return v;
}
__device__ __forceinline__ float wave_max(float v) {
#pragma unroll
    for (int o = 1; o < 64; o <<= 1) v = fmaxf(v, __shfl_xor(v, o));
    return v;
}
__device__ __forceinline__ float sigmoidf_(float x) { return 1.0f / (1.0f + __expf(-x)); }
__device__ __forceinline__ float logsigmoidf_(float z) { return z < 0.f ? z - log1pf(__expf(z)) : -log1pf(__expf(-z)); }
__device__ __forceinline__ u32x4 pack8(f32x4 a, f32x4 b) { u32x4 w; w.x = pk2(a[0], a[1]); w.y = pk2(a[2], a[3]); w.z = pk2(b[0], b[1]); w.w = pk2(b[2], b[3]); return w; }
__device__ __forceinline__ void unpack8(u32x4 w, f32x4& a, f32x4& b) {
    a[0] = __uint_as_float(w.x << 16); a[1] = __uint_as_float(w.x & 0xffff0000u); a[2] = __uint_as_float(w.y << 16); a[3] = __uint_as_float(w.y & 0xffff0000u);
    b[0] = __uint_as_float(w.z << 16); b[1] = __uint_as_float(w.z & 0xffff0000u); b[2] = __uint_as_float(w.w << 16); b[3] = __uint_as_float(w.w & 0xffff0000u);
}
__device__ __forceinline__ int ld_agent_i(const int* p) { return (int)__hip_atomic_load((const unsigned*)p, RLX_AGENT); }

#define XB_TMO      128
#define XB_XCNT(j)  (256  + 64 * (j))
#define XB_XSUB(j)  (1280 + 64 * (j))
#define XB_XGEN(j)  (2304 + 64 * (j))
#define XB_TOP      3328
#define XB_TOPGEN   3392
#define XCD_BAR_WORDS 3456
#define XB_SPIN_CAP (1u << 22)
__device__ __forceinline__ unsigned xb_ld(unsigned* p)              { return __hip_atomic_load(p, __ATOMIC_RELAXED, __HIP_MEMORY_SCOPE_AGENT); }
__device__ __forceinline__ unsigned xb_add(unsigned* p, unsigned v) { return __hip_atomic_fetch_add(p, v, __ATOMIC_RELAXED, __HIP_MEMORY_SCOPE_AGENT); }
__device__ __forceinline__ unsigned xb_xcc_id() { return (unsigned)__builtin_amdgcn_s_getreg((3 << 11) | 20) & 0xFu; }
#define XB_SPIN(cond, bar) do { unsigned _sp = 0; while (cond) { __builtin_amdgcn_s_sleep(1); \
    if ((++_sp & 255u) == 0u) { if (xb_ld(&(bar)[XB_TMO])) break; if (_sp > XB_SPIN_CAP) { atomicAdd(&(bar)[XB_TMO], 1u); break; } } } } while (0)
struct XcdBarrier { unsigned* bar; unsigned x; volatile LAS unsigned* st; };
__device__ __forceinline__ XcdBarrier xcd_barrier_post(unsigned* bar, volatile LAS unsigned* st) {
    XcdBarrier b; b.bar = bar; b.x = xb_xcc_id(); b.st = st;
    if (threadIdx.x == 0) (void)xb_add(&bar[XB_XCNT(b.x)], 1u);
    return b;
}
__device__ __forceinline__ void xcd_barrier_complete(unsigned* bar, unsigned x, unsigned& nloc, unsigned& nx) {
    const unsigned G = gridDim.x * gridDim.y * gridDim.z;
    unsigned sum, cnt, mine, sp = 0u;
    for (;;) {
        sum = 0u; cnt = 0u; mine = 0u;
#pragma unroll
        for (unsigned j = 0; j < 16; ++j) { const unsigned c = xb_ld(&bar[XB_XCNT(j)]); sum += c; cnt += (c > 0u) ? 1u : 0u; mine = (j == x) ? c : mine; }
        if (sum == G) break;
        __builtin_amdgcn_s_sleep(1);
        if ((++sp & 255u) == 0u) { if (xb_ld(&bar[XB_TMO])) break; if (sp > XB_SPIN_CAP) { atomicAdd(&bar[XB_TMO], 1u); break; } }
    }
    nloc = mine > 0u ? mine : 1u; nx = cnt > 0u ? cnt : 1u;
}
__device__ __forceinline__ void xcd_barrier(const XcdBarrier& b) {
    asm volatile("s_waitcnt vmcnt(0)" ::: "memory");
    __syncthreads();
    if (threadIdx.x == 0) {
        unsigned* bar = b.bar;
        __builtin_amdgcn_s_waitcnt(0);
        unsigned nloc = b.st[0], nx = b.st[1];
        if (nloc == 0u) { xcd_barrier_complete(bar, b.x, nloc, nx); b.st[0] = nloc; b.st[1] = nx; }
        const unsigned old = xb_add(&bar[XB_XSUB(b.x)], 1u);
        const unsigned gen = old / nloc;
        if (old + 1u == (gen + 1u) * nloc) {
            __builtin_amdgcn_fence(__ATOMIC_RELEASE, "agent");
            asm volatile("s_waitcnt vmcnt(0)" ::: "memory");
            const unsigned og = xb_add(&bar[XB_TOP], 1u);
            const unsigned tg = og / nx;
            if (og + 1u == (tg + 1u) * nx) xb_add(&bar[XB_TOPGEN], 1u);
            else XB_SPIN(xb_ld(&bar[XB_TOPGEN]) == tg, bar);
            __builtin_amdgcn_fence(__ATOMIC_ACQUIRE, "agent");
            xb_add(&bar[XB_XGEN(b.x)], 1u);
            asm volatile("s_waitcnt vmcnt(0)" ::: "memory");
        } else {
            XB_SPIN(xb_ld(&bar[XB_XGEN(b.x)]) == gen, bar);
            __builtin_amdgcn_fence(__ATOMIC_ACQUIRE, "agent");
            asm volatile("s_waitcnt vmcnt(0)" ::: "memory");
        }
    }
    __syncthreads();
}

struct Args { const float* in[26]; float* out; unsigned char* ws; int ph_lo, ph_hi; };
struct Frame {
    LAS unsigned char* lds; unsigned char* ws; unsigned* ctl;
    int tid, lane, wave, G, bid;
    const float* const* in;
    float* out;
};
#define WSP(type, off) ((type*)(F.ws + (off)))
enum { I_X = 0, I_MEM, I_NMIXG, I_WIN, I_GGW, I_GGB, I_GNG, I_GOW, I_CW, I_CBIAS, I_COW, I_MXW, I_NXG, I_NMG, I_XQ, I_XK, I_XV, I_XO, I_NMOEG, I_RW, I_RB, I_GUW, I_GUB, I_DNW, I_DNB, I_NFG };

constexpr int BM = 256, BK = 64, HALF = 128, HTB = HALF * BK * 2, NXCD = 8, WGM = 8;
__device__ __forceinline__ int lds_byte(int r, int c) { const int st = (r >> 4) * 2 + (c >> 5), rr = r & 15, cc = c & 31, ob = rr * 64 + cc * 2; return st * 1024 + (ob ^ (((ob >> 9) & 1) << 5)); }
__device__ __forceinline__ void stage_rc(int b, int& R, int& C) { const int st = b / 1024, sb = b % 1024, swz = sb ^ (((sb >> 9) & 1) << 5); R = (st >> 1) * 16 + swz / 64; C = (st & 1) * 32 + (swz % 64) / 2; }
__device__ __forceinline__ int perm32(int rho) { const int n = rho >> 4, i = rho & 15; return 8 * (i >> 2) + 4 * n + (i & 3); }

struct Unit { int pm, pn, e; };
__device__ __forceinline__ bool static_next(int i, int G, int c, int nM, int nN, Unit& u) {
    const int nwg = nM * nN; const long L = (long)i * G + c; if (L >= nwg) return false;
    int wgid = (int)L; { const int q = nwg / NXCD, r = nwg % NXCD, xcd = wgid % NXCD, off = wgid / NXCD; wgid = (xcd < r ? xcd * (q + 1) : r * (q + 1) + (xcd - r) * q) + off; }
    const int nig = WGM * nN, gid = wgid / nig, fm = gid * WGM, gsz = (nM - fm) < WGM ? (nM - fm) : WGM;
    u.pm = fm + ((wgid % nig) % gsz); u.pn = (wgid % nig) / gsz; u.e = 0; return true;
}
struct DenseSched {
    const char* A; const char* Bt; int K, nM, nN, G, c;
    __device__ __forceinline__ void init(const void* A_, const void* Bt_, int M, int N, int K_, int G_, int c_) { A = (const char*)A_; Bt = (const char*)Bt_; K = K_; nM = M / BM; nN = N / BM; G = G_; c = c_; }
    __device__ __forceinline__ bool next(int i, Unit& u) const { return static_next(i, G, c, nM, nN, u); }
    __device__ __forceinline__ const char* a_base() const { return A; }
    __device__ __forceinline__ const char* b_base(const Unit& u) const { return Bt + (size_t)u.pn * BM * K * 2; }
    __device__ __forceinline__ unsigned a_src_row(const Unit& u, int r) const { return (unsigned)(u.pm * BM + r); }
};
struct GroupSched {
    const char* A; const char* Bt; int K, N, nM, nN, G, c; const int* tile_e; const int* row_tok;
    __device__ __forceinline__ void init(const void* A_, const void* Bt_, int ntiles, int N_, int K_, int G_, int c_, const int* te, const int* rt) { A = (const char*)A_; Bt = (const char*)Bt_; K = K_; N = N_; nM = ntiles; nN = N_ / BM; G = G_; c = c_; tile_e = te; row_tok = rt; }
    __device__ __forceinline__ bool next(int i, Unit& u) const { if (!static_next(i, G, c, nM, nN, u)) return false; u.e = __builtin_amdgcn_readfirstlane(ld_agent_i(tile_e + u.pm)); return true; }
    __device__ __forceinline__ const char* a_base() const { return A; }
    __device__ __forceinline__ const char* b_base(const Unit& u) const { return Bt + ((size_t)u.e * N + (size_t)u.pn * BM) * K * 2; }
    __device__ __forceinline__ unsigned a_src_row(const Unit& u, int r) const { return row_tok ? (unsigned)ld_agent_i(row_tok + u.pm * BM + r) : (unsigned)(u.pm * BM + r); }
};

template <class Epi, class Sched>
__device__ __forceinline__ void gemm_ref(LAS unsigned char* lds, const Sched& S, const Epi& E) {
    const int tid = threadIdx.x, tx = tid & 15, ty = tid >> 4, K = S.K;
    LAS float* As = (LAS float*)lds; LAS float* Bs = As + 16 * 260;
    const int lr = tid >> 1, kh = tid & 1;
    for (int i = 0;; ++i) {
        Unit u; if (!S.next(i, u)) break;
        float acc[8][16];
#pragma unroll
        for (int j = 0; j < 8; ++j)
#pragma unroll
            for (int q = 0; q < 16; ++q) acc[j][q] = 0.f;
        const char* Ab = S.a_base() + ((size_t)S.a_src_row(u, lr) * K + 8 * kh) * 2;
        const char* Bb = S.b_base(u) + ((size_t)lr * K + 8 * kh) * 2;
        for (int k0 = 0; k0 < K; k0 += 16) {
            const bf16x8 av = *(const bf16x8*)(Ab + (size_t)k0 * 2), bv = *(const bf16x8*)(Bb + (size_t)k0 * 2);
            __syncthreads();
#pragma unroll
            for (int j = 0; j < 8; ++j) { As[(8 * kh + j) * 260 + lr] = bf2f((unsigned short)av[j]); Bs[(8 * kh + j) * 260 + lr] = bf2f((unsigned short)bv[j]); }
            __syncthreads();
#pragma unroll 4
            for (int kk = 0; kk < 16; ++kk) {
                float a[8], b[16];
#pragma unroll
                for (int j = 0; j < 8; ++j) a[j] = As[kk * 260 + ty + 32 * j];
                const f32x4 b0 = *(const LAS f32x4*)(Bs + kk * 260 + 8 * tx), b1 = *(const LAS f32x4*)(Bs + kk * 260 + 8 * tx + 4);
                const f32x4 b2 = *(const LAS f32x4*)(Bs + kk * 260 + 128 + 8 * tx), b3 = *(const LAS f32x4*)(Bs + kk * 260 + 128 + 8 * tx + 4);
#pragma unroll
                for (int q = 0; q < 4; ++q) { b[q] = b0[q]; b[4 + q] = b1[q]; b[8 + q] = b2[q]; b[12 + q] = b3[q]; }
#pragma unroll
                for (int j = 0; j < 8; ++j)
#pragma unroll
                    for (int q = 0; q < 16; ++q) acc[j][q] += a[j] * b[q];
            }
        }
#pragma unroll 8
        for (int j = 0; j < 8; ++j) {
            const f32x4 a0 = {acc[j][0], acc[j][1], acc[j][2], acc[j][3]}, a1 = {acc[j][4], acc[j][5], acc[j][6], acc[j][7]};
            const f32x4 b0 = {acc[j][8], acc[j][9], acc[j][10], acc[j][11]}, b1 = {acc[j][12], acc[j][13], acc[j][14], acc[j][15]};
            E.template row8<false>(u.pm * BM + ty + 32 * j, u, 8 * tx, a0, a1, b0, b1);
        }
    }
    __syncthreads();
}

template <class Epi, class Sched>
__device__ __forceinline__ void gemm_mfma(LAS unsigned char* lds, const Sched& S, const Epi& E) {
    const int tid = threadIdx.x, wid = __builtin_amdgcn_readfirstlane(tid >> 6), lane = tid & 63, wr = wid >> 2, wc = wid & 3, fr = lane & 15, fq = lane >> 4;
    const int K = S.K, nt = K / BK;
    int Rr[2], Cc[2]; unsigned voffB[2];
#pragma unroll
    for (int i = 0; i < 2; ++i) { stage_rc(tid * 16 + i * 8192, Rr[i], Cc[i]); const int Rb = (Rr[i] & ~31) + perm32(Rr[i] & 31); voffB[i] = (unsigned)(Rb * K + Cc[i]) * 2u; }
    const size_t kstep = (size_t)(BK * 2);
    const size_t hstep = (size_t)HALF * K * 2;
    const unsigned ldsw = (unsigned)wid * 1024u;
    const int aoff = lds_byte(wr * 64 + fr, fq * 8), boff = lds_byte(wc * 32 + fr, fq * 8);
#define PG8_SA(b, h) (((b) * 2 + (h)) * HTB)
#define PG8_SB(b, h) ((4 + (b) * 2 + (h)) * HTB)
#define PG8_STAGE(bufoff, gbase, voff) do { _Pragma("unroll") for (int _i = 0; _i < 2; ++_i) \
        __builtin_amdgcn_global_load_lds((const unsigned*)((const char*)(gbase) + (voff)[_i]), (LAS unsigned*)(lds + (bufoff) + ldsw + _i * 8192), 16, 0, 0); } while (0)
#define PG8_LDA(dst, b, h) do { _Pragma("unroll") for (int m = 0; m < 4; ++m) _Pragma("unroll") for (int k = 0; k < 2; ++k) dst[m][k] = *(const LAS bf16x8*)(lds + PG8_SA(b, h) + aoff + m * 2048 + k * 1024); } while (0)
#define PG8_LDB(dst, b, h) do { _Pragma("unroll") for (int n = 0; n < 2; ++n) _Pragma("unroll") for (int k = 0; k < 2; ++k) dst[n][k] = *(const LAS bf16x8*)(lds + PG8_SB(b, h) + boff + n * 2048 + k * 1024); } while (0)
#define PG8_MMA(ai, bj, At, Bt) do { __builtin_amdgcn_s_setprio(1); _Pragma("unroll") for (int m = 0; m < 4; ++m) _Pragma("unroll") for (int n = 0; n < 2; ++n) _Pragma("unroll") for (int k = 0; k < 2; ++k) \
        acc[ai][bj][m][n] = __builtin_amdgcn_mfma_f32_16x16x32_bf16(Bt[n][k], At[m][k], acc[ai][bj][m][n], 0, 0, 0); __builtin_amdgcn_s_setprio(0); } while (0)
#define PG8_WAIT_V(n) asm volatile("s_waitcnt vmcnt(" #n ")" ::: "memory")
#define PG8_WAIT_L(n) asm volatile("s_waitcnt lgkmcnt(" #n ")" ::: "memory")
#define PG8_BAR __builtin_amdgcn_s_barrier()
#define PG8_SCHED __builtin_amdgcn_sched_barrier(0)
#define PG8_AOFF(dst, uu) do { _Pragma("unroll") for (int _h = 0; _h < 2; ++_h) _Pragma("unroll") for (int _i = 0; _i < 2; ++_i) dst[_h][_i] = (S.a_src_row(uu, _h * HALF + Rr[_i]) * (unsigned)K + (unsigned)Cc[_i]) * 2u; } while (0)
    Unit cur, nxt; int ui = 0;
    if (!S.next(0, cur)) return;
    f32x4 acc[2][2][4][2];
#pragma unroll
    for (int a = 0; a < 2; ++a)
#pragma unroll
        for (int b = 0; b < 2; ++b)
#pragma unroll
            for (int m = 0; m < 4; ++m)
#pragma unroll
                for (int n = 0; n < 2; ++n) acc[a][b][m][n] = (f32x4){0.f, 0.f, 0.f, 0.f};
    bf16x8 At[4][2], B0[2][2], B1[2][2];
    unsigned coff[2][2], noff[2][2];
    PG8_AOFF(coff, cur);
    const char* cA = S.a_base(); const char* cB = S.b_base(cur);
    PG8_STAGE(PG8_SB(0, 0), cB, voffB); PG8_STAGE(PG8_SB(0, 1), cB + hstep, voffB); PG8_STAGE(PG8_SA(0, 0), cA, coff[0]); PG8_STAGE(PG8_SA(0, 1), cA, coff[1]);
    if (wr == 1) PG8_BAR;
    PG8_WAIT_V(2); PG8_BAR;
    PG8_STAGE(PG8_SB(1, 0), cB + kstep, voffB); PG8_STAGE(PG8_SA(1, 0), cA + kstep, coff[0]); PG8_STAGE(PG8_SB(1, 1), cB + hstep + kstep, voffB);
    PG8_WAIT_V(6); PG8_BAR;
    for (;;) {
        const bool has_next = S.next(ui + 1, nxt);
        const char* nB = cB;
#pragma unroll
        for (int _h = 0; _h < 2; ++_h)
#pragma unroll
            for (int _i = 0; _i < 2; ++_i) noff[_h][_i] = coff[_h][_i];
        if (has_next) { nB = S.b_base(nxt); PG8_AOFF(noff, nxt); }
        for (int t = 0; t < nt; t += 2) {
            const bool last = (t == nt - 2);
            const char* a1 = cA + (size_t)(t + 1) * kstep;
            const char* a2 = last ? cA : cA + (size_t)(t + 2) * kstep; const char* b2 = last ? nB : cB + (size_t)(t + 2) * kstep;
            const char* a3 = a2 + kstep; const char* b3 = b2 + kstep;
            unsigned o2[2][2];
#pragma unroll
            for (int _h = 0; _h < 2; ++_h)
#pragma unroll
                for (int _i = 0; _i < 2; ++_i) o2[_h][_i] = last ? noff[_h][_i] : coff[_h][_i];
            PG8_LDB(B0, 0, 0); PG8_LDB(B1, 0, 1); PG8_SCHED; PG8_LDA(At, 0, 0); PG8_STAGE(PG8_SA(1, 1), a1, coff[1]);
            PG8_WAIT_V(8); PG8_WAIT_L(0); PG8_BAR; PG8_MMA(0, 0, At, B0); PG8_MMA(0, 1, At, B1); PG8_BAR; PG8_SCHED;
            PG8_LDA(At, 0, 1); PG8_STAGE(PG8_SB(0, 0), b2, voffB); PG8_STAGE(PG8_SB(0, 1), b2 + hstep, voffB); PG8_STAGE(PG8_SA(0, 0), a2, o2[0]);
            PG8_WAIT_V(8); PG8_WAIT_L(0); PG8_BAR; PG8_MMA(1, 0, At, B0); PG8_MMA(1, 1, At, B1); PG8_BAR; PG8_SCHED;
            PG8_LDB(B0, 1, 0); PG8_LDB(B1, 1, 1); PG8_SCHED; PG8_LDA(At, 1, 0); PG8_STAGE(PG8_SA(0, 1), a2, o2[1]);
            PG8_WAIT_V(8); PG8_WAIT_L(0); PG8_BAR; PG8_MMA(0, 0, At, B0); PG8_MMA(0, 1, At, B1); PG8_BAR; PG8_SCHED;
            PG8_LDA(At, 1, 1); PG8_STAGE(PG8_SB(1, 0), b3, voffB); PG8_STAGE(PG8_SB(1, 1), b3 + hstep, voffB); PG8_STAGE(PG8_SA(1, 0), a3, o2[0]);
            PG8_WAIT_V(8); PG8_WAIT_L(0); PG8_BAR; PG8_MMA(1, 0, At, B0); PG8_MMA(1, 1, At, B1); PG8_BAR; PG8_SCHED;
        }
        if (wr == 0) PG8_BAR;
#pragma unroll 2
        for (int ai = 0; ai < 2; ++ai)
#pragma unroll 4
            for (int m = 0; m < 4; ++m)
                E.template row8<true>(cur.pm * BM + ai * HALF + wr * 64 + m * 16 + fr, cur, wc * 32 + 8 * fq, acc[ai][0][m][0], acc[ai][0][m][1], acc[ai][1][m][0], acc[ai][1][m][1]);
        if (!has_next) break;
#pragma unroll
        for (int a = 0; a < 2; ++a)
#pragma unroll
            for (int b = 0; b < 2; ++b)
#pragma unroll
                for (int m = 0; m < 4; ++m)
#pragma unroll
                    for (int n = 0; n < 2; ++n) acc[a][b][m][n] = (f32x4){0.f, 0.f, 0.f, 0.f};
        cur = nxt; cB = nB;
#pragma unroll
        for (int _h = 0; _h < 2; ++_h)
#pragma unroll
            for (int _i = 0; _i < 2; ++_i) coff[_h][_i] = noff[_h][_i];
        ++ui;
        if (wr == 1) PG8_BAR;
    }
    PG8_WAIT_V(0);
    PG8_BAR;
#undef PG8_SA
#undef PG8_SB
#undef PG8_STAGE
#undef PG8_LDA
#undef PG8_LDB
#undef PG8_MMA
#undef PG8_WAIT_V
#undef PG8_WAIT_L
#undef PG8_BAR
#undef PG8_SCHED
#undef PG8_AOFF
}
template <class Epi, class Sched>
__device__ __forceinline__ void gemm_any(LAS unsigned char* lds, const Sched& S, const Epi& E) {
#if OPT_GEMM
    gemm_mfma<Epi, Sched>(lds, S, E);
#else
    gemm_ref<Epi, Sched>(lds, S, E);
#endif
}

__device__ __forceinline__ void st_bf8(bf16* p, f32x4 a, f32x4 b) { *(u32x4*)p = pack8(a, b); }
__device__ __forceinline__ void ld_bf8(const bf16* p, f32x4& a, f32x4& b) { unpack8(*(const u32x4*)p, a, b); }

struct EpiInProj {
    bf16 *Q, *Kk, *V, *SR, *CB, *U, *SGA, *SGB; float* LA; const float* gate_b;
    template <bool MF> __device__ __forceinline__ void row8(int row, const Unit& u, int c0, f32x4 a0, f32x4 a1, f32x4 b0, f32x4 b1) const {
        const int pn = u.pn;
        if (pn >= TN_LA && pn < TN_CB) {
            const int col = (pn - TN_LA) * 256 + c0; float* p = LA + (size_t)row * QK + col; const float* gb = gate_b + col;
            const f32x4 g0 = *(const f32x4*)gb, g1 = *(const f32x4*)(gb + 4), g2 = *(const f32x4*)(gb + 128), g3 = *(const f32x4*)(gb + 132);
#pragma unroll
            for (int j = 0; j < 4; ++j) { a0[j] = logsigmoidf_(a0[j] + g0[j]) * 0.0625f; a1[j] = logsigmoidf_(a1[j] + g1[j]) * 0.0625f; b0[j] = logsigmoidf_(b0[j] + g2[j]) * 0.0625f; b1[j] = logsigmoidf_(b1[j] + g3[j]) * 0.0625f; }
            *(f32x4*)p = a0; *(f32x4*)(p + 4) = a1; *(f32x4*)(p + 128) = b0; *(f32x4*)(p + 132) = b1; return; }
        if (pn >= TN_U && pn < TN_GA) { st_bf8(U + (size_t)row * D + (pn - TN_U) * 128 + c0, a0 * b0, a1 * b1); return; }
        bf16* base; int ld, ct, mode = 0; float sc = 1.0f;
        if (pn < TN_K) { base = Q; ld = QK; ct = pn - TN_Q; sc = 0.0625f; }
        else if (pn < TN_V) { base = Kk; ld = QK; ct = pn - TN_K; }
        else if (pn < TN_R) { base = V; ld = VD; ct = pn - TN_V; }
        else if (pn < TN_LA) { base = SR; ld = VD; ct = pn - TN_R; mode = 1; }
        else if (pn < TN_U) { base = CB; ld = D; ct = pn - TN_CB; }
        else if (pn < TN_GB) { base = SGA; ld = D; ct = pn - TN_GA; mode = 2; }
        else { base = SGB; ld = D; ct = pn - TN_GB; mode = 2; }
        if (mode) {
#pragma unroll
            for (int j = 0; j < 4; ++j) { const float s0 = sigmoidf_(a0[j]), s1 = sigmoidf_(a1[j]), s2 = sigmoidf_(b0[j]), s3 = sigmoidf_(b1[j]);
                a0[j] = (mode == 1) ? a0[j] * s0 : s0; a1[j] = (mode == 1) ? a1[j] * s1 : s1; b0[j] = (mode == 1) ? b0[j] * s2 : s2; b1[j] = (mode == 1) ? b1[j] * s3 : s3; }
        } else { a0 *= sc; a1 *= sc; b0 *= sc; b1 *= sc; }
        bf16* p = base + (size_t)row * ld + ct * 256 + c0; st_bf8(p, a0, a1); st_bf8(p + 128, b0, b1);
    }
};
struct EpiGateA {
    float* T1; const bf16* SGA;
    template <bool MF> __device__ __forceinline__ void row8(int row, const Unit& u, int c0, f32x4 a0, f32x4 a1, f32x4 b0, f32x4 b1) const {
        const size_t o = (size_t)row * D + u.pn * 256 + c0; f32x4 g0, g1, g2, g3; ld_bf8(SGA + o, g0, g1); ld_bf8(SGA + o + 128, g2, g3);
        *(f32x4*)(T1 + o) = a0 * g0; *(f32x4*)(T1 + o + 4) = a1 * g1; *(f32x4*)(T1 + o + 128) = b0 * g2; *(f32x4*)(T1 + o + 132) = b1 * g3;
    }
};
struct EpiGateB {
    const float* T1; const bf16* SGB; bf16* MG;
    template <bool MF> __device__ __forceinline__ void row8(int row, const Unit& u, int c0, f32x4 a0, f32x4 a1, f32x4 b0, f32x4 b1) const {
        const size_t o = (size_t)row * D + u.pn * 256 + c0; f32x4 g0, g1, g2, g3; ld_bf8(SGB + o, g0, g1); ld_bf8(SGB + o + 128, g2, g3);
        const f32x4 t0 = *(const f32x4*)(T1 + o), t1 = *(const f32x4*)(T1 + o + 4), t2 = *(const f32x4*)(T1 + o + 128), t3 = *(const f32x4*)(T1 + o + 132);
        st_bf8(MG + o, t0 + a0 * g0, t1 + a1 * g1); st_bf8(MG + o + 128, t2 + b0 * g2, t3 + b1 * g3);
    }
};
struct EpiResid1 {
    const float* X; float* X1; bf16* X1B; float* SS1;
    template <bool MF> __device__ __forceinline__ void row8(int row, const Unit& u, int c0, f32x4 a0, f32x4 a1, f32x4 b0, f32x4 b1) const {
        const size_t o = (size_t)row * D + u.pn * 256 + c0;
        a0 += *(const f32x4*)(X + o); a1 += *(const f32x4*)(X + o + 4); b0 += *(const f32x4*)(X + o + 128); b1 += *(const f32x4*)(X + o + 132);
        *(f32x4*)(X1 + o) = a0; *(f32x4*)(X1 + o + 4) = a1; *(f32x4*)(X1 + o + 128) = b0; *(f32x4*)(X1 + o + 132) = b1;
        st_bf8(X1B + o, a0, a1); st_bf8(X1B + o + 128, b0, b1);
        float s = 0.f;
#pragma unroll
        for (int j = 0; j < 4; ++j) s += a0[j] * a0[j] + a1[j] * a1[j] + b0[j] * b0[j] + b1[j] * b1[j];
        if (MF) { s += __shfl_xor(s, 16); s += __shfl_xor(s, 32); if ((threadIdx.x & 63) < 16) atomicAdd(SS1 + row, s); }
        else atomicAdd(SS1 + row, s);
    }
};
struct EpiXQ {
    bf16* QX; const float* SS1;
    template <bool MF> __device__ __forceinline__ void row8(int row, const Unit& u, int c0, f32x4 a0, f32x4 a1, f32x4 b0, f32x4 b1) const {
        const float r = rsqrtf(SS1[row] * (1.0f / D) + EPS); bf16* p = QX + (size_t)row * XA + u.pn * 256 + c0;
        st_bf8(p, a0 * r, a1 * r); st_bf8(p + 128, b0 * r, b1 * r);
    }
};
struct EpiResid2 {
    float* X1;
    template <bool MF> __device__ __forceinline__ void row8(int row, const Unit& u, int c0, f32x4 a0, f32x4 a1, f32x4 b0, f32x4 b1) const {
        float* p = X1 + (size_t)row * D + u.pn * 256 + c0;
        *(f32x4*)p = *(const f32x4*)p + a0; *(f32x4*)(p + 4) = *(const f32x4*)(p + 4) + a1; *(f32x4*)(p + 128) = *(const f32x4*)(p + 128) + b0; *(f32x4*)(p + 132) = *(const f32x4*)(p + 132) + b1;
    }
};
struct EpiGU {
    bf16* ACT; const float* gub;
    template <bool MF> __device__ __forceinline__ void row8(int row, const Unit& u, int c0, f32x4 a0, f32x4 a1, f32x4 b0, f32x4 b1) const {
        const int f = u.pn * 128 + c0; const float* bg = gub + (size_t)u.e * (2 * FF) + f;
        const f32x4 g0 = *(const f32x4*)bg, g1 = *(const f32x4*)(bg + 4), u0 = *(const f32x4*)(bg + FF), u1 = *(const f32x4*)(bg + FF + 4);
        f32x4 r0, r1;
#pragma unroll
        for (int j = 0; j < 4; ++j) {
            float g = fminf(a0[j] + g0[j], 7.0f), up = fminf(fmaxf(b0[j] + u0[j], -7.0f), 7.0f); r0[j] = (up + 1.0f) * g * sigmoidf_(1.702f * g);
            g = fminf(a1[j] + g1[j], 7.0f); up = fminf(fmaxf(b1[j] + u1[j], -7.0f), 7.0f); r1[j] = (up + 1.0f) * g * sigmoidf_(1.702f * g);
        }
        st_bf8(ACT + (size_t)row * FF + f, r0, r1);
    }
};
struct EpiDown {
    bf16* YS; const float* dnb;
    template <bool MF> __device__ __forceinline__ void row8(int row, const Unit& u, int c0, f32x4 a0, f32x4 a1, f32x4 b0, f32x4 b1) const {
        const int col = u.pn * 256 + c0; const float* bb = dnb + (size_t)u.e * D + col; bf16* p = YS + (size_t)row * D + col;
        st_bf8(p, a0 + *(const f32x4*)bb, a1 + *(const f32x4*)(bb + 4)); st_bf8(p + 128, b0 + *(const f32x4*)(bb + 128), b1 + *(const f32x4*)(bb + 132));
    }
};

__device__ __forceinline__ void tr_item(const float* W, int ldw, int K, int srccol0, bf16* WT, int dstrow0, const float* ksc, LAS float* scr, int kb, int lane) {
    const int k0 = 64 * kb;
#pragma unroll 8
    for (int i = 0; i < 32; ++i) { const int kk = 2 * i + (lane >> 5); float v = W[(size_t)(k0 + kk) * ldw + srccol0 + (lane & 31)]; if (ksc) v *= ksc[k0 + kk]; scr[kk * 33 + (lane & 31)] = v; }
    LDS_WAIT(); asm volatile("" ::: "memory");
    const int c = lane & 7;
#pragma unroll
    for (int j = 0; j < 4; ++j) { const int n = (lane >> 3) + 8 * j; const LAS float* s = scr + (8 * c) * 33 + n;
        u32x4 o; o.x = pk2(s[0 * 33], s[1 * 33]); o.y = pk2(s[2 * 33], s[3 * 33]); o.z = pk2(s[4 * 33], s[5 * 33]); o.w = pk2(s[6 * 33], s[7 * 33]);
        *(u32x4*)(WT + (size_t)(dstrow0 + n) * K + k0 + 8 * c) = o; }
    LDS_WAIT(); asm volatile("" ::: "memory");
}
__device__ __forceinline__ void fold_item(const float* Win, const float* GW, bf16* WT, int n0, LAS float* scr, int kb, int lane) {
    const int k0 = 64 * kb, nn = lane & 31;
    float gw[16];
#pragma unroll
    for (int r = 0; r < 16; ++r) gw[r] = GW[r * QK + n0 + nn];
#pragma unroll 4
    for (int i = 0; i < 32; ++i) { const int kk = 2 * i + (lane >> 5); const float* wr = Win + (size_t)(k0 + kk) * NIN_SRC + SRC_ALOW; float v = 0.f;
#pragma unroll
        for (int r = 0; r < 16; ++r) v += wr[r] * gw[r];
        scr[kk * 33 + nn] = v; }
    LDS_WAIT(); asm volatile("" ::: "memory");
    const int c = lane & 7;
#pragma unroll
    for (int j = 0; j < 4; ++j) { const int n = (lane >> 3) + 8 * j; const LAS float* s = scr + (8 * c) * 33 + n;
        u32x4 o; o.x = pk2(s[0 * 33], s[1 * 33]); o.y = pk2(s[2 * 33], s[3 * 33]); o.z = pk2(s[4 * 33], s[5 * 33]); o.w = pk2(s[6 * 33], s[7 * 33]);
        *(u32x4*)(WT + (size_t)(TN_LA * 256 + n0 + n) * D + k0 + 8 * c) = o; }
    LDS_WAIT(); asm volatile("" ::: "memory");
}
__device__ __forceinline__ void rms_row_to_bf16(const float* xrow, const float* g, bf16* orow, int lane) {
    f32x4 v[8]; float s = 0.f;
#pragma unroll
    for (int j = 0; j < 8; ++j) { v[j] = *(const f32x4*)(xrow + 4 * lane + 256 * j); s += (v[j][0] * v[j][0] + v[j][1] * v[j][1]) + (v[j][2] * v[j][2] + v[j][3] * v[j][3]); }
    const float r = rsqrtf(wave_sum(s) * (1.0f / D) + EPS);
#pragma unroll
    for (int j = 0; j < 8; ++j) { const f32x4 gg = *(const f32x4*)(g + 4 * lane + 256 * j); u32x2 o; o.x = pk2(v[j][0] * r * gg[0], v[j][1] * r * gg[1]); o.y = pk2(v[j][2] * r * gg[2], v[j][3] * r * gg[3]); *(u32x2*)(orow + 4 * lane + 256 * j) = o; }
}
__device__ __forceinline__ void p0_prologue(Frame& F) {
    LAS float* scr = (LAS float*)(F.lds + F.wave * 16384);
    const int gw = F.bid * NWAVES + F.wave, NGW = F.G * NWAVES, lane = F.lane;
    const float* Win = F.in[I_WIN];
    bf16* WIN = WSP(bf16, WS_WIN);
    for (int it = gw; it < 544 * 32; it += NGW) {
        const int nb = it % 544, kb = it / 544, n0 = 32 * nb;
        if (n0 >= TN_LA * 256 && n0 < TN_CB * 256) { fold_item(Win, F.in[I_GGW], WIN, n0 - TN_LA * 256, scr, kb, lane); continue; }
        int src;
        if (n0 < TN_LA * 256) src = n0;
        else if (n0 < TN_U * 256) src = SRC_CB + (n0 - TN_CB * 256);
        else if (n0 < TN_GA * 256) { const int rel = n0 - TN_U * 256, p = rel >> 8, w = rel & 255; src = (w < 128) ? SRC_CC + 128 * p + w : SRC_CHH + 128 * p + (w - 128); }
        else if (n0 < TN_GB * 256) src = SRC_GA + (n0 - TN_GA * 256);
        else src = SRC_GB + (n0 - TN_GB * 256);
        tr_item(Win, NIN_SRC, D, src, WIN, n0, nullptr, scr, kb, lane);
    }
    for (int it = gw; it < 3 * 2048; it += NGW) { const int w = it / 2048, r = it % 2048, nb = r % 64, kb = r / 64;
        const float* W = F.in[w == 0 ? I_GOW : (w == 1 ? I_COW : I_MXW)]; bf16* WT = WSP(bf16, w == 0 ? WS_WGO : (w == 1 ? WS_WCO : WS_WMX));
        tr_item(W, D, D, 32 * nb, WT, 32 * nb, nullptr, scr, kb, lane); }
    for (int it = gw; it < 3 * 512; it += NGW) { const int w = it / 512, r = it % 512, nb = r % 16, kb = r / 16;
        if (w == 0) tr_item(F.in[I_XQ], XA, D, 32 * nb, WSP(bf16, WS_WXQ), 32 * nb, F.in[I_NXG], scr, kb, lane);
        else tr_item(F.in[w == 1 ? I_XK : I_XV], XA, D, 32 * nb, WSP(bf16, WS_WXKV), (w - 1) * XA + 32 * nb, nullptr, scr, kb, lane); }
    for (int it = gw; it < 512; it += NGW) { const int nb = it % 64, kb = it / 64; tr_item(F.in[I_XO], D, XA, 32 * nb, WSP(bf16, WS_WXO), 32 * nb, nullptr, scr, kb, lane); }
    for (int it = gw; it < NE * 4096; it += NGW) { const int e = it / 4096, r = it % 4096, nb = r % 128, kb = r / 128, n0 = 32 * nb, p = n0 >> 8, w = n0 & 255;
        const int src = (w < 128) ? 128 * p + w : FF + 128 * p + (w - 128);
        tr_item(F.in[I_GUW] + (size_t)e * D * (2 * FF), 2 * FF, D, src, WSP(bf16, WS_WGU) + (size_t)e * (2 * FF) * D, n0, nullptr, scr, kb, lane); }
    for (int it = gw; it < NE * 2048; it += NGW) { const int e = it / 2048, r = it % 2048, nb = r % 64, kb = r / 64;
        tr_item(F.in[I_DNW] + (size_t)e * FF * D, D, FF, 32 * nb, WSP(bf16, WS_WDN) + (size_t)e * D * FF, 32 * nb, nullptr, scr, kb, lane); }
    { const float* rw = F.in[I_RW]; const float* g = F.in[I_NMOEG]; float* WR = WSP(float, WS_WR);
      for (int i = F.bid * NTHR + F.tid; i < NE * D; i += F.G * NTHR) { const int e = i / D, k = i % D; WR[i] = rw[k * NE + e] * g[k]; } }
    for (int m = gw; m < T; m += NGW) rms_row_to_bf16(F.in[I_X] + (size_t)m * D, F.in[I_NMIXG], WSP(bf16, WS_XN) + (size_t)m * D, lane);
    for (int m = gw; m < MEM; m += NGW) rms_row_to_bf16(F.in[I_MEM] + (size_t)m * D, F.in[I_NMG], WSP(bf16, WS_MEMN) + (size_t)m * D, lane);
    { u32x4* z = (u32x4*)(WSP(bf16, WS_H3) + (size_t)T * D); for (int i = F.bid * NTHR + F.tid; i < 256; i += F.G * NTHR) z[i] = (u32x4){0u, 0u, 0u, 0u}; }
}

__device__ __forceinline__ void p_memkv(Frame& F) {
    const bf16* A = WSP(bf16, WS_MEMN); const bf16* B = WSP(bf16, WS_WXKV); bf16* KM = WSP(bf16, WS_KM); bf16* VMT = WSP(bf16, WS_VMT);
    for (int o = F.bid * NTHR + F.tid; o < MEM * 2 * XA; o += F.G * NTHR) {
        const int m = o & 255, n = o >> 8;
        const bf16* a = A + (size_t)m * D; const bf16* b = B + (size_t)n * D; float s = 0.f;
        for (int k = 0; k < D; k += 8) { f32x4 a0, a1, b0, b1; ld_bf8(a + k, a0, a1); ld_bf8(b + k, b0, b1);
#pragma unroll
            for (int j = 0; j < 4; ++j) s += a0[j] * b0[j] + a1[j] * b1[j]; }
        if (n < XA) KM[(size_t)m * XA + n] = (bf16)f2bf(s); else VMT[(size_t)(n - XA) * MEM + m] = (bf16)f2bf(s);
    }
}

__device__ __forceinline__ void p_conv(Frame& F) {
    const bf16* U = WSP(bf16, WS_U); const bf16* CB = WSP(bf16, WS_CB); bf16* Z = WSP(bf16, WS_Z);
    const float* cw = F.in[I_CW]; const float* cb = F.in[I_CBIAS];
    for (int task = F.bid * NTHR + F.tid; task < (T / 64) * (D / 8); task += F.G * NTHR) {
        const int cg = task & 255, tb = task >> 8, c = 8 * cg, t0 = 64 * tb;
        f32x4 w0a = *(const f32x4*)(cw + c), w0b = *(const f32x4*)(cw + c + 4), w1a = *(const f32x4*)(cw + D + c), w1b = *(const f32x4*)(cw + D + c + 4);
        f32x4 w2a = *(const f32x4*)(cw + 2 * D + c), w2b = *(const f32x4*)(cw + 2 * D + c + 4), ba = *(const f32x4*)(cb + c), bb = *(const f32x4*)(cb + c + 4);
        f32x4 p2a = {0.f, 0.f, 0.f, 0.f}, p2b = p2a, p1a = p2a, p1b = p2a;
        if (t0 >= 2) { ld_bf8(U + (size_t)(t0 - 2) * D + c, p2a, p2b); ld_bf8(U + (size_t)(t0 - 1) * D + c, p1a, p1b); }
        for (int t = t0; t < t0 + 64; ++t) {
            f32x4 ua, ub, ca, cbv; ld_bf8(U + (size_t)t * D + c, ua, ub); ld_bf8(CB + (size_t)t * D + c, ca, cbv);
            const f32x4 ya = ca * (w0a * p2a + w1a * p1a + w2a * ua + ba), yb = cbv * (w0b * p2b + w1b * p1b + w2b * ub + bb);
            st_bf8(Z + (size_t)t * D + c, ya, yb);
            p2a = p1a; p2b = p1b; p1a = ua; p1b = ub;
        }
    }
}
__device__ __forceinline__ void p_glaprep(Frame& F) {
    const bf16* Q = WSP(bf16, WS_Q); const bf16* Kk = WSP(bf16, WS_K); const bf16* V = WSP(bf16, WS_V); const float* LA = WSP(float, WS_LA);
    bf16* QT = WSP(bf16, WS_QT); bf16* KH = WSP(bf16, WS_KH); bf16* KHT = WSP(bf16, WS_KHT); bf16* QG = WSP(bf16, WS_QG); bf16* VT = WSP(bf16, WS_VT);
    float* DL = WSP(float, WS_DL); float* DG = WSP(float, WS_DG);
    LAS float* part = (LAS float*)F.lds;
    const int col = F.tid & 63, sub = F.tid >> 6;
    for (int unit = F.bid; unit < NG * 16; unit += F.G) {
        const int g = unit >> 4, cs = unit & 15, gc = cs * 64 + col, h = gc >> 8, kc = gc & 255;
        float carry = 0.f;
        for (int c = 0; c < GC; ++c) {
            const int chunk = g * GC + c, t0 = chunk * CH + 8 * sub;
            float la[8], qv[8], kv[8];
#pragma unroll
            for (int j = 0; j < 8; ++j) { la[j] = LA[(size_t)(t0 + j) * QK + gc]; qv[j] = bf2f(Q[(size_t)(t0 + j) * QK + gc]); kv[j] = bf2f(Kk[(size_t)(t0 + j) * QK + gc]); }
#pragma unroll
            for (int j = 1; j < 8; ++j) la[j] += la[j - 1];
            __syncthreads();
            part[sub * 64 + col] = la[7];
            __syncthreads();
            float off = 0.f, tot = 0.f;
#pragma unroll
            for (int s = 0; s < 8; ++s) { const float p = part[s * 64 + col]; off += (s < sub) ? p : 0.f; tot += p; }
            unsigned kt[4];
#pragma unroll
            for (int j = 0; j < 8; ++j) { const float b = off + la[j], eb = __expf(b), enb = __expf(-b), eg = __expf(carry + b);
                QT[(size_t)(t0 + j) * QK + gc] = (bf16)f2bf(qv[j] * eb); const unsigned khv = f2bf(kv[j] * enb); KH[(size_t)(t0 + j) * QK + gc] = (bf16)khv;
                QG[(size_t)(t0 + j) * QK + gc] = (bf16)f2bf(qv[j] * eg);
                if (j & 1) kt[j >> 1] |= khv << 16; else kt[j >> 1] = khv; }
            *(u32x4*)(KHT + ((size_t)(chunk * GH + h) * DK + kc) * CH + 8 * sub) = (u32x4){kt[0], kt[1], kt[2], kt[3]};
            if (sub == 0) DL[(size_t)chunk * QK + gc] = __expf(tot);
            carry += tot;
        }
        if (sub == 0) DG[(size_t)g * QK + gc] = __expf(carry);
    }
    for (int unit = F.bid; unit < NCH * (VD / 64); unit += F.G) {
        const int chunk = unit >> 5, vs = unit & 31, vc = vs * 64 + col, t0 = chunk * CH + 8 * sub;
        unsigned w[4];
#pragma unroll
        for (int j = 0; j < 8; ++j) { const unsigned x = V[(size_t)(t0 + j) * VD + vc]; if (j & 1) w[j >> 1] |= x << 16; else w[j >> 1] = x; }
        *(u32x4*)(VT + ((size_t)chunk * VD + vc) * CH + 8 * sub) = (u32x4){w[0], w[1], w[2], w[3]};
    }
}

__device__ __forceinline__ void p_gla_ref(Frame& F) {
    const bf16* Q = WSP(bf16, WS_Q); const bf16* Kk = WSP(bf16, WS_K); const bf16* V = WSP(bf16, WS_V); const float* LA = WSP(float, WS_LA); float* O32 = WSP(float, WS_O32);
    LAS float* red = (LAS float*)F.lds;
    const int k = F.tid & 255, vh = F.tid >> 8;
    for (int unit = F.bid; unit < GH * 64; unit += F.G) {
        const int h = unit >> 6, vb = unit & 63, vcol = h * DV + vb * 8 + vh * 4;
        float s0 = 0.f, s1 = 0.f, s2 = 0.f, s3 = 0.f;
        for (int tb = 0; tb < T; tb += 8) {
            LAS float* rb = red + ((tb >> 3) & 1) * 256;
#pragma unroll
            for (int j = 0; j < 8; ++j) {
                const int t = tb + j; const float a = __expf(LA[(size_t)t * QK + h * DK + k]), kk = bf2f(Kk[(size_t)t * QK + h * DK + k]), qq = bf2f(Q[(size_t)t * QK + h * DK + k]);
                const u32x2 vv = *(const u32x2*)(V + (size_t)t * VD + vcol);
                const float v0 = __uint_as_float(vv.x << 16), v1 = __uint_as_float(vv.x & 0xffff0000u), v2 = __uint_as_float(vv.y << 16), v3 = __uint_as_float(vv.y & 0xffff0000u);
                s0 = a * s0 + kk * v0; s1 = a * s1 + kk * v1; s2 = a * s2 + kk * v2; s3 = a * s3 + kk * v3;
                const float p0 = wave_sum(qq * s0), p1 = wave_sum(qq * s1), p2 = wave_sum(qq * s2), p3 = wave_sum(qq * s3);
                if (F.lane == 0) *(LAS f32x4*)(rb + (j * 8 + F.wave) * 4) = (f32x4){p0, p1, p2, p3};
            }
            __syncthreads();
            if (F.tid < 64) { const int j = F.tid >> 3, vhh = (F.tid >> 2) & 1, q = F.tid & 3; float s = 0.f;
#pragma unroll
                for (int w = 0; w < 4; ++w) s += rb[(j * 8 + vhh * 4 + w) * 4 + q];
                O32[(size_t)(tb + j) * VD + h * DV + vb * 8 + vhh * 4 + q] = s; }
        }
        __syncthreads();
    }
}
__device__ __forceinline__ void p_gla_norm_ref(Frame& F) {
    const float* O32 = WSP(float, WS_O32); const bf16* SR = WSP(bf16, WS_SR); bf16* OA = WSP(bf16, WS_OA); const float* g = F.in[I_GNG];
    const int gw = F.bid * NWAVES + F.wave, NGW = F.G * NWAVES;
    for (int it = gw; it < T * GH; it += NGW) {
        const size_t o = (size_t)it * DV + 8 * F.lane;
        const f32x4 a = *(const f32x4*)(O32 + o), b = *(const f32x4*)(O32 + o + 4);
        float s = 0.f;
#pragma unroll
        for (int j = 0; j < 4; ++j) s += a[j] * a[j] + b[j] * b[j];
        const float r = rsqrtf(wave_sum(s) * (1.0f / DV) + EPS);
        f32x4 s0, s1; ld_bf8(SR + o, s0, s1);
        const f32x4 g0 = *(const f32x4*)(g + 8 * F.lane), g1 = *(const f32x4*)(g + 8 * F.lane + 4);
        st_bf8(OA + o, a * r * g0 * s0, b * r * g1 * s1);
    }
}

__device__ __forceinline__ bf16x8 as_bf8(u32x4 w) { return __builtin_bit_cast(bf16x8, w); }
#define MFMA16(A, B, C) __builtin_amdgcn_mfma_f32_16x16x32_bf16((A), (B), (C), 0, 0, 0)
__device__ __forceinline__ void p_gla_a(Frame& F) {
    const bf16* QT = WSP(bf16, WS_QT); const bf16* KH = WSP(bf16, WS_KH); const bf16* KHT = WSP(bf16, WS_KHT); const bf16* VT = WSP(bf16, WS_VT); const float* DL = WSP(float, WS_DL);
    bf16* OL = WSP(bf16, WS_OL); float* SLOC = WSP(float, WS_SLOC);
    constexpr int QS = 528, KS = 144;
    LAS unsigned char* sQ = F.lds; LAS unsigned char* sK = sQ + 64 * QS; LAS unsigned char* sKT = sK + 64 * QS; LAS unsigned char* sVT = sKT + 256 * KS; LAS unsigned char* sP = sVT + 128 * KS;
    LAS float* sDL = (LAS float*)(sP + 64 * KS);
    static_assert(2 * 64 * QS + 256 * KS + 128 * KS + 64 * KS + 1024 <= MISC_OFF, "gla lds");
    const int tid = F.tid, lane = F.lane, w = F.wave, lr = lane & 15, lg = lane >> 4;
    for (int unit = F.bid; unit < NG * GH * 4; unit += F.G) {
        const int g = unit >> 4, h = (unit >> 2) & 3, vs = unit & 3;
        f32x4 S[16];
#pragma unroll
        for (int kt = 0; kt < 16; ++kt) S[kt] = (f32x4){0.f, 0.f, 0.f, 0.f};
        u32x4 rq[4], rk[4], rt[4], rv[2], rd = {0u, 0u, 0u, 0u};
#define GLA_LOAD(chunk_) do { const int _t0 = (chunk_) * CH; \
        _Pragma("unroll") for (int q = 0; q < 4; ++q) { const int p = tid + 512 * q, row = p >> 5, c16 = p & 31; \
            rq[q] = *(const u32x4*)(QT + (size_t)(_t0 + row) * QK + h * DK + c16 * 8); rk[q] = *(const u32x4*)(KH + (size_t)(_t0 + row) * QK + h * DK + c16 * 8); \
            rt[q] = *(const u32x4*)(KHT + (size_t)((chunk_) * GH + h) * DK * CH + (size_t)p * 8); } \
        _Pragma("unroll") for (int q = 0; q < 2; ++q) { const int p = tid + 512 * q; rv[q] = *(const u32x4*)(VT + ((size_t)(chunk_) * VD + h * DV + vs * 128) * CH + (size_t)p * 8); } \
        if (tid < 64) rd = *(const u32x4*)(DL + (size_t)(chunk_) * QK + h * DK + 4 * tid); } while (0)
        GLA_LOAD(g * GC);
        for (int c = 0; c < GC; ++c) {
            const int chunk = g * GC + c, t0 = chunk * CH;
#pragma unroll
            for (int q = 0; q < 4; ++q) { const int p = tid + 512 * q; *(LAS u32x4*)(sQ + (p >> 5) * QS + (p & 31) * 16) = rq[q]; *(LAS u32x4*)(sK + (p >> 5) * QS + (p & 31) * 16) = rk[q]; *(LAS u32x4*)(sKT + (p >> 3) * KS + (p & 7) * 16) = rt[q]; }
#pragma unroll
            for (int q = 0; q < 2; ++q) { const int p = tid + 512 * q; *(LAS u32x4*)(sVT + (p >> 3) * KS + (p & 7) * 16) = rv[q]; }
            if (tid < 64) *(LAS u32x4*)(sDL + 4 * tid) = rd;
            __syncthreads();
            if (c + 1 < GC) GLA_LOAD(chunk + 1);
            { const int ti = w >> 1;
#pragma unroll
              for (int jj = 0; jj < 2; ++jj) { const int tj = 2 * (w & 1) + jj; f32x4 pa = {0.f, 0.f, 0.f, 0.f};
                if (tj <= ti) {
#pragma unroll
                    for (int s = 0; s < 8; ++s) { const bf16x8 a = *(const LAS bf16x8*)(sK + (16 * tj + lr) * QS + (32 * s + 8 * lg) * 2), b = *(const LAS bf16x8*)(sQ + (16 * ti + lr) * QS + (32 * s + 8 * lg) * 2); pa = MFMA16(a, b, pa); }
                    const int i = 16 * ti + lr, j0 = 16 * tj + 4 * lg;
#pragma unroll
                    for (int r = 0; r < 4; ++r) pa[r] = (j0 + r <= i) ? pa[r] : 0.f;
                }
                u32x2 pw; pw.x = pk2(pa[0], pa[1]); pw.y = pk2(pa[2], pa[3]);
                *(LAS u32x2*)(sP + (16 * ti + lr) * KS + (16 * tj + 4 * lg) * 2) = pw; } }
            f32x4 oacc[4];
#pragma unroll
            for (int ti = 0; ti < 4; ++ti) oacc[ti] = (f32x4){0.f, 0.f, 0.f, 0.f};
#pragma unroll
            for (int s = 0; s < 8; ++s) {
                u32x4 sw; sw.x = pk2(S[2 * s][0], S[2 * s][1]); sw.y = pk2(S[2 * s][2], S[2 * s][3]); sw.z = pk2(S[2 * s + 1][0], S[2 * s + 1][1]); sw.w = pk2(S[2 * s + 1][2], S[2 * s + 1][3]);
                const bf16x8 a = as_bf8(sw);
#pragma unroll
                for (int ti = 0; ti < 4; ++ti) { const LAS unsigned char* qp = sQ + (16 * ti + lr) * QS + (32 * s + 4 * lg) * 2; const u32x2 lo = *(const LAS u32x2*)qp, hi = *(const LAS u32x2*)(qp + 32);
                    oacc[ti] = MFMA16(a, as_bf8((u32x4){lo.x, lo.y, hi.x, hi.y}), oacc[ti]); }
            }
            __syncthreads();
            bf16x8 vf[2];
#pragma unroll
            for (int s2 = 0; s2 < 2; ++s2) vf[s2] = *(const LAS bf16x8*)(sVT + (16 * w + lr) * KS + (32 * s2 + 8 * lg) * 2);
#pragma unroll
            for (int s2 = 0; s2 < 2; ++s2)
#pragma unroll
                for (int ti = 0; ti < 4; ++ti) { const bf16x8 b = *(const LAS bf16x8*)(sP + (16 * ti + lr) * KS + (32 * s2 + 8 * lg) * 2); oacc[ti] = MFMA16(vf[s2], b, oacc[ti]); }
#pragma unroll
            for (int ti = 0; ti < 4; ++ti) { u32x2 ow; ow.x = pk2(oacc[ti][0], oacc[ti][1]); ow.y = pk2(oacc[ti][2], oacc[ti][3]);
                *(u32x2*)(OL + (size_t)(t0 + 16 * ti + lr) * VD + h * DV + vs * 128 + 16 * w + 4 * lg) = ow; }
#pragma unroll
            for (int kt = 0; kt < 16; ++kt) {
#pragma unroll
                for (int s2 = 0; s2 < 2; ++s2) { const bf16x8 a = *(const LAS bf16x8*)(sKT + (16 * kt + lr) * KS + (32 * s2 + 8 * lg) * 2); S[kt] = MFMA16(a, vf[s2], S[kt]); }
                S[kt] *= *(const LAS f32x4*)(sDL + 16 * kt + 4 * lg);
            }
            __syncthreads();
        }
#undef GLA_LOAD
#pragma unroll
        for (int kt = 0; kt < 16; ++kt)
#pragma unroll
            for (int r = 0; r < 4; ++r) SLOC[((size_t)(g * GH + h) * DK + 16 * kt + 4 * lg + r) * DV + vs * 128 + 16 * w + lr] = S[kt][r];
    }
}
__device__ __forceinline__ void p_gla_b(Frame& F) {
    const float* SLOC = WSP(float, WS_SLOC); const float* DG = WSP(float, WS_DG); bf16* SG0 = WSP(bf16, WS_SG0);
    for (int idx = F.bid * NTHR + F.tid; idx < GH * DV * (DK / 8); idx += F.G * NTHR) {
        const int v = idx & 511, k8 = (idx >> 9) & 31, h = idx >> 14;
        float s[8];
#pragma unroll
        for (int j = 0; j < 8; ++j) s[j] = 0.f;
        for (int g = 0; g < NG; ++g) {
            *(u32x4*)(SG0 + ((size_t)(g * GH + h) * DV + v) * DK + 8 * k8) = (u32x4){pk2(s[0], s[1]), pk2(s[2], s[3]), pk2(s[4], s[5]), pk2(s[6], s[7])};
            if (g == NG - 1) break;
            const float* dg = DG + (size_t)g * QK + h * DK + 8 * k8; const f32x4 d0 = *(const f32x4*)dg, d1 = *(const f32x4*)(dg + 4);
#pragma unroll
            for (int j = 0; j < 8; ++j) s[j] = (j < 4 ? d0[j & 3] : d1[j & 3]) * s[j] + SLOC[((size_t)(g * GH + h) * DK + 8 * k8 + j) * DV + v];
        }
    }
}
__device__ __forceinline__ void p_gla_c(Frame& F) {
    const bf16* QG = WSP(bf16, WS_QG); const bf16* SG0 = WSP(bf16, WS_SG0); const bf16* OL = WSP(bf16, WS_OL); const bf16* SR = WSP(bf16, WS_SR); bf16* OA = WSP(bf16, WS_OA); const float* gn = F.in[I_GNG];
    const int lane = F.lane, w = F.wave, lr = lane & 15, lg = lane >> 4;
    for (int unit = F.bid; unit < (T / 128) * GH; unit += F.G) {
        const int rt = unit >> 2, h = unit & 3, g = rt >> 3, row = rt * 128 + 16 * w + lr;
        f32x4 o[32];
#pragma unroll
        for (int vt = 0; vt < 32; ++vt) o[vt] = (f32x4){0.f, 0.f, 0.f, 0.f};
        if (g > 0) {
            const bf16* sg = SG0 + ((size_t)(g * GH + h) * DV + lr) * DK + 8 * lg; const bf16* qg = QG + (size_t)row * QK + h * DK + 8 * lg;
#pragma unroll 1
            for (int s = 0; s < 8; ++s) {
                const bf16x8 b = *(const bf16x8*)(qg + 32 * s);
#pragma unroll
                for (int vt = 0; vt < 32; ++vt) { const bf16x8 a = *(const bf16x8*)(sg + (size_t)(16 * vt) * DK + 32 * s); o[vt] = MFMA16(a, b, o[vt]); }
            }
        }
        const size_t ob = (size_t)row * VD + h * DV + 4 * lg;
        float ss = 0.f;
#pragma unroll
        for (int vt = 0; vt < 32; ++vt) { const u32x2 ol = *(const u32x2*)(OL + ob + 16 * vt);
            o[vt][0] += __uint_as_float(ol.x << 16); o[vt][1] += __uint_as_float(ol.x & 0xffff0000u); o[vt][2] += __uint_as_float(ol.y << 16); o[vt][3] += __uint_as_float(ol.y & 0xffff0000u);
            ss += (o[vt][0] * o[vt][0] + o[vt][1] * o[vt][1]) + (o[vt][2] * o[vt][2] + o[vt][3] * o[vt][3]); }
        ss += __shfl_xor(ss, 16); ss += __shfl_xor(ss, 32);
        const float r = rsqrtf(ss * (1.0f / DV) + EPS);
#pragma unroll
        for (int vt = 0; vt < 32; ++vt) { const u32x2 sr = *(const u32x2*)(SR + ob + 16 * vt); const f32x4 gg = *(const f32x4*)(gn + 16 * vt + 4 * lg);
            u32x2 ow; ow.x = pk2(o[vt][0] * r * gg[0] * __uint_as_float(sr.x << 16), o[vt][1] * r * gg[1] * __uint_as_float(sr.x & 0xffff0000u));
            ow.y = pk2(o[vt][2] * r * gg[2] * __uint_as_float(sr.y << 16), o[vt][3] * r * gg[3] * __uint_as_float(sr.y & 0xffff0000u));
            *(u32x2*)(OA + ob + 16 * vt) = ow; }
    }
}

__device__ __forceinline__ void p_attn_ref(Frame& F) {
    const bf16* QX = WSP(bf16, WS_QX); const bf16* KM = WSP(bf16, WS_KM); const bf16* VMT = WSP(bf16, WS_VMT); bf16* OX = WSP(bf16, WS_OX);
    LAS float* pbuf = (LAS float*)F.lds + F.wave * 256;
    const int gw = F.bid * NWAVES + F.wave, NGW = F.G * NWAVES, lane = F.lane;
    for (int it = gw; it < T * XH; it += NGW) {
        const int t = it >> 2, h = it & 3; const bf16* q = QX + (size_t)t * XA + h * XD;
        float s[4] = {0.f, 0.f, 0.f, 0.f};
        for (int d = 0; d < XD; d += 8) { f32x4 q0, q1; ld_bf8(q + d, q0, q1);
#pragma unroll
            for (int c = 0; c < 4; ++c) { f32x4 k0, k1; ld_bf8(KM + (size_t)(lane + 64 * c) * XA + h * XD + d, k0, k1);
#pragma unroll
                for (int j = 0; j < 4; ++j) s[c] += q0[j] * k0[j] + q1[j] * k1[j]; } }
        const float sc = 0.08838834764831845f;
        float mx = fmaxf(fmaxf(s[0], s[1]), fmaxf(s[2], s[3])) * sc; mx = wave_max(mx);
        float e[4], sum = 0.f;
#pragma unroll
        for (int c = 0; c < 4; ++c) { e[c] = __expf(s[c] * sc - mx); sum += e[c]; }
        sum = wave_sum(sum); const float inv = 1.0f / sum;
#pragma unroll
        for (int c = 0; c < 4; ++c) pbuf[lane + 64 * c] = bf2f((unsigned short)f2bf(e[c] * inv));
        LDS_WAIT(); asm volatile("" ::: "memory");
        float o0 = 0.f, o1 = 0.f; const bf16* v0 = VMT + (size_t)(h * XD + 2 * lane) * MEM; const bf16* v1 = v0 + MEM;
        for (int m = 0; m < MEM; m += 8) { f32x4 a0, a1, b0, b1; ld_bf8(v0 + m, a0, a1); ld_bf8(v1 + m, b0, b1); const f32x4 p0 = *(const LAS f32x4*)(pbuf + m), p1 = *(const LAS f32x4*)(pbuf + m + 4);
#pragma unroll
            for (int j = 0; j < 4; ++j) { o0 += p0[j] * a0[j] + p1[j] * a1[j]; o1 += p0[j] * b0[j] + p1[j] * b1[j]; } }
        *(unsigned*)(OX + (size_t)t * XA + h * XD + 2 * lane) = pk2(o0, o1);
        LDS_WAIT(); asm volatile("" ::: "memory");
    }
}

typedef float f32x16 __attribute__((ext_vector_type(16)));
__device__ __forceinline__ void p_router(Frame& F) {
    const float* X2 = WSP(float, WS_X1); bf16* H3 = WSP(bf16, WS_H3); const float* WR = WSP(float, WS_WR); const float* g = F.in[I_NMOEG]; const float* rb = F.in[I_RB];
    int* TKE = WSP(int, WS_TKE); int* TKP = WSP(int, WS_TKP); float* TKW = WSP(float, WS_TKW); unsigned* cnt = F.ctl + CW_CNT;
    LAS unsigned* lcnt = (LAS unsigned*)F.lds;
    LAS int* le = (LAS int*)(F.lds + 256);
    LAS int* lp = (LAS int*)(F.lds + 256 + 1024);
    LAS float* P = (LAS float*)(F.lds + 4096);
    LAS float* SSQ = (LAS float*)(F.lds + 4096 + 8 * 32 * 33 * 4);
    const int lane = F.lane, th = F.wave & 1, kq = F.wave >> 1, li = lane & 31, hh = lane >> 5;
    for (int blk = F.bid; blk < T / 64; blk += F.G) {
        __syncthreads();
        if (F.tid < 64) lcnt[F.tid] = 0u;
        const float* xr = X2 + (size_t)(blk * 64 + th * 32 + li) * D + kq * 512 + 4 * hh;
        const float* wr = WR + (size_t)li * D + kq * 512 + 4 * hh;
        f32x16 acc;
#pragma unroll
        for (int r = 0; r < 16; ++r) acc[r] = 0.f;
        float ss = 0.f;
#pragma unroll 4
        for (int q = 0; q < 64; ++q) {
            const f32x4 a = *(const f32x4*)(xr + 8 * q), b = *(const f32x4*)(wr + 8 * q);
            ss += (a[0] * a[0] + a[1] * a[1]) + (a[2] * a[2] + a[3] * a[3]);
#pragma unroll
            for (int s = 0; s < 4; ++s) acc = __builtin_amdgcn_mfma_f32_32x32x2f32(a[s], b[s], acc, 0, 0, 0);
        }
        ss += __shfl_xor(ss, 32);
#pragma unroll
        for (int r = 0; r < 16; ++r) P[(F.wave * 32 + (r & 3) + 8 * (r >> 2) + 4 * hh) * 33 + li] = acc[r];
        if (lane < 32) SSQ[F.wave * 32 + lane] = ss;
        __syncthreads();
        if (F.tid < 64) {
            const int tl = F.tid, th2 = tl >> 5, ti = tl & 31, t = blk * 64 + tl;
            float ssq = 0.f;
#pragma unroll
            for (int k4 = 0; k4 < 4; ++k4) ssq += SSQ[(k4 * 2 + th2) * 32 + ti];
            const float r = rsqrtf(ssq * (1.0f / D) + EPS);
            float v0 = -3.0e38f, v1 = -3.0e38f, v2 = -3.0e38f, v3 = -3.0e38f; int i0 = 0, i1 = 0, i2 = 0, i3 = 0;
            for (int e = 0; e < NE; ++e) {
                float x = 0.f;
#pragma unroll
                for (int k4 = 0; k4 < 4; ++k4) x += P[((k4 * 2 + th2) * 32 + ti) * 33 + e];
                x = x * r + rb[e];
                if (x > v3) {
                    if (x > v2) { v3 = v2; i3 = i2;
                        if (x > v1) { v2 = v1; i2 = i1;
                            if (x > v0) { v1 = v0; i1 = i0; v0 = x; i0 = e; } else { v1 = x; i1 = e; } }
                        else { v2 = x; i2 = e; } }
                    else { v3 = x; i3 = e; } }
            }
            const float e1 = __expf(v1 - v0), e2 = __expf(v2 - v0), e3 = __expf(v3 - v0), inv = 1.0f / (1.0f + e1 + e2 + e3);
            const unsigned p0 = __hip_atomic_fetch_add(lcnt + i0, 1u, __ATOMIC_RELAXED, __HIP_MEMORY_SCOPE_WORKGROUP);
            const unsigned p1 = __hip_atomic_fetch_add(lcnt + i1, 1u, __ATOMIC_RELAXED, __HIP_MEMORY_SCOPE_WORKGROUP);
            const unsigned p2 = __hip_atomic_fetch_add(lcnt + i2, 1u, __ATOMIC_RELAXED, __HIP_MEMORY_SCOPE_WORKGROUP);
            const unsigned p3 = __hip_atomic_fetch_add(lcnt + i3, 1u, __ATOMIC_RELAXED, __HIP_MEMORY_SCOPE_WORKGROUP);
            le[tl * 4 + 0] = i0; le[tl * 4 + 1] = i1; le[tl * 4 + 2] = i2; le[tl * 4 + 3] = i3;
            lp[tl * 4 + 0] = (int)p0; lp[tl * 4 + 1] = (int)p1; lp[tl * 4 + 2] = (int)p2; lp[tl * 4 + 3] = (int)p3;
            *(int4*)(TKE + t * 4) = make_int4(i0, i1, i2, i3);
            *(f32x4*)(TKW + t * 4) = (f32x4){inv, e1 * inv, e2 * inv, e3 * inv};
        }
        __syncthreads();
        if (F.tid < NE) lcnt[32 + F.tid] = __hip_atomic_fetch_add(cnt + 64 * F.tid, lcnt[F.tid], RLX_AGENT);
        __syncthreads();
        if (F.tid < 256) { const int tl = F.tid >> 2, k = F.tid & 3; TKP[(blk * 64 + tl) * 4 + k] = lp[tl * 4 + k] + (int)lcnt[32 + le[tl * 4 + k]]; }
        for (int tt = 0; tt < 8; ++tt) { const int t = blk * 64 + F.wave * 8 + tt; rms_row_to_bf16(X2 + (size_t)t * D, g, H3 + (size_t)t * D, lane); }
    }
}
__device__ __forceinline__ void p_lists(Frame& F) {
    unsigned* cnt = F.ctl + CW_CNT; int* TKE = WSP(int, WS_TKE); int* TKP = WSP(int, WS_TKP); int* ROWTOK = WSP(int, WS_ROWTOK); int* TILE = WSP(int, WS_TILE);
    LAS int* poff = (LAS int*)F.lds;
    LAS int* lc = (LAS int*)(F.lds + 256);
    __syncthreads();
    if (F.tid < NE) lc[F.tid] = (int)__hip_atomic_load(cnt + 64 * F.tid, RLX_AGENT);
    __syncthreads();
    if (F.tid == 0) { int o = 0; for (int e = 0; e < NE; ++e) { poff[e] = o; o += (lc[e] + 255) / 256 * 256; } poff[NE] = o; }
    __syncthreads();
    for (int i = F.bid * NTHR + F.tid; i < T * TOPK; i += F.G * NTHR) { const int e = TKE[i], slot = poff[e] + TKP[i]; TKP[i] = slot; ROWTOK[slot] = i >> 2; }
    if (F.bid == 0) {
        for (int e = 0; e < NE; ++e) for (int s = poff[e] + lc[e] + F.tid; s < poff[e + 1]; s += NTHR) ROWTOK[s] = T;
        for (int e = 0; e < NE; ++e) for (int tl = poff[e] / 256 + F.tid; tl < poff[e + 1] / 256; tl += NTHR) TILE[tl] = e;
        if (F.tid == 0) TILE[512] = poff[NE] / 256;
    }
    __syncthreads();
}
__device__ __forceinline__ void p_combine(Frame& F) {
    const float* X2 = WSP(float, WS_X1); const bf16* YS = WSP(bf16, WS_YS); const int* TKP = WSP(int, WS_TKP); const float* TKW = WSP(float, WS_TKW); const float* g = F.in[I_NFG];
    const int gw = F.bid * NWAVES + F.wave, NGW = F.G * NWAVES, lane = F.lane;
    for (int t = gw; t < T; t += NGW) {
        int sl[4]; float w[4];
#pragma unroll
        for (int k = 0; k < 4; ++k) { sl[k] = TKP[t * 4 + k]; w[k] = TKW[t * 4 + k]; }
        f32x4 v[8]; float s = 0.f;
#pragma unroll
        for (int j = 0; j < 8; ++j) { v[j] = *(const f32x4*)(X2 + (size_t)t * D + 4 * lane + 256 * j);
#pragma unroll
            for (int k = 0; k < 4; ++k) { const u32x2 y = *(const u32x2*)(YS + (size_t)sl[k] * D + 4 * lane + 256 * j);
                v[j][0] += w[k] * __uint_as_float(y.x << 16); v[j][1] += w[k] * __uint_as_float(y.x & 0xffff0000u); v[j][2] += w[k] * __uint_as_float(y.y << 16); v[j][3] += w[k] * __uint_as_float(y.y & 0xffff0000u); }
            s += (v[j][0] * v[j][0] + v[j][1] * v[j][1]) + (v[j][2] * v[j][2] + v[j][3] * v[j][3]); }
        const float r = rsqrtf(wave_sum(s) * (1.0f / D) + EPS);
#pragma unroll
        for (int j = 0; j < 8; ++j) { const f32x4 gg = *(const f32x4*)(g + 4 * lane + 256 * j); *(f32x4*)(F.out + (size_t)t * D + 4 * lane + 256 * j) = v[j] * r * gg; }
    }
}

constexpr int NPHASE = 16;
__global__ void __launch_bounds__(NTHR, 2) hybrid_fwd(Args args) {
    extern __shared__ __attribute__((aligned(16))) unsigned char lds_raw[];
    Frame F;
    F.lds = (LAS unsigned char*)lds_raw; F.ws = args.ws; F.ctl = (unsigned*)(args.ws + WS_CTL);
    F.tid = threadIdx.x; F.lane = F.tid & 63; F.wave = __builtin_amdgcn_readfirstlane(F.tid >> 6); F.G = gridDim.x; F.bid = blockIdx.x;
    F.in = args.in; F.out = args.out;
    volatile LAS unsigned* MISC = (volatile LAS unsigned*)(F.lds + MISC_OFF);
    if (F.tid < 32) MISC[F.tid] = 0u;
    __syncthreads();
#if MK_ONE_LAUNCH
    XcdBarrier bar = xcd_barrier_post(F.ctl + CW_BAR, MISC + 8);
#define GRID_BAR() xcd_barrier(bar)
#else
#define GRID_BAR() do {} while (0)
#endif
    const int lo = args.ph_lo, hi = args.ph_hi;
#ifndef ONLY_PHASE
#define ONLY_PHASE -1
#endif
#define IN(k) (lo <= (k) && (k) < hi && (ONLY_PHASE < 0 || ONLY_PHASE == (k)))
#define SEAM(k) do { if (IN(k) && IN((k) + 1)) GRID_BAR(); } while (0)

    if (IN(0)) { p0_prologue(F); }
    SEAM(0);
    if (IN(1)) {
        DenseSched S; S.init(WSP(bf16, WS_XN), WSP(bf16, WS_WIN), T, NIN, D, F.G, F.bid);
        EpiInProj E{WSP(bf16, WS_Q), WSP(bf16, WS_K), WSP(bf16, WS_V), WSP(bf16, WS_SR), WSP(bf16, WS_CB), WSP(bf16, WS_U), WSP(bf16, WS_SGA), WSP(bf16, WS_SGB), WSP(float, WS_LA), F.in[I_GGB]};
        gemm_any(F.lds, S, E);
        p_memkv(F);
    }
    SEAM(1);
    if (IN(2)) { p_conv(F); p_glaprep(F); }
    SEAM(2);
    if (IN(3)) {
#if OPT_GLA
        p_gla_a(F);
#else
        p_gla_ref(F);
#endif
    }
    SEAM(3);
    if (IN(4)) {
#if OPT_GLA
        p_gla_b(F);
#endif
    }
    SEAM(4);
    if (IN(5)) {
#if OPT_GLA
        p_gla_c(F);
#else
        p_gla_norm_ref(F);
#endif
    }
    SEAM(5);
    if (IN(6)) {
        { DenseSched S; S.init(WSP(bf16, WS_OA), WSP(bf16, WS_WGO), T, D, D, F.G, F.bid); EpiGateA E{WSP(float, WS_T1), WSP(bf16, WS_SGA)}; gemm_any(F.lds, S, E); }
        VM_WAIT(); __syncthreads();
        { DenseSched S; S.init(WSP(bf16, WS_Z), WSP(bf16, WS_WCO), T, D, D, F.G, F.bid); EpiGateB E{WSP(float, WS_T1), WSP(bf16, WS_SGB), WSP(bf16, WS_MG)}; gemm_any(F.lds, S, E); }
    }
    SEAM(6);
    if (IN(7)) { DenseSched S; S.init(WSP(bf16, WS_MG), WSP(bf16, WS_WMX), T, D, D, F.G, F.bid); EpiResid1 E{F.in[I_X], WSP(float, WS_X1), WSP(bf16, WS_X1B), (float*)(F.ctl + CW_SS1)}; gemm_any(F.lds, S, E); }
    SEAM(7);
    if (IN(8)) { DenseSched S; S.init(WSP(bf16, WS_X1B), WSP(bf16, WS_WXQ), T, XA, D, F.G, F.bid); EpiXQ E{WSP(bf16, WS_QX), (const float*)(F.ctl + CW_SS1)}; gemm_any(F.lds, S, E); }
    SEAM(8);
    if (IN(9)) {
#if OPT_ATT
#else
        p_attn_ref(F);
#endif
    }
    SEAM(9);
    if (IN(10)) { DenseSched S; S.init(WSP(bf16, WS_OX), WSP(bf16, WS_WXO), T, D, XA, F.G, F.bid); EpiResid2 E{WSP(float, WS_X1)}; gemm_any(F.lds, S, E); }
    SEAM(10);
    if (IN(11)) { p_router(F); }
    SEAM(11);
    if (IN(12)) { p_lists(F); }
    SEAM(12);
    if (IN(13)) { const int ntiles = __builtin_amdgcn_readfirstlane(ld_agent_i(WSP(int, WS_TILE) + 512));
        GroupSched S; S.init(WSP(bf16, WS_H3), WSP(bf16, WS_WGU), ntiles, 2 * FF, D, F.G, F.bid, WSP(int, WS_TILE), WSP(int, WS_ROWTOK)); EpiGU E{WSP(bf16, WS_ACT), F.in[I_GUB]}; gemm_any(F.lds, S, E); }
    SEAM(13);
    if (IN(14)) { const int ntiles = __builtin_amdgcn_readfirstlane(ld_agent_i(WSP(int, WS_TILE) + 512));
        GroupSched S; S.init(WSP(bf16, WS_ACT), WSP(bf16, WS_WDN), ntiles, D, FF, F.G, F.bid, WSP(int, WS_TILE), nullptr); EpiDown E{WSP(bf16, WS_YS), F.in[I_DNB]}; gemm_any(F.lds, S, E); }
    SEAM(14);
    if (IN(15)) { p_combine(F); }
#undef IN
#undef SEAM
}

extern "C" void kernel_launch(void* const* d_in, const int* in_sizes, int n_in, void* d_out, int out_size, void* d_ws, size_t ws_size, hipStream_t stream) {
    static int grid = 0;
    if (grid == 0) {
        if (n_in != 26 || out_size != T * D || ws_size < WS_END) { fprintf(stderr, "kernel_launch: unexpected problem (n_in %d, out %d, ws %zu < %zu)\n", n_in, out_size, ws_size, (size_t)WS_END); grid = -1; return; }
        int dev = 0, cus = 0, per_cu = 0;
        if (hipGetDevice(&dev) != hipSuccess || hipDeviceGetAttribute(&cus, hipDeviceAttributeMultiprocessorCount, dev) != hipSuccess) { grid = -1; return; }
        if (hipFuncSetAttribute((const void*)hybrid_fwd, hipFuncAttributeMaxDynamicSharedMemorySize, LDS_BYTES) != hipSuccess) { fprintf(stderr, "kernel_launch: hipFuncSetAttribute failed\n"); grid = -1; return; }
        if (hipOccupancyMaxActiveBlocksPerMultiprocessor(&per_cu, (const void*)hybrid_fwd, NTHR, LDS_BYTES) != hipSuccess || per_cu < 1) fprintf(stderr, "kernel_launch: occupancy query says %d\n", per_cu);
        (void)hipGetLastError();
        grid = cus;
    }
    if (grid < 0) return;
    (void)hipMemsetAsync((char*)d_ws + WS_CTL, 0, CTL_ZERO_BYTES, stream);
    Args a{};
    for (int i = 0; i < 26; ++i) a.in[i] = (const float*)d_in[i];
    a.out = (float*)d_out; a.ws = (unsigned char*)d_ws;
#if MK_ONE_LAUNCH
    a.ph_lo = 0; a.ph_hi = NPHASE;
    hipLaunchKernelGGL(hybrid_fwd, dim3(grid), dim3(NTHR), LDS_BYTES, stream, a);
#else
    for (int p = 0; p < NPHASE; ++p) { a.ph_lo = p; a.ph_hi = p + 1; hipLaunchKernelGGL(hybrid_fwd, dim3(grid), dim3(NTHR), LDS_BYTES, stream, a); }
#endif
}
```

```cpp
#include <hip/hip_runtime.h>
#include <cstdio>
#include <cstdint>

#ifndef MK_ONE_LAUNCH
#define MK_ONE_LAUNCH 1
#endif
#ifndef OPT_GEMM
#define OPT_GEMM 1
#endif
#ifndef OPT_GLA
#define OPT_GLA 1
#endif
#ifndef OPT_ATT
#define OPT_ATT 1
#endif

#define GAS __attribute__((address_space(1)))
#define LAS __attribute__((address_space(3)))
typedef unsigned short bf16;
typedef short bf16x8 __attribute__((ext_vector_type(8)));
typedef short bf16x4 __attribute__((ext_vector_type(4)));
typedef float f32x4 __attribute__((ext_vector_type(4)));
typedef float f32x2 __attribute__((ext_vector_type(2)));
typedef unsigned u32x4 __attribute__((ext_vector_type(4)));
typedef unsigned u32x2 __attribute__((ext_vector_type(2)));
#define RLX_AGENT __ATOMIC_RELAXED, __HIP_MEMORY_SCOPE_AGENT
#define LDS_WAIT() asm volatile("s_waitcnt lgkmcnt(0)" ::: "memory")
#define VM_WAIT() asm volatile("s_waitcnt vmcnt(0)" ::: "memory")

constexpr int T = 16384, D = 2048, MEM = 256;
constexpr int GH = 4, DK = 256, DV = 512, QK = GH * DK  , VD = GH * DV  ;
constexpr int CH = 64, NCH = T / CH  , NG = 16, GC = NCH / NG  , GT = GC * CH  ;
constexpr int XH = 4, XD = 128, XA = XH * XD  ;
constexpr int NE = 32, TOPK = 4, FF = 2048;
constexpr int NIN_SRC = 16400, NIN = 17408;
constexpr float EPS = 1e-5f;
constexpr int PROWS = T * TOPK + NE * 256;
constexpr int MAXTILES = PROWS / 256;

constexpr int SRC_ALOW = 6144, SRC_CB = 6160, SRC_CC = 8208, SRC_CHH = 10256, SRC_GA = 12304, SRC_GB = 14352;
constexpr int TN_Q = 0, TN_K = 4, TN_V = 8, TN_R = 16, TN_LA = 24, TN_CB = 28, TN_U = 36, TN_GA = 52, TN_GB = 60, TN_END = 68;

constexpr size_t MiB = 1u << 20;
constexpr size_t WS_CTL = 0, CTL_ZERO_BYTES = 1 * MiB;
constexpr size_t WS_WIN = 1 * MiB;
constexpr size_t WS_WGO = WS_WIN + 68 * MiB;
constexpr size_t WS_WCO = WS_WGO + 8 * MiB;
constexpr size_t WS_WMX = WS_WCO + 8 * MiB;
constexpr size_t WS_WXQ = WS_WMX + 8 * MiB;
constexpr size_t WS_WXKV = WS_WXQ + 2 * MiB;
constexpr size_t WS_WXO = WS_WXKV + 4 * MiB;
constexpr size_t WS_WR = WS_WXO + 2 * MiB;
constexpr size_t WS_WGU = WS_WR + 1 * MiB;
constexpr size_t WS_WDN = WS_WGU + 512 * MiB;
constexpr size_t WS_XN = WS_WDN + 256 * MiB;
constexpr size_t WS_Q = WS_XN + 64 * MiB;
constexpr size_t WS_K = WS_Q + 32 * MiB;
constexpr size_t WS_V = WS_K + 32 * MiB;
constexpr size_t WS_SR = WS_V + 64 * MiB;
constexpr size_t WS_LA = WS_SR + 64 * MiB;
constexpr size_t WS_CB = WS_LA + 64 * MiB;
constexpr size_t WS_U = WS_CB + 64 * MiB;
constexpr size_t WS_SGA = WS_U + 64 * MiB;
constexpr size_t WS_SGB = WS_SGA + 64 * MiB;
constexpr size_t WS_QT = WS_SGB + 64 * MiB;
constexpr size_t WS_KH = WS_QT + 32 * MiB;
constexpr size_t WS_KHT = WS_KH + 32 * MiB;
constexpr size_t WS_QG = WS_KHT + 32 * MiB;
constexpr size_t WS_VT = WS_QG + 32 * MiB;
constexpr size_t WS_DL = WS_VT + 64 * MiB;
constexpr size_t WS_DG = WS_DL + 1 * MiB;
constexpr size_t WS_Z = WS_DG + 1 * MiB;
constexpr size_t WS_OL = WS_Z + 64 * MiB;
constexpr size_t WS_SLOC = WS_OL + 64 * MiB;
constexpr size_t WS_SG0 = WS_SLOC + 32 * MiB;
constexpr size_t WS_O32 = WS_SG0 + 16 * MiB;
constexpr size_t WS_OA = WS_O32 + 128 * MiB;
constexpr size_t WS_T1 = WS_OA + 64 * MiB;
constexpr size_t WS_MG = WS_T1 + 128 * MiB;
constexpr size_t WS_X1 = WS_MG + 64 * MiB;
constexpr size_t WS_X1B = WS_X1 + 128 * MiB;
constexpr size_t WS_QX = WS_X1B + 64 * MiB;
constexpr size_t WS_OX = WS_QX + 16 * MiB;
constexpr size_t WS_MEMN = WS_OX + 16 * MiB;
constexpr size_t WS_KM = WS_MEMN + 1 * MiB;
constexpr size_t WS_VMT = WS_KM + 1 * MiB;
constexpr size_t WS_H3 = WS_VMT + 1 * MiB;
constexpr size_t WS_TKE = WS_H3 + 65 * MiB;
constexpr size_t WS_TKP = WS_TKE + 1 * MiB;
constexpr size_t WS_TKW = WS_TKP + 1 * MiB;
constexpr size_t WS_ROWTOK = WS_TKW + 1 * MiB;
constexpr size_t WS_TILE = WS_ROWTOK + 1 * MiB;
constexpr size_t WS_ACT = WS_TILE + 1 * MiB;
constexpr size_t WS_YS = WS_ACT + 288 * MiB;
constexpr size_t WS_END = WS_YS + 288 * MiB;
constexpr int CW_BAR = 4096;
constexpr int CW_CNT = 16384;
constexpr int CW_SS1 = 65536;
static_assert((CW_SS1 + T) * 4 <= (int)CTL_ZERO_BYTES, "ctl");

constexpr int NWAVES = 8, NTHR = 512;
constexpr int LDS_BYTES = 147456;
constexpr int MISC_OFF = 147200;

__device__ __forceinline__ float bf2f(unsigned short b) { return __uint_as_float(((unsigned)b) << 16); }
__device__ __forceinline__ unsigned f2bf(float f) { unsigned u = __float_as_uint(f); return (u + 0x7fffu + ((u >> 16) & 1u)) >> 16; }
__device__ __forceinline__ unsigned pk2(float lo, float hi) { return f2bf(lo) | (f2bf(hi) << 16); }
__device__ __forceinline__ float wave_sum(float v) {
#pragma unroll
    for (int o = 1; o < 64; o <<= 1) v += __shfl_xor(v, o);
    return v;
}
__device__ __forceinline__ float wave_max(float v) {
#pragma unroll
    for (int o = 1; o < 64; o <<= 1) v = fmaxf(v, __shfl_xor(v, o));
    return v;
}
__device__ __forceinline__ float sigmoidf_(float x) { return 1.0f / (1.0f + __expf(-x)); }
__device__ __forceinline__ float logsigmoidf_(float z) { return z < 0.f ? z - log1pf(__expf(z)) : -log1pf(__expf(-z)); }
__device__ __forceinline__ u32x4 pack8(f32x4 a, f32x4 b) { u32x4 w; w.x = pk2(a[0], a[1]); w.y = pk2(a[2], a[3]); w.z = pk2(b[0], b[1]); w.w = pk2(b[2], b[3]); return w; }
__device__ __forceinline__ void unpack8(u32x4 w, f32x4& a, f32x4& b) {
    a[0] = __uint_as_float(w.x << 16); a[1] = __uint_as_float(w.x & 0xffff0000u); a[2] = __uint_as_float(w.y << 16); a[3] = __uint_as_float(w.y & 0xffff0000u);
    b[0] = __uint_as_float(w.z << 16); b[1] = __uint_as_float(w.z & 0xffff0000u); b[2] = __uint_as_float(w.w << 16); b[3] = __uint_as_float(w.w & 0xffff0000u);
}
__device__ __forceinline__ int ld_agent_i(const int* p) { return (int)__hip_atomic_load((const unsigned*)p, RLX_AGENT); }

#define XB_TMO      128
#define XB_XCNT(j)  (256  + 64 * (j))
#define XB_XSUB(j)  (1280 + 64 * (j))
#define XB_XGEN(j)  (2304 + 64 * (j))
#define XB_TOP      3328
#define XB_TOPGEN   3392
#define XCD_BAR_WORDS 3456
#define XB_SPIN_CAP (1u << 22)
__device__ __forceinline__ unsigned xb_ld(unsigned* p)              { return __hip_atomic_load(p, __ATOMIC_RELAXED, __HIP_MEMORY_SCOPE_AGENT); }
__device__ __forceinline__ unsigned xb_add(unsigned* p, unsigned v) { return __hip_atomic_fetch_add(p, v, __ATOMIC_RELAXED, __HIP_MEMORY_SCOPE_AGENT); }
__device__ __forceinline__ unsigned xb_xcc_id() { return (unsigned)__builtin_amdgcn_s_getreg((3 << 11) | 20) & 0xFu; }
#define XB_SPIN(cond, bar) do { unsigned _sp = 0; while (cond) { __builtin_amdgcn_s_sleep(1); \
    if ((++_sp & 255u) == 0u) { if (xb_ld(&(bar)[XB_TMO])) break; if (_sp > XB_SPIN_CAP) { atomicAdd(&(bar)[XB_TMO], 1u); break; } } } } while (0)
struct XcdBarrier { unsigned* bar; unsigned x; volatile LAS unsigned* st; };
__device__ __forceinline__ XcdBarrier xcd_barrier_post(unsigned* bar, volatile LAS unsigned* st) {
    XcdBarrier b; b.bar = bar; b.x = xb_xcc_id(); b.st = st;
    if (threadIdx.x == 0) (void)xb_add(&bar[XB_XCNT(b.x)], 1u);
    return b;
}
__device__ __forceinline__ void xcd_barrier_complete(unsigned* bar, unsigned x, unsigned& nloc, unsigned& nx) {
    const unsigned G = gridDim.x * gridDim.y * gridDim.z;
    unsigned sum, cnt, mine, sp = 0u;
    for (;;) {
        sum = 0u; cnt = 0u; mine = 0u;
#pragma unroll
        for (unsigned j = 0; j < 16; ++j) { const unsigned c = xb_ld(&bar[XB_XCNT(j)]); sum += c; cnt += (c > 0u) ? 1u : 0u; mine = (j == x) ? c : mine; }
        if (sum == G) break;
        __builtin_amdgcn_s_sleep(1);
        if ((++sp & 255u) == 0u) { if (xb_ld(&bar[XB_TMO])) break; if (sp > XB_SPIN_CAP) { atomicAdd(&bar[XB_TMO], 1u); break; } }
    }
    nloc = mine > 0u ? mine : 1u; nx = cnt > 0u ? cnt : 1u;
}
__device__ __forceinline__ void xcd_barrier(const XcdBarrier& b) {
    asm volatile("s_waitcnt vmcnt(0)" ::: "memory");
    __syncthreads();
    if (threadIdx.x == 0) {
        unsigned* bar = b.bar;
        __builtin_amdgcn_s_waitcnt(0);
        unsigned nloc = b.st[0], nx = b.st[1];
        if (nloc == 0u) { xcd_barrier_complete(bar, b.x, nloc, nx); b.st[0] = nloc; b.st[1] = nx; }
        const unsigned old = xb_add(&bar[XB_XSUB(b.x)], 1u);
        const unsigned gen = old / nloc;
        if (old + 1u == (gen + 1u) * nloc) {
            __builtin_amdgcn_fence(__ATOMIC_RELEASE, "agent");
            asm volatile("s_waitcnt vmcnt(0)" ::: "memory");
            const unsigned og = xb_add(&bar[XB_TOP], 1u);
            const unsigned tg = og / nx;
            if (og + 1u == (tg + 1u) * nx) xb_add(&bar[XB_TOPGEN], 1u);
            else XB_SPIN(xb_ld(&bar[XB_TOPGEN]) == tg, bar);
            __builtin_amdgcn_fence(__ATOMIC_ACQUIRE, "agent");
            xb_add(&bar[XB_XGEN(b.x)], 1u);
            asm volatile("s_waitcnt vmcnt(0)" ::: "memory");
        } else {
            XB_SPIN(xb_ld(&bar[XB_XGEN(b.x)]) == gen, bar);
            __builtin_amdgcn_fence(__ATOMIC_ACQUIRE, "agent");
            asm volatile("s_waitcnt vmcnt(0)" ::: "memory");
        }
    }
    __syncthreads();
}

struct Args { const float* in[26]; float* out; unsigned char* ws; int ph_lo, ph_hi; };
struct Frame {
    LAS unsigned char* lds; unsigned char* ws; unsigned* ctl;
    int tid, lane, wave, G, bid;
    const float* const* in;
    float* out;
};
#define WSP(type, off) ((type*)(F.ws + (off)))
enum { I_X = 0, I_MEM, I_NMIXG, I_WIN, I_GGW, I_GGB, I_GNG, I_GOW, I_CW, I_CBIAS, I_COW, I_MXW, I_NXG, I_NMG, I_XQ, I_XK, I_XV, I_XO, I_NMOEG, I_RW, I_RB, I_GUW, I_GUB, I_DNW, I_DNB, I_NFG };

constexpr int BM = 256, BK = 64, HALF = 128, HTB = HALF * BK * 2, NXCD = 8, WGM = 8;
__device__ __forceinline__ int lds_byte(int r, int c) { const int st = (r >> 4) * 2 + (c >> 5), rr = r & 15, cc = c & 31, ob = rr * 64 + cc * 2; return st * 1024 + (ob ^ (((ob >> 9) & 1) << 5)); }
__device__ __forceinline__ void stage_rc(int b, int& R, int& C) { const int st = b / 1024, sb = b % 1024, swz = sb ^ (((sb >> 9) & 1) << 5); R = (st >> 1) * 16 + swz / 64; C = (st & 1) * 32 + (swz % 64) / 2; }
__device__ __forceinline__ int perm32(int rho) { const int n = rho >> 4, i = rho & 15; return 8 * (i >> 2) + 4 * n + (i & 3); }

struct Unit { int pm, pn, e; };
__device__ __forceinline__ bool static_next(int i, int G, int c, int nM, int nN, Unit& u) {
    const int nwg = nM * nN; const long L = (long)i * G + c; if (L >= nwg) return false;
    int wgid = (int)L; { const int q = nwg / NXCD, r = nwg % NXCD, xcd = wgid % NXCD, off = wgid / NXCD; wgid = (xcd < r ? xcd * (q + 1) : r * (q + 1) + (xcd - r) * q) + off; }
    const int nig = WGM * nN, gid = wgid / nig, fm = gid * WGM, gsz = (nM - fm) < WGM ? (nM - fm) : WGM;
    u.pm = fm + ((wgid % nig) % gsz); u.pn = (wgid % nig) / gsz; u.e = 0; return true;
}
struct DenseSched {
    const char* A; const char* Bt; int K, nM, nN, G, c;
    __device__ __forceinline__ void init(const void* A_, const void* Bt_, int M, int N, int K_, int G_, int c_) { A = (const char*)A_; Bt = (const char*)Bt_; K = K_; nM = M / BM; nN = N / BM; G = G_; c = c_; }
    __device__ __forceinline__ bool next(int i, Unit& u) const { return static_next(i, G, c, nM, nN, u); }
    __device__ __forceinline__ const char* a_base() const { return A; }
    __device__ __forceinline__ const char* b_base(const Unit& u) const { return Bt + (size_t)u.pn * BM * K * 2; }
    __device__ __forceinline__ unsigned a_src_row(const Unit& u, int r) const { return (unsigned)(u.pm * BM + r); }
};
struct GroupSched {
    const char* A; const char* Bt; int K, N, nM, nN, G, c; const int* tile_e; const int* row_tok;
    __device__ __forceinline__ void init(const void* A_, const void* Bt_, int ntiles, int N_, int K_, int G_, int c_, const int* te, const int* rt) { A = (const char*)A_; Bt = (const char*)Bt_; K = K_; N = N_; nM = ntiles; nN = N_ / BM; G = G_; c = c_; tile_e = te; row_tok = rt; }
    __device__ __forceinline__ bool next(int i, Unit& u) const { if (!static_next(i, G, c, nM, nN, u)) return false; u.e = __builtin_amdgcn_readfirstlane(ld_agent_i(tile_e + u.pm)); return true; }
    __device__ __forceinline__ const char* a_base() const { return A; }
    __device__ __forceinline__ const char* b_base(const Unit& u) const { return Bt + ((size_t)u.e * N + (size_t)u.pn * BM) * K * 2; }
    __device__ __forceinline__ unsigned a_src_row(const Unit& u, int r) const { return row_tok ? (unsigned)ld_agent_i(row_tok + u.pm * BM + r) : (unsigned)(u.pm * BM + r); }
};

template <class Epi, class Sched>
__device__ __forceinline__ void gemm_ref(LAS unsigned char* lds, const Sched& S, const Epi& E) {
    const int tid = threadIdx.x, tx = tid & 15, ty = tid >> 4, K = S.K;
    LAS float* As = (LAS float*)lds; LAS float* Bs = As + 16 * 260;
    const int lr = tid >> 1, kh = tid & 1;
    for (int i = 0;; ++i) {
        Unit u; if (!S.next(i, u)) break;
        float acc[8][16];
#pragma unroll
        for (int j = 0; j < 8; ++j)
#pragma unroll
            for (int q = 0; q < 16; ++q) acc[j][q] = 0.f;
        const char* Ab = S.a_base() + ((size_t)S.a_src_row(u, lr) * K + 8 * kh) * 2;
        const char* Bb = S.b_base(u) + ((size_t)lr * K + 8 * kh) * 2;
        for (int k0 = 0; k0 < K; k0 += 16) {
            const bf16x8 av = *(const bf16x8*)(Ab + (size_t)k0 * 2), bv = *(const bf16x8*)(Bb + (size_t)k0 * 2);
            __syncthreads();
#pragma unroll
            for (int j = 0; j < 8; ++j) { As[(8 * kh + j) * 260 + lr] = bf2f((unsigned short)av[j]); Bs[(8 * kh + j) * 260 + lr] = bf2f((unsigned short)bv[j]); }
            __syncthreads();
#pragma unroll 4
            for (int kk = 0; kk < 16; ++kk) {
                float a[8], b[16];
#pragma unroll
                for (int j = 0; j < 8; ++j) a[j] = As[kk * 260 + ty + 32 * j];
                const f32x4 b0 = *(const LAS f32x4*)(Bs + kk * 260 + 8 * tx), b1 = *(const LAS f32x4*)(Bs + kk * 260 + 8 * tx + 4);
                const f32x4 b2 = *(const LAS f32x4*)(Bs + kk * 260 + 128 + 8 * tx), b3 = *(const LAS f32x4*)(Bs + kk * 260 + 128 + 8 * tx + 4);
#pragma unroll
                for (int q = 0; q < 4; ++q) { b[q] = b0[q]; b[4 + q] = b1[q]; b[8 + q] = b2[q]; b[12 + q] = b3[q]; }
#pragma unroll
                for (int j = 0; j < 8; ++j)
#pragma unroll
                    for (int q = 0; q < 16; ++q) acc[j][q] += a[j] * b[q];
            }
        }
#pragma unroll 8
        for (int j = 0; j < 8; ++j) {
            const f32x4 a0 = {acc[j][0], acc[j][1], acc[j][2], acc[j][3]}, a1 = {acc[j][4], acc[j][5], acc[j][6], acc[j][7]};
            const f32x4 b0 = {acc[j][8], acc[j][9], acc[j][10], acc[j][11]}, b1 = {acc[j][12], acc[j][13], acc[j][14], acc[j][15]};
            E.template row8<false>(u.pm * BM + ty + 32 * j, u, 8 * tx, a0, a1, b0, b1);
        }
    }
    __syncthreads();
}

template <class Epi, class Sched>
__device__ __forceinline__ void gemm_mfma(LAS unsigned char* lds, const Sched& S, const Epi& E) {
    const int tid = threadIdx.x, wid = __builtin_amdgcn_readfirstlane(tid >> 6), lane = tid & 63, wr = wid >> 2, wc = wid & 3, fr = lane & 15, fq = lane >> 4;
    const int K = S.K, nt = K / BK;
    int Rr[2], Cc[2]; unsigned voffB[2];
#pragma unroll
    for (int i = 0; i < 2; ++i) { stage_rc(tid * 16 + i * 8192, Rr[i], Cc[i]); const int Rb = (Rr[i] & ~31) + perm32(Rr[i] & 31); voffB[i] = (unsigned)(Rb * K + Cc[i]) * 2u; }
    const size_t kstep = (size_t)(BK * 2);
    const size_t hstep = (size_t)HALF * K * 2;
    const unsigned ldsw = (unsigned)wid * 1024u;
    const int aoff = lds_byte(wr * 64 + fr, fq * 8), boff = lds_byte(wc * 32 + fr, fq * 8);
#define PG8_SA(b, h) (((b) * 2 + (h)) * HTB)
#define PG8_SB(b, h) ((4 + (b) * 2 + (h)) * HTB)
#define PG8_STAGE(bufoff, gbase, voff) do { _Pragma("unroll") for (int _i = 0; _i < 2; ++_i) \
        __builtin_amdgcn_global_load_lds((const unsigned*)((const char*)(gbase) + (voff)[_i]), (LAS unsigned*)(lds + (bufoff) + ldsw + _i * 8192), 16, 0, 0); } while (0)
#define PG8_LDA(dst, b, h) do { _Pragma("unroll") for (int m = 0; m < 4; ++m) _Pragma("unroll") for (int k = 0; k < 2; ++k) dst[m][k] = *(const LAS bf16x8*)(lds + PG8_SA(b, h) + aoff + m * 2048 + k * 1024); } while (0)
#define PG8_LDB(dst, b, h) do { _Pragma("unroll") for (int n = 0; n < 2; ++n) _Pragma("unroll") for (int k = 0; k < 2; ++k) dst[n][k] = *(const LAS bf16x8*)(lds + PG8_SB(b, h) + boff + n * 2048 + k * 1024); } while (0)
#define PG8_MMA(ai, bj, At, Bt) do { __builtin_amdgcn_s_setprio(1); _Pragma("unroll") for (int m = 0; m < 4; ++m) _Pragma("unroll") for (int n = 0; n < 2; ++n) _Pragma("unroll") for (int k = 0; k < 2; ++k) \
        acc[ai][bj][m][n] = __builtin_amdgcn_mfma_f32_16x16x32_bf16(Bt[n][k], At[m][k], acc[ai][bj][m][n], 0, 0, 0); __builtin_amdgcn_s_setprio(0); } while (0)
#define PG8_WAIT_V(n) asm volatile("s_waitcnt vmcnt(" #n ")" ::: "memory")
#define PG8_WAIT_L(n) asm volatile("s_waitcnt lgkmcnt(" #n ")" ::: "memory")
#define PG8_BAR __builtin_amdgcn_s_barrier()
#define PG8_SCHED __builtin_amdgcn_sched_barrier(0)
#define PG8_AOFF(dst, uu) do { _Pragma("unroll") for (int _h = 0; _h < 2; ++_h) _Pragma("unroll") for (int _i = 0; _i < 2; ++_i) dst[_h][_i] = (S.a_src_row(uu, _h * HALF + Rr[_i]) * (unsigned)K + (unsigned)Cc[_i]) * 2u; } while (0)
    Unit cur, nxt; int ui = 0;
    if (!S.next(0, cur)) return;
    f32x4 acc[2][2][4][2];
#pragma unroll
    for (int a = 0; a < 2; ++a)
#pragma unroll
        for (int b = 0; b < 2; ++b)
#pragma unroll
            for (int m = 0; m < 4; ++m)
#pragma unroll
                for (int n = 0; n < 2; ++n) acc[a][b][m][n] = (f32x4){0.f, 0.f, 0.f, 0.f};
    bf16x8 At[4][2], B0[2][2], B1[2][2];
    unsigned coff[2][2], noff[2][2];
    PG8_AOFF(coff, cur);
    const char* cA = S.a_base(); const char* cB = S.b_base(cur);
    PG8_STAGE(PG8_SB(0, 0), cB, voffB); PG8_STAGE(PG8_SB(0, 1), cB + hstep, voffB); PG8_STAGE(PG8_SA(0, 0), cA, coff[0]); PG8_STAGE(PG8_SA(0, 1), cA, coff[1]);
    if (wr == 1) PG8_BAR;
    PG8_WAIT_V(2); PG8_BAR;
    PG8_STAGE(PG8_SB(1, 0), cB + kstep, voffB); PG8_STAGE(PG8_SA(1, 0), cA + kstep, coff[0]); PG8_STAGE(PG8_SB(1, 1), cB + hstep + kstep, voffB);
    PG8_WAIT_V(6); PG8_BAR;
    for (;;) {
        const bool has_next = S.next(ui + 1, nxt);
        const char* nB = cB;
#pragma unroll
        for (int _h = 0; _h < 2; ++_h)
#pragma unroll
            for (int _i = 0; _i < 2; ++_i) noff[_h][_i] = coff[_h][_i];
        if (has_next) { nB = S.b_base(nxt); PG8_AOFF(noff, nxt); }
        for (int t = 0; t < nt; t += 2) {
            const bool last = (t == nt - 2);
            const char* a1 = cA + (size_t)(t + 1) * kstep;
            const char* a2 = last ? cA : cA + (size_t)(t + 2) * kstep; const char* b2 = last ? nB : cB + (size_t)(t + 2) * kstep;
            const char* a3 = a2 + kstep; const char* b3 = b2 + kstep;
            unsigned o2[2][2];
#pragma unroll
            for (int _h = 0; _h < 2; ++_h)
#pragma unroll
                for (int _i = 0; _i < 2; ++_i) o2[_h][_i] = last ? noff[_h][_i] : coff[_h][_i];
            PG8_LDB(B0, 0, 0); PG8_LDB(B1, 0, 1); PG8_SCHED; PG8_LDA(At, 0, 0); PG8_STAGE(PG8_SA(1, 1), a1, coff[1]);
            PG8_WAIT_V(8); PG8_WAIT_L(0); PG8_BAR; PG8_MMA(0, 0, At, B0); PG8_MMA(0, 1, At, B1); PG8_BAR; PG8_SCHED;
            PG8_LDA(At, 0, 1); PG8_STAGE(PG8_SB(0, 0), b2, voffB); PG8_STAGE(PG8_SB(0, 1), b2 + hstep, voffB); PG8_STAGE(PG8_SA(0, 0), a2, o2[0]);
            PG8_WAIT_V(8); PG8_WAIT_L(0); PG8_BAR; PG8_MMA(1, 0, At, B0); PG8_MMA(1, 1, At, B1); PG8_BAR; PG8_SCHED;
            PG8_LDB(B0, 1, 0); PG8_LDB(B1, 1, 1); PG8_SCHED; PG8_LDA(At, 1, 0); PG8_STAGE(PG8_SA(0, 1), a2, o2[1]);
            PG8_WAIT_V(8); PG8_WAIT_L(0); PG8_BAR; PG8_MMA(0, 0, At, B0); PG8_MMA(0, 1, At, B1); PG8_BAR; PG8_SCHED;
            PG8_LDA(At, 1, 1); PG8_STAGE(PG8_SB(1, 0), b3, voffB); PG8_STAGE(PG8_SB(1, 1), b3 + hstep, voffB); PG8_STAGE(PG8_SA(1, 0), a3, o2[0]);
            PG8_WAIT_V(8); PG8_WAIT_L(0); PG8_BAR; PG8_MMA(1, 0, At, B0); PG8_MMA(1, 1, At, B1); PG8_BAR; PG8_SCHED;
        }
        if (wr == 0) PG8_BAR;
#pragma unroll 2
        for (int ai = 0; ai < 2; ++ai)
#pragma unroll 4
            for (int m = 0; m < 4; ++m)
                E.template row8<true>(cur.pm * BM + ai * HALF + wr * 64 + m * 16 + fr, cur, wc * 32 + 8 * fq, acc[ai][0][m][0], acc[ai][0][m][1], acc[ai][1][m][0], acc[ai][1][m][1]);
        if (!has_next) break;
#pragma unroll
        for (int a = 0; a < 2; ++a)
#pragma unroll
            for (int b = 0; b < 2; ++b)
#pragma unroll
                for (int m = 0; m < 4; ++m)
#pragma unroll
                    for (int n = 0; n < 2; ++n) acc[a][b][m][n] = (f32x4){0.f, 0.f, 0.f, 0.f};
        cur = nxt; cB = nB;
#pragma unroll
        for (int _h = 0; _h < 2; ++_h)
#pragma unroll
            for (int _i = 0; _i < 2; ++_i) coff[_h][_i] = noff[_h][_i];
        ++ui;
        if (wr == 1) PG8_BAR;
    }
    PG8_WAIT_V(0);
    PG8_BAR;
#undef PG8_SA
#undef PG8_SB
#undef PG8_STAGE
#undef PG8_LDA
#undef PG8_LDB
#undef PG8_MMA
#undef PG8_WAIT_V
#undef PG8_WAIT_L
#undef PG8_BAR
#undef PG8_SCHED
#undef PG8_AOFF
}
template <class Epi, class Sched>
__device__ __forceinline__ void gemm_any(LAS unsigned char* lds, const Sched& S, const Epi& E) {
#if OPT_GEMM
    gemm_mfma<Epi, Sched>(lds, S, E);
#else
    gemm_ref<Epi, Sched>(lds, S, E);
#endif
}

__device__ __forceinline__ void st_bf8(bf16* p, f32x4 a, f32x4 b) { *(u32x4*)p = pack8(a, b); }
__device__ __forceinline__ void ld_bf8(const bf16* p, f32x4& a, f32x4& b) { unpack8(*(const u32x4*)p, a, b); }

struct EpiInProj {
    bf16 *Q, *Kk, *V, *SR, *CB, *U, *SGA, *SGB; float* LA; const float* gate_b;
    template <bool MF> __device__ __forceinline__ void row8(int row, const Unit& u, int c0, f32x4 a0, f32x4 a1, f32x4 b0, f32x4 b1) const {
        const int pn = u.pn;
        if (pn >= TN_LA && pn < TN_CB) {
            const int col = (pn - TN_LA) * 256 + c0; float* p = LA + (size_t)row * QK + col; const float* gb = gate_b + col;
            const f32x4 g0 = *(const f32x4*)gb, g1 = *(const f32x4*)(gb + 4), g2 = *(const f32x4*)(gb + 128), g3 = *(const f32x4*)(gb + 132);
#pragma unroll
            for (int j = 0; j < 4; ++j) { a0[j] = logsigmoidf_(a0[j] + g0[j]) * 0.0625f; a1[j] = logsigmoidf_(a1[j] + g1[j]) * 0.0625f; b0[j] = logsigmoidf_(b0[j] + g2[j]) * 0.0625f; b1[j] = logsigmoidf_(b1[j] + g3[j]) * 0.0625f; }
            *(f32x4*)p = a0; *(f32x4*)(p + 4) = a1; *(f32x4*)(p + 128) = b0; *(f32x4*)(p + 132) = b1; return; }
        if (pn >= TN_U && pn < TN_GA) { st_bf8(U + (size_t)row * D + (pn - TN_U) * 128 + c0, a0 * b0, a1 * b1); return; }
        bf16* base; int ld, ct, mode = 0; float sc = 1.0f;
        if (pn < TN_K) { base = Q; ld = QK; ct = pn - TN_Q; sc = 0.0625f; }
        else if (pn < TN_V) { base = Kk; ld = QK; ct = pn - TN_K; }
        else if (pn < TN_R) { base = V; ld = VD; ct = pn - TN_V; }
        else if (pn < TN_LA) { base = SR; ld = VD; ct = pn - TN_R; mode = 1; }
        else if (pn < TN_U) { base = CB; ld = D; ct = pn - TN_CB; }
        else if (pn < TN_GB) { base = SGA; ld = D; ct = pn - TN_GA; mode = 2; }
        else { base = SGB; ld = D; ct = pn - TN_GB; mode = 2; }
        if (mode) {
#pragma unroll
            for (int j = 0; j < 4; ++j) { const float s0 = sigmoidf_(a0[j]), s1 = sigmoidf_(a1[j]), s2 = sigmoidf_(b0[j]), s3 = sigmoidf_(b1[j]);
                a0[j] = (mode == 1) ? a0[j] * s0 : s0; a1[j] = (mode == 1) ? a1[j] * s1 : s1; b0[j] = (mode == 1) ? b0[j] * s2 : s2; b1[j] = (mode == 1) ? b1[j] * s3 : s3; }
        } else { a0 *= sc; a1 *= sc; b0 *= sc; b1 *= sc; }
        bf16* p = base + (size_t)row * ld + ct * 256 + c0; st_bf8(p, a0, a1); st_bf8(p + 128, b0, b1);
    }
};
struct EpiGateA {
    float* T1; const bf16* SGA;
    template <bool MF> __device__ __forceinline__ void row8(int row, const Unit& u, int c0, f32x4 a0, f32x4 a1, f32x4 b0, f32x4 b1) const {
        const size_t o = (size_t)row * D + u.pn * 256 + c0; f32x4 g0, g1, g2, g3; ld_bf8(SGA + o, g0, g1); ld_bf8(SGA + o + 128, g2, g3);
        *(f32x4*)(T1 + o) = a0 * g0; *(f32x4*)(T1 + o + 4) = a1 * g1; *(f32x4*)(T1 + o + 128) = b0 * g2; *(f32x4*)(T1 + o + 132) = b1 * g3;
    }
};
struct EpiGateB {
    const float* T1; const bf16* SGB; bf16* MG;
    template <bool MF> __device__ __forceinline__ void row8(int row, const Unit& u, int c0, f32x4 a0, f32x4 a1, f32x4 b0, f32x4 b1) const {
        const size_t o = (size_t)row * D + u.pn * 256 + c0; f32x4 g0, g1, g2, g3; ld_bf8(SGB + o, g0, g1); ld_bf8(SGB + o + 128, g2, g3);
        const f32x4 t0 = *(const f32x4*)(T1 + o), t1 = *(const f32x4*)(T1 + o + 4), t2 = *(const f32x4*)(T1 + o + 128), t3 = *(const f32x4*)(T1 + o + 132);
        st_bf8(MG + o, t0 + a0 * g0, t1 + a1 * g1); st_bf8(MG + o + 128, t2 + b0 * g2, t3 + b1 * g3);
    }
};
struct EpiResid1 {
    const float* X; float* X1; bf16* X1B; float* SS1;
    template <bool MF> __device__ __forceinline__ void row8(int row, const Unit& u, int c0, f32x4 a0, f32x4 a1, f32x4 b0, f32x4 b1) const {
        const size_t o = (size_t)row * D + u.pn * 256 + c0;
        a0 += *(const f32x4*)(X + o); a1 += *(const f32x4*)(X + o + 4); b0 += *(const f32x4*)(X + o + 128); b1 += *(const f32x4*)(X + o + 132);
        *(f32x4*)(X1 + o) = a0; *(f32x4*)(X1 + o + 4) = a1; *(f32x4*)(X1 + o + 128) = b0; *(f32x4*)(X1 + o + 132) = b1;
        st_bf8(X1B + o, a0, a1); st_bf8(X1B + o + 128, b0, b1);
        float s = 0.f;
#pragma unroll
        for (int j = 0; j < 4; ++j) s += a0[j] * a0[j] + a1[j] * a1[j] + b0[j] * b0[j] + b1[j] * b1[j];
        if (MF) { s += __shfl_xor(s, 16); s += __shfl_xor(s, 32); if ((threadIdx.x & 63) < 16) atomicAdd(SS1 + row, s); }
        else atomicAdd(SS1 + row, s);
    }
};
struct EpiXQ {
    bf16* QX; const float* SS1;
    template <bool MF> __device__ __forceinline__ void row8(int row, const Unit& u, int c0, f32x4 a0, f32x4 a1, f32x4 b0, f32x4 b1) const {
        const float r = rsqrtf(SS1[row] * (1.0f / D) + EPS); bf16* p = QX + (size_t)row * XA + u.pn * 256 + c0;
        st_bf8(p, a0 * r, a1 * r); st_bf8(p + 128, b0 * r, b1 * r);
    }
};
struct EpiResid2 {
    float* X1;
    template <bool MF> __device__ __forceinline__ void row8(int row, const Unit& u, int c0, f32x4 a0, f32x4 a1, f32x4 b0, f32x4 b1) const {
        float* p = X1 + (size_t)row * D + u.pn * 256 + c0;
        *(f32x4*)p = *(const f32x4*)p + a0; *(f32x4*)(p + 4) = *(const f32x4*)(p + 4) + a1; *(f32x4*)(p + 128) = *(const f32x4*)(p + 128) + b0; *(f32x4*)(p + 132) = *(const f32x4*)(p + 132) + b1;
    }
};
struct EpiGU {
    bf16* ACT; const float* gub;
    template <bool MF> __device__ __forceinline__ void row8(int row, const Unit& u, int c0, f32x4 a0, f32x4 a1, f32x4 b0, f32x4 b1) const {
        const int f = u.pn * 128 + c0; const float* bg = gub + (size_t)u.e * (2 * FF) + f;
        const f32x4 g0 = *(const f32x4*)bg, g1 = *(const f32x4*)(bg + 4), u0 = *(const f32x4*)(bg + FF), u1 = *(const f32x4*)(bg + FF + 4);
        f32x4 r0, r1;
#pragma unroll
        for (int j = 0; j < 4; ++j) {
            float g = fminf(a0[j] + g0[j], 7.0f), up = fminf(fmaxf(b0[j] + u0[j], -7.0f), 7.0f); r0[j] = (up + 1.0f) * g * sigmoidf_(1.702f * g);
            g = fminf(a1[j] + g1[j], 7.0f); up = fminf(fmaxf(b1[j] + u1[j], -7.0f), 7.0f); r1[j] = (up + 1.0f) * g * sigmoidf_(1.702f * g);
        }
        st_bf8(ACT + (size_t)row * FF + f, r0, r1);
    }
};
struct EpiDown {
    bf16* YS; const float* dnb;
    template <bool MF> __device__ __forceinline__ void row8(int row, const Unit& u, int c0, f32x4 a0, f32x4 a1, f32x4 b0, f32x4 b1) const {
        const int col = u.pn * 256 + c0; const float* bb = dnb + (size_t)u.e * D + col; bf16* p = YS + (size_t)row * D + col;
        st_bf8(p, a0 + *(const f32x4*)bb, a1 + *(const f32x4*)(bb + 4)); st_bf8(p + 128, b0 + *(const f32x4*)(bb + 128), b1 + *(const f32x4*)(bb + 132));
    }
};

__device__ __forceinline__ void tr_item(const float* W, int ldw, int K, int srccol0, bf16* WT, int dstrow0, const float* ksc, LAS float* scr, int kb, int lane) {
    const int k0 = 64 * kb;
#pragma unroll 8
    for (int i = 0; i < 32; ++i) { const int kk = 2 * i + (lane >> 5); float v = W[(size_t)(k0 + kk) * ldw + srccol0 + (lane & 31)]; if (ksc) v *= ksc[k0 + kk]; scr[kk * 33 + (lane & 31)] = v; }
    LDS_WAIT(); asm volatile("" ::: "memory");
    const int c = lane & 7;
#pragma unroll
    for (int j = 0; j < 4; ++j) { const int n = (lane >> 3) + 8 * j; const LAS float* s = scr + (8 * c) * 33 + n;
        u32x4 o; o.x = pk2(s[0 * 33], s[1 * 33]); o.y = pk2(s[2 * 33], s[3 * 33]); o.z = pk2(s[4 * 33], s[5 * 33]); o.w = pk2(s[6 * 33], s[7 * 33]);
        *(u32x4*)(WT + (size_t)(dstrow0 + n) * K + k0 + 8 * c) = o; }
    LDS_WAIT(); asm volatile("" ::: "memory");
}
__device__ __forceinline__ void fold_item(const float* Win, const float* GW, bf16* WT, int n0, LAS float* scr, int kb, int lane) {
    const int k0 = 64 * kb, nn = lane & 31;
    float gw[16];
#pragma unroll
    for (int r = 0; r < 16; ++r) gw[r] = GW[r * QK + n0 + nn];
#pragma unroll 4
    for (int i = 0; i < 32; ++i) { const int kk = 2 * i + (lane >> 5); const float* wr = Win + (size_t)(k0 + kk) * NIN_SRC + SRC_ALOW; float v = 0.f;
#pragma unroll
        for (int r = 0; r < 16; ++r) v += wr[r] * gw[r];
        scr[kk * 33 + nn] = v; }
    LDS_WAIT(); asm volatile("" ::: "memory");
    const int c = lane & 7;
#pragma unroll
    for (int j = 0; j < 4; ++j) { const int n = (lane >> 3) + 8 * j; const LAS float* s = scr + (8 * c) * 33 + n;
        u32x4 o; o.x = pk2(s[0 * 33], s[1 * 33]); o.y = pk2(s[2 * 33], s[3 * 33]); o.z = pk2(s[4 * 33], s[5 * 33]); o.w = pk2(s[6 * 33], s[7 * 33]);
        *(u32x4*)(WT + (size_t)(TN_LA * 256 + n0 + n) * D + k0 + 8 * c) = o; }
    LDS_WAIT(); asm volatile("" ::: "memory");
}
__device__ __forceinline__ void rms_row_to_bf16(const float* xrow, const float* g, bf16* orow, int lane) {
    f32x4 v[8]; float s = 0.f;
#pragma unroll
    for (int j = 0; j < 8; ++j) { v[j] = *(const f32x4*)(xrow + 4 * lane + 256 * j); s += (v[j][0] * v[j][0] + v[j][1] * v[j][1]) + (v[j][2] * v[j][2] + v[j][3] * v[j][3]); }
    const float r = rsqrtf(wave_sum(s) * (1.0f / D) + EPS);
#pragma unroll
    for (int j = 0; j < 8; ++j) { const f32x4 gg = *(const f32x4*)(g + 4 * lane + 256 * j); u32x2 o; o.x = pk2(v[j][0] * r * gg[0], v[j][1] * r * gg[1]); o.y = pk2(v[j][2] * r * gg[2], v[j][3] * r * gg[3]); *(u32x2*)(orow + 4 * lane + 256 * j) = o; }
}
__device__ __forceinline__ void p0_prologue(Frame& F) {
    LAS float* scr = (LAS float*)(F.lds + F.wave * 16384);
    const int gw = F.bid * NWAVES + F.wave, NGW = F.G * NWAVES, lane = F.lane;
    const float* Win = F.in[I_WIN];
    bf16* WIN = WSP(bf16, WS_WIN);
    for (int it = gw; it < 544 * 32; it += NGW) {
        const int nb = it % 544, kb = it / 544, n0 = 32 * nb;
        if (n0 >= TN_LA * 256 && n0 < TN_CB * 256) { fold_item(Win, F.in[I_GGW], WIN, n0 - TN_LA * 256, scr, kb, lane); continue; }
        int src;
        if (n0 < TN_LA * 256) src = n0;
        else if (n0 < TN_U * 256) src = SRC_CB + (n0 - TN_CB * 256);
        else if (n0 < TN_GA * 256) { const int rel = n0 - TN_U * 256, p = rel >> 8, w = rel & 255; src = (w < 128) ? SRC_CC + 128 * p + w : SRC_CHH + 128 * p + (w - 128); }
        else if (n0 < TN_GB * 256) src = SRC_GA + (n0 - TN_GA * 256);
        else src = SRC_GB + (n0 - TN_GB * 256);
        tr_item(Win, NIN_SRC, D, src, WIN, n0, nullptr, scr, kb, lane);
    }
    for (int it = gw; it < 3 * 2048; it += NGW) { const int w = it / 2048, r = it % 2048, nb = r % 64, kb = r / 64;
        const float* W = F.in[w == 0 ? I_GOW : (w == 1 ? I_COW : I_MXW)]; bf16* WT = WSP(bf16, w == 0 ? WS_WGO : (w == 1 ? WS_WCO : WS_WMX));
        tr_item(W, D, D, 32 * nb, WT, 32 * nb, nullptr, scr, kb, lane); }
    for (int it = gw; it < 3 * 512; it += NGW) { const int w = it / 512, r = it % 512, nb = r % 16, kb = r / 16;
        if (w == 0) tr_item(F.in[I_XQ], XA, D, 32 * nb, WSP(bf16, WS_WXQ), 32 * nb, F.in[I_NXG], scr, kb, lane);
        else tr_item(F.in[w == 1 ? I_XK : I_XV], XA, D, 32 * nb, WSP(bf16, WS_WXKV), (w - 1) * XA + 32 * nb, nullptr, scr, kb, lane); }
    for (int it = gw; it < 512; it += NGW) { const int nb = it % 64, kb = it / 64; tr_item(F.in[I_XO], D, XA, 32 * nb, WSP(bf16, WS_WXO), 32 * nb, nullptr, scr, kb, lane); }
    for (int it = gw; it < NE * 4096; it += NGW) { const int e = it / 4096, r = it % 4096, nb = r % 128, kb = r / 128, n0 = 32 * nb, p = n0 >> 8, w = n0 & 255;
        const int src = (w < 128) ? 128 * p + w : FF + 128 * p + (w - 128);
        tr_item(F.in[I_GUW] + (size_t)e * D * (2 * FF), 2 * FF, D, src, WSP(bf16, WS_WGU) + (size_t)e * (2 * FF) * D, n0, nullptr, scr, kb, lane); }
    for (int it = gw; it < NE * 2048; it += NGW) { const int e = it / 2048, r = it % 2048, nb = r % 64, kb = r / 64;
        tr_item(F.in[I_DNW] + (size_t)e * FF * D, D, FF, 32 * nb, WSP(bf16, WS_WDN) + (size_t)e * D * FF, 32 * nb, nullptr, scr, kb, lane); }
    { const float* rw = F.in[I_RW]; const float* g = F.in[I_NMOEG]; float* WR = WSP(float, WS_WR);
      for (int i = F.bid * NTHR + F.tid; i < NE * D; i += F.G * NTHR) { const int e = i / D, k = i % D; WR[i] = rw[k * NE + e] * g[k]; } }
    for (int m = gw; m < T; m += NGW) rms_row_to_bf16(F.in[I_X] + (size_t)m * D, F.in[I_NMIXG], WSP(bf16, WS_XN) + (size_t)m * D, lane);
    for (int m = gw; m < MEM; m += NGW) rms_row_to_bf16(F.in[I_MEM] + (size_t)m * D, F.in[I_NMG], WSP(bf16, WS_MEMN) + (size_t)m * D, lane);
    { u32x4* z = (u32x4*)(WSP(bf16, WS_H3) + (size_t)T * D); for (int i = F.bid * NTHR + F.tid; i < 256; i += F.G * NTHR) z[i] = (u32x4){0u, 0u, 0u, 0u}; }
}

__device__ __forceinline__ void p_memkv(Frame& F) {
    const bf16* A = WSP(bf16, WS_MEMN); const bf16* B = WSP(bf16, WS_WXKV); bf16* KM = WSP(bf16, WS_KM); bf16* VMT = WSP(bf16, WS_VMT);
    for (int o = F.bid * NTHR + F.tid; o < MEM * 2 * XA; o += F.G * NTHR) {
        const int m = o & 255, n = o >> 8;
        const bf16* a = A + (size_t)m * D; const bf16* b = B + (size_t)n * D; float s = 0.f;
        for (int k = 0; k < D; k += 8) { f32x4 a0, a1, b0, b1; ld_bf8(a + k, a0, a1); ld_bf8(b + k, b0, b1);
#pragma unroll
            for (int j = 0; j < 4; ++j) s += a0[j] * b0[j] + a1[j] * b1[j]; }
        if (n < XA) KM[(size_t)m * XA + n] = (bf16)f2bf(s); else VMT[(size_t)(n - XA) * MEM + m] = (bf16)f2bf(s);
    }
}

__device__ __forceinline__ void p_conv(Frame& F) {
    const bf16* U = WSP(bf16, WS_U); const bf16* CB = WSP(bf16, WS_CB); bf16* Z = WSP(bf16, WS_Z);
    const float* cw = F.in[I_CW]; const float* cb = F.in[I_CBIAS];
    for (int task = F.bid * NTHR + F.tid; task < (T / 64) * (D / 8); task += F.G * NTHR) {
        const int cg = task & 255, tb = task >> 8, c = 8 * cg, t0 = 64 * tb;
        f32x4 w0a = *(const f32x4*)(cw + c), w0b = *(const f32x4*)(cw + c + 4), w1a = *(const f32x4*)(cw + D + c), w1b = *(const f32x4*)(cw + D + c + 4);
        f32x4 w2a = *(const f32x4*)(cw + 2 * D + c), w2b = *(const f32x4*)(cw + 2 * D + c + 4), ba = *(const f32x4*)(cb + c), bb = *(const f32x4*)(cb + c + 4);
        f32x4 p2a = {0.f, 0.f, 0.f, 0.f}, p2b = p2a, p1a = p2a, p1b = p2a;
        if (t0 >= 2) { ld_bf8(U + (size_t)(t0 - 2) * D + c, p2a, p2b); ld_bf8(U + (size_t)(t0 - 1) * D + c, p1a, p1b); }
        for (int t = t0; t < t0 + 64; ++t) {
            f32x4 ua, ub, ca, cbv; ld_bf8(U + (size_t)t * D + c, ua, ub); ld_bf8(CB + (size_t)t * D + c, ca, cbv);
            const f32x4 ya = ca * (w0a * p2a + w1a * p1a + w2a * ua + ba), yb = cbv * (w0b * p2b + w1b * p1b + w2b * ub + bb);
            st_bf8(Z + (size_t)t * D + c, ya, yb);
            p2a = p1a; p2b = p1b; p1a = ua; p1b = ub;
        }
    }
}
__device__ __forceinline__ void p_glaprep(Frame& F) {
    const bf16* Q = WSP(bf16, WS_Q); const bf16* Kk = WSP(bf16, WS_K); const bf16* V = WSP(bf16, WS_V); const float* LA = WSP(float, WS_LA);
    bf16* QT = WSP(bf16, WS_QT); bf16* KH = WSP(bf16, WS_KH); bf16* KHT = WSP(bf16, WS_KHT); bf16* QG = WSP(bf16, WS_QG); bf16* VT = WSP(bf16, WS_VT);
    float* DL = WSP(float, WS_DL); float* DG = WSP(float, WS_DG);
    LAS float* part = (LAS float*)F.lds;
    const int col = F.tid & 63, sub = F.tid >> 6;
    for (int unit = F.bid; unit < NG * 16; unit += F.G) {
        const int g = unit >> 4, cs = unit & 15, gc = cs * 64 + col, h = gc >> 8, kc = gc & 255;
        float carry = 0.f;
        for (int c = 0; c < GC; ++c) {
            const int chunk = g * GC + c, t0 = chunk * CH + 8 * sub;
            float la[8], qv[8], kv[8];
#pragma unroll
            for (int j = 0; j < 8; ++j) { la[j] = LA[(size_t)(t0 + j) * QK + gc]; qv[j] = bf2f(Q[(size_t)(t0 + j) * QK + gc]); kv[j] = bf2f(Kk[(size_t)(t0 + j) * QK + gc]); }
#pragma unroll
            for (int j = 1; j < 8; ++j) la[j] += la[j - 1];
            __syncthreads();
            part[sub * 64 + col] = la[7];
            __syncthreads();
            float off = 0.f, tot = 0.f;
#pragma unroll
            for (int s = 0; s < 8; ++s) { const float p = part[s * 64 + col]; off += (s < sub) ? p : 0.f; tot += p; }
            unsigned kt[4];
#pragma unroll
            for (int j = 0; j < 8; ++j) { const float b = off + la[j], eb = __expf(b), enb = __expf(-b), eg = __expf(carry + b);
                QT[(size_t)(t0 + j) * QK + gc] = (bf16)f2bf(qv[j] * eb); const unsigned khv = f2bf(kv[j] * enb); KH[(size_t)(t0 + j) * QK + gc] = (bf16)khv;
                QG[(size_t)(t0 + j) * QK + gc] = (bf16)f2bf(qv[j] * eg);
                if (j & 1) kt[j >> 1] |= khv << 16; else kt[j >> 1] = khv; }
            *(u32x4*)(KHT + ((size_t)(chunk * GH + h) * DK + kc) * CH + 8 * sub) = (u32x4){kt[0], kt[1], kt[2], kt[3]};
            if (sub == 0) DL[(size_t)chunk * QK + gc] = __expf(tot);
            carry += tot;
        }
        if (sub == 0) DG[(size_t)g * QK + gc] = __expf(carry);
    }
    for (int unit = F.bid; unit < NCH * (VD / 64); unit += F.G) {
        const int chunk = unit >> 5, vs = unit & 31, vc = vs * 64 + col, t0 = chunk * CH + 8 * sub;
        unsigned w[4];
#pragma unroll
        for (int j = 0; j < 8; ++j) { const unsigned x = V[(size_t)(t0 + j) * VD + vc]; if (j & 1) w[j >> 1] |= x << 16; else w[j >> 1] = x; }
        *(u32x4*)(VT + ((size_t)chunk * VD + vc) * CH + 8 * sub) = (u32x4){w[0], w[1], w[2], w[3]};
    }
}

__device__ __forceinline__ void p_gla_ref(Frame& F) {
    const bf16* Q = WSP(bf16, WS_Q); const bf16* Kk = WSP(bf16, WS_K); const bf16* V = WSP(bf16, WS_V); const float* LA = WSP(float, WS_LA); float* O32 = WSP(float, WS_O32);
    LAS float* red = (LAS float*)F.lds;
    const int k = F.tid & 255, vh = F.tid >> 8;
    for (int unit = F.bid; unit < GH * 64; unit += F.G) {
        const int h = unit >> 6, vb = unit & 63, vcol = h * DV + vb * 8 + vh * 4;
        float s0 = 0.f, s1 = 0.f, s2 = 0.f, s3 = 0.f;
        for (int tb = 0; tb < T; tb += 8) {
            LAS float* rb = red + ((tb >> 3) & 1) * 256;
#pragma unroll
            for (int j = 0; j < 8; ++j) {
                const int t = tb + j; const float a = __expf(LA[(size_t)t * QK + h * DK + k]), kk = bf2f(Kk[(size_t)t * QK + h * DK + k]), qq = bf2f(Q[(size_t)t * QK + h * DK + k]);
                const u32x2 vv = *(const u32x2*)(V + (size_t)t * VD + vcol);
                const float v0 = __uint_as_float(vv.x << 16), v1 = __uint_as_float(vv.x & 0xffff0000u), v2 = __uint_as_float(vv.y << 16), v3 = __uint_as_float(vv.y & 0xffff0000u);
                s0 = a * s0 + kk * v0; s1 = a * s1 + kk * v1; s2 = a * s2 + kk * v2; s3 = a * s3 + kk * v3;
                const float p0 = wave_sum(qq * s0), p1 = wave_sum(qq * s1), p2 = wave_sum(qq * s2), p3 = wave_sum(qq * s3);
                if (F.lane == 0) *(LAS f32x4*)(rb + (j * 8 + F.wave) * 4) = (f32x4){p0, p1, p2, p3};
            }
            __syncthreads();
            if (F.tid < 64) { const int j = F.tid >> 3, vhh = (F.tid >> 2) & 1, q = F.tid & 3; float s = 0.f;
#pragma unroll
                for (int w = 0; w < 4; ++w) s += rb[(j * 8 + vhh * 4 + w) * 4 + q];
                O32[(size_t)(tb + j) * VD + h * DV + vb * 8 + vhh * 4 + q] = s; }
        }
        __syncthreads();
    }
}
__device__ __forceinline__ void p_gla_norm_ref(Frame& F) {
    const float* O32 = WSP(float, WS_O32); const bf16* SR = WSP(bf16, WS_SR); bf16* OA = WSP(bf16, WS_OA); const float* g = F.in[I_GNG];
    const int gw = F.bid * NWAVES + F.wave, NGW = F.G * NWAVES;
    for (int it = gw; it < T * GH; it += NGW) {
        const size_t o = (size_t)it * DV + 8 * F.lane;
        const f32x4 a = *(const f32x4*)(O32 + o), b = *(const f32x4*)(O32 + o + 4);
        float s = 0.f;
#pragma unroll
        for (int j = 0; j < 4; ++j) s += a[j] * a[j] + b[j] * b[j];
        const float r = rsqrtf(wave_sum(s) * (1.0f / DV) + EPS);
        f32x4 s0, s1; ld_bf8(SR + o, s0, s1);
        const f32x4 g0 = *(const f32x4*)(g + 8 * F.lane), g1 = *(const f32x4*)(g + 8 * F.lane + 4);
        st_bf8(OA + o, a * r * g0 * s0, b * r * g1 * s1);
    }
}

__device__ __forceinline__ bf16x8 as_bf8(u32x4 w) { return __builtin_bit_cast(bf16x8, w); }
#define MFMA16(A, B, C) __builtin_amdgcn_mfma_f32_16x16x32_bf16((A), (B), (C), 0, 0, 0)
__device__ __forceinline__ void p_gla_a(Frame& F) {
    const bf16* QT = WSP(bf16, WS_QT); const bf16* KH = WSP(bf16, WS_KH); const bf16* KHT = WSP(bf16, WS_KHT); const bf16* VT = WSP(bf16, WS_VT); const float* DL = WSP(float, WS_DL);
    bf16* OL = WSP(bf16, WS_OL); float* SLOC = WSP(float, WS_SLOC);
    constexpr int QS = 528, KS = 144;
    LAS unsigned char* sQ = F.lds; LAS unsigned char* sK = sQ + 64 * QS; LAS unsigned char* sKT = sK + 64 * QS; LAS unsigned char* sVT = sKT + 256 * KS; LAS unsigned char* sP = sVT + 128 * KS;
    LAS float* sDL = (LAS float*)(sP + 64 * KS);
    static_assert(2 * 64 * QS + 256 * KS + 128 * KS + 64 * KS + 1024 <= MISC_OFF, "gla lds");
    const int tid = F.tid, lane = F.lane, w = F.wave, lr = lane & 15, lg = lane >> 4;
    for (int unit = F.bid; unit < NG * GH * 4; unit += F.G) {
        const int g = unit >> 4, h = (unit >> 2) & 3, vs = unit & 3;
        f32x4 S[16];
#pragma unroll
        for (int kt = 0; kt < 16; ++kt) S[kt] = (f32x4){0.f, 0.f, 0.f, 0.f};
        u32x4 rq[4], rk[4], rt[4], rv[2], rd = {0u, 0u, 0u, 0u};
#define GLA_LOAD(chunk_) do { const int _t0 = (chunk_) * CH; \
        _Pragma("unroll") for (int q = 0; q < 4; ++q) { const int p = tid + 512 * q, row = p >> 5, c16 = p & 31; \
            rq[q] = *(const u32x4*)(QT + (size_t)(_t0 + row) * QK + h * DK + c16 * 8); rk[q] = *(const u32x4*)(KH + (size_t)(_t0 + row) * QK + h * DK + c16 * 8); \
            rt[q] = *(const u32x4*)(KHT + (size_t)((chunk_) * GH + h) * DK * CH + (size_t)p * 8); } \
        _Pragma("unroll") for (int q = 0; q < 2; ++q) { const int p = tid + 512 * q; rv[q] = *(const u32x4*)(VT + ((size_t)(chunk_) * VD + h * DV + vs * 128) * CH + (size_t)p * 8); } \
        if (tid < 64) rd = *(const u32x4*)(DL + (size_t)(chunk_) * QK + h * DK + 4 * tid); } while (0)
        GLA_LOAD(g * GC);
        for (int c = 0; c < GC; ++c) {
            const int chunk = g * GC + c, t0 = chunk * CH;
#pragma unroll
            for (int q = 0; q < 4; ++q) { const int p = tid + 512 * q; *(LAS u32x4*)(sQ + (p >> 5) * QS + (p & 31) * 16) = rq[q]; *(LAS u32x4*)(sK + (p >> 5) * QS + (p & 31) * 16) = rk[q]; *(LAS u32x4*)(sKT + (p >> 3) * KS + (p & 7) * 16) = rt[q]; }
#pragma unroll
            for (int q = 0; q < 2; ++q) { const int p = tid + 512 * q; *(LAS u32x4*)(sVT + (p >> 3) * KS + (p & 7) * 16) = rv[q]; }
            if (tid < 64) *(LAS u32x4*)(sDL + 4 * tid) = rd;
            __syncthreads();
            if (c + 1 < GC) GLA_LOAD(chunk + 1);
            { const int ti = w >> 1;
#pragma unroll
              for (int jj = 0; jj < 2; ++jj) { const int tj = 2 * (w & 1) + jj; f32x4 pa = {0.f, 0.f, 0.f, 0.f};
                if (tj <= ti) {
#pragma unroll
                    for (int s = 0; s < 8; ++s) { const bf16x8 a = *(const LAS bf16x8*)(sK + (16 * tj + lr) * QS + (32 * s + 8 * lg) * 2), b = *(const LAS bf16x8*)(sQ + (16 * ti + lr) * QS + (32 * s + 8 * lg) * 2); pa = MFMA16(a, b, pa); }
                    const int i = 16 * ti + lr, j0 = 16 * tj + 4 * lg;
#pragma unroll
                    for (int r = 0; r < 4; ++r) pa[r] = (j0 + r <= i) ? pa[r] : 0.f;
                }
                u32x2 pw; pw.x = pk2(pa[0], pa[1]); pw.y = pk2(pa[2], pa[3]);
                *(LAS u32x2*)(sP + (16 * ti + lr) * KS + (16 * tj + 4 * lg) * 2) = pw; } }
            f32x4 oacc[4];
#pragma unroll
            for (int ti = 0; ti < 4; ++ti) oacc[ti] = (f32x4){0.f, 0.f, 0.f, 0.f};
#pragma unroll
            for (int s = 0; s < 8; ++s) {
                u32x4 sw; sw.x = pk2(S[2 * s][0], S[2 * s][1]); sw.y = pk2(S[2 * s][2], S[2 * s][3]); sw.z = pk2(S[2 * s + 1][0], S[2 * s + 1][1]); sw.w = pk2(S[2 * s + 1][2], S[2 * s + 1][3]);
                const bf16x8 a = as_bf8(sw);
#pragma unroll
                for (int ti = 0; ti < 4; ++ti) { const LAS unsigned char* qp = sQ + (16 * ti + lr) * QS + (32 * s + 4 * lg) * 2; const u32x2 lo = *(const LAS u32x2*)qp, hi = *(const LAS u32x2*)(qp + 32);
                    oacc[ti] = MFMA16(a, as_bf8((u32x4){lo.x, lo.y, hi.x, hi.y}), oacc[ti]); }
            }
            __syncthreads();
            bf16x8 vf[2];
#pragma unroll
            for (int s2 = 0; s2 < 2; ++s2) vf[s2] = *(const LAS bf16x8*)(sVT + (16 * w + lr) * KS + (32 * s2 + 8 * lg) * 2);
#pragma unroll
            for (int s2 = 0; s2 < 2; ++s2)
#pragma unroll
                for (int ti = 0; ti < 4; ++ti) { const bf16x8 b = *(const LAS bf16x8*)(sP + (16 * ti + lr) * KS + (32 * s2 + 8 * lg) * 2); oacc[ti] = MFMA16(vf[s2], b, oacc[ti]); }
#pragma unroll
            for (int ti = 0; ti < 4; ++ti) { u32x2 ow; ow.x = pk2(oacc[ti][0], oacc[ti][1]); ow.y = pk2(oacc[ti][2], oacc[ti][3]);
                *(u32x2*)(OL + (size_t)(t0 + 16 * ti + lr) * VD + h * DV + vs * 128 + 16 * w + 4 * lg) = ow; }
#pragma unroll
            for (int kt = 0; kt < 16; ++kt) {
#pragma unroll
                for (int s2 = 0; s2 < 2; ++s2) { const bf16x8 a = *(const LAS bf16x8*)(sKT + (16 * kt + lr) * KS + (32 * s2 + 8 * lg) * 2); S[kt] = MFMA16(a, vf[s2], S[kt]); }
                S[kt] *= *(const LAS f32x4*)(sDL + 16 * kt + 4 * lg);
            }
            __syncthreads();
        }
#undef GLA_LOAD
#pragma unroll
        for (int kt = 0; kt < 16; ++kt)
#pragma unroll
            for (int r = 0; r < 4; ++r) SLOC[((size_t)(g * GH + h) * DK + 16 * kt + 4 * lg + r) * DV + vs * 128 + 16 * w + lr] = S[kt][r];
    }
}
__device__ __forceinline__ void p_gla_b(Frame& F) {
    const float* SLOC = WSP(float, WS_SLOC); const float* DG = WSP(float, WS_DG); bf16* SG0 = WSP(bf16, WS_SG0);
    for (int idx = F.bid * NTHR + F.tid; idx < GH * DV * (DK / 8); idx += F.G * NTHR) {
        const int v = idx & 511, k8 = (idx >> 9) & 31, h = idx >> 14;
        float s[8];
#pragma unroll
        for (int j = 0; j < 8; ++j) s[j] = 0.f;
        for (int g = 0; g < NG; ++g) {
            *(u32x4*)(SG0 + ((size_t)(g * GH + h) * DV + v) * DK + 8 * k8) = (u32x4){pk2(s[0], s[1]), pk2(s[2], s[3]), pk2(s[4], s[5]), pk2(s[6], s[7])};
            if (g == NG - 1) break;
            const float* dg = DG + (size_t)g * QK + h * DK + 8 * k8; const f32x4 d0 = *(const f32x4*)dg, d1 = *(const f32x4*)(dg + 4);
#pragma unroll
            for (int j = 0; j < 8; ++j) s[j] = (j < 4 ? d0[j & 3] : d1[j & 3]) * s[j] + SLOC[((size_t)(g * GH + h) * DK + 8 * k8 + j) * DV + v];
        }
    }
}
__device__ __forceinline__ void p_gla_c(Frame& F) {
    const bf16* QG = WSP(bf16, WS_QG); const bf16* SG0 = WSP(bf16, WS_SG0); const bf16* OL = WSP(bf16, WS_OL); const bf16* SR = WSP(bf16, WS_SR); bf16* OA = WSP(bf16, WS_OA); const float* gn = F.in[I_GNG];
    const int lane = F.lane, w = F.wave, lr = lane & 15, lg = lane >> 4;
    for (int unit = F.bid; unit < (T / 128) * GH; unit += F.G) {
        const int rt = unit >> 2, h = unit & 3, g = rt >> 3, row = rt * 128 + 16 * w + lr;
        f32x4 o[32];
#pragma unroll
        for (int vt = 0; vt < 32; ++vt) o[vt] = (f32x4){0.f, 0.f, 0.f, 0.f};
        if (g > 0) {
            const bf16* sg = SG0 + ((size_t)(g * GH + h) * DV + lr) * DK + 8 * lg; const bf16* qg = QG + (size_t)row * QK + h * DK + 8 * lg;
#pragma unroll 1
            for (int s = 0; s < 8; ++s) {
                const bf16x8 b = *(const bf16x8*)(qg + 32 * s);
#pragma unroll
                for (int vt = 0; vt < 32; ++vt) { const bf16x8 a = *(const bf16x8*)(sg + (size_t)(16 * vt) * DK + 32 * s); o[vt] = MFMA16(a, b, o[vt]); }
            }
        }
        const size_t ob = (size_t)row * VD + h * DV + 4 * lg;
        float ss = 0.f;
#pragma unroll
        for (int vt = 0; vt < 32; ++vt) { const u32x2 ol = *(const u32x2*)(OL + ob + 16 * vt);
            o[vt][0] += __uint_as_float(ol.x << 16); o[vt][1] += __uint_as_float(ol.x & 0xffff0000u); o[vt][2] += __uint_as_float(ol.y << 16); o[vt][3] += __uint_as_float(ol.y & 0xffff0000u);
            ss += (o[vt][0] * o[vt][0] + o[vt][1] * o[vt][1]) + (o[vt][2] * o[vt][2] + o[vt][3] * o[vt][3]); }
        ss += __shfl_xor(ss, 16); ss += __shfl_xor(ss, 32);
        const float r = rsqrtf(ss * (1.0f / DV) + EPS);
#pragma unroll
        for (int vt = 0; vt < 32; ++vt) { const u32x2 sr = *(const u32x2*)(SR + ob + 16 * vt); const f32x4 gg = *(const f32x4*)(gn + 16 * vt + 4 * lg);
            u32x2 ow; ow.x = pk2(o[vt][0] * r * gg[0] * __uint_as_float(sr.x << 16), o[vt][1] * r * gg[1] * __uint_as_float(sr.x & 0xffff0000u));
            ow.y = pk2(o[vt][2] * r * gg[2] * __uint_as_float(sr.y << 16), o[vt][3] * r * gg[3] * __uint_as_float(sr.y & 0xffff0000u));
            *(u32x2*)(OA + ob + 16 * vt) = ow; }
    }
}

__device__ __forceinline__ void p_attn_ref(Frame& F) {
    const bf16* QX = WSP(bf16, WS_QX); const bf16* KM = WSP(bf16, WS_KM); const bf16* VMT = WSP(bf16, WS_VMT); bf16* OX = WSP(bf16, WS_OX);
    LAS float* pbuf = (LAS float*)F.lds + F.wave * 256;
    const int gw = F.bid * NWAVES + F.wave, NGW = F.G * NWAVES, lane = F.lane;
    for (int it = gw; it < T * XH; it += NGW) {
        const int t = it >> 2, h = it & 3; const bf16* q = QX + (size_t)t * XA + h * XD;
        float s[4] = {0.f, 0.f, 0.f, 0.f};
        for (int d = 0; d < XD; d += 8) { f32x4 q0, q1; ld_bf8(q + d, q0, q1);
#pragma unroll
            for (int c = 0; c < 4; ++c) { f32x4 k0, k1; ld_bf8(KM + (size_t)(lane + 64 * c) * XA + h * XD + d, k0, k1);
#pragma unroll
                for (int j = 0; j < 4; ++j) s[c] += q0[j] * k0[j] + q1[j] * k1[j]; } }
        const float sc = 0.08838834764831845f;
        float mx = fmaxf(fmaxf(s[0], s[1]), fmaxf(s[2], s[3])) * sc; mx = wave_max(mx);
        float e[4], sum = 0.f;
#pragma unroll
        for (int c = 0; c < 4; ++c) { e[c] = __expf(s[c] * sc - mx); sum += e[c]; }
        sum = wave_sum(sum); const float inv = 1.0f / sum;
#pragma unroll
        for (int c = 0; c < 4; ++c) pbuf[lane + 64 * c] = bf2f((unsigned short)f2bf(e[c] * inv));
        LDS_WAIT(); asm volatile("" ::: "memory");
        float o0 = 0.f, o1 = 0.f; const bf16* v0 = VMT + (size_t)(h * XD + 2 * lane) * MEM; const bf16* v1 = v0 + MEM;
        for (int m = 0; m < MEM; m += 8) { f32x4 a0, a1, b0, b1; ld_bf8(v0 + m, a0, a1); ld_bf8(v1 + m, b0, b1); const f32x4 p0 = *(const LAS f32x4*)(pbuf + m), p1 = *(const LAS f32x4*)(pbuf + m + 4);
#pragma unroll
            for (int j = 0; j < 4; ++j) { o0 += p0[j] * a0[j] + p1[j] * a1[j]; o1 += p0[j] * b0[j] + p1[j] * b1[j]; } }
        *(unsigned*)(OX + (size_t)t * XA + h * XD + 2 * lane) = pk2(o0, o1);
        LDS_WAIT(); asm volatile("" ::: "memory");
    }
}

__device__ __forceinline__ void p_attn(Frame& F) {
    const bf16* QX = WSP(bf16, WS_QX); const bf16* KM = WSP(bf16, WS_KM); const bf16* VMT = WSP(bf16, WS_VMT); bf16* OX = WSP(bf16, WS_OX);
    constexpr int KSt = 272, VSt = 528;
    LAS unsigned char* sK = F.lds; LAS unsigned char* sV = sK + 256 * KSt;
    static_assert(256 * KSt + 128 * VSt <= MISC_OFF, "attn lds");
    const int tid = F.tid, lane = F.lane, w = F.wave, lr = lane & 15, lg = lane >> 4;
    int curh = -1;
    for (int unit = F.bid; unit < (T / 128) * XH; unit += F.G) {
        const int h = unit & 3, rt = unit >> 2;
        if (h != curh) {
            __syncthreads();
#pragma unroll
            for (int q = 0; q < 8; ++q) { const int p = tid + 512 * q;
                *(LAS u32x4*)(sK + (p >> 4) * KSt + (p & 15) * 16) = *(const u32x4*)(KM + (size_t)(p >> 4) * XA + h * XD + (p & 15) * 8);
                *(LAS u32x4*)(sV + (p >> 5) * VSt + (p & 31) * 16) = *(const u32x4*)(VMT + (size_t)(h * XD + (p >> 5)) * MEM + (p & 31) * 8); }
            __syncthreads();
            curh = h;
        }
        const int row = rt * 128 + 16 * w + lr;
        bf16x8 qf[4];
#pragma unroll
        for (int s = 0; s < 4; ++s) qf[s] = *(const bf16x8*)(QX + (size_t)row * XA + h * XD + 32 * s + 8 * lg);
        f32x4 sc[16];
#pragma unroll
        for (int kt = 0; kt < 16; ++kt) { sc[kt] = (f32x4){0.f, 0.f, 0.f, 0.f};
#pragma unroll
            for (int s = 0; s < 4; ++s) { const bf16x8 a = *(const LAS bf16x8*)(sK + (16 * kt + lr) * KSt + (32 * s + 8 * lg) * 2); sc[kt] = MFMA16(a, qf[s], sc[kt]); } }
        float m = -3.0e38f;
#pragma unroll
        for (int kt = 0; kt < 16; ++kt) m = fmaxf(m, fmaxf(fmaxf(sc[kt][0], sc[kt][1]), fmaxf(sc[kt][2], sc[kt][3])));
        m = fmaxf(m, __shfl_xor(m, 16)); m = fmaxf(m, __shfl_xor(m, 32));
        const float c = 0.08838834764831845f * 1.4426950408889634f;
        float sum = 0.f;
#pragma unroll
        for (int kt = 0; kt < 16; ++kt)
#pragma unroll
            for (int r = 0; r < 4; ++r) { const float p = exp2f((sc[kt][r] - m) * c); sc[kt][r] = p; sum += p; }
        sum += __shfl_xor(sum, 16); sum += __shfl_xor(sum, 32);
        const float inv = 1.0f / sum;
        f32x4 oa[8];
#pragma unroll
        for (int dt = 0; dt < 8; ++dt) oa[dt] = (f32x4){0.f, 0.f, 0.f, 0.f};
#pragma unroll
        for (int s = 0; s < 8; ++s) {
            u32x4 pw; pw.x = pk2(sc[2 * s][0], sc[2 * s][1]); pw.y = pk2(sc[2 * s][2], sc[2 * s][3]); pw.z = pk2(sc[2 * s + 1][0], sc[2 * s + 1][1]); pw.w = pk2(sc[2 * s + 1][2], sc[2 * s + 1][3]);
            const bf16x8 b = as_bf8(pw);
#pragma unroll
            for (int dt = 0; dt < 8; ++dt) { const LAS unsigned char* vp = sV + (16 * dt + lr) * VSt + (32 * s + 4 * lg) * 2; const u32x2 lo = *(const LAS u32x2*)vp, hi = *(const LAS u32x2*)(vp + 32);
                oa[dt] = MFMA16(as_bf8((u32x4){lo.x, lo.y, hi.x, hi.y}), b, oa[dt]); }
        }
#pragma unroll
        for (int dt = 0; dt < 8; ++dt) { u32x2 ow; ow.x = pk2(oa[dt][0] * inv, oa[dt][1] * inv); ow.y = pk2(oa[dt][2] * inv, oa[dt][3] * inv);
            *(u32x2*)(OX + (size_t)row * XA + h * XD + 16 * dt + 4 * lg) = ow; }
    }
    __syncthreads();
}

typedef float f32x16 __attribute__((ext_vector_type(16)));
__device__ __forceinline__ void p_router(Frame& F) {
    const float* X2 = WSP(float, WS_X1); bf16* H3 = WSP(bf16, WS_H3); const float* WR = WSP(float, WS_WR); const float* g = F.in[I_NMOEG]; const float* rb = F.in[I_RB];
    int* TKE = WSP(int, WS_TKE); int* TKP = WSP(int, WS_TKP); float* TKW = WSP(float, WS_TKW); unsigned* cnt = F.ctl + CW_CNT;
    LAS unsigned* lcnt = (LAS unsigned*)F.lds;
    LAS int* le = (LAS int*)(F.lds + 256);
    LAS int* lp = (LAS int*)(F.lds + 256 + 1024);
    LAS float* P = (LAS float*)(F.lds + 4096);
    LAS float* SSQ = (LAS float*)(F.lds + 4096 + 8 * 32 * 33 * 4);
    const int lane = F.lane, th = F.wave & 1, kq = F.wave >> 1, li = lane & 31, hh = lane >> 5;
    for (int blk = F.bid; blk < T / 64; blk += F.G) {
        __syncthreads();
        if (F.tid < 64) lcnt[F.tid] = 0u;
        const float* xr = X2 + (size_t)(blk * 64 + th * 32 + li) * D + kq * 512 + 4 * hh;
        const float* wr = WR + (size_t)li * D + kq * 512 + 4 * hh;
        f32x16 acc;
#pragma unroll
        for (int r = 0; r < 16; ++r) acc[r] = 0.f;
        float ss = 0.f;
#pragma unroll 4
        for (int q = 0; q < 64; ++q) {
            const f32x4 a = *(const f32x4*)(xr + 8 * q), b = *(const f32x4*)(wr + 8 * q);
            ss += (a[0] * a[0] + a[1] * a[1]) + (a[2] * a[2] + a[3] * a[3]);
#pragma unroll
            for (int s = 0; s < 4; ++s) acc = __builtin_amdgcn_mfma_f32_32x32x2f32(a[s], b[s], acc, 0, 0, 0);
        }
        ss += __shfl_xor(ss, 32);
#pragma unroll
        for (int r = 0; r < 16; ++r) P[(F.wave * 32 + (r & 3) + 8 * (r >> 2) + 4 * hh) * 33 + li] = acc[r];
        if (lane < 32) SSQ[F.wave * 32 + lane] = ss;
        __syncthreads();
        if (F.tid < 64) {
            const int tl = F.tid, th2 = tl >> 5, ti = tl & 31, t = blk * 64 + tl;
            float ssq = 0.f;
#pragma unroll
            for (int k4 = 0; k4 < 4; ++k4) ssq += SSQ[(k4 * 2 + th2) * 32 + ti];
            const float r = rsqrtf(ssq * (1.0f / D) + EPS);
            float v0 = -3.0e38f, v1 = -3.0e38f, v2 = -3.0e38f, v3 = -3.0e38f; int i0 = 0, i1 = 0, i2 = 0, i3 = 0;
            for (int e = 0; e < NE; ++e) {
                float x = 0.f;
#pragma unroll
                for (int k4 = 0; k4 < 4; ++k4) x += P[((k4 * 2 + th2) * 32 + ti) * 33 + e];
                x = x * r + rb[e];
                if (x > v3) {
                    if (x > v2) { v3 = v2; i3 = i2;
                        if (x > v1) { v2 = v1; i2 = i1;
                            if (x > v0) { v1 = v0; i1 = i0; v0 = x; i0 = e; } else { v1 = x; i1 = e; } }
                        else { v2 = x; i2 = e; } }
                    else { v3 = x; i3 = e; } }
            }
            const float e1 = __expf(v1 - v0), e2 = __expf(v2 - v0), e3 = __expf(v3 - v0), inv = 1.0f / (1.0f + e1 + e2 + e3);
            const unsigned p0 = __hip_atomic_fetch_add(lcnt + i0, 1u, __ATOMIC_RELAXED, __HIP_MEMORY_SCOPE_WORKGROUP);
            const unsigned p1 = __hip_atomic_fetch_add(lcnt + i1, 1u, __ATOMIC_RELAXED, __HIP_MEMORY_SCOPE_WORKGROUP);
            const unsigned p2 = __hip_atomic_fetch_add(lcnt + i2, 1u, __ATOMIC_RELAXED, __HIP_MEMORY_SCOPE_WORKGROUP);
            const unsigned p3 = __hip_atomic_fetch_add(lcnt + i3, 1u, __ATOMIC_RELAXED, __HIP_MEMORY_SCOPE_WORKGROUP);
            le[tl * 4 + 0] = i0; le[tl * 4 + 1] = i1; le[tl * 4 + 2] = i2; le[tl * 4 + 3] = i3;
            lp[tl * 4 + 0] = (int)p0; lp[tl * 4 + 1] = (int)p1; lp[tl * 4 + 2] = (int)p2; lp[tl * 4 + 3] = (int)p3;
            *(int4*)(TKE + t * 4) = make_int4(i0, i1, i2, i3);
            *(f32x4*)(TKW + t * 4) = (f32x4){inv, e1 * inv, e2 * inv, e3 * inv};
        }
        __syncthreads();
        if (F.tid < NE) lcnt[32 + F.tid] = __hip_atomic_fetch_add(cnt + 64 * F.tid, lcnt[F.tid], RLX_AGENT);
        __syncthreads();
        if (F.tid < 256) { const int tl = F.tid >> 2, k = F.tid & 3; TKP[(blk * 64 + tl) * 4 + k] = lp[tl * 4 + k] + (int)lcnt[32 + le[tl * 4 + k]]; }
        for (int tt = 0; tt < 8; ++tt) { const int t = blk * 64 + F.wave * 8 + tt; rms_row_to_bf16(X2 + (size_t)t * D, g, H3 + (size_t)t * D, lane); }
    }
}
__device__ __forceinline__ void p_lists(Frame& F) {
    unsigned* cnt = F.ctl + CW_CNT; int* TKE = WSP(int, WS_TKE); int* TKP = WSP(int, WS_TKP); int* ROWTOK = WSP(int, WS_ROWTOK); int* TILE = WSP(int, WS_TILE);
    LAS int* poff = (LAS int*)F.lds;
    LAS int* lc = (LAS int*)(F.lds + 256);
    __syncthreads();
    if (F.tid < NE) lc[F.tid] = (int)__hip_atomic_load(cnt + 64 * F.tid, RLX_AGENT);
    __syncthreads();
    if (F.tid == 0) { int o = 0; for (int e = 0; e < NE; ++e) { poff[e] = o; o += (lc[e] + 255) / 256 * 256; } poff[NE] = o; }
    __syncthreads();
    for (int i = F.bid * NTHR + F.tid; i < T * TOPK; i += F.G * NTHR) { const int e = TKE[i], slot = poff[e] + TKP[i]; TKP[i] = slot; ROWTOK[slot] = i >> 2; }
    if (F.bid == 0) {
        for (int e = 0; e < NE; ++e) for (int s = poff[e] + lc[e] + F.tid; s < poff[e + 1]; s += NTHR) ROWTOK[s] = T;
        for (int e = 0; e < NE; ++e) for (int tl = poff[e] / 256 + F.tid; tl < poff[e + 1] / 256; tl += NTHR) TILE[tl] = e;
        if (F.tid == 0) TILE[512] = poff[NE] / 256;
    }
    __syncthreads();
}
__device__ __forceinline__ void p_combine(Frame& F) {
    const float* X2 = WSP(float, WS_X1); const bf16* YS = WSP(bf16, WS_YS); const int* TKP = WSP(int, WS_TKP); const float* TKW = WSP(float, WS_TKW); const float* g = F.in[I_NFG];
    const int gw = F.bid * NWAVES + F.wave, NGW = F.G * NWAVES, lane = F.lane;
    for (int t = gw; t < T; t += NGW) {
        int sl[4]; float w[4];
#pragma unroll
        for (int k = 0; k < 4; ++k) { sl[k] = TKP[t * 4 + k]; w[k] = TKW[t * 4 + k]; }
        f32x4 v[8]; float s = 0.f;
#pragma unroll
        for (int j = 0; j < 8; ++j) { v[j] = *(const f32x4*)(X2 + (size_t)t * D + 4 * lane + 256 * j);
#pragma unroll
            for (int k = 0; k < 4; ++k) { const u32x2 y = *(const u32x2*)(YS + (size_t)sl[k] * D + 4 * lane + 256 * j);
                v[j][0] += w[k] * __uint_as_float(y.x << 16); v[j][1] += w[k] * __uint_as_float(y.x & 0xffff0000u); v[j][2] += w[k] * __uint_as_float(y.y << 16); v[j][3] += w[k] * __uint_as_float(y.y & 0xffff0000u); }
            s += (v[j][0] * v[j][0] + v[j][1] * v[j][1]) + (v[j][2] * v[j][2] + v[j][3] * v[j][3]); }
        const float r = rsqrtf(wave_sum(s) * (1.0f / D) + EPS);
#pragma unroll
        for (int j = 0; j < 8; ++j) { const f32x4 gg = *(const f32x4*)(g + 4 * lane + 256 * j); *(f32x4*)(F.out + (size_t)t * D + 4 * lane + 256 * j) = v[j] * r * gg; }
    }
}

constexpr int NPHASE = 16;
__global__ void __launch_bounds__(NTHR, 2) hybrid_fwd(Args args) {
    extern __shared__ __attribute__((aligned(16))) unsigned char lds_raw[];
    Frame F;
    F.lds = (LAS unsigned char*)lds_raw; F.ws = args.ws; F.ctl = (unsigned*)(args.ws + WS_CTL);
    F.tid = threadIdx.x; F.lane = F.tid & 63; F.wave = __builtin_amdgcn_readfirstlane(F.tid >> 6); F.G = gridDim.x; F.bid = blockIdx.x;
    F.in = args.in; F.out = args.out;
    volatile LAS unsigned* MISC = (volatile LAS unsigned*)(F.lds + MISC_OFF);
    if (F.tid < 32) MISC[F.tid] = 0u;
    __syncthreads();
#if MK_ONE_LAUNCH
    XcdBarrier bar = xcd_barrier_post(F.ctl + CW_BAR, MISC + 8);
#define GRID_BAR() xcd_barrier(bar)
#else
#define GRID_BAR() do {} while (0)
#endif
    const int lo = args.ph_lo, hi = args.ph_hi;
#ifndef ONLY_PHASE
#define ONLY_PHASE -1
#endif
#define IN(k) (lo <= (k) && (k) < hi && (ONLY_PHASE < 0 || ONLY_PHASE == (k)))
#define SEAM(k) do { if (IN(k) && IN((k) + 1)) GRID_BAR(); } while (0)

    if (IN(0)) { p0_prologue(F); }
    SEAM(0);
    if (IN(1)) {
        DenseSched S; S.init(WSP(bf16, WS_XN), WSP(bf16, WS_WIN), T, NIN, D, F.G, F.bid);
        EpiInProj E{WSP(bf16, WS_Q), WSP(bf16, WS_K), WSP(bf16, WS_V), WSP(bf16, WS_SR), WSP(bf16, WS_CB), WSP(bf16, WS_U), WSP(bf16, WS_SGA), WSP(bf16, WS_SGB), WSP(float, WS_LA), F.in[I_GGB]};
        gemm_any(F.lds, S, E);
        p_memkv(F);
    }
    SEAM(1);
    if (IN(2)) { p_conv(F); p_glaprep(F); }
    SEAM(2);
    if (IN(3)) {
#if OPT_GLA
        p_gla_a(F);
#else
        p_gla_ref(F);
#endif
    }
    SEAM(3);
    if (IN(4)) {
#if OPT_GLA
        p_gla_b(F);
#endif
    }
    SEAM(4);
    if (IN(5)) {
#if OPT_GLA
        p_gla_c(F);
#else
        p_gla_norm_ref(F);
#endif
    }
    SEAM(5);
    if (IN(6)) {
        { DenseSched S; S.init(WSP(bf16, WS_OA), WSP(bf16, WS_WGO), T, D, D, F.G, F.bid); EpiGateA E{WSP(float, WS_T1), WSP(bf16, WS_SGA)}; gemm_any(F.lds, S, E); }
        VM_WAIT(); __syncthreads();
        { DenseSched S; S.init(WSP(bf16, WS_Z), WSP(bf16, WS_WCO), T, D, D, F.G, F.bid); EpiGateB E{WSP(float, WS_T1), WSP(bf16, WS_SGB), WSP(bf16, WS_MG)}; gemm_any(F.lds, S, E); }
    }
    SEAM(6);
    if (IN(7)) { DenseSched S; S.init(WSP(bf16, WS_MG), WSP(bf16, WS_WMX), T, D, D, F.G, F.bid); EpiResid1 E{F.in[I_X], WSP(float, WS_X1), WSP(bf16, WS_X1B), (float*)(F.ctl + CW_SS1)}; gemm_any(F.lds, S, E); }
    SEAM(7);
    if (IN(8)) { DenseSched S; S.init(WSP(bf16, WS_X1B), WSP(bf16, WS_WXQ), T, XA, D, F.G, F.bid); EpiXQ E{WSP(bf16, WS_QX), (const float*)(F.ctl + CW_SS1)}; gemm_any(F.lds, S, E); }
    SEAM(8);
    if (IN(9)) {
#if OPT_ATT
        p_attn(F);
#else
        p_attn_ref(F);
#endif
    }
    SEAM(9);
    if (IN(10)) { DenseSched S; S.init(WSP(bf16, WS_OX), WSP(bf16, WS_WXO), T, D, XA, F.G, F.bid); EpiResid2 E{WSP(float, WS_X1)}; gemm_any(F.lds, S, E); }
    SEAM(10);
    if (IN(11)) { p_router(F); }
    SEAM(11);
    if (IN(12)) { p_lists(F); }
    SEAM(12);
    if (IN(13)) { const int ntiles = __builtin_amdgcn_readfirstlane(ld_agent_i(WSP(int, WS_TILE) + 512));
        GroupSched S; S.init(WSP(bf16, WS_H3), WSP(bf16, WS_WGU), ntiles, 2 * FF, D, F.G, F.bid, WSP(int, WS_TILE), WSP(int, WS_ROWTOK)); EpiGU E{WSP(bf16, WS_ACT), F.in[I_GUB]}; gemm_any(F.lds, S, E); }
    SEAM(13);
    if (IN(14)) { const int ntiles = __builtin_amdgcn_readfirstlane(ld_agent_i(WSP(int, WS_TILE) + 512));
        GroupSched S; S.init(WSP(bf16, WS_ACT), WSP(bf16, WS_WDN), ntiles, D, FF, F.G, F.bid, WSP(int, WS_TILE), nullptr); EpiDown E{WSP(bf16, WS_YS), F.in[I_DNB]}; gemm_any(F.lds, S, E); }
    SEAM(14);
    if (IN(15)) { p_combine(F); }
#undef IN
#undef SEAM
}

extern "C" void kernel_launch(void* const* d_in, const int* in_sizes, int n_in, void* d_out, int out_size, void* d_ws, size_t ws_size, hipStream_t stream) {
    static int grid = 0;
    if (grid == 0) {
        if (n_in != 26 || out_size != T * D || ws_size < WS_END) { fprintf(stderr, "kernel_launch: unexpected problem (n_in %d, out %d, ws %zu < %zu)\n", n_in, out_size, ws_size, (size_t)WS_END); grid = -1; return; }
        int dev = 0, cus = 0, per_cu = 0;
        if (hipGetDevice(&dev) != hipSuccess || hipDeviceGetAttribute(&cus, hipDeviceAttributeMultiprocessorCount, dev) != hipSuccess) { grid = -1; return; }
        if (hipFuncSetAttribute((const void*)hybrid_fwd, hipFuncAttributeMaxDynamicSharedMemorySize, LDS_BYTES) != hipSuccess) { fprintf(stderr, "kernel_launch: hipFuncSetAttribute failed\n"); grid = -1; return; }
        if (hipOccupancyMaxActiveBlocksPerMultiprocessor(&per_cu, (const void*)hybrid_fwd, NTHR, LDS_BYTES) != hipSuccess || per_cu < 1) fprintf(stderr, "kernel_launch: occupancy query says %d\n", per_cu);
        (void)hipGetLastError();
        grid = cus;
    }
    if (grid < 0) return;
    (void)hipMemsetAsync((char*)d_ws + WS_CTL, 0, CTL_ZERO_BYTES, stream);
    Args a{};
    for (int i = 0; i < 26; ++i) a.in[i] = (const float*)d_in[i];
    a.out = (float*)d_out; a.ws = (unsigned char*)d_ws;
#if MK_ONE_LAUNCH
    a.ph_lo = 0; a.ph_hi = NPHASE;
    hipLaunchKernelGGL(hybrid_fwd, dim3(grid), dim3(NTHR), LDS_BYTES, stream, a);
#else
    for (int p = 0; p < NPHASE; ++p) { a.ph_lo = p; a.ph_hi = p + 1; hipLaunchKernelGGL(hybrid_fwd, dim3(grid), dim3(NTHR), LDS_BYTES, stream, a); }
#endif
}
```

```cpp
#include <hip/hip_runtime.h>
#include <cstdio>
#include <cstdint>

#ifndef MK_ONE_LAUNCH
#define MK_ONE_LAUNCH 1
#endif
#ifndef OPT_GEMM
#define OPT_GEMM 1
#endif
#ifndef OPT_GLA
#define OPT_GLA 1
#endif
#ifndef MOE_FP8
#define MOE_FP8 1
#endif
#ifndef OPT_ATT
#define OPT_ATT 1
#endif

#define GAS __attribute__((address_space(1)))
#define LAS __attribute__((address_space(3)))
typedef unsigned short bf16;
typedef short bf16x8 __attribute__((ext_vector_type(8)));
typedef short bf16x4 __attribute__((ext_vector_type(4)));
typedef float f32x4 __attribute__((ext_vector_type(4)));
typedef float f32x2 __attribute__((ext_vector_type(2)));
typedef unsigned u32x4 __attribute__((ext_vector_type(4)));
typedef unsigned u32x2 __attribute__((ext_vector_type(2)));
#define RLX_AGENT __ATOMIC_RELAXED, __HIP_MEMORY_SCOPE_AGENT
#define LDS_WAIT() asm volatile("s_waitcnt lgkmcnt(0)" ::: "memory")
#define VM_WAIT() asm volatile("s_waitcnt vmcnt(0)" ::: "memory")

constexpr int T = 16384, D = 2048, MEM = 256;
constexpr int GH = 4, DK = 256, DV = 512, QK = GH * DK  , VD = GH * DV  ;
constexpr int CH = 64, NCH = T / CH  , NG = 16, GC = NCH / NG  , GT = GC * CH  ;
constexpr int XH = 4, XD = 128, XA = XH * XD  ;
constexpr int NE = 32, TOPK = 4, FF = 2048;
constexpr int NIN_SRC = 16400, NIN = 16384;
constexpr float EPS = 1e-5f;
constexpr int PROWS = T * TOPK + NE * 256;
constexpr int MAXTILES = PROWS / 256;

constexpr int SRC_ALOW = 6144, SRC_CB = 6160, SRC_CC = 8208, SRC_CHH = 10256, SRC_GA = 12304, SRC_GB = 14352;
constexpr int TN_Q = 0, TN_K = 4, TN_V = 8, TN_R = 16, TN_CB = 24, TN_U = 32, TN_GA = 48, TN_GB = 56, TN_END = 64;

constexpr size_t MiB = 1u << 20;
constexpr size_t WS_CTL = 0, CTL_ZERO_BYTES = 1 * MiB;
constexpr size_t WS_WIN = 1 * MiB;
constexpr size_t WS_WGO = WS_WIN + 68 * MiB;
constexpr size_t WS_WCO = WS_WGO + 8 * MiB;
constexpr size_t WS_WMX = WS_WCO + 8 * MiB;
constexpr size_t WS_WXQ = WS_WMX + 8 * MiB;
constexpr size_t WS_WXKV = WS_WXQ + 2 * MiB;
constexpr size_t WS_WXO = WS_WXKV + 4 * MiB;
constexpr size_t WS_WR = WS_WXO + 2 * MiB;
constexpr size_t WS_WGU = WS_WR + 1 * MiB;
constexpr size_t WS_WDN = WS_WGU + 512 * MiB;
constexpr size_t WS_XN = WS_WDN + 256 * MiB;
constexpr size_t WS_Q = WS_XN + 64 * MiB;
constexpr size_t WS_K = WS_Q + 32 * MiB;
constexpr size_t WS_V = WS_K + 32 * MiB;
constexpr size_t WS_SR = WS_V + 64 * MiB;
constexpr size_t WS_LA = WS_SR + 64 * MiB;
constexpr size_t WS_CB = WS_LA + 64 * MiB;
constexpr size_t WS_U = WS_CB + 64 * MiB;
constexpr size_t WS_SGA = WS_U + 64 * MiB;
constexpr size_t WS_SGB = WS_SGA + 64 * MiB;
constexpr size_t WS_QT = WS_SGB + 64 * MiB;
constexpr size_t WS_KH = WS_QT + 32 * MiB;
constexpr size_t WS_KHT = WS_KH + 32 * MiB;
constexpr size_t WS_QG = WS_KHT + 32 * MiB;
constexpr size_t WS_VT = WS_QG + 32 * MiB;
constexpr size_t WS_DL = WS_VT + 64 * MiB;
constexpr size_t WS_DG = WS_DL + 1 * MiB;
constexpr size_t WS_Z = WS_DG + 1 * MiB;
constexpr size_t WS_OL = WS_Z + 64 * MiB;
constexpr size_t WS_SLOC = WS_OL + 64 * MiB;
constexpr size_t WS_SG0 = WS_SLOC + 32 * MiB;
constexpr size_t WS_O32 = WS_SG0 + 16 * MiB;
constexpr size_t WS_OA = WS_O32 + 128 * MiB;
constexpr size_t WS_T1 = WS_OA + 64 * MiB;
constexpr size_t WS_MG = WS_T1 + 128 * MiB;
constexpr size_t WS_X1 = WS_MG + 64 * MiB;
constexpr size_t WS_X1B = WS_X1 + 128 * MiB;
constexpr size_t WS_QX = WS_X1B + 64 * MiB;
constexpr size_t WS_OX = WS_QX + 16 * MiB;
constexpr size_t WS_MEMN = WS_OX + 16 * MiB;
constexpr size_t WS_KM = WS_MEMN + 1 * MiB;
constexpr size_t WS_VMT = WS_KM + 1 * MiB;
constexpr size_t WS_H3 = WS_VMT + 1 * MiB;
constexpr size_t WS_TKE = WS_H3 + 65 * MiB;
constexpr size_t WS_TKP = WS_TKE + 1 * MiB;
constexpr size_t WS_TKW = WS_TKP + 1 * MiB;
constexpr size_t WS_ROWTOK = WS_TKW + 1 * MiB;
constexpr size_t WS_TILE = WS_ROWTOK + 1 * MiB;
constexpr size_t WS_SSP = WS_TILE + 1 * MiB;
constexpr size_t WS_WAL = WS_SSP + 8 * MiB;
constexpr size_t WS_ALOW = WS_WAL + 1 * MiB;
constexpr size_t WS_WGW = WS_ALOW + 1 * MiB;
constexpr size_t WS_RTE = WS_WGW + 1 * MiB;
constexpr size_t WS_ACT = WS_RTE + 2 * MiB;
constexpr size_t WS_YS = WS_ACT + 288 * MiB;
constexpr size_t WS_END = WS_YS + 288 * MiB;
constexpr int CW_BAR = 4096;
constexpr int CW_CNT = 16384;
constexpr int CW_SS1 = 65536;
static_assert((CW_SS1 + T) * 4 <= (int)CTL_ZERO_BYTES, "ctl");

constexpr int NWAVES = 8, NTHR = 512;
constexpr int LDS_BYTES = 147456;
constexpr int MISC_OFF = 147200;

__device__ __forceinline__ float bf2f(unsigned short b) { return __uint_as_float(((unsigned)b) << 16); }
typedef __bf16 bf16x2_t __attribute__((ext_vector_type(2)));
__device__ __forceinline__ unsigned pk2(float lo, float hi) { const f32x2 v = {lo, hi}; return __builtin_bit_cast(unsigned, __builtin_convertvector(v, bf16x2_t)); }
__device__ __forceinline__ unsigned f2bf(float f) { return pk2(f, 0.f) & 0xffffu; }
__device__ __forceinline__ float wave_sum(float v) {
#pragma unroll
    for (int o = 1; o < 64; o <<= 1) v += __shfl_xor(v, o);
    return v;
}
__device__ __forceinline__ float wave_max(float v) {
#pragma unroll
    for (int o = 1; o < 64; o <<= 1) v = fmaxf(v, __shfl_xor(v, o));
    return v;
}
__device__ __forceinline__ float sigmoidf_(float x) { return __builtin_amdgcn_rcpf(1.0f + __builtin_amdgcn_exp2f(x * -1.4426950408889634f)); }
__device__ __forceinline__ float logsigmoidf_(float z) { return fminf(z, 0.f) - 0.6931471805599453f * __builtin_amdgcn_logf(1.0f + __builtin_amdgcn_exp2f(fabsf(z) * -1.4426950408889634f)); }
__device__ __forceinline__ u32x4 pack8(f32x4 a, f32x4 b) { u32x4 w; w.x = pk2(a[0], a[1]); w.y = pk2(a[2], a[3]); w.z = pk2(b[0], b[1]); w.w = pk2(b[2], b[3]); return w; }
__device__ __forceinline__ void unpack8(u32x4 w, f32x4& a, f32x4& b) {
    a[0] = __uint_as_float(w.x << 16); a[1] = __uint_as_float(w.x & 0xffff0000u); a[2] = __uint_as_float(w.y << 16); a[3] = __uint_as_float(w.y & 0xffff0000u);
    b[0] = __uint_as_float(w.z << 16); b[1] = __uint_as_float(w.z & 0xffff0000u); b[2] = __uint_as_float(w.w << 16); b[3] = __uint_as_float(w.w & 0xffff0000u);
}
__device__ __forceinline__ unsigned pk4_fp8(float a, float b, float c, float d) {
    a = fminf(fmaxf(a, -448.f), 448.f); b = fminf(fmaxf(b, -448.f), 448.f); c = fminf(fmaxf(c, -448.f), 448.f); d = fminf(fmaxf(d, -448.f), 448.f);
    int w = 0; w = __builtin_amdgcn_cvt_pk_fp8_f32(a, b, w, false); w = __builtin_amdgcn_cvt_pk_fp8_f32(c, d, w, true); return (unsigned)w; }
__device__ __forceinline__ bf16x8 as_bf8(u32x4 w) { return __builtin_bit_cast(bf16x8, w); }
#define MFMA16(A, B, C) __builtin_amdgcn_mfma_f32_16x16x32_bf16((A), (B), (C), 0, 0, 0)
__device__ __forceinline__ int ld_agent_i(const int* p) { return (int)__hip_atomic_load((const unsigned*)p, RLX_AGENT); }

#define XB_TMO      128
#define XB_XCNT(j)  (256  + 64 * (j))
#define XB_XSUB(j)  (1280 + 64 * (j))
#define XB_XGEN(j)  (2304 + 64 * (j))
#define XB_TOP      3328
#define XB_TOPGEN   3392
#define XCD_BAR_WORDS 3456
#define XB_SPIN_CAP (1u << 22)
__device__ __forceinline__ unsigned xb_ld(unsigned* p)              { return __hip_atomic_load(p, __ATOMIC_RELAXED, __HIP_MEMORY_SCOPE_AGENT); }
__device__ __forceinline__ unsigned xb_add(unsigned* p, unsigned v) { return __hip_atomic_fetch_add(p, v, __ATOMIC_RELAXED, __HIP_MEMORY_SCOPE_AGENT); }
__device__ __forceinline__ unsigned xb_xcc_id() { return (unsigned)__builtin_amdgcn_s_getreg((3 << 11) | 20) & 0xFu; }
#define XB_SPIN(cond, bar) do { unsigned _sp = 0; while (cond) { __builtin_amdgcn_s_sleep(1); \
    if ((++_sp & 255u) == 0u) { if (xb_ld(&(bar)[XB_TMO])) break; if (_sp > XB_SPIN_CAP) { atomicAdd(&(bar)[XB_TMO], 1u); break; } } } } while (0)
struct XcdBarrier { unsigned* bar; unsigned x; volatile LAS unsigned* st; };
__device__ __forceinline__ XcdBarrier xcd_barrier_post(unsigned* bar, volatile LAS unsigned* st) {
    XcdBarrier b; b.bar = bar; b.x = xb_xcc_id(); b.st = st;
    if (threadIdx.x == 0) (void)xb_add(&bar[XB_XCNT(b.x)], 1u);
    return b;
}
__device__ __forceinline__ void xcd_barrier_complete(unsigned* bar, unsigned x, unsigned& nloc, unsigned& nx) {
    const unsigned G = gridDim.x * gridDim.y * gridDim.z;
    unsigned sum, cnt, mine, sp = 0u;
    for (;;) {
        sum = 0u; cnt = 0u; mine = 0u;
#pragma unroll
        for (unsigned j = 0; j < 16; ++j) { const unsigned c = xb_ld(&bar[XB_XCNT(j)]); sum += c; cnt += (c > 0u) ? 1u : 0u; mine = (j == x) ? c : mine; }
        if (sum == G) break;
        __builtin_amdgcn_s_sleep(1);
        if ((++sp & 255u) == 0u) { if (xb_ld(&bar[XB_TMO])) break; if (sp > XB_SPIN_CAP) { atomicAdd(&bar[XB_TMO], 1u); break; } }
    }
    nloc = mine > 0u ? mine : 1u; nx = cnt > 0u ? cnt : 1u;
}
__device__ __forceinline__ void xcd_barrier(const XcdBarrier& b) {
    asm volatile("s_waitcnt vmcnt(0)" ::: "memory");
    __syncthreads();
    if (threadIdx.x == 0) {
        unsigned* bar = b.bar;
        __builtin_amdgcn_s_waitcnt(0);
        unsigned nloc = b.st[0], nx = b.st[1];
        if (nloc == 0u) { xcd_barrier_complete(bar, b.x, nloc, nx); b.st[0] = nloc; b.st[1] = nx; }
        const unsigned old = xb_add(&bar[XB_XSUB(b.x)], 1u);
        const unsigned gen = old / nloc;
        if (old + 1u == (gen + 1u) * nloc) {
            __builtin_amdgcn_fence(__ATOMIC_RELEASE, "agent");
            asm volatile("s_waitcnt vmcnt(0)" ::: "memory");
            const unsigned og = xb_add(&bar[XB_TOP], 1u);
            const unsigned tg = og / nx;
            if (og + 1u == (tg + 1u) * nx) xb_add(&bar[XB_TOPGEN], 1u);
            else XB_SPIN(xb_ld(&bar[XB_TOPGEN]) == tg, bar);
            __builtin_amdgcn_fence(__ATOMIC_ACQUIRE, "agent");
            xb_add(&bar[XB_XGEN(b.x)], 1u);
            asm volatile("s_waitcnt vmcnt(0)" ::: "memory");
        } else {
            XB_SPIN(xb_ld(&bar[XB_XGEN(b.x)]) == gen, bar);
            __builtin_amdgcn_fence(__ATOMIC_ACQUIRE, "agent");
            asm volatile("s_waitcnt vmcnt(0)" ::: "memory");
        }
    }
    __syncthreads();
}

struct Args { const float* in[26]; float* out; unsigned char* ws; int ph_lo, ph_hi, probe, pad; };
struct Frame {
    LAS unsigned char* lds; unsigned char* ws; unsigned* ctl;
    int tid, lane, wave, G, bid;
    const float* const* in;
    float* out;
};
#define WSP(type, off) ((type*)(F.ws + (off)))
enum { I_X = 0, I_MEM, I_NMIXG, I_WIN, I_GGW, I_GGB, I_GNG, I_GOW, I_CW, I_CBIAS, I_COW, I_MXW, I_NXG, I_NMG, I_XQ, I_XK, I_XV, I_XO, I_NMOEG, I_RW, I_RB, I_GUW, I_GUB, I_DNW, I_DNB, I_NFG };

constexpr int BM = 256, BK = 64, HALF = 128, HTB = HALF * BK * 2, NXCD = 8, WGM = 8;
__device__ __forceinline__ int lds_byte(int r, int c) { const int st = (r >> 4) * 2 + (c >> 5), rr = r & 15, cc = c & 31, ob = rr * 64 + cc * 2; return st * 1024 + (ob ^ (((ob >> 9) & 1) << 5)); }
__device__ __forceinline__ void stage_rc(int b, int& R, int& C) { const int st = b / 1024, sb = b % 1024, swz = sb ^ (((sb >> 9) & 1) << 5); R = (st >> 1) * 16 + swz / 64; C = (st & 1) * 32 + (swz % 64) / 2; }
__device__ __forceinline__ int g8(int rr) { return ((rr >> 3) & 1) * 4 + ((rr >> 1) & 1); }
__device__ __forceinline__ int lds_byte8(int r, int c) { return (r >> 4) * 2048 + (r & 15) * 128 + ((c ^ g8(r & 15)) << 4); }
__device__ __forceinline__ void stage_rc8(int b, int& R, int& C) { const int s = b >> 4, rr = (s >> 3) & 15; R = (s >> 7) * 16 + rr; C = 8 * ((s & 7) ^ g8(rr)); }
__device__ __forceinline__ int perm32(int rho) { const int n = rho >> 4, i = rho & 15; return 8 * (i >> 2) + 4 * n + (i & 3); }

struct Unit { int pm, pn, e; };
__device__ __forceinline__ bool static_next(int i, int G, int c, int nM, int nN, Unit& u) {
    const int nwg = nM * nN; const long L = (long)i * G + c; if (L >= nwg) return false;
    int wgid = (int)L; { const int q = nwg / NXCD, r = nwg % NXCD, xcd = wgid % NXCD, off = wgid / NXCD; wgid = (xcd < r ? xcd * (q + 1) : r * (q + 1) + (xcd - r) * q) + off; }
    const int nig = WGM * nN, gid = wgid / nig, fm = gid * WGM, gsz = (nM - fm) < WGM ? (nM - fm) : WGM;
    u.pm = fm + ((wgid % nig) % gsz); u.pn = (wgid % nig) / gsz; u.e = 0; return true;
}
struct DenseSched {
    const char* A; const char* Bt; int K, nM, nN, G, c, i0, ni, pair;
    __device__ __forceinline__ void init(const void* A_, const void* Bt_, int M, int N, int K_, int G_, int c_, int i0_ = 0, int ni_ = 1 << 30, int pair_ = 0) { A = (const char*)A_; Bt = (const char*)Bt_; K = K_; nM = M / BM; nN = N / BM; G = G_; c = c_; i0 = i0_; ni = ni_; pair = pair_; }
    __device__ __forceinline__ bool next(int i, Unit& u) const { if (pair) { if (i >= 2 * ni) return false; return static_next(i0 + (i >> 1), G, c - (i & 1) * pair, nM, nN, u); } if (i >= ni) return false; if (!static_next(i0 + i, G, c, nM, nN, u)) return false; if (ks) { u.e = u.pn / (nN >> 1); u.pn -= u.e * (nN >> 1); } return true; }
    int ks = 0;
    __device__ __forceinline__ const char* a_base() const { return A; }
    __device__ __forceinline__ size_t a_off(const Unit& u) const { return ks ? (size_t)u.e * K : 0; }
    __device__ __forceinline__ const char* b_base(const Unit& u) const { return Bt + (size_t)u.pn * BM * K * 2 + (ks ? (size_t)u.e * K : 0); }
    __device__ __forceinline__ unsigned a_src_row(const Unit& u, int r) const { return (unsigned)(u.pm * BM + r); }
    __device__ __forceinline__ int koff(const Unit& u, int nt) const { return 0; }
    __device__ __forceinline__ int nkt(int bk) const { return (ks ? K / 2 : K) / bk; }
};
constexpr int LAY_OFF = 131072, LAY_CNT = 64, LAY_TILE = 128;
__device__ __forceinline__ void moe_layout(LAS unsigned char* lds, const unsigned* cnt) {
    LAS int* lay = (LAS int*)(lds + LAY_OFF);
    __syncthreads();
    if (threadIdx.x < NE) lay[LAY_CNT + threadIdx.x] = (int)__hip_atomic_load(cnt + 64 * threadIdx.x, RLX_AGENT);
    __syncthreads();
    if (threadIdx.x == 0) { int o = 0; for (int e = 0; e < NE; ++e) { lay[e] = o; o += (lay[LAY_CNT + e] + 255) / 256 * 256; } lay[NE] = o; }
    __syncthreads();
    for (int tl = threadIdx.x; tl < lay[NE] / 256; tl += NTHR) { int e = 0; for (int q = 1; q < NE; ++q) e = (tl * 256 >= lay[q]) ? q : e; lay[LAY_TILE + tl] = e; }
    __syncthreads();
}
struct GroupSched {
    const char* A; const char* Bt; int K, N, nM, nN, G, c, eb; const LAS int* lay; const int* rte;
    __device__ __forceinline__ void init(const void* A_, const void* Bt_, int ntiles, int N_, int K_, int G_, int c_, const LAS int* lay_, const int* rte_, int eb_ = 2) { A = (const char*)A_; Bt = (const char*)Bt_; eb = eb_; K = K_; N = N_; nM = ntiles; nN = N_ / BM; G = G_; c = c_; lay = lay_; rte = rte_; }
    __device__ __forceinline__ bool next(int i, Unit& u) const { if (!static_next(i, G, c, nM, nN, u)) return false; u.e = __builtin_amdgcn_readfirstlane(lay[LAY_TILE + u.pm]); return true; }
    __device__ __forceinline__ const char* a_base() const { return A; }
    __device__ __forceinline__ const char* b_base(const Unit& u) const { return eb == 1 ? Bt + ((size_t)u.e * nN + (size_t)u.pn) * (size_t)(K / 128) * 32768 : Bt + ((size_t)u.e * N + (size_t)u.pn * BM) * K * eb; }
    __device__ __forceinline__ int koff(const Unit& u, int nt) const { return (2 * u.pm) & (nt - 1); }
    __device__ __forceinline__ size_t a_off(const Unit& u) const { return 0; }
    __device__ __forceinline__ int nkt(int bk) const { return K / bk; }
    __device__ __forceinline__ unsigned a_src_row(const Unit& u, int r) const { if (!rte) return (unsigned)(u.pm * BM + r); const int pos = u.pm * BM + r - lay[u.e]; return pos < lay[LAY_CNT + u.e] ? (unsigned)ld_agent_i(rte + (size_t)u.e * T + pos) : (unsigned)T; }
};

template <class Epi, class Sched>
__device__ __forceinline__ void gemm_ref(LAS unsigned char* lds, const Sched& S, const Epi& E) {
    const int tid = threadIdx.x, tx = tid & 15, ty = tid >> 4, K = S.K;
    LAS float* As = (LAS float*)lds; LAS float* Bs = As + 16 * 260;
    const int lr = tid >> 1, kh = tid & 1;
    for (int i = 0;; ++i) {
        Unit u; if (!S.next(i, u)) break;
        float acc[8][16];
#pragma unroll
        for (int j = 0; j < 8; ++j)
#pragma unroll
            for (int q = 0; q < 16; ++q) acc[j][q] = 0.f;
        const char* Ab = S.a_base() + S.a_off(u) + ((size_t)S.a_src_row(u, lr) * K + 8 * kh) * 2;
        const char* Bb = S.b_base(u) + ((size_t)lr * K + 8 * kh) * 2;
        for (int k0 = 0; k0 < 16 * S.nkt(16); k0 += 16) {
            const bf16x8 av = *(const bf16x8*)(Ab + (size_t)k0 * 2), bv = *(const bf16x8*)(Bb + (size_t)k0 * 2);
            __syncthreads();
#pragma unroll
            for (int j = 0; j < 8; ++j) { As[(8 * kh + j) * 260 + lr] = bf2f((unsigned short)av[j]); Bs[(8 * kh + j) * 260 + lr] = bf2f((unsigned short)bv[j]); }
            __syncthreads();
#pragma unroll 4
            for (int kk = 0; kk < 16; ++kk) {
                float a[8], b[16];
#pragma unroll
                for (int j = 0; j < 8; ++j) a[j] = As[kk * 260 + ty + 32 * j];
                const f32x4 b0 = *(const LAS f32x4*)(Bs + kk * 260 + 8 * tx), b1 = *(const LAS f32x4*)(Bs + kk * 260 + 8 * tx + 4);
                const f32x4 b2 = *(const LAS f32x4*)(Bs + kk * 260 + 128 + 8 * tx), b3 = *(const LAS f32x4*)(Bs + kk * 260 + 128 + 8 * tx + 4);
#pragma unroll
                for (int q = 0; q < 4; ++q) { b[q] = b0[q]; b[4 + q] = b1[q]; b[8 + q] = b2[q]; b[12 + q] = b3[q]; }
#pragma unroll
                for (int j = 0; j < 8; ++j)
#pragma unroll
                    for (int q = 0; q < 16; ++q) acc[j][q] += a[j] * b[q];
            }
        }
#pragma unroll 8
        for (int j = 0; j < 8; ++j) {
            const f32x4 a0 = {acc[j][0], acc[j][1], acc[j][2], acc[j][3]}, a1 = {acc[j][4], acc[j][5], acc[j][6], acc[j][7]};
            const f32x4 b0 = {acc[j][8], acc[j][9], acc[j][10], acc[j][11]}, b1 = {acc[j][12], acc[j][13], acc[j][14], acc[j][15]};
            typename Epi::Ctx cx; E.load(u.pm * BM + ty + 32 * j, u, 8 * tx, cx); E.template fin<false>(u.pm * BM + ty + 32 * j, u, 8 * tx, cx, a0, a1, b0, b1);
        }
    }
    __syncthreads();
}

__device__ __forceinline__ void glds16s(const void* sbase, unsigned voff, unsigned lds_dst) {
    asm volatile("s_mov_b32 m0, %2\n\ts_nop 0\n\tglobal_load_lds_dwordx4 %1, %0" :: "s"(sbase), "v"(voff), "s"(lds_dst) : "memory", "m0");
}
typedef int i32x8 __attribute__((ext_vector_type(8)));
typedef int i32x4_t __attribute__((ext_vector_type(4)));
template <class Epi, class Sched, bool FP8 = false>
__device__ __forceinline__ void gemm_mfma(LAS unsigned char* lds, const Sched& S, const Epi& E, const bool do_epi = true) {
    const int tid = threadIdx.x, wid = __builtin_amdgcn_readfirstlane(tid >> 6), lane = tid & 63, wr = wid >> 2, wc = wid & 3, fr = lane & 15, fq = lane >> 4;
    const int K = S.K, nt = S.nkt(FP8 ? 128 : BK); const unsigned rowb = (unsigned)K * (FP8 ? 1u : 2u), rowbB = FP8 ? 128u : rowb;
    unsigned voffB[2];
#pragma unroll
    for (int i = 0; i < 2; ++i) { int R_, C_; if constexpr (FP8) stage_rc8(tid * 16 + i * 8192, R_, C_); else stage_rc(tid * 16 + i * 8192, R_, C_); const int Rb = (R_ & ~31) + perm32(R_ & 31); voffB[i] = (unsigned)Rb * rowbB + (unsigned)C_ * 2u; }
    const size_t kstep = (size_t)(BK * 2);
    const size_t kstepB = FP8 ? (size_t)32768 : kstep, hstep = (size_t)HALF * rowbB;
    const unsigned ldsw = (unsigned)wid * 1024u, lds0 = (unsigned)(uintptr_t)lds;
    const int aoff = FP8 ? lds_byte8(wr * 64 + fr, 2 * fq) : lds_byte(wr * 64 + fr, fq * 8), boff = FP8 ? lds_byte8(wc * 32 + fr, 2 * fq) : lds_byte(wc * 32 + fr, fq * 8);
    const int aoff1 = FP8 ? lds_byte8(wr * 64 + fr, 2 * fq + 1) : 0, boff1 = FP8 ? lds_byte8(wc * 32 + fr, 2 * fq + 1) : 0;

#define PG8_SA(b, h) (((b) * 2 + (h)) * HTB)
#define PG8_SB(b, h) ((4 + (b) * 2 + (h)) * HTB)
#define PG8_STAGE(bufoff, gbase, voff) do { _Pragma("unroll") for (int _i = 0; _i < 2; ++_i) \
        glds16s((const void*)(gbase), (voff)[_i], (unsigned)__builtin_amdgcn_readfirstlane((int)(lds0 + (unsigned)(bufoff) + ldsw + (unsigned)_i * 8192u))); } while (0)
#define PG8_LDA(dst, b, h) do { _Pragma("unroll") for (int m = 0; m < 4; ++m) { if constexpr (FP8) { const LAS unsigned char* _p = lds + PG8_SA(b, h) + m * 2048; \
            dst##8[m] = __builtin_shufflevector(*(const LAS i32x4_t*)(_p + aoff), *(const LAS i32x4_t*)(_p + aoff1), 0, 1, 2, 3, 4, 5, 6, 7); } \
        else { _Pragma("unroll") for (int k = 0; k < 2; ++k) dst[m][k] = *(const LAS bf16x8*)(lds + PG8_SA(b, h) + aoff + m * 2048 + k * 1024); } } } while (0)
#define PG8_LDB(dst, b, h) do { _Pragma("unroll") for (int n = 0; n < 2; ++n) { if constexpr (FP8) { const LAS unsigned char* _p = lds + PG8_SB(b, h) + n * 2048; \
            dst##8[n] = __builtin_shufflevector(*(const LAS i32x4_t*)(_p + boff), *(const LAS i32x4_t*)(_p + boff1), 0, 1, 2, 3, 4, 5, 6, 7); } \
        else { _Pragma("unroll") for (int k = 0; k < 2; ++k) dst[n][k] = *(const LAS bf16x8*)(lds + PG8_SB(b, h) + boff + n * 2048 + k * 1024); } } } while (0)
#define PG8_MMA(ai, bj, At, Bt) do { __builtin_amdgcn_s_setprio(1); _Pragma("unroll") for (int m = 0; m < 4; ++m) _Pragma("unroll") for (int n = 0; n < 2; ++n) { \
        if constexpr (FP8) { asm volatile("v_mfma_f32_16x16x128_f8f6f4 %0, %1, %2, %0" : "+v"(acc[ai][bj][m][n]) : "v"(Bt##8[n]), "v"(At##8[m])); } \
        else { _Pragma("unroll") for (int k = 0; k < 2; ++k) acc[ai][bj][m][n] = __builtin_amdgcn_mfma_f32_16x16x32_bf16(Bt[n][k], At[m][k], acc[ai][bj][m][n], 0, 0, 0); } } \
        __builtin_amdgcn_s_setprio(0); } while (0)
#define PG8_WAIT_V(n) asm volatile("s_waitcnt vmcnt(" #n ")" ::: "memory")
#define PG8_WAIT_L(n) asm volatile("s_waitcnt lgkmcnt(" #n ")" ::: "memory")
#define PG8_BAR __builtin_amdgcn_s_barrier()
#define PG8_SCHED __builtin_amdgcn_sched_barrier(0)
#define PG8_AOFF(dst, uu) do { _Pragma("unroll") for (int _i = 0; _i < 2; ++_i) { int _R, _C; if constexpr (FP8) stage_rc8(tid * 16 + _i * 8192, _R, _C); else stage_rc(tid * 16 + _i * 8192, _R, _C); _Pragma("unroll") for (int _h = 0; _h < 2; ++_h) dst[_h][_i] = S.a_src_row(uu, _h * HALF + _R) * rowb + (unsigned)_C * 2u; } } while (0)
    Unit cur, nxt; int ui = 0;
    if (!S.next(0, cur)) return;
    f32x4 acc[2][2][4][2];
#pragma unroll
    for (int a = 0; a < 2; ++a)
#pragma unroll
        for (int b = 0; b < 2; ++b)
#pragma unroll
            for (int m = 0; m < 4; ++m)
#pragma unroll
                for (int n = 0; n < 2; ++n) acc[a][b][m][n] = (f32x4){0.f, 0.f, 0.f, 0.f};
    bf16x8 At[4][2], B0[2][2], B1[2][2]; i32x8 At8[4], B08[2], B18[2];
    unsigned coff[2][2], noff[2][2];
    PG8_AOFF(coff, cur);
    const char* cA = S.a_base() + S.a_off(cur); const char* cB = S.b_base(cur);
    int ck = S.koff(cur, nt), nk = 0;
    PG8_STAGE(PG8_SB(0, 0), cB + ck * kstepB, voffB); PG8_STAGE(PG8_SB(0, 1), cB + hstep + ck * kstepB, voffB); PG8_STAGE(PG8_SA(0, 0), cA + ck * kstep, coff[0]); PG8_STAGE(PG8_SA(0, 1), cA + ck * kstep, coff[1]);
    if (wr == 1) PG8_BAR;
    PG8_WAIT_V(2); PG8_BAR;
    PG8_STAGE(PG8_SB(1, 0), cB + (ck + 1) * kstepB, voffB); PG8_STAGE(PG8_SA(1, 0), cA + (ck + 1) * kstep, coff[0]); PG8_STAGE(PG8_SB(1, 1), cB + hstep + (ck + 1) * kstepB, voffB);
    PG8_WAIT_V(6); PG8_BAR;
    for (;;) {
        const bool has_next = S.next(ui + 1, nxt);
        const char* nB = cB; const char* nA = cA;
#pragma unroll
        for (int _h = 0; _h < 2; ++_h)
#pragma unroll
            for (int _i = 0; _i < 2; ++_i) noff[_h][_i] = coff[_h][_i];
        nk = ck;
        if (has_next) { nB = S.b_base(nxt); nA = S.a_base() + S.a_off(nxt); PG8_AOFF(noff, nxt); nk = S.koff(nxt, nt); }
        for (int t = 0; t < nt; t += 2) {
            const bool last = (t == nt - 2);
            const int k1 = (t + 1 + ck) & (nt - 1), k2 = last ? nk : ((t + 2 + ck) & (nt - 1));
            const char* a1 = cA + (size_t)k1 * kstep;
            const char* a2 = (last ? nA : cA) + (size_t)k2 * kstep; const char* b2 = (last ? nB : cB) + (size_t)k2 * kstepB;
            const char* a3 = a2 + kstep; const char* b3 = b2 + kstepB;
            unsigned o2[2][2];
#pragma unroll
            for (int _h = 0; _h < 2; ++_h)
#pragma unroll
                for (int _i = 0; _i < 2; ++_i) o2[_h][_i] = last ? noff[_h][_i] : coff[_h][_i];
            PG8_LDB(B0, 0, 0); PG8_LDB(B1, 0, 1); PG8_SCHED; PG8_LDA(At, 0, 0); PG8_STAGE(PG8_SA(1, 1), a1, coff[1]);
            PG8_WAIT_V(8); PG8_WAIT_L(0); PG8_BAR; PG8_MMA(0, 0, At, B0); PG8_MMA(0, 1, At, B1); PG8_BAR; PG8_SCHED;
            PG8_LDA(At, 0, 1); PG8_STAGE(PG8_SB(0, 0), b2, voffB); PG8_STAGE(PG8_SB(0, 1), b2 + hstep, voffB); PG8_STAGE(PG8_SA(0, 0), a2, o2[0]);
            PG8_WAIT_V(8); PG8_WAIT_L(0); PG8_BAR; PG8_MMA(1, 0, At, B0); PG8_MMA(1, 1, At, B1); PG8_BAR; PG8_SCHED;
            PG8_LDB(B0, 1, 0); PG8_LDB(B1, 1, 1); PG8_SCHED; PG8_LDA(At, 1, 0); PG8_STAGE(PG8_SA(0, 1), a2, o2[1]);
            PG8_WAIT_V(8); PG8_WAIT_L(0); PG8_BAR; PG8_MMA(0, 0, At, B0); PG8_MMA(0, 1, At, B1); PG8_BAR; PG8_SCHED;
            PG8_LDA(At, 1, 1); PG8_STAGE(PG8_SB(1, 0), b3, voffB); PG8_STAGE(PG8_SB(1, 1), b3 + hstep, voffB); PG8_STAGE(PG8_SA(1, 0), a3, o2[0]);
            PG8_WAIT_V(8); PG8_WAIT_L(0); PG8_BAR; PG8_MMA(1, 0, At, B0); PG8_MMA(1, 1, At, B1); PG8_BAR; PG8_SCHED;
        }
#ifndef ALIGN_EPI
#define ALIGN_EPI 1
#endif
        if (ALIGN_EPI && wr == 0) PG8_BAR;
        if constexpr (FP8) asm volatile("s_nop 15\n\ts_nop 15" ::: "memory");
        if (do_epi) {
            constexpr int NB = Epi::NB; const int rbase = cur.pm * BM + wr * 64 + fr, c0 = wc * 32 + 8 * fq;
#pragma unroll
            for (int g0 = 0; g0 < 8; g0 += NB) {
                typename Epi::Ctx cx[NB];
#pragma unroll
                for (int i = 0; i < NB; ++i) E.load(rbase + ((g0 + i) >> 2) * HALF + ((g0 + i) & 3) * 16, cur, c0, cx[i]);
#pragma unroll
                for (int i = 0; i < NB; ++i) { const int ai = (g0 + i) >> 2, m = (g0 + i) & 3;
                    E.template fin<true>(rbase + ai * HALF + m * 16, cur, c0, cx[i], acc[ai][0][m][0], acc[ai][0][m][1], acc[ai][1][m][0], acc[ai][1][m][1]); }
            }
        }
        if (!has_next) break;
#pragma unroll
        for (int a = 0; a < 2; ++a)
#pragma unroll
            for (int b = 0; b < 2; ++b)
#pragma unroll
                for (int m = 0; m < 4; ++m)
#pragma unroll
                    for (int n = 0; n < 2; ++n) acc[a][b][m][n] = (f32x4){0.f, 0.f, 0.f, 0.f};
        cur = nxt; cB = nB; cA = nA; ck = nk;
#pragma unroll
        for (int _h = 0; _h < 2; ++_h)
#pragma unroll
            for (int _i = 0; _i < 2; ++_i) coff[_h][_i] = noff[_h][_i];
        ++ui;
        if (ALIGN_EPI && wr == 1) PG8_BAR;
    }
    PG8_WAIT_V(0);
    if (!ALIGN_EPI && wr == 0) PG8_BAR;
    PG8_BAR;
#undef PG8_SA
#undef PG8_SB
#undef PG8_STAGE
#undef PG8_LDA
#undef PG8_LDB
#undef PG8_MMA
#undef PG8_WAIT_V
#undef PG8_WAIT_L
#undef PG8_BAR
#undef PG8_SCHED
#undef PG8_AOFF
}
#ifndef SKEW_TICKS
#define SKEW_TICKS 0
#endif
__device__ __forceinline__ void phase_skew(int bid) {
    if (SKEW_TICKS > 0 && (bid & 1)) { const unsigned long long t0 = __builtin_amdgcn_s_memrealtime(); while (__builtin_amdgcn_s_memrealtime() - t0 < (unsigned long long)SKEW_TICKS) __builtin_amdgcn_s_sleep(8); }
}
template <class Epi, class Sched, bool FP8 = false>
__device__ __forceinline__ void gemm_any(LAS unsigned char* lds, const Sched& S, const Epi& E, const bool do_epi = true) {
#if OPT_GEMM
    gemm_mfma<Epi, Sched, FP8>(lds, S, E, do_epi);
#else
    gemm_ref<Epi, Sched>(lds, S, E);
#endif
}

__device__ __forceinline__ void st_bf8(bf16* p, f32x4 a, f32x4 b) { *(u32x4*)p = pack8(a, b); }
__device__ __forceinline__ void ld_bf8(const bf16* p, f32x4& a, f32x4& b) { unpack8(*(const u32x4*)p, a, b); }
constexpr float W8_SCALE = 128.0f, H8_SCALE = 8.0f, A8_SCALE = 4.0f;

struct EpiInProj {
    static constexpr int NB = 1; struct Ctx { int dummy; };
    bf16 *Q, *Kk, *V, *SR, *CB, *U, *SGA, *SGB;
    __device__ __forceinline__ void load(int row, const Unit& u, int c0, Ctx& c) const {}
    template <bool MF> __device__ __forceinline__ void fin(int row, const Unit& u, int c0, const Ctx& c, f32x4 a0, f32x4 a1, f32x4 b0, f32x4 b1) const {
        const int pn = u.pn;
        if (pn >= TN_U && pn < TN_GA) { st_bf8(U + (size_t)row * D + (pn - TN_U) * 128 + c0, a0 * b0, a1 * b1); return; }
        bf16* base; int ld, ct, mode = 0; float sc = 1.0f;
        if (pn < TN_K) { base = Q; ld = QK; ct = pn - TN_Q; sc = 0.0625f; }
        else if (pn < TN_V) { base = Kk; ld = QK; ct = pn - TN_K; }
        else if (pn < TN_R) { base = V; ld = VD; ct = pn - TN_V; }
        else if (pn < TN_CB) { base = SR; ld = VD; ct = pn - TN_R; mode = 1; }
        else if (pn < TN_U) { base = CB; ld = D; ct = pn - TN_CB; }
        else if (pn < TN_GB) { base = SGA; ld = D; ct = pn - TN_GA; mode = 2; }
        else { base = SGB; ld = D; ct = pn - TN_GB; mode = 2; }
        if (mode) {
#pragma unroll
            for (int j = 0; j < 4; ++j) { const float s0 = sigmoidf_(a0[j]), s1 = sigmoidf_(a1[j]), s2 = sigmoidf_(b0[j]), s3 = sigmoidf_(b1[j]);
                a0[j] = (mode == 1) ? a0[j] * s0 : s0; a1[j] = (mode == 1) ? a1[j] * s1 : s1; b0[j] = (mode == 1) ? b0[j] * s2 : s2; b1[j] = (mode == 1) ? b1[j] * s3 : s3; }
        } else { a0 *= sc; a1 *= sc; b0 *= sc; b1 *= sc; }
        bf16* p = base + (size_t)row * ld + ct * 256 + c0; st_bf8(p, a0, a1); st_bf8(p + 128, b0, b1);
    }
};
struct EpiGateA {
    static constexpr int NB = 4; struct Ctx { u32x4 s0, s1; };
    bf16* T1; const bf16* SGA;
    __device__ __forceinline__ void load(int row, const Unit& u, int c0, Ctx& c) const { const size_t o = (size_t)row * D + u.pn * 256 + c0; c.s0 = *(const u32x4*)(SGA + o); c.s1 = *(const u32x4*)(SGA + o + 128); }
    template <bool MF> __device__ __forceinline__ void fin(int row, const Unit& u, int c0, const Ctx& c, f32x4 a0, f32x4 a1, f32x4 b0, f32x4 b1) const {
        const size_t o = (size_t)row * D + u.pn * 256 + c0; f32x4 g0, g1, g2, g3; unpack8(c.s0, g0, g1); unpack8(c.s1, g2, g3);
        st_bf8(T1 + o, a0 * g0, a1 * g1); st_bf8(T1 + o + 128, b0 * g2, b1 * g3);
    }
};
struct EpiGateB {
    static constexpr int NB = 2; struct Ctx { u32x4 s0, s1, t0, t1; };
    const bf16* T1; const bf16* SGB; bf16* MG;
    __device__ __forceinline__ void load(int row, const Unit& u, int c0, Ctx& c) const { const size_t o = (size_t)row * D + u.pn * 256 + c0; c.s0 = *(const u32x4*)(SGB + o); c.s1 = *(const u32x4*)(SGB + o + 128); c.t0 = *(const u32x4*)(T1 + o); c.t1 = *(const u32x4*)(T1 + o + 128); }
    template <bool MF> __device__ __forceinline__ void fin(int row, const Unit& u, int c0, const Ctx& c, f32x4 a0, f32x4 a1, f32x4 b0, f32x4 b1) const {
        const size_t o = (size_t)row * D + u.pn * 256 + c0; f32x4 g0, g1, g2, g3, t0, t1, t2, t3; unpack8(c.s0, g0, g1); unpack8(c.s1, g2, g3); unpack8(c.t0, t0, t1); unpack8(c.t1, t2, t3);
        st_bf8(MG + o, t0 + a0 * g0, t1 + a1 * g1); st_bf8(MG + o + 128, t2 + b0 * g2, t3 + b1 * g3);
    }
};
#if OPT_GEMM
constexpr int SSP_N = 32;
#else
constexpr int SSP_N = 128;
#endif
struct EpiResid1 {
    static constexpr int NB = 4; struct Ctx { f32x4 x0, x1, x2, x3; };
    const float* X; bf16* XB; float* SSP;
    __device__ __forceinline__ void load(int row, const Unit& u, int c0, Ctx& c) const { const size_t o = (size_t)row * D + u.pn * 256 + c0; c.x0 = *(const f32x4*)(X + o); c.x1 = *(const f32x4*)(X + o + 4); c.x2 = *(const f32x4*)(X + o + 128); c.x3 = *(const f32x4*)(X + o + 132); }
    template <bool MF> __device__ __forceinline__ void fin(int row, const Unit& u, int c0, const Ctx& c, f32x4 a0, f32x4 a1, f32x4 b0, f32x4 b1) const {
        const size_t o = (size_t)row * D + u.pn * 256 + c0;
        a0 += c.x0; a1 += c.x1; b0 += c.x2; b1 += c.x3;
        st_bf8(XB + o, a0, a1); st_bf8(XB + o + 128, b0, b1);
        float s = 0.f;
#pragma unroll
        for (int j = 0; j < 4; ++j) s += a0[j] * a0[j] + a1[j] * a1[j] + b0[j] * b0[j] + b1[j] * b1[j];
        if (MF) { s += __shfl_xor(s, 16); s += __shfl_xor(s, 32); if ((threadIdx.x & 63) < 16) SSP[(size_t)row * SSP_N + 4 * u.pn + (c0 >> 5)] = s; }
        else SSP[(size_t)row * SSP_N + 16 * u.pn + (c0 >> 3)] = s;
    }
};
constexpr ptrdiff_t QX_HALF = ((ptrdiff_t)WS_O32 - (ptrdiff_t)WS_QX) / 2;
struct EpiXQ {
    static constexpr int NB = 8; struct Ctx { float r; };
    bf16* QX; const float* SSP;
    __device__ __forceinline__ void load(int row, const Unit& u, int c0, Ctx& c) const {
        const float* sp = SSP + (size_t)row * SSP_N; f32x4 t = *(const f32x4*)sp;
#pragma unroll
        for (int j = 1; j < SSP_N / 4; ++j) t += *(const f32x4*)(sp + 4 * j);
        c.r = rsqrtf(((t[0] + t[1]) + (t[2] + t[3])) * (1.0f / D) + EPS);
    }
    template <bool MF> __device__ __forceinline__ void fin(int row, const Unit& u, int c0, const Ctx& c, f32x4 a0, f32x4 a1, f32x4 b0, f32x4 b1) const {
        bf16* p = QX + (ptrdiff_t)u.e * QX_HALF + (size_t)row * XA + u.pn * 256 + c0; st_bf8(p, a0 * c.r, a1 * c.r); st_bf8(p + 128, b0 * c.r, b1 * c.r);
    }
};
struct EpiResid2 {
    static constexpr int NB = 8; struct Ctx { u32x4 x0, x1; };
    bf16* XB;
    __device__ __forceinline__ void load(int row, const Unit& u, int c0, Ctx& c) const { const bf16* p = XB + (size_t)row * D + u.pn * 256 + c0; c.x0 = *(const u32x4*)p; c.x1 = *(const u32x4*)(p + 128); }
    template <bool MF> __device__ __forceinline__ void fin(int row, const Unit& u, int c0, const Ctx& c, f32x4 a0, f32x4 a1, f32x4 b0, f32x4 b1) const {
        bf16* p = XB + (size_t)row * D + u.pn * 256 + c0; f32x4 x0, x1, x2, x3; unpack8(c.x0, x0, x1); unpack8(c.x1, x2, x3);
        st_bf8(p, x0 + a0, x1 + a1); st_bf8(p + 128, x2 + b0, x3 + b1);
    }
};
struct EpiGU8 {
    static constexpr int NB = 8; struct Ctx { f32x4 g0, g1, u0, u1; };
    unsigned char* ACT8; const float* gub;
    __device__ __forceinline__ void load(int row, const Unit& u, int c0, Ctx& c) const { const float* bg = gub + (size_t)u.e * (2 * FF) + u.pn * 128 + c0; c.g0 = *(const f32x4*)bg; c.g1 = *(const f32x4*)(bg + 4); c.u0 = *(const f32x4*)(bg + FF); c.u1 = *(const f32x4*)(bg + FF + 4); }
    template <bool MF> __device__ __forceinline__ void fin(int row, const Unit& u, int c0, const Ctx& c, f32x4 a0, f32x4 a1, f32x4 b0, f32x4 b1) const {
        const int f = u.pn * 128 + c0; const float is = 1.0f / (W8_SCALE * H8_SCALE);
        f32x4 r0, r1;
#pragma unroll
        for (int j = 0; j < 4; ++j) {
            float g = fminf(a0[j] * is + c.g0[j], 7.0f), up = fminf(fmaxf(b0[j] * is + c.u0[j], -7.0f), 7.0f); r0[j] = (up + 1.0f) * g * sigmoidf_(1.702f * g) * A8_SCALE;
            g = fminf(a1[j] * is + c.g1[j], 7.0f); up = fminf(fmaxf(b1[j] * is + c.u1[j], -7.0f), 7.0f); r1[j] = (up + 1.0f) * g * sigmoidf_(1.702f * g) * A8_SCALE;
        }
        u32x2 o; o.x = pk4_fp8(r0[0], r0[1], r0[2], r0[3]); o.y = pk4_fp8(r1[0], r1[1], r1[2], r1[3]);
        *(u32x2*)(ACT8 + (size_t)row * FF + f) = o;
    }
};
constexpr float Y8_SCALE = 16.0f;
struct EpiDown8 {
    static constexpr int NB = 8; struct Ctx { f32x4 b0, b1, b2, b3; };
    unsigned char* YS; const float* dnb;
    __device__ __forceinline__ void load(int row, const Unit& u, int c0, Ctx& c) const { const float* bb = dnb + (size_t)u.e * D + u.pn * 256 + c0; c.b0 = *(const f32x4*)bb; c.b1 = *(const f32x4*)(bb + 4); c.b2 = *(const f32x4*)(bb + 128); c.b3 = *(const f32x4*)(bb + 132); }
    template <bool MF> __device__ __forceinline__ void fin(int row, const Unit& u, int c0, const Ctx& c, f32x4 a0, f32x4 a1, f32x4 b0, f32x4 b1) const {
        unsigned char* p = YS + (size_t)row * D + u.pn * 256 + c0; const float is = Y8_SCALE / (W8_SCALE * A8_SCALE);
        a0 = a0 * is + c.b0 * Y8_SCALE; a1 = a1 * is + c.b1 * Y8_SCALE; b0 = b0 * is + c.b2 * Y8_SCALE; b1 = b1 * is + c.b3 * Y8_SCALE;
        u32x2 o; o.x = pk4_fp8(a0[0], a0[1], a0[2], a0[3]); o.y = pk4_fp8(a1[0], a1[1], a1[2], a1[3]); *(u32x2*)p = o;
        o.x = pk4_fp8(b0[0], b0[1], b0[2], b0[3]); o.y = pk4_fp8(b1[0], b1[1], b1[2], b1[3]); *(u32x2*)(p + 128) = o;
    }
};

__device__ __forceinline__ void tr_item_fp8(const float* W, int ldw, int K, int srccol0, unsigned char* WT, int dstrow0, LAS float* scr, int kb, int lane) {
    const int k0 = 128 * kb;
#pragma unroll 8
    for (int i = 0; i < 64; ++i) { const int kk = 2 * i + (lane >> 5); scr[kk * 33 + (lane & 31)] = W[(size_t)(k0 + kk) * ldw + srccol0 + (lane & 31)] * W8_SCALE; }
    LDS_WAIT(); asm volatile("" ::: "memory");
    const int c = lane & 7;
#pragma unroll
    for (int j = 0; j < 4; ++j) { const int n = (lane >> 3) + 8 * j; const LAS float* s = scr + (16 * c) * 33 + n;
        u32x4 o; o.x = pk4_fp8(s[0 * 33], s[1 * 33], s[2 * 33], s[3 * 33]); o.y = pk4_fp8(s[4 * 33], s[5 * 33], s[6 * 33], s[7 * 33]);
        o.z = pk4_fp8(s[8 * 33], s[9 * 33], s[10 * 33], s[11 * 33]); o.w = pk4_fp8(s[12 * 33], s[13 * 33], s[14 * 33], s[15 * 33]);
        *(u32x4*)(WT + (size_t)(dstrow0 + n) * K + k0 + 16 * c) = o; }
    LDS_WAIT(); asm volatile("" ::: "memory");
}
__device__ __forceinline__ void tr_item(const float* W, int ldw, int K, int srccol0, bf16* WT, int dstrow0, const float* ksc, LAS float* scr, int kb, int lane) {
    const int k0 = 64 * kb;
    float v[32];
#pragma unroll
    for (int i = 0; i < 32; ++i) v[i] = __builtin_nontemporal_load(W + (size_t)(k0 + 2 * i + (lane >> 5)) * ldw + srccol0 + (lane & 31));
#pragma unroll
    for (int i = 0; i < 32; ++i) { const int kk = 2 * i + (lane >> 5); scr[kk * 33 + (lane & 31)] = ksc ? v[i] * ksc[k0 + kk] : v[i]; }
    LDS_WAIT(); asm volatile("" ::: "memory");
    const int c = lane & 7;
#pragma unroll
    for (int j = 0; j < 4; ++j) { const int n = (lane >> 3) + 8 * j; const LAS float* s = scr + (8 * c) * 33 + n;
        u32x4 o; o.x = pk2(s[0 * 33], s[1 * 33]); o.y = pk2(s[2 * 33], s[3 * 33]); o.z = pk2(s[4 * 33], s[5 * 33]); o.w = pk2(s[6 * 33], s[7 * 33]);
        *(u32x4*)(WT + (size_t)(dstrow0 + n) * K + k0 + 8 * c) = o; }
    LDS_WAIT(); asm volatile("" ::: "memory");
}
__device__ __forceinline__ void tr8_load(const float* W, int ldw, int srccol0, int kb32, int lane, f32x4 (&v)[8]) {
    const char* base = (const char*)(W + (size_t)(32 * kb32) * ldw + srccol0);
    const unsigned voff = (unsigned)((lane >> 4) * ldw + 4 * (lane & 15)) * 4u;
#pragma unroll
    for (int i = 0; i < 8; ++i) v[i] = __builtin_nontemporal_load((const f32x4*)(base + (size_t)(4 * i) * ldw * 4 + voff));
}
__device__ __forceinline__ void tr8_quarter(const f32x4 (&v)[8], LAS float* scr, int lane, u32x4 (&o)[2]) {
    LAS float* w = scr + (lane >> 4) * 68 + 4 * (lane & 15);
#pragma unroll
    for (int i = 0; i < 8; ++i) *(LAS f32x4*)(w + 4 * i * 68) = v[i] * W8_SCALE;
    LDS_WAIT(); asm volatile("" ::: "memory");
    const LAS float* s = scr + lane;
    o[0].x = pk4_fp8(s[0 * 68], s[1 * 68], s[2 * 68], s[3 * 68]); o[0].y = pk4_fp8(s[4 * 68], s[5 * 68], s[6 * 68], s[7 * 68]);
    o[0].z = pk4_fp8(s[8 * 68], s[9 * 68], s[10 * 68], s[11 * 68]); o[0].w = pk4_fp8(s[12 * 68], s[13 * 68], s[14 * 68], s[15 * 68]);
    o[1].x = pk4_fp8(s[16 * 68], s[17 * 68], s[18 * 68], s[19 * 68]); o[1].y = pk4_fp8(s[20 * 68], s[21 * 68], s[22 * 68], s[23 * 68]);
    o[1].z = pk4_fp8(s[24 * 68], s[25 * 68], s[26 * 68], s[27 * 68]); o[1].w = pk4_fp8(s[28 * 68], s[29 * 68], s[30 * 68], s[31 * 68]);
    LDS_WAIT(); asm volatile("" ::: "memory");
}
__device__ __forceinline__ void tr8_store(const u32x4 (&pc)[4][2], unsigned char* WT, int K, int dstrow0, int kb, LAS float* scr, int lane) {
    LAS unsigned* t = (LAS unsigned*)scr;
    LAS unsigned* wl = t + lane * 33;
#pragma unroll
    for (int q = 0; q < 4; ++q)
#pragma unroll
        for (int j = 0; j < 2; ++j) { LAS unsigned* d = wl + 8 * q + 4 * j; const u32x4 x = pc[q][j]; d[0] = x.x; d[1] = x.y; d[2] = x.z; d[3] = x.w; }
    LDS_WAIT(); asm volatile("" ::: "memory");
    const LAS unsigned* rl = t + (lane >> 3) * 33 + 4 * (lane & 7);
    unsigned char* gb = WT + ((size_t)((dstrow0 >> 8) * (K >> 7) + kb) * 256 + (dstrow0 & 255)) * 128;
    const unsigned gvo = (unsigned)((lane >> 3) * 128 + 16 * (lane & 7));
#pragma unroll
    for (int j = 0; j < 8; ++j) { const LAS unsigned* sdw = rl + 8 * 33 * j;
        const u32x4 x = {sdw[0], sdw[1], sdw[2], sdw[3]};
        __builtin_nontemporal_store(x, (u32x4*)(gb + 1024 * j + gvo)); }
    LDS_WAIT(); asm volatile("" ::: "memory");
}
__device__ __forceinline__ void ex8_decode(const Frame& F, int sup, const float*& W, int& ldw, int& src, unsigned char*& WT, int& K, int& dst, int& kb) {
    if (sup < NE * 1024) { const int e = sup / 1024, r = sup % 1024, nb = r % 64, p = nb >> 2, w = (nb & 3) * 64; kb = r / 64;
        W = F.in[I_GUW] + (size_t)e * D * (2 * FF); ldw = 2 * FF; src = (w < 128) ? 128 * p + w : FF + 128 * p + (w - 128); WT = WSP(unsigned char, WS_WGU) + (size_t)e * (2 * FF) * D; K = D; dst = 64 * nb; }
    else { const int s2 = sup - NE * 1024, e = s2 / 512, r = s2 % 512, nb = r % 32; kb = r / 32;
        W = F.in[I_DNW] + (size_t)e * FF * D; ldw = D; src = 64 * nb; WT = WSP(unsigned char, WS_WDN) + (size_t)e * D * FF; K = FF; dst = 64 * nb; }
}
__device__ __forceinline__ void rms_row_to_bf16(const float* xrow, const float* g, bf16* orow, int lane) {
    f32x4 v[8]; float s = 0.f;
#pragma unroll
    for (int j = 0; j < 8; ++j) { v[j] = *(const f32x4*)(xrow + 4 * lane + 256 * j); s += (v[j][0] * v[j][0] + v[j][1] * v[j][1]) + (v[j][2] * v[j][2] + v[j][3] * v[j][3]); }
    const float r = rsqrtf(wave_sum(s) * (1.0f / D) + EPS);
#pragma unroll
    for (int j = 0; j < 8; ++j) { const f32x4 gg = *(const f32x4*)(g + 4 * lane + 256 * j); u32x2 o; o.x = pk2(v[j][0] * r * gg[0], v[j][1] * r * gg[1]); o.y = pk2(v[j][2] * r * gg[2], v[j][3] * r * gg[3]); *(u32x2*)(orow + 4 * lane + 256 * j) = o; }
}
__device__ __forceinline__ void p0_prologue(Frame& F, const int part, const int cb, const int CNG) {
    LAS float* scr = (LAS float*)(F.lds + F.wave * 16896);
    const int gw = cb * NWAVES + F.wave, NGW = CNG * NWAVES, lane = F.lane, gt = cb * NTHR + F.tid, NGT = CNG * NTHR;
    const float* Win = F.in[I_WIN];
    bf16* WIN = WSP(bf16, WS_WIN);
    if (part == 0) {
    for (int it = gw; it < 512 * 32; it += NGW) {
        const int nb = it % 512, kb = it / 512, n0 = 32 * nb;
        int src;
        if (n0 < TN_CB * 256) src = n0;
        else if (n0 < TN_U * 256) src = SRC_CB + (n0 - TN_CB * 256);
        else if (n0 < TN_GA * 256) { const int rel = n0 - TN_U * 256, p = rel >> 8, w = rel & 255; src = (w < 128) ? SRC_CC + 128 * p + w : SRC_CHH + 128 * p + (w - 128); }
        else if (n0 < TN_GB * 256) src = SRC_GA + (n0 - TN_GA * 256);
        else src = SRC_GB + (n0 - TN_GB * 256);
        tr_item(Win, NIN_SRC, D, src, WIN, n0, nullptr, scr, kb, lane);
    }
    for (int it = gw; it < 32; it += NGW) tr_item(Win, NIN_SRC, D, SRC_ALOW, WSP(bf16, WS_WAL), 0, nullptr, scr, it, lane);
    { const float* GW = F.in[I_GGW]; bf16* WGW = WSP(bf16, WS_WGW); for (int i = gt; i < QK * 32; i += NGT) { const int n = i >> 5, k = i & 31; WGW[i] = (k < 16) ? (bf16)f2bf(GW[k * QK + n]) : (bf16)0; } }
    }
    if (part == 1) {
    for (int it = gw; it < 3 * 2048; it += NGW) { const int w = it / 2048, r = it % 2048, nb = r % 64, kb = r / 64;
        const float* W = F.in[w == 0 ? I_GOW : (w == 1 ? I_COW : I_MXW)]; bf16* WT = WSP(bf16, w == 0 ? WS_WGO : (w == 1 ? WS_WCO : WS_WMX));
        tr_item(W, D, D, 32 * nb, WT, 32 * nb, nullptr, scr, kb, lane); }
    for (int it = gw; it < 3 * 512; it += NGW) { const int w = it / 512, r = it % 512, nb = r % 16, kb = r / 16;
        if (w == 0) tr_item(F.in[I_XQ], XA, D, 32 * nb, WSP(bf16, WS_WXQ), 32 * nb, F.in[I_NXG], scr, kb, lane);
        else tr_item(F.in[w == 1 ? I_XK : I_XV], XA, D, 32 * nb, WSP(bf16, WS_WXKV), (w - 1) * XA + 32 * nb, nullptr, scr, kb, lane); }
    for (int it = gw; it < 512; it += NGW) { const int nb = it % 64, kb = it / 64; tr_item(F.in[I_XO], D, XA, 32 * nb, WSP(bf16, WS_WXO), 32 * nb, nullptr, scr, kb, lane); }
#if MOE_FP8
    { LAS float* scr8 = (LAS float*)(F.lds + F.wave * 16896);
      constexpr int NSUP = NE * 1024 + NE * 512;
      f32x4 va[8], vb[8]; u32x4 pc[4][2];
      const float* W; int ldw, src, K, dst, kb; unsigned char* WT;
      if (gw < NSUP) { ex8_decode(F, gw, W, ldw, src, WT, K, dst, kb); tr8_load(W, ldw, src, 4 * kb + 0, lane, va); }
      for (int sup = gw; sup < NSUP; sup += NGW) {
          tr8_load(W, ldw, src, 4 * kb + 1, lane, vb); tr8_quarter(va, scr8, lane, pc[0]);
          tr8_load(W, ldw, src, 4 * kb + 2, lane, va); tr8_quarter(vb, scr8, lane, pc[1]);
          tr8_load(W, ldw, src, 4 * kb + 3, lane, vb); tr8_quarter(va, scr8, lane, pc[2]);
          const float* W1 = W; int ldw1 = ldw, src1 = src, K1 = K, dst1 = dst, kb1 = kb; unsigned char* WT1 = WT;
          if (sup + NGW < NSUP) { ex8_decode(F, sup + NGW, W1, ldw1, src1, WT1, K1, dst1, kb1); tr8_load(W1, ldw1, src1, 4 * kb1 + 0, lane, va); }
          tr8_quarter(vb, scr8, lane, pc[3]);
          tr8_store(pc, WT, K, dst, kb, scr8, lane);
          W = W1; ldw = ldw1; src = src1; K = K1; dst = dst1; kb = kb1; WT = WT1;
      } }
#endif
    { const float* rw = F.in[I_RW]; const float* g = F.in[I_NMOEG]; float* WR = WSP(float, WS_WR);
      for (int i = gt; i < NE * D; i += NGT) { const int e = i / D, k = i % D; WR[i] = rw[k * NE + e] * g[k]; } }
    }
    if (part == 0) {
    for (int m = gw; m < T; m += 2 * NGW) {
        const float* x0 = F.in[I_X] + (size_t)m * D; const bool two = (m + NGW < T); const float* x1 = F.in[I_X] + (size_t)(two ? m + NGW : m) * D; const float* gmix = F.in[I_NMIXG];
        f32x4 v0[8], v1[8]; float s0 = 0.f, s1 = 0.f;
#pragma unroll
        for (int j = 0; j < 8; ++j) { v0[j] = *(const f32x4*)(x0 + 4 * lane + 256 * j); v1[j] = *(const f32x4*)(x1 + 4 * lane + 256 * j); }
#pragma unroll
        for (int j = 0; j < 8; ++j) { s0 += (v0[j][0] * v0[j][0] + v0[j][1] * v0[j][1]) + (v0[j][2] * v0[j][2] + v0[j][3] * v0[j][3]); s1 += (v1[j][0] * v1[j][0] + v1[j][1] * v1[j][1]) + (v1[j][2] * v1[j][2] + v1[j][3] * v1[j][3]); }
        const float r0 = rsqrtf(wave_sum(s0) * (1.0f / D) + EPS), r1 = rsqrtf(wave_sum(s1) * (1.0f / D) + EPS);
        bf16* o0 = WSP(bf16, WS_XN) + (size_t)m * D; bf16* o1 = WSP(bf16, WS_XN) + (size_t)(m + NGW) * D;
#pragma unroll
        for (int j = 0; j < 8; ++j) { const f32x4 gg = *(const f32x4*)(gmix + 4 * lane + 256 * j);
            u32x2 a; a.x = pk2(v0[j][0] * r0 * gg[0], v0[j][1] * r0 * gg[1]); a.y = pk2(v0[j][2] * r0 * gg[2], v0[j][3] * r0 * gg[3]); *(u32x2*)(o0 + 4 * lane + 256 * j) = a;
            if (two) { u32x2 b; b.x = pk2(v1[j][0] * r1 * gg[0], v1[j][1] * r1 * gg[1]); b.y = pk2(v1[j][2] * r1 * gg[2], v1[j][3] * r1 * gg[3]); *(u32x2*)(o1 + 4 * lane + 256 * j) = b; } }
    }
    }
    if (part == 1) {
    for (int m = gw; m < MEM; m += NGW) rms_row_to_bf16(F.in[I_MEM] + (size_t)m * D, F.in[I_NMG], WSP(bf16, WS_MEMN) + (size_t)m * D, lane);
    { u32x4* z = (u32x4*)(WSP(bf16, WS_H3) + (size_t)T * D); u32x4* z8 = (u32x4*)(WSP(unsigned char, WS_H3) + (size_t)T * D); for (int i = gt; i < 256; i += NGT) { z[i] = (u32x4){0u, 0u, 0u, 0u}; z8[i] = (u32x4){0u, 0u, 0u, 0u}; } }
    }
}

__device__ __forceinline__ void p_memkv(Frame& F) {
    const bf16* A = WSP(bf16, WS_MEMN); const bf16* B = WSP(bf16, WS_WXKV); bf16* KM = WSP(bf16, WS_KM); bf16* VMT = WSP(bf16, WS_VMT);
    LAS f32x4* red = (LAS f32x4*)F.lds;
    const int lane = F.lane, w = F.wave, lr = lane & 15, lg = lane >> 4;
    for (int unit = F.bid; unit < (MEM / 16) * (2 * XA / 64); unit += F.G) {
        const int mt = unit & 15, nt = unit >> 4; const bool isk = nt < 8;
        const bf16* ap = A + (size_t)(16 * mt + lr) * D + 256 * w + 8 * lg; const bf16* bp = B + (size_t)(64 * nt + lr) * D + 256 * w + 8 * lg;
        bf16x8 af[8], bf[4][8];
#pragma unroll
        for (int s = 0; s < 8; ++s) { af[s] = *(const bf16x8*)(ap + 32 * s);
#pragma unroll
            for (int j = 0; j < 4; ++j) bf[j][s] = *(const bf16x8*)(bp + (size_t)(16 * j) * D + 32 * s); }
        f32x4 acc[4];
#pragma unroll
        for (int j = 0; j < 4; ++j) { acc[j] = (f32x4){0.f, 0.f, 0.f, 0.f};
#pragma unroll
            for (int s = 0; s < 8; ++s) acc[j] = isk ? MFMA16(bf[j][s], af[s], acc[j]) : MFMA16(af[s], bf[j][s], acc[j]); }
        __syncthreads();
#pragma unroll
        for (int j = 0; j < 4; ++j) red[(w * 4 + j) * 64 + lane] = acc[j];
        __syncthreads();
        if (w < 4) { f32x4 t = red[w * 64 + lane];
#pragma unroll
            for (int ww = 1; ww < 8; ++ww) t += red[(ww * 4 + w) * 64 + lane];
            u32x2 o; o.x = pk2(t[0], t[1]); o.y = pk2(t[2], t[3]);
            if (isk) *(u32x2*)(KM + (size_t)(16 * mt + lr) * XA + 64 * nt + 16 * w + 4 * lg) = o;
            else *(u32x2*)(VMT + (size_t)(64 * nt - XA + 16 * w + lr) * MEM + 16 * mt + 4 * lg) = o;
        }
    }
    __syncthreads();
}

__device__ __forceinline__ void p_alow(Frame& F) {
    const bf16* XN = WSP(bf16, WS_XN); const bf16* WAL = WSP(bf16, WS_WAL); const bf16* WGW = WSP(bf16, WS_WGW); const float* GB = F.in[I_GGB]; float* LA = WSP(float, WS_LA);
    LAS f32x4* red = (LAS f32x4*)F.lds;
    const int lane = F.lane, lr = lane & 15, lg = lane >> 4, tk = F.wave >> 1, kh = F.wave & 1;
    for (int t4 = F.bid; t4 < T / 64; t4 += F.G) {
        const int task = 4 * t4 + tk;
        const bf16* ap = WAL + (size_t)lr * D + 1024 * kh + 8 * lg; const bf16* bp = XN + (size_t)(16 * task + lr) * D + 1024 * kh + 8 * lg;
        f32x4 acc = {0.f, 0.f, 0.f, 0.f};
#pragma unroll 16
        for (int s = 0; s < 32; ++s) acc = MFMA16(*(const bf16x8*)(ap + 32 * s), *(const bf16x8*)(bp + 32 * s), acc);
        __syncthreads();
        red[(tk * 2 + kh) * 64 + lane] = acc;
        __syncthreads();
#if OPT_GLA
        if (kh == 0) *(f32x4*)(WSP(float, WS_ALOW) + (size_t)(16 * task + lr) * 16 + 4 * lg) = red[(tk * 2) * 64 + lane] + red[(tk * 2 + 1) * 64 + lane];
        continue;
#endif
        u32x4 bw = {0u, 0u, 0u, 0u};
        if (lg < 2) { const f32x4 x0 = red[(tk * 2) * 64 + lr + 32 * lg] + red[(tk * 2 + 1) * 64 + lr + 32 * lg], x1 = red[(tk * 2) * 64 + lr + 32 * lg + 16] + red[(tk * 2 + 1) * 64 + lr + 32 * lg + 16];
            bw = (u32x4){pk2(x0[0], x0[1]), pk2(x0[2], x0[3]), pk2(x1[0], x1[1]), pk2(x1[2], x1[3])}; }
        const bf16x8 bfr = as_bf8(bw);
#pragma unroll 4
        for (int q = 0; q < 32; ++q) { const int nt = 32 * kh + q;
            const bf16x8 afr = *(const bf16x8*)(WGW + (size_t)(16 * nt + lr) * 32 + 8 * lg);
            f32x4 z = MFMA16(afr, bfr, ((f32x4){0.f, 0.f, 0.f, 0.f}));
            const f32x4 gb = *(const f32x4*)(GB + 16 * nt + 4 * lg);
#pragma unroll
            for (int r = 0; r < 4; ++r) z[r] = logsigmoidf_(z[r] + gb[r]) * 0.0625f;
            *(f32x4*)(LA + (size_t)(16 * task + lr) * QK + 16 * nt + 4 * lg) = z; }
    }
    __syncthreads();
}

__device__ __forceinline__ void p_conv(Frame& F) {
    const bf16* U = WSP(bf16, WS_U); const bf16* CB = WSP(bf16, WS_CB); bf16* Z = WSP(bf16, WS_Z);
    const float* cw = F.in[I_CW]; const float* cb = F.in[I_CBIAS];
    for (int task = F.bid * NTHR + F.tid; task < (T / 64) * (D / 8); task += F.G * NTHR) {
        const int cg = task & 255, tb = task >> 8, c = 8 * cg, t0 = 64 * tb;
        f32x4 w0a = *(const f32x4*)(cw + c), w0b = *(const f32x4*)(cw + c + 4), w1a = *(const f32x4*)(cw + D + c), w1b = *(const f32x4*)(cw + D + c + 4);
        f32x4 w2a = *(const f32x4*)(cw + 2 * D + c), w2b = *(const f32x4*)(cw + 2 * D + c + 4), ba = *(const f32x4*)(cb + c), bb = *(const f32x4*)(cb + c + 4);
        f32x4 p2a = {0.f, 0.f, 0.f, 0.f}, p2b = p2a, p1a = p2a, p1b = p2a;
        if (t0 >= 2) { ld_bf8(U + (size_t)(t0 - 2) * D + c, p2a, p2b); ld_bf8(U + (size_t)(t0 - 1) * D + c, p1a, p1b); }
        for (int t = t0; t < t0 + 64; ++t) {
            f32x4 ua, ub, ca, cbv; ld_bf8(U + (size_t)t * D + c, ua, ub); ld_bf8(CB + (size_t)t * D + c, ca, cbv);
            const f32x4 ya = ca * (w0a * p2a + w1a * p1a + w2a * ua + ba), yb = cbv * (w0b * p2b + w1b * p1b + w2b * ub + bb);
            st_bf8(Z + (size_t)t * D + c, ya, yb);
            p2a = p1a; p2b = p1b; p1a = ua; p1b = ub;
        }
    }
}
__device__ __forceinline__ void p_glaprep(Frame& F) {
    const bf16* Q = WSP(bf16, WS_Q); const bf16* Kk = WSP(bf16, WS_K); const float* ALOW = WSP(float, WS_ALOW); const float* GW = F.in[I_GGW]; const float* GB = F.in[I_GGB];
    bf16* QT = WSP(bf16, WS_QT); bf16* KH = WSP(bf16, WS_KH); bf16* KHT = WSP(bf16, WS_KHT); bf16* QG = WSP(bf16, WS_QG);
    float* DL = WSP(float, WS_DL); float* DG = WSP(float, WS_DG);
    LAS float* part = (LAS float*)F.lds;
    LAS float* sal = part + 512;
    const int col = F.tid & 63, sub = F.tid >> 6;
    for (int unit = F.bid; unit < NG * 16; unit += F.G) {
        const int g = unit >> 4, cs = unit & 15, gc = cs * 64 + col, h = gc >> 8, kc = gc & 255;
        float gw[16];
#pragma unroll
        for (int r = 0; r < 16; ++r) gw[r] = GW[r * QK + gc];
        const float gbv = GB[gc];
        float carry = 0.f;
        bf16 qr[8], kr[8]; f32x4 av = {0.f, 0.f, 0.f, 0.f};
#define PREP_LOAD(chunk_) do { const int _t0 = (chunk_) * CH + 8 * sub; \
        _Pragma("unroll") for (int j = 0; j < 8; ++j) { qr[j] = Q[(size_t)(_t0 + j) * QK + gc]; kr[j] = Kk[(size_t)(_t0 + j) * QK + gc]; } \
        if (F.tid < 256) av = *(const f32x4*)(ALOW + (size_t)(chunk_) * CH * 16 + 4 * F.tid); } while (0)
        PREP_LOAD(g * GC);
        for (int c = 0; c < GC; ++c) {
            const int chunk = g * GC + c, t0 = chunk * CH + 8 * sub;
            float la[8], qv[8], kv[8];
#pragma unroll
            for (int j = 0; j < 8; ++j) { qv[j] = bf2f(qr[j]); kv[j] = bf2f(kr[j]); }
            if (F.tid < 256) *(LAS f32x4*)(sal + 4 * F.tid) = av;
            __syncthreads();
            if (c + 1 < GC) PREP_LOAD(chunk + 1);
#pragma unroll
            for (int j = 0; j < 8; ++j) { const LAS f32x4* ar = (const LAS f32x4*)(sal + (8 * sub + j) * 16); const f32x4 a0 = ar[0], a1 = ar[1], a2 = ar[2], a3 = ar[3];
                float z = gbv;
#pragma unroll
                for (int r = 0; r < 4; ++r) z += a0[r] * gw[r];
#pragma unroll
                for (int r = 0; r < 4; ++r) z += a1[r] * gw[4 + r];
#pragma unroll
                for (int r = 0; r < 4; ++r) z += a2[r] * gw[8 + r];
#pragma unroll
                for (int r = 0; r < 4; ++r) z += a3[r] * gw[12 + r];
                la[j] = logsigmoidf_(z) * 0.0625f; }
#pragma unroll
            for (int j = 1; j < 8; ++j) la[j] += la[j - 1];
            part[sub * 64 + col] = la[7];
            __syncthreads();
            float off = 0.f, tot = 0.f;
#pragma unroll
            for (int s = 0; s < 8; ++s) { const float p = part[s * 64 + col]; off += (s < sub) ? p : 0.f; tot += p; }
            unsigned kt[4];
#pragma unroll
            for (int j = 0; j < 8; ++j) { const float b = off + la[j], eb = __expf(b), enb = __expf(-b), eg = __expf(carry + b);
                QT[(size_t)(t0 + j) * QK + gc] = (bf16)f2bf(qv[j] * eb); const unsigned khv = f2bf(kv[j] * enb); KH[(size_t)(t0 + j) * QK + gc] = (bf16)khv;
                QG[(size_t)(t0 + j) * QK + gc] = (bf16)f2bf(qv[j] * eg);
                if (j & 1) kt[j >> 1] |= khv << 16; else kt[j >> 1] = khv; }
            *(u32x4*)(KHT + ((size_t)(chunk * GH + h) * DK + kc) * CH + 8 * sub) = (u32x4){kt[0], kt[1], kt[2], kt[3]};
            if (sub == 0) DL[(size_t)chunk * QK + gc] = __expf(tot);
            carry += tot;
        }
#undef PREP_LOAD
        if (sub == 0) DG[(size_t)g * QK + gc] = __expf(carry);
    }
}

__device__ __forceinline__ void p_gla_ref(Frame& F) {
    const bf16* Q = WSP(bf16, WS_Q); const bf16* Kk = WSP(bf16, WS_K); const bf16* V = WSP(bf16, WS_V); const float* LA = WSP(float, WS_LA); float* O32 = WSP(float, WS_O32);
    LAS float* red = (LAS float*)F.lds;
    const int k = F.tid & 255, vh = F.tid >> 8;
    for (int unit = F.bid; unit < GH * 64; unit += F.G) {
        const int h = unit >> 6, vb = unit & 63, vcol = h * DV + vb * 8 + vh * 4;
        float s0 = 0.f, s1 = 0.f, s2 = 0.f, s3 = 0.f;
        for (int tb = 0; tb < T; tb += 8) {
            LAS float* rb = red + ((tb >> 3) & 1) * 256;
#pragma unroll
            for (int j = 0; j < 8; ++j) {
                const int t = tb + j; const float a = __expf(LA[(size_t)t * QK + h * DK + k]), kk = bf2f(Kk[(size_t)t * QK + h * DK + k]), qq = bf2f(Q[(size_t)t * QK + h * DK + k]);
                const u32x2 vv = *(const u32x2*)(V + (size_t)t * VD + vcol);
                const float v0 = __uint_as_float(vv.x << 16), v1 = __uint_as_float(vv.x & 0xffff0000u), v2 = __uint_as_float(vv.y << 16), v3 = __uint_as_float(vv.y & 0xffff0000u);
                s0 = a * s0 + kk * v0; s1 = a * s1 + kk * v1; s2 = a * s2 + kk * v2; s3 = a * s3 + kk * v3;
                const float p0 = wave_sum(qq * s0), p1 = wave_sum(qq * s1), p2 = wave_sum(qq * s2), p3 = wave_sum(qq * s3);
                if (F.lane == 0) *(LAS f32x4*)(rb + (j * 8 + F.wave) * 4) = (f32x4){p0, p1, p2, p3};
            }
            __syncthreads();
            if (F.tid < 64) { const int j = F.tid >> 3, vhh = (F.tid >> 2) & 1, q = F.tid & 3; float s = 0.f;
#pragma unroll
                for (int w = 0; w < 4; ++w) s += rb[(j * 8 + vhh * 4 + w) * 4 + q];
                O32[(size_t)(tb + j) * VD + h * DV + vb * 8 + vhh * 4 + q] = s; }
        }
        __syncthreads();
    }
}
__device__ __forceinline__ void p_gla_norm_ref(Frame& F) {
    const float* O32 = WSP(float, WS_O32); const bf16* SR = WSP(bf16, WS_SR); bf16* OA = WSP(bf16, WS_OA); const float* g = F.in[I_GNG];
    const int gw = F.bid * NWAVES + F.wave, NGW = F.G * NWAVES;
    for (int it = gw; it < T * GH; it += NGW) {
        const size_t o = (size_t)it * DV + 8 * F.lane;
        const f32x4 a = *(const f32x4*)(O32 + o), b = *(const f32x4*)(O32 + o + 4);
        float s = 0.f;
#pragma unroll
        for (int j = 0; j < 4; ++j) s += a[j] * a[j] + b[j] * b[j];
        const float r = rsqrtf(wave_sum(s) * (1.0f / DV) + EPS);
        f32x4 s0, s1; ld_bf8(SR + o, s0, s1);
        const f32x4 g0 = *(const f32x4*)(g + 8 * F.lane), g1 = *(const f32x4*)(g + 8 * F.lane + 4);
        st_bf8(OA + o, a * r * g0 * s0, b * r * g1 * s1);
    }
}

__device__ __forceinline__ void p_gla_a(Frame& F) {
    const bf16* QT = WSP(bf16, WS_QT); const bf16* KH = WSP(bf16, WS_KH); const bf16* KHT = WSP(bf16, WS_KHT); const bf16* V = WSP(bf16, WS_V); const float* DL = WSP(float, WS_DL);
    bf16* OL = WSP(bf16, WS_OL); float* SLOC = WSP(float, WS_SLOC);
    constexpr int QS = 528, KQ = 544, KS = 160;
    LAS unsigned char* sQ = F.lds; LAS unsigned char* sK = sQ + 64 * QS; LAS unsigned char* sKT = sK + 64 * KQ; LAS unsigned char* sVT = sKT + 256 * KS; LAS unsigned char* sP = sVT + 128 * KS;
    LAS float* sDL = (LAS float*)(sP + 64 * KS);
    static_assert(64 * QS + 64 * KQ + 256 * KS + 128 * KS + 64 * KS + 1024 <= MISC_OFF, "gla lds");
    const int tid = F.tid, lane = F.lane, w = F.wave, lr = lane & 15, lg = lane >> 4;
    for (int unit0 = F.bid; unit0 < NG * GH * 4; unit0 += F.G) {
        const int unit = (F.G == NG * GH * 4) ? ((((unit0 & 7) + 8 * (unit0 >> 5)) << 2) | ((unit0 >> 3) & 3)) : unit0;
        const int g = unit >> 4, h = (unit >> 2) & 3, vs = unit & 3;
        f32x4 S[16];
#pragma unroll
        for (int kt = 0; kt < 16; ++kt) S[kt] = (f32x4){0.f, 0.f, 0.f, 0.f};
        u32x4 rq[4], rk[4], rt[4], rv[2], rd = {0u, 0u, 0u, 0u};
#define GLA_LOAD(chunk_) do { const int _t0 = (chunk_) * CH; \
        _Pragma("unroll") for (int q = 0; q < 4; ++q) { const int p = tid + 512 * q, row = p >> 5, c16 = p & 31; \
            rq[q] = *(const u32x4*)(QT + (size_t)(_t0 + row) * QK + h * DK + c16 * 8); rk[q] = *(const u32x4*)(KH + (size_t)(_t0 + row) * QK + h * DK + c16 * 8); \
            rt[q] = *(const u32x4*)(KHT + (size_t)((chunk_) * GH + h) * DK * CH + (size_t)p * 8); } \
        _Pragma("unroll") for (int q = 0; q < 2; ++q) rv[q] = *(const u32x4*)(V + (size_t)(_t0 + lane) * VD + h * DV + vs * 128 + 8 * (2 * w + q)); \
        if (tid < 64) rd = *(const u32x4*)(DL + (size_t)(chunk_) * QK + h * DK + 4 * tid); } while (0)
        GLA_LOAD(g * GC);
        for (int c = 0; c < GC; ++c) {
            const int chunk = g * GC + c, t0 = chunk * CH;
#pragma unroll
            for (int q = 0; q < 4; ++q) { const int p = tid + 512 * q; *(LAS u32x4*)(sQ + (p >> 5) * QS + (p & 31) * 16) = rq[q]; *(LAS u32x4*)(sK + (p >> 5) * KQ + (p & 31) * 16) = rk[q]; *(LAS u32x4*)(sKT + (p >> 3) * KS + (p & 7) * 16) = rt[q]; }
#pragma unroll
            for (int q = 0; q < 2; ++q) { LAS unsigned char* vp = sVT + (8 * (2 * w + q)) * KS + 2 * lane;
                *(LAS unsigned short*)(vp) = (unsigned short)rv[q].x; *(LAS unsigned short*)(vp + KS) = (unsigned short)(rv[q].x >> 16); *(LAS unsigned short*)(vp + 2 * KS) = (unsigned short)rv[q].y; *(LAS unsigned short*)(vp + 3 * KS) = (unsigned short)(rv[q].y >> 16);
                *(LAS unsigned short*)(vp + 4 * KS) = (unsigned short)rv[q].z; *(LAS unsigned short*)(vp + 5 * KS) = (unsigned short)(rv[q].z >> 16); *(LAS unsigned short*)(vp + 6 * KS) = (unsigned short)rv[q].w; *(LAS unsigned short*)(vp + 7 * KS) = (unsigned short)(rv[q].w >> 16); }
            if (tid < 64) *(LAS u32x4*)(sDL + 4 * tid) = rd;
            __syncthreads();
            if (c + 1 < GC) GLA_LOAD(chunk + 1);
            { const int ti = w >> 1;
#pragma unroll
              for (int jj = 0; jj < 2; ++jj) { const int tj = 2 * (w & 1) + jj; f32x4 pa = {0.f, 0.f, 0.f, 0.f};
                if (tj <= ti) {
#pragma unroll
                    for (int s = 0; s < 8; ++s) { const bf16x8 a = *(const LAS bf16x8*)(sK + (16 * tj + lr) * KQ + (32 * s + 8 * lg) * 2), b = *(const LAS bf16x8*)(sQ + (16 * ti + lr) * QS + (32 * s + 8 * lg) * 2); pa = MFMA16(a, b, pa); }
                    const int i = 16 * ti + lr, j0 = 16 * tj + 4 * lg;
#pragma unroll
                    for (int r = 0; r < 4; ++r) pa[r] = (j0 + r <= i) ? pa[r] : 0.f;
                }
                u32x2 pw; pw.x = pk2(pa[0], pa[1]); pw.y = pk2(pa[2], pa[3]);
                *(LAS u32x2*)(sP + (16 * ti + lr) * KS + (16 * tj + 4 * lg) * 2) = pw; } }
            f32x4 oacc[4];
#pragma unroll
            for (int ti = 0; ti < 4; ++ti) oacc[ti] = (f32x4){0.f, 0.f, 0.f, 0.f};
#pragma unroll
            for (int s = 0; s < 8; ++s) {
                u32x4 sw; sw.x = pk2(S[2 * s][0], S[2 * s][1]); sw.y = pk2(S[2 * s][2], S[2 * s][3]); sw.z = pk2(S[2 * s + 1][0], S[2 * s + 1][1]); sw.w = pk2(S[2 * s + 1][2], S[2 * s + 1][3]);
                const bf16x8 a = as_bf8(sw);
#pragma unroll
                for (int ti = 0; ti < 4; ++ti) { const LAS unsigned char* qp = sQ + (16 * ti + lr) * QS + (32 * s + 4 * lg) * 2; const u32x2 lo = *(const LAS u32x2*)qp, hi = *(const LAS u32x2*)(qp + 32);
                    oacc[ti] = MFMA16(a, as_bf8((u32x4){lo.x, lo.y, hi.x, hi.y}), oacc[ti]); }
            }
            __syncthreads();
            bf16x8 vf[2];
#pragma unroll
            for (int s2 = 0; s2 < 2; ++s2) vf[s2] = *(const LAS bf16x8*)(sVT + (16 * w + lr) * KS + (32 * s2 + 8 * lg) * 2);
#pragma unroll
            for (int s2 = 0; s2 < 2; ++s2)
#pragma unroll
                for (int ti = 0; ti < 4; ++ti) { const bf16x8 b = *(const LAS bf16x8*)(sP + (16 * ti + lr) * KS + (32 * s2 + 8 * lg) * 2); oacc[ti] = MFMA16(vf[s2], b, oacc[ti]); }
#pragma unroll
            for (int ti = 0; ti < 4; ++ti) { u32x2 ow; ow.x = pk2(oacc[ti][0], oacc[ti][1]); ow.y = pk2(oacc[ti][2], oacc[ti][3]);
                *(u32x2*)(OL + (size_t)(t0 + 16 * ti + lr) * VD + h * DV + vs * 128 + 16 * w + 4 * lg) = ow; }
#pragma unroll
            for (int kt = 0; kt < 16; ++kt) {
#pragma unroll
                for (int s2 = 0; s2 < 2; ++s2) { const bf16x8 a = *(const LAS bf16x8*)(sKT + (16 * kt + lr) * KS + (32 * s2 + 8 * lg) * 2); S[kt] = MFMA16(a, vf[s2], S[kt]); }
                S[kt] *= *(const LAS f32x4*)(sDL + 16 * kt + 4 * lg);
            }
            __syncthreads();
        }
#undef GLA_LOAD
#pragma unroll
        for (int kt = 0; kt < 16; ++kt)
#pragma unroll
            for (int r = 0; r < 4; ++r) SLOC[((size_t)(g * GH + h) * DK + 16 * kt + 4 * lg + r) * DV + vs * 128 + 16 * w + lr] = S[kt][r];
    }
}
__device__ __forceinline__ void p_gla_b(Frame& F) {
    const float* SLOC = WSP(float, WS_SLOC); const float* DG = WSP(float, WS_DG); bf16* SG0 = WSP(bf16, WS_SG0);
    for (int idx = F.bid * NTHR + F.tid; idx < GH * DV * (DK / 4); idx += F.G * NTHR) {
        const int v = idx & 511, k4 = (idx >> 9) & 63, h = idx >> 15;
        float x[NG - 1][4]; f32x4 d[NG - 1];
#pragma unroll
        for (int g = 0; g < NG - 1; ++g) { d[g] = *(const f32x4*)(DG + (size_t)g * QK + h * DK + 4 * k4);
#pragma unroll
            for (int j = 0; j < 4; ++j) x[g][j] = SLOC[((size_t)(g * GH + h) * DK + 4 * k4 + j) * DV + v]; }
        float s[4] = {0.f, 0.f, 0.f, 0.f};
#pragma unroll
        for (int g = 0; g < NG; ++g) {
            *(u32x2*)(SG0 + ((size_t)(g * GH + h) * DV + v) * DK + 4 * k4) = (u32x2){pk2(s[0], s[1]), pk2(s[2], s[3])};
            if (g < NG - 1) {
#pragma unroll
                for (int j = 0; j < 4; ++j) s[j] = d[g][j] * s[j] + x[g][j]; }
        }
    }
}
__device__ __forceinline__ void p_gla_c(Frame& F) {
    const bf16* QG = WSP(bf16, WS_QG); const bf16* SG0 = WSP(bf16, WS_SG0); const bf16* OL = WSP(bf16, WS_OL); const bf16* SR = WSP(bf16, WS_SR); bf16* OA = WSP(bf16, WS_OA); const float* gn = F.in[I_GNG];
    LAS float* red = (LAS float*)F.lds;
    const int lane = F.lane, w = F.wave, lr = lane & 15, lg = lane >> 4;
    for (int unit = F.bid; unit < (T / 128) * GH; unit += F.G) {
        const int rt = unit >> 2, h = unit & 3, g = rt >> 3, row0 = rt * 128;
        f32x4 o[8][4];
#pragma unroll
        for (int it = 0; it < 8; ++it)
#pragma unroll
            for (int vt = 0; vt < 4; ++vt) o[it][vt] = (f32x4){0.f, 0.f, 0.f, 0.f};
        if (g > 0) {
            const bf16* sg = SG0 + ((size_t)(g * GH + h) * DV + 64 * w + lr) * DK + 8 * lg; const bf16* qg = QG + (size_t)(row0 + lr) * QK + h * DK + 8 * lg;
#pragma unroll 2
            for (int s = 0; s < 8; ++s) {
                bf16x8 a[4], b[8];
#pragma unroll
                for (int vt = 0; vt < 4; ++vt) a[vt] = *(const bf16x8*)(sg + (size_t)(16 * vt) * DK + 32 * s);
#pragma unroll
                for (int it = 0; it < 8; ++it) b[it] = *(const bf16x8*)(qg + (size_t)(16 * it) * QK + 32 * s);
#pragma unroll
                for (int it = 0; it < 8; ++it)
#pragma unroll
                    for (int vt = 0; vt < 4; ++vt) o[it][vt] = MFMA16(a[vt], b[it], o[it][vt]);
            }
        }
        const size_t ob = (size_t)(row0 + lr) * VD + h * DV + 64 * w + 4 * lg;
        float ss[8];
#pragma unroll
        for (int it = 0; it < 8; ++it) { ss[it] = 0.f;
#pragma unroll
            for (int vt = 0; vt < 4; ++vt) { const u32x2 ol = *(const u32x2*)(OL + ob + (size_t)(16 * it) * VD + 16 * vt);
                o[it][vt][0] += __uint_as_float(ol.x << 16); o[it][vt][1] += __uint_as_float(ol.x & 0xffff0000u); o[it][vt][2] += __uint_as_float(ol.y << 16); o[it][vt][3] += __uint_as_float(ol.y & 0xffff0000u);
                ss[it] += (o[it][vt][0] * o[it][vt][0] + o[it][vt][1] * o[it][vt][1]) + (o[it][vt][2] * o[it][vt][2] + o[it][vt][3] * o[it][vt][3]); }
            ss[it] += __shfl_xor(ss[it], 16); ss[it] += __shfl_xor(ss[it], 32); }
        __syncthreads();
        if (lg == 0) {
#pragma unroll
            for (int it = 0; it < 8; ++it) red[w * 128 + 16 * it + lr] = ss[it]; }
        __syncthreads();
#pragma unroll
        for (int it = 0; it < 8; ++it) { float t = 0.f;
#pragma unroll
            for (int ww = 0; ww < 8; ++ww) t += red[ww * 128 + 16 * it + lr];
            const float r = rsqrtf(t * (1.0f / DV) + EPS);
#pragma unroll
            for (int vt = 0; vt < 4; ++vt) { const size_t oo = ob + (size_t)(16 * it) * VD + 16 * vt; const u32x2 sr = *(const u32x2*)(SR + oo); const f32x4 gg = *(const f32x4*)(gn + 64 * w + 16 * vt + 4 * lg);
                u32x2 ow; ow.x = pk2(o[it][vt][0] * r * gg[0] * __uint_as_float(sr.x << 16), o[it][vt][1] * r * gg[1] * __uint_as_float(sr.x & 0xffff0000u));
                ow.y = pk2(o[it][vt][2] * r * gg[2] * __uint_as_float(sr.y << 16), o[it][vt][3] * r * gg[3] * __uint_as_float(sr.y & 0xffff0000u));
                *(u32x2*)(OA + oo) = ow; } }
    }
    __syncthreads();
}

__device__ __forceinline__ void p_attn_ref(Frame& F) {
    const bf16* QX = WSP(bf16, WS_QX); const bf16* KM = WSP(bf16, WS_KM); const bf16* VMT = WSP(bf16, WS_VMT); bf16* OX = WSP(bf16, WS_OX);
    LAS float* pbuf = (LAS float*)F.lds + F.wave * 256;
    const int gw = F.bid * NWAVES + F.wave, NGW = F.G * NWAVES, lane = F.lane;
    for (int it = gw; it < T * XH; it += NGW) {
        const int t = it >> 2, h = it & 3; const bf16* q = QX + (size_t)t * XA + h * XD;
        float s[4] = {0.f, 0.f, 0.f, 0.f};
        for (int d = 0; d < XD; d += 8) { f32x4 q0, q1, q2, q3; ld_bf8(q + d, q0, q1); ld_bf8(q + d + QX_HALF, q2, q3); q0 += q2; q1 += q3;
#pragma unroll
            for (int c = 0; c < 4; ++c) { f32x4 k0, k1; ld_bf8(KM + (size_t)(lane + 64 * c) * XA + h * XD + d, k0, k1);
#pragma unroll
                for (int j = 0; j < 4; ++j) s[c] += q0[j] * k0[j] + q1[j] * k1[j]; } }
        const float sc = 0.08838834764831845f;
        float mx = fmaxf(fmaxf(s[0], s[1]), fmaxf(s[2], s[3])) * sc; mx = wave_max(mx);
        float e[4], sum = 0.f;
#pragma unroll
        for (int c = 0; c < 4; ++c) { e[c] = __expf(s[c] * sc - mx); sum += e[c]; }
        sum = wave_sum(sum); const float inv = 1.0f / sum;
#pragma unroll
        for (int c = 0; c < 4; ++c) pbuf[lane + 64 * c] = bf2f((unsigned short)f2bf(e[c] * inv));
        LDS_WAIT(); asm volatile("" ::: "memory");
        float o0 = 0.f, o1 = 0.f; const bf16* v0 = VMT + (size_t)(h * XD + 2 * lane) * MEM; const bf16* v1 = v0 + MEM;
        for (int m = 0; m < MEM; m += 8) { f32x4 a0, a1, b0, b1; ld_bf8(v0 + m, a0, a1); ld_bf8(v1 + m, b0, b1); const f32x4 p0 = *(const LAS f32x4*)(pbuf + m), p1 = *(const LAS f32x4*)(pbuf + m + 4);
#pragma unroll
            for (int j = 0; j < 4; ++j) { o0 += p0[j] * a0[j] + p1[j] * a1[j]; o1 += p0[j] * b0[j] + p1[j] * b1[j]; } }
        *(unsigned*)(OX + (size_t)t * XA + h * XD + 2 * lane) = pk2(o0, o1);
        LDS_WAIT(); asm volatile("" ::: "memory");
    }
}

__device__ __forceinline__ void p_attn(Frame& F) {
    const bf16* QX = WSP(bf16, WS_QX); const bf16* KM = WSP(bf16, WS_KM); const bf16* VMT = WSP(bf16, WS_VMT); bf16* OX = WSP(bf16, WS_OX);
    constexpr int KSt = 288, VSt = 528;
    LAS unsigned char* sK = F.lds; LAS unsigned char* sV = sK + 256 * KSt;
    static_assert(256 * KSt + 128 * VSt <= MISC_OFF, "attn lds");
    const int tid = F.tid, lane = F.lane, w = F.wave, lr = lane & 15, lg = lane >> 4;
    int curh = -1;
    for (int unit = F.bid; unit < (T / 128) * XH; unit += F.G) {
        const int h = unit & 3, rt = unit >> 2;
        if (h != curh) {
            __syncthreads();
#pragma unroll
            for (int q = 0; q < 8; ++q) { const int p = tid + 512 * q;
                *(LAS u32x4*)(sK + (p >> 4) * KSt + (p & 15) * 16) = *(const u32x4*)(KM + (size_t)(p >> 4) * XA + h * XD + (p & 15) * 8);
                *(LAS u32x4*)(sV + (p >> 5) * VSt + (p & 31) * 16) = *(const u32x4*)(VMT + (size_t)(h * XD + (p >> 5)) * MEM + (p & 31) * 8); }
            __syncthreads();
            curh = h;
        }
        const int row = rt * 128 + 16 * w + lr;
        bf16x8 qf[4];
#pragma unroll
        for (int s = 0; s < 4; ++s) { const bf16* qp = QX + (size_t)row * XA + h * XD + 32 * s + 8 * lg;
            f32x4 a0, a1, b0, b1; unpack8(*(const u32x4*)qp, a0, a1); unpack8(*(const u32x4*)(qp + QX_HALF), b0, b1); qf[s] = as_bf8(pack8(a0 + b0, a1 + b1)); }
        f32x4 sc[16];
#pragma unroll
        for (int kt = 0; kt < 16; ++kt) { sc[kt] = (f32x4){0.f, 0.f, 0.f, 0.f};
#pragma unroll
            for (int s = 0; s < 4; ++s) { const bf16x8 a = *(const LAS bf16x8*)(sK + (16 * kt + lr) * KSt + (32 * s + 8 * lg) * 2); sc[kt] = MFMA16(a, qf[s], sc[kt]); } }
        float m = -3.0e38f;
#pragma unroll
        for (int kt = 0; kt < 16; ++kt) m = fmaxf(m, fmaxf(fmaxf(sc[kt][0], sc[kt][1]), fmaxf(sc[kt][2], sc[kt][3])));
        m = fmaxf(m, __shfl_xor(m, 16)); m = fmaxf(m, __shfl_xor(m, 32));
        const float c = 0.08838834764831845f * 1.4426950408889634f;
        float sum = 0.f;
#pragma unroll
        for (int kt = 0; kt < 16; ++kt)
#pragma unroll
            for (int r = 0; r < 4; ++r) { const float p = exp2f((sc[kt][r] - m) * c); sc[kt][r] = p; sum += p; }
        sum += __shfl_xor(sum, 16); sum += __shfl_xor(sum, 32);
        const float inv = 1.0f / sum;
        f32x4 oa[8];
#pragma unroll
        for (int dt = 0; dt < 8; ++dt) oa[dt] = (f32x4){0.f, 0.f, 0.f, 0.f};
#pragma unroll
        for (int s = 0; s < 8; ++s) {
            u32x4 pw; pw.x = pk2(sc[2 * s][0], sc[2 * s][1]); pw.y = pk2(sc[2 * s][2], sc[2 * s][3]); pw.z = pk2(sc[2 * s + 1][0], sc[2 * s + 1][1]); pw.w = pk2(sc[2 * s + 1][2], sc[2 * s + 1][3]);
            const bf16x8 b = as_bf8(pw);
#pragma unroll
            for (int dt = 0; dt < 8; ++dt) { const LAS unsigned char* vp = sV + (16 * dt + lr) * VSt + (32 * s + 4 * lg) * 2; const u32x2 lo = *(const LAS u32x2*)vp, hi = *(const LAS u32x2*)(vp + 32);
                oa[dt] = MFMA16(as_bf8((u32x4){lo.x, lo.y, hi.x, hi.y}), b, oa[dt]); }
        }
#pragma unroll
        for (int dt = 0; dt < 8; ++dt) { u32x2 ow; ow.x = pk2(oa[dt][0] * inv, oa[dt][1] * inv); ow.y = pk2(oa[dt][2] * inv, oa[dt][3] * inv);
            *(u32x2*)(OX + (size_t)row * XA + h * XD + 16 * dt + 4 * lg) = ow; }
    }
    __syncthreads();
}

typedef float f32x16 __attribute__((ext_vector_type(16)));
__device__ __forceinline__ void p_router(Frame& F) {
    const bf16* X2 = WSP(bf16, WS_X1B); bf16* H3 = WSP(bf16, WS_H3); const float* WR = WSP(float, WS_WR); const float* g = F.in[I_NMOEG]; const float* rb = F.in[I_RB];
    int* TKE = WSP(int, WS_TKE); int* TKP = WSP(int, WS_TKP); float* TKW = WSP(float, WS_TKW); unsigned* cnt = F.ctl + CW_CNT; int* RTE = WSP(int, WS_RTE);
    LAS unsigned* lcnt = (LAS unsigned*)F.lds;
    LAS int* le = (LAS int*)(F.lds + 256);
    LAS int* lp = (LAS int*)(F.lds + 256 + 1024);
    LAS float* P = (LAS float*)(F.lds + 4096);
    LAS float* SSQ = (LAS float*)(F.lds + 4096 + 8 * 32 * 33 * 4);
    const int lane = F.lane, th = F.wave & 1, kq = F.wave >> 1, li = lane & 31, hh = lane >> 5;
    for (int blk = F.bid; blk < T / 64; blk += F.G) {
        __syncthreads();
        if (F.tid < 64) lcnt[F.tid] = 0u;
        const bf16* xr = X2 + (size_t)(blk * 64 + th * 32 + li) * D + kq * 512 + 4 * hh;
        const float* wr = WR + (size_t)li * D + kq * 512 + 4 * hh;
        f32x16 acc;
#pragma unroll
        for (int r = 0; r < 16; ++r) acc[r] = 0.f;
        float ss = 0.f;
#pragma unroll 4
        for (int q = 0; q < 64; ++q) {
            const u32x2 aw = *(const u32x2*)(xr + 8 * q); const f32x4 a = {__uint_as_float(aw.x << 16), __uint_as_float(aw.x & 0xffff0000u), __uint_as_float(aw.y << 16), __uint_as_float(aw.y & 0xffff0000u)}, b = *(const f32x4*)(wr + 8 * q);
            ss += (a[0] * a[0] + a[1] * a[1]) + (a[2] * a[2] + a[3] * a[3]);
#pragma unroll
            for (int s = 0; s < 4; ++s) acc = __builtin_amdgcn_mfma_f32_32x32x2f32(a[s], b[s], acc, 0, 0, 0);
        }
        ss += __shfl_xor(ss, 32);
#pragma unroll
        for (int r = 0; r < 16; ++r) P[(F.wave * 32 + (r & 3) + 8 * (r >> 2) + 4 * hh) * 33 + li] = acc[r];
        if (lane < 32) SSQ[F.wave * 32 + lane] = ss;
        __syncthreads();
        if (F.tid < 64) {
            const int tl = F.tid, th2 = tl >> 5, ti = tl & 31, t = blk * 64 + tl;
            float ssq = 0.f;
#pragma unroll
            for (int k4 = 0; k4 < 4; ++k4) ssq += SSQ[(k4 * 2 + th2) * 32 + ti];
            const float r = rsqrtf(ssq * (1.0f / D) + EPS);
            float v0 = -3.0e38f, v1 = -3.0e38f, v2 = -3.0e38f, v3 = -3.0e38f; int i0 = 0, i1 = 0, i2 = 0, i3 = 0;
            for (int e = 0; e < NE; ++e) {
                float x = 0.f;
#pragma unroll
                for (int k4 = 0; k4 < 4; ++k4) x += P[((k4 * 2 + th2) * 32 + ti) * 33 + e];
                x = x * r + rb[e];
                if (x > v3) {
                    if (x > v2) { v3 = v2; i3 = i2;
                        if (x > v1) { v2 = v1; i2 = i1;
                            if (x > v0) { v1 = v0; i1 = i0; v0 = x; i0 = e; } else { v1 = x; i1 = e; } }
                        else { v2 = x; i2 = e; } }
                    else { v3 = x; i3 = e; } }
            }
            const float e1 = __expf(v1 - v0), e2 = __expf(v2 - v0), e3 = __expf(v3 - v0), inv = 1.0f / (1.0f + e1 + e2 + e3);
            const unsigned p0 = __hip_atomic_fetch_add(lcnt + i0, 1u, __ATOMIC_RELAXED, __HIP_MEMORY_SCOPE_WORKGROUP);
            const unsigned p1 = __hip_atomic_fetch_add(lcnt + i1, 1u, __ATOMIC_RELAXED, __HIP_MEMORY_SCOPE_WORKGROUP);
            const unsigned p2 = __hip_atomic_fetch_add(lcnt + i2, 1u, __ATOMIC_RELAXED, __HIP_MEMORY_SCOPE_WORKGROUP);
            const unsigned p3 = __hip_atomic_fetch_add(lcnt + i3, 1u, __ATOMIC_RELAXED, __HIP_MEMORY_SCOPE_WORKGROUP);
            le[tl * 4 + 0] = i0; le[tl * 4 + 1] = i1; le[tl * 4 + 2] = i2; le[tl * 4 + 3] = i3;
            lp[tl * 4 + 0] = (int)p0; lp[tl * 4 + 1] = (int)p1; lp[tl * 4 + 2] = (int)p2; lp[tl * 4 + 3] = (int)p3;
            *(int4*)(TKE + t * 4) = make_int4(i0, i1, i2, i3);
            *(f32x4*)(TKW + t * 4) = (f32x4){inv, e1 * inv, e2 * inv, e3 * inv};
        }
        __syncthreads();
        if (F.tid < NE) lcnt[32 + F.tid] = __hip_atomic_fetch_add(cnt + 64 * F.tid, lcnt[F.tid], RLX_AGENT);
        __syncthreads();
        if (F.tid < 256) { const int tl = F.tid >> 2, k = F.tid & 3, ee = le[tl * 4 + k], pos = lp[tl * 4 + k] + (int)lcnt[32 + ee]; TKP[(blk * 64 + tl) * 4 + k] = pos; RTE[(size_t)ee * T + pos] = blk * 64 + tl; }
#if MOE_FP8
        for (int tt = 0; tt < 8; ++tt) { const int t = blk * 64 + F.wave * 8 + tt; const bf16* xr2 = X2 + (size_t)t * D; unsigned char* o8 = (unsigned char*)H3 + (size_t)t * D;
            f32x4 v[8]; float s2 = 0.f;
#pragma unroll
            for (int j = 0; j < 8; ++j) { const u32x2 xw = *(const u32x2*)(xr2 + 4 * lane + 256 * j); v[j] = (f32x4){__uint_as_float(xw.x << 16), __uint_as_float(xw.x & 0xffff0000u), __uint_as_float(xw.y << 16), __uint_as_float(xw.y & 0xffff0000u)}; s2 += (v[j][0] * v[j][0] + v[j][1] * v[j][1]) + (v[j][2] * v[j][2] + v[j][3] * v[j][3]); }
            const float r2 = rsqrtf(wave_sum(s2) * (1.0f / D) + EPS) * H8_SCALE;
#pragma unroll
            for (int j = 0; j < 8; ++j) { const f32x4 gg = *(const f32x4*)(g + 4 * lane + 256 * j); *(unsigned*)(o8 + 4 * lane + 256 * j) = pk4_fp8(v[j][0] * r2 * gg[0], v[j][1] * r2 * gg[1], v[j][2] * r2 * gg[2], v[j][3] * r2 * gg[3]); } }
#else
        for (int tt = 0; tt < 8; ++tt) { const int t = blk * 64 + F.wave * 8 + tt; rms_row_to_bf16(X2 + (size_t)t * D, g, H3 + (size_t)t * D, lane); }
#endif
    }
}
__device__ __forceinline__ void p_lists(Frame& F) {
    unsigned* cnt = F.ctl + CW_CNT; int* TKE = WSP(int, WS_TKE); int* TKP = WSP(int, WS_TKP); int* ROWTOK = WSP(int, WS_ROWTOK); int* TILE = WSP(int, WS_TILE);
    LAS int* poff = (LAS int*)F.lds;
    LAS int* lc = (LAS int*)(F.lds + 256);
    __syncthreads();
    if (F.tid < NE) lc[F.tid] = (int)__hip_atomic_load(cnt + 64 * F.tid, RLX_AGENT);
    __syncthreads();
    if (F.tid == 0) { int o = 0; for (int e = 0; e < NE; ++e) { poff[e] = o; o += (lc[e] + 255) / 256 * 256; } poff[NE] = o; }
    __syncthreads();
    for (int i = F.bid * NTHR + F.tid; i < T * TOPK; i += F.G * NTHR) { const int e = TKE[i], slot = poff[e] + TKP[i]; TKP[i] = slot; ROWTOK[slot] = i >> 2; }
    if (F.bid == 0) {
        for (int e = 0; e < NE; ++e) for (int s = poff[e] + lc[e] + F.tid; s < poff[e + 1]; s += NTHR) ROWTOK[s] = T;
        for (int e = 0; e < NE; ++e) for (int tl = poff[e] / 256 + F.tid; tl < poff[e + 1] / 256; tl += NTHR) TILE[tl] = e;
        if (F.tid == 0) TILE[512] = poff[NE] / 256;
    }
    __syncthreads();
}
__device__ __forceinline__ void p_combine(Frame& F) {
    const bf16* X2 = WSP(bf16, WS_X1B); const unsigned char* YS = WSP(unsigned char, WS_YS); const int* TKP = WSP(int, WS_TKP); const float* TKW = WSP(float, WS_TKW); const float* g = F.in[I_NFG];
    const int gw = F.bid * NWAVES + F.wave, NGW = F.G * NWAVES, lane = F.lane;
    moe_layout(F.lds, F.ctl + CW_CNT); const LAS int* lay = (const LAS int*)(F.lds + LAY_OFF); const int* TKE = WSP(int, WS_TKE);
    int sl[4]; float w[4];
    if (gw < T) {
#pragma unroll
        for (int k = 0; k < 4; ++k) { sl[k] = lay[TKE[gw * 4 + k]] + TKP[gw * 4 + k]; w[k] = TKW[gw * 4 + k] * (1.0f / Y8_SCALE); } }
    for (int t = gw; t < T; t += NGW) {
        int sn[4] = {0, 0, 0, 0}; float wn[4] = {0.f, 0.f, 0.f, 0.f};
        if (t + NGW < T) {
#pragma unroll
            for (int k = 0; k < 4; ++k) { sn[k] = lay[TKE[(t + NGW) * 4 + k]] + TKP[(t + NGW) * 4 + k]; wn[k] = TKW[(t + NGW) * 4 + k] * (1.0f / Y8_SCALE); } }
        f32x4 v[8]; float s = 0.f;
#pragma unroll
        for (int j = 0; j < 8; ++j) { { const u32x2 xw = *(const u32x2*)(X2 + (size_t)t * D + 4 * lane + 256 * j); v[j] = (f32x4){__uint_as_float(xw.x << 16), __uint_as_float(xw.x & 0xffff0000u), __uint_as_float(xw.y << 16), __uint_as_float(xw.y & 0xffff0000u)}; }
#pragma unroll
            for (int k = 0; k < 4; ++k) { const int y = __builtin_nontemporal_load((const int*)(YS + (size_t)sl[k] * D + 4 * lane + 256 * j)); const f32x2 y01 = __builtin_amdgcn_cvt_pk_f32_fp8(y, false), y23 = __builtin_amdgcn_cvt_pk_f32_fp8(y, true);
                v[j][0] += w[k] * y01[0]; v[j][1] += w[k] * y01[1]; v[j][2] += w[k] * y23[0]; v[j][3] += w[k] * y23[1]; }
            s += (v[j][0] * v[j][0] + v[j][1] * v[j][1]) + (v[j][2] * v[j][2] + v[j][3] * v[j][3]); }
        const float r = rsqrtf(wave_sum(s) * (1.0f / D) + EPS);
#pragma unroll
        for (int j = 0; j < 8; ++j) { const f32x4 gg = *(const f32x4*)(g + 4 * lane + 256 * j); __builtin_nontemporal_store(v[j] * r * gg, (f32x4*)(F.out + (size_t)t * D + 4 * lane + 256 * j)); }
#pragma unroll
        for (int k = 0; k < 4; ++k) { sl[k] = sn[k]; w[k] = wn[k]; }
    }
}

constexpr int NPHASE = 16;
__global__ void __launch_bounds__(NTHR, 2) hybrid_fwd(Args args) {
    extern __shared__ __attribute__((aligned(16))) unsigned char lds_raw[];
    Frame F;
    F.lds = (LAS unsigned char*)lds_raw; F.ws = args.ws; F.ctl = (unsigned*)(args.ws + WS_CTL);
    F.tid = threadIdx.x; F.lane = F.tid & 63; F.wave = __builtin_amdgcn_readfirstlane(F.tid >> 6); F.G = gridDim.x; F.bid = blockIdx.x;
    F.in = args.in; F.out = args.out;
    volatile LAS unsigned* MISC = (volatile LAS unsigned*)(F.lds + MISC_OFF);
    if (F.tid < 32) MISC[F.tid] = 0u;
    __syncthreads();
#if MK_ONE_LAUNCH
    XcdBarrier bar = xcd_barrier_post(F.ctl + CW_BAR, MISC + 8);
#define GRID_BAR() xcd_barrier(bar)
#else
#define GRID_BAR() do {} while (0)
#endif
    const int lo = args.ph_lo, hi = args.ph_hi;
#ifndef ONLY_PHASE
#define ONLY_PHASE -1
#endif
#define IN(k) (lo <= (k) && (k) < hi && (ONLY_PHASE < 0 || ONLY_PHASE == (k)))
#define SEAM(k) do { if (IN(k) && IN((k) + 1)) GRID_BAR(); } while (0)

#ifndef DUP_PHASE
#define DUP_PHASE -1
#endif
#ifndef DUP_NOEPI
#define DUP_NOEPI 0
#endif
    bool do_epi = true, do_epi_flag = true;
#define PHASE(k, ...) do { if (IN(k)) { __VA_ARGS__ if (DUP_PHASE == (k)) { GRID_BAR(); do_epi = (DUP_NOEPI == 1) ? (args.probe != 0) : true; do_epi_flag = false; __VA_ARGS__ do_epi = true; do_epi_flag = true; } } SEAM(k); } while (0)
    constexpr int MAIN_ROUNDS = 4;
    const bool split = (F.G == 256);
    const int sgrp = F.bid >> 3;
    const bool conv_role = !split || (sgrp & 3) == 0;
    PHASE(0, p0_prologue(F, 0, F.bid, F.G););
    PHASE(12,
        if (conv_role) { p0_prologue(F, 1, split ? ((sgrp >> 2) * 8 + (F.bid & 7)) : F.bid, split ? 64 : F.G); }
        else { const int j = (sgrp - (sgrp >> 2) - 1) * 8 + (F.bid & 7);
          DenseSched S; S.init(WSP(bf16, WS_XN), WSP(bf16, WS_WIN), T, NIN, D, 192, MAIN_ROUNDS * 256 + j);
          EpiInProj E{WSP(bf16, WS_Q), WSP(bf16, WS_K), WSP(bf16, WS_V), WSP(bf16, WS_SR), WSP(bf16, WS_CB), WSP(bf16, WS_U), WSP(bf16, WS_SGA), WSP(bf16, WS_SGB)};
          gemm_any(F.lds, S, E, do_epi); });
    PHASE(1,
        { DenseSched S; S.init(WSP(bf16, WS_XN), WSP(bf16, WS_WIN), T, NIN, D, F.G, F.bid, 0, split ? MAIN_ROUNDS : (1 << 30));
          EpiInProj E{WSP(bf16, WS_Q), WSP(bf16, WS_K), WSP(bf16, WS_V), WSP(bf16, WS_SR), WSP(bf16, WS_CB), WSP(bf16, WS_U), WSP(bf16, WS_SGA), WSP(bf16, WS_SGB)};
          gemm_any(F.lds, S, E, do_epi); }
        p_alow(F););
    PHASE(2, p_memkv(F); p_conv(F); p_glaprep(F););
#if OPT_GLA
    PHASE(3, p_gla_a(F););
    PHASE(4, p_gla_b(F););
    PHASE(5, p_gla_c(F););
#else
    PHASE(3, p_gla_ref(F););
    PHASE(4, ;);
    PHASE(5, p_gla_norm_ref(F););
#endif
    PHASE(6,
        { DenseSched S; S.init(WSP(bf16, WS_OA), WSP(bf16, WS_WGO), T, D, D, F.G, F.bid); EpiGateA E{WSP(bf16, WS_T1), WSP(bf16, WS_SGA)}; gemm_any(F.lds, S, E, do_epi); }
        VM_WAIT(); __syncthreads();
        { DenseSched S; S.init(WSP(bf16, WS_Z), WSP(bf16, WS_WCO), T, D, D, F.G, F.bid); EpiGateB E{WSP(bf16, WS_T1), WSP(bf16, WS_SGB), WSP(bf16, WS_MG)}; gemm_any(F.lds, S, E, do_epi); });
    PHASE(7, { DenseSched S; S.init(WSP(bf16, WS_MG), WSP(bf16, WS_WMX), T, D, D, F.G, F.bid); EpiResid1 E{F.in[I_X], WSP(bf16, WS_X1B), WSP(float, WS_SSP)}; gemm_any(F.lds, S, E, do_epi); });
    PHASE(8, { DenseSched S; S.init(WSP(bf16, WS_X1B), WSP(bf16, WS_WXQ), T, 2 * XA, D, F.G, F.bid); S.ks = 1; EpiXQ E{WSP(bf16, WS_QX), WSP(float, WS_SSP)}; gemm_any(F.lds, S, E, do_epi); });
#if OPT_ATT
    PHASE(9, p_attn(F););
#else
    PHASE(9, p_attn_ref(F););
#endif
    PHASE(10, { DenseSched S; S.init(WSP(bf16, WS_OX), WSP(bf16, WS_WXO), T, D, XA, F.G, F.bid); EpiResid2 E{WSP(bf16, WS_X1B)}; gemm_any(F.lds, S, E, do_epi); });
    PHASE(11, p_router(F););
#if MOE_FP8
    PHASE(13, { moe_layout(F.lds, F.ctl + CW_CNT); const LAS int* lay = (const LAS int*)(F.lds + LAY_OFF); const int ntiles = __builtin_amdgcn_readfirstlane(lay[NE]) / 256;
        GroupSched S; S.init(WSP(unsigned char, WS_H3), WSP(unsigned char, WS_WGU), ntiles, 2 * FF, D, F.G, F.bid, lay, WSP(int, WS_RTE), 1); EpiGU8 E{WSP(unsigned char, WS_ACT), F.in[I_GUB]};
        gemm_any<EpiGU8, GroupSched, true>(F.lds, S, E, do_epi); });
    PHASE(14, { moe_layout(F.lds, F.ctl + CW_CNT); const LAS int* lay = (const LAS int*)(F.lds + LAY_OFF); const int ntiles = __builtin_amdgcn_readfirstlane(lay[NE]) / 256;
        GroupSched S; S.init(WSP(unsigned char, WS_ACT), WSP(unsigned char, WS_WDN), ntiles, D, FF, F.G, F.bid, lay, nullptr, 1); EpiDown8 E{WSP(unsigned char, WS_YS), F.in[I_DNB]};
        gemm_any<EpiDown8, GroupSched, true>(F.lds, S, E, do_epi); });
#endif
    PHASE(15, p_combine(F););
#undef PHASE
#undef IN
#undef SEAM
}

extern "C" void kernel_launch(void* const* d_in, const int* in_sizes, int n_in, void* d_out, int out_size, void* d_ws, size_t ws_size, hipStream_t stream) {
    static int grid = 0;
    if (grid == 0) {
        if (n_in != 26 || out_size != T * D || ws_size < WS_END) { fprintf(stderr, "kernel_launch: unexpected problem (n_in %d, out %d, ws %zu < %zu)\n", n_in, out_size, ws_size, (size_t)WS_END); grid = -1; return; }
        int dev = 0, cus = 0, per_cu = 0;
        if (hipGetDevice(&dev) != hipSuccess || hipDeviceGetAttribute(&cus, hipDeviceAttributeMultiprocessorCount, dev) != hipSuccess) { grid = -1; return; }
        if (hipFuncSetAttribute((const void*)hybrid_fwd, hipFuncAttributeMaxDynamicSharedMemorySize, LDS_BYTES) != hipSuccess) { fprintf(stderr, "kernel_launch: hipFuncSetAttribute failed\n"); grid = -1; return; }
        if (hipOccupancyMaxActiveBlocksPerMultiprocessor(&per_cu, (const void*)hybrid_fwd, NTHR, LDS_BYTES) != hipSuccess || per_cu < 1) fprintf(stderr, "kernel_launch: occupancy query says %d\n", per_cu);
        (void)hipGetLastError();
        grid = cus;
    }
    if (grid < 0) return;
    (void)hipMemsetAsync((char*)d_ws + WS_CTL, 0, CTL_ZERO_BYTES, stream);
    Args a{};
    for (int i = 0; i < 26; ++i) a.in[i] = (const float*)d_in[i];
    a.out = (float*)d_out; a.ws = (unsigned char*)d_ws;
#if MK_ONE_LAUNCH
    a.ph_lo = 0; a.ph_hi = NPHASE;
    hipLaunchKernelGGL(hybrid_fwd, dim3(grid), dim3(NTHR), LDS_BYTES, stream, a);
#else
    for (int p = 0; p < NPHASE; ++p) { a.ph_lo = p; a.ph_hi = p + 1; hipLaunchKernelGGL(hybrid_fwd, dim3(grid), dim3(NTHR), LDS_BYTES, stream, a); }
#endif
}
```

```cpp
#include <hip/hip_runtime.h>
#include <cstdio>
#include <cstdint>

#ifndef MK_ONE_LAUNCH
#define MK_ONE_LAUNCH 1
#endif
#ifndef OPT_GEMM
#define OPT_GEMM 1
#endif
#ifndef OPT_GLA
#define OPT_GLA 1
#endif
#ifndef MOE_FP8
#define MOE_FP8 1
#endif
#ifndef OPT_ATT
#define OPT_ATT 1
#endif

#define GAS __attribute__((address_space(1)))
#define LAS __attribute__((address_space(3)))
typedef unsigned short bf16;
typedef short bf16x8 __attribute__((ext_vector_type(8)));
typedef short bf16x4 __attribute__((ext_vector_type(4)));
typedef float f32x4 __attribute__((ext_vector_type(4)));
typedef float f32x2 __attribute__((ext_vector_type(2)));
typedef unsigned u32x4 __attribute__((ext_vector_type(4)));
typedef unsigned u32x2 __attribute__((ext_vector_type(2)));
#define RLX_AGENT __ATOMIC_RELAXED, __HIP_MEMORY_SCOPE_AGENT
#define LDS_WAIT() asm volatile("s_waitcnt lgkmcnt(0)" ::: "memory")
#define VM_WAIT() asm volatile("s_waitcnt vmcnt(0)" ::: "memory")

constexpr int T = 16384, D = 2048, MEM = 256;
constexpr int GH = 4, DK = 256, DV = 512, QK = GH * DK  , VD = GH * DV  ;
constexpr int CH = 64, NCH = T / CH  , NG = 16, GC = NCH / NG  , GT = GC * CH  ;
constexpr int XH = 4, XD = 128, XA = XH * XD  ;
constexpr int NE = 32, TOPK = 4, FF = 2048;
constexpr int NIN_SRC = 16400, NIN = 16384;
constexpr float EPS = 1e-5f;
constexpr int PROWS = T * TOPK + NE * 256;
constexpr int MAXTILES = PROWS / 256;

constexpr int SRC_ALOW = 6144, SRC_CB = 6160, SRC_CC = 8208, SRC_CHH = 10256, SRC_GA = 12304, SRC_GB = 14352;
constexpr int TN_Q = 0, TN_K = 4, TN_V = 8, TN_R = 16, TN_CB = 24, TN_U = 32, TN_GA = 48, TN_GB = 56, TN_END = 64;

constexpr size_t MiB = 1u << 20;
constexpr size_t WS_CTL = 0, CTL_ZERO_BYTES = 1 * MiB;
constexpr size_t WS_WIN = 1 * MiB;
constexpr size_t WS_WGO = WS_WIN + 68 * MiB;
constexpr size_t WS_WCO = WS_WGO + 8 * MiB;
constexpr size_t WS_WMX = WS_WCO + 8 * MiB;
constexpr size_t WS_WXQ = WS_WMX + 8 * MiB;
constexpr size_t WS_WXKV = WS_WXQ + 2 * MiB;
constexpr size_t WS_WXO = WS_WXKV + 4 * MiB;
constexpr size_t WS_WR = WS_WXO + 2 * MiB;
constexpr size_t WS_WGU = WS_WR + 1 * MiB;
constexpr size_t WS_WDN = WS_WGU + 512 * MiB;
constexpr size_t WS_XN = WS_WDN + 256 * MiB;
constexpr size_t WS_Q = WS_XN + 64 * MiB;
constexpr size_t WS_K = WS_Q + 32 * MiB;
constexpr size_t WS_V = WS_K + 32 * MiB;
constexpr size_t WS_SR = WS_V + 64 * MiB;
constexpr size_t WS_LA = WS_SR + 64 * MiB;
constexpr size_t WS_CB = WS_LA + 64 * MiB;
constexpr size_t WS_U = WS_CB + 64 * MiB;
constexpr size_t WS_SGA = WS_U + 64 * MiB;
constexpr size_t WS_SGB = WS_SGA + 64 * MiB;
constexpr size_t WS_QT = WS_SGB + 64 * MiB;
constexpr size_t WS_KH = WS_QT + 32 * MiB;
constexpr size_t WS_KHT = WS_KH + 32 * MiB;
constexpr size_t WS_QG = WS_KHT + 32 * MiB;
constexpr size_t WS_VT = WS_QG + 32 * MiB;
constexpr size_t WS_DL = WS_VT + 64 * MiB;
constexpr size_t WS_DG = WS_DL + 1 * MiB;
constexpr size_t WS_Z = WS_DG + 1 * MiB;
constexpr size_t WS_OL = WS_Z + 64 * MiB;
constexpr size_t WS_SLOC = WS_OL + 64 * MiB;
constexpr size_t WS_SG0 = WS_SLOC + 32 * MiB;
constexpr size_t WS_O32 = WS_SG0 + 16 * MiB;
constexpr size_t WS_OA = WS_O32 + 128 * MiB;
constexpr size_t WS_T1 = WS_OA + 64 * MiB;
constexpr size_t WS_MG = WS_T1 + 128 * MiB;
constexpr size_t WS_X1 = WS_MG + 64 * MiB;
constexpr size_t WS_X1B = WS_X1 + 128 * MiB;
constexpr size_t WS_QX = WS_X1B + 64 * MiB;
constexpr size_t WS_OX = WS_QX + 16 * MiB;
constexpr size_t WS_MEMN = WS_OX + 16 * MiB;
constexpr size_t WS_KM = WS_MEMN + 1 * MiB;
constexpr size_t WS_VMT = WS_KM + 1 * MiB;
constexpr size_t WS_H3 = WS_VMT + 1 * MiB;
constexpr size_t WS_TKE = WS_H3 + 65 * MiB;
constexpr size_t WS_TKP = WS_TKE + 1 * MiB;
constexpr size_t WS_TKW = WS_TKP + 1 * MiB;
constexpr size_t WS_ROWTOK = WS_TKW + 1 * MiB;
constexpr size_t WS_TILE = WS_ROWTOK + 1 * MiB;
constexpr size_t WS_SSP = WS_TILE + 1 * MiB;
constexpr size_t WS_WAL = WS_SSP + 8 * MiB;
constexpr size_t WS_ALOW = WS_WAL + 1 * MiB;
constexpr size_t WS_WGW = WS_ALOW + 1 * MiB;
constexpr size_t WS_RTE = WS_WGW + 1 * MiB;
constexpr size_t WS_ACT = WS_RTE + 2 * MiB;
constexpr size_t WS_YS = WS_ACT + 288 * MiB;
constexpr size_t WS_END = WS_YS + 288 * MiB;
constexpr int CW_BAR = 4096;
constexpr int CW_CNT = 16384;
constexpr int CW_SS1 = 65536;
static_assert((CW_SS1 + T) * 4 <= (int)CTL_ZERO_BYTES, "ctl");

constexpr int NWAVES = 8, NTHR = 512;
constexpr int LDS_BYTES = 147456;
constexpr int MISC_OFF = 147200;

__device__ __forceinline__ float bf2f(unsigned short b) { return __uint_as_float(((unsigned)b) << 16); }
typedef __bf16 bf16x2_t __attribute__((ext_vector_type(2)));
__device__ __forceinline__ unsigned pk2(float lo, float hi) { const f32x2 v = {lo, hi}; return __builtin_bit_cast(unsigned, __builtin_convertvector(v, bf16x2_t)); }
__device__ __forceinline__ unsigned f2bf(float f) { return pk2(f, 0.f) & 0xffffu; }
__device__ __forceinline__ float wave_sum(float v) {
#pragma unroll
    for (int o = 1; o < 64; o <<= 1) v += __shfl_xor(v, o);
    return v;
}
__device__ __forceinline__ float wave_max(float v) {
#pragma unroll
    for (int o = 1; o < 64; o <<= 1) v = fmaxf(v, __shfl_xor(v, o));
    return v;
}
__device__ __forceinline__ float sigmoidf_(float x) { return __builtin_amdgcn_rcpf(1.0f + __builtin_amdgcn_exp2f(x * -1.4426950408889634f)); }
__device__ __forceinline__ float logsigmoidf_(float z) { return fminf(z, 0.f) - 0.6931471805599453f * __builtin_amdgcn_logf(1.0f + __builtin_amdgcn_exp2f(fabsf(z) * -1.4426950408889634f)); }
__device__ __forceinline__ u32x4 pack8(f32x4 a, f32x4 b) { u32x4 w; w.x = pk2(a[0], a[1]); w.y = pk2(a[2], a[3]); w.z = pk2(b[0], b[1]); w.w = pk2(b[2], b[3]); return w; }
__device__ __forceinline__ void unpack8(u32x4 w, f32x4& a, f32x4& b) {
    a[0] = __uint_as_float(w.x << 16); a[1] = __uint_as_float(w.x & 0xffff0000u); a[2] = __uint_as_float(w.y << 16); a[3] = __uint_as_float(w.y & 0xffff0000u);
    b[0] = __uint_as_float(w.z << 16); b[1] = __uint_as_float(w.z & 0xffff0000u); b[2] = __uint_as_float(w.w << 16); b[3] = __uint_as_float(w.w & 0xffff0000u);
}
__device__ __forceinline__ unsigned pk4_fp8(float a, float b, float c, float d) {
    a = fminf(fmaxf(a, -448.f), 448.f); b = fminf(fmaxf(b, -448.f), 448.f); c = fminf(fmaxf(c, -448.f), 448.f); d = fminf(fmaxf(d, -448.f), 448.f);
    int w = 0; w = __builtin_amdgcn_cvt_pk_fp8_f32(a, b, w, false); w = __builtin_amdgcn_cvt_pk_fp8_f32(c, d, w, true); return (unsigned)w; }
__device__ __forceinline__ bf16x8 as_bf8(u32x4 w) { return __builtin_bit_cast(bf16x8, w); }
#define MFMA16(A, B, C) __builtin_amdgcn_mfma_f32_16x16x32_bf16((A), (B), (C), 0, 0, 0)
__device__ __forceinline__ int ld_agent_i(const int* p) { return (int)__hip_atomic_load((const unsigned*)p, RLX_AGENT); }

#define XB_TMO      128
#define XB_XCNT(j)  (256  + 64 * (j))
#define XB_XSUB(j)  (1280 + 64 * (j))
#define XB_XGEN(j)  (2304 + 64 * (j))
#define XB_TOP      3328
#define XB_TOPGEN   3392
#define XCD_BAR_WORDS 3456
#define XB_SPIN_CAP (1u << 22)
__device__ __forceinline__ unsigned xb_ld(unsigned* p)              { return __hip_atomic_load(p, __ATOMIC_RELAXED, __HIP_MEMORY_SCOPE_AGENT); }
__device__ __forceinline__ unsigned xb_add(unsigned* p, unsigned v) { return __hip_atomic_fetch_add(p, v, __ATOMIC_RELAXED, __HIP_MEMORY_SCOPE_AGENT); }
__device__ __forceinline__ unsigned xb_xcc_id() { return (unsigned)__builtin_amdgcn_s_getreg((3 << 11) | 20) & 0xFu; }
#define XB_SPIN(cond, bar) do { unsigned _sp = 0; while (cond) { __builtin_amdgcn_s_sleep(1); \
    if ((++_sp & 255u) == 0u) { if (xb_ld(&(bar)[XB_TMO])) break; if (_sp > XB_SPIN_CAP) { atomicAdd(&(bar)[XB_TMO], 1u); break; } } } } while (0)
struct XcdBarrier { unsigned* bar; unsigned x; volatile LAS unsigned* st; };
__device__ __forceinline__ XcdBarrier xcd_barrier_post(unsigned* bar, volatile LAS unsigned* st) {
    XcdBarrier b; b.bar = bar; b.x = xb_xcc_id(); b.st = st;
    if (threadIdx.x == 0) (void)xb_add(&bar[XB_XCNT(b.x)], 1u);
    return b;
}
__device__ __forceinline__ void xcd_barrier_complete(unsigned* bar, unsigned x, unsigned& nloc, unsigned& nx) {
    const unsigned G = gridDim.x * gridDim.y * gridDim.z;
    unsigned sum, cnt, mine, sp = 0u;
    for (;;) {
        sum = 0u; cnt = 0u; mine = 0u;
#pragma unroll
        for (unsigned j = 0; j < 16; ++j) { const unsigned c = xb_ld(&bar[XB_XCNT(j)]); sum += c; cnt += (c > 0u) ? 1u : 0u; mine = (j == x) ? c : mine; }
        if (sum == G) break;
        __builtin_amdgcn_s_sleep(1);
        if ((++sp & 255u) == 0u) { if (xb_ld(&bar[XB_TMO])) break; if (sp > XB_SPIN_CAP) { atomicAdd(&bar[XB_TMO], 1u); break; } }
    }
    nloc = mine > 0u ? mine : 1u; nx = cnt > 0u ? cnt : 1u;
}
__device__ __forceinline__ void xcd_barrier(const XcdBarrier& b) {
    asm volatile("s_waitcnt vmcnt(0)" ::: "memory");
    __syncthreads();
    if (threadIdx.x == 0) {
        unsigned* bar = b.bar;
        __builtin_amdgcn_s_waitcnt(0);
        unsigned nloc = b.st[0], nx = b.st[1];
        if (nloc == 0u) { xcd_barrier_complete(bar, b.x, nloc, nx); b.st[0] = nloc; b.st[1] = nx; }
        const unsigned old = xb_add(&bar[XB_XSUB(b.x)], 1u);
        const unsigned gen = old / nloc;
        if (old + 1u == (gen + 1u) * nloc) {
            __builtin_amdgcn_fence(__ATOMIC_RELEASE, "agent");
            asm volatile("s_waitcnt vmcnt(0)" ::: "memory");
            const unsigned og = xb_add(&bar[XB_TOP], 1u);
            const unsigned tg = og / nx;
            if (og + 1u == (tg + 1u) * nx) xb_add(&bar[XB_TOPGEN], 1u);
            else XB_SPIN(xb_ld(&bar[XB_TOPGEN]) == tg, bar);
            __builtin_amdgcn_fence(__ATOMIC_ACQUIRE, "agent");
            xb_add(&bar[XB_XGEN(b.x)], 1u);
            asm volatile("s_waitcnt vmcnt(0)" ::: "memory");
        } else {
            XB_SPIN(xb_ld(&bar[XB_XGEN(b.x)]) == gen, bar);
            __builtin_amdgcn_fence(__ATOMIC_ACQUIRE, "agent");
            asm volatile("s_waitcnt vmcnt(0)" ::: "memory");
        }
    }
    __syncthreads();
}

struct Args { const float* in[26]; float* out; unsigned char* ws; int ph_lo, ph_hi, probe, pad; };
struct Frame {
    LAS unsigned char* lds; unsigned char* ws; unsigned* ctl;
    int tid, lane, wave, G, bid;
    const float* const* in;
    float* out;
};
#define WSP(type, off) ((type*)(F.ws + (off)))
enum { I_X = 0, I_MEM, I_NMIXG, I_WIN, I_GGW, I_GGB, I_GNG, I_GOW, I_CW, I_CBIAS, I_COW, I_MXW, I_NXG, I_NMG, I_XQ, I_XK, I_XV, I_XO, I_NMOEG, I_RW, I_RB, I_GUW, I_GUB, I_DNW, I_DNB, I_NFG };

constexpr int BM = 256, BK = 64, HALF = 128, HTB = HALF * BK * 2, NXCD = 8, WGM = 8;
__device__ __forceinline__ int lds_byte(int r, int c) { const int st = (r >> 4) * 2 + (c >> 5), rr = r & 15, cc = c & 31, ob = rr * 64 + cc * 2; return st * 1024 + (ob ^ (((ob >> 9) & 1) << 5)); }
__device__ __forceinline__ void stage_rc(int b, int& R, int& C) { const int st = b / 1024, sb = b % 1024, swz = sb ^ (((sb >> 9) & 1) << 5); R = (st >> 1) * 16 + swz / 64; C = (st & 1) * 32 + (swz % 64) / 2; }
__device__ __forceinline__ int g8(int rr) { return ((rr >> 3) & 1) * 4 + ((rr >> 1) & 1); }
__device__ __forceinline__ int lds_byte8(int r, int c) { return (r >> 4) * 2048 + (r & 15) * 128 + ((c ^ g8(r & 15)) << 4); }
__device__ __forceinline__ void stage_rc8(int b, int& R, int& C) { const int s = b >> 4, rr = (s >> 3) & 15; R = (s >> 7) * 16 + rr; C = 8 * ((s & 7) ^ g8(rr)); }
__device__ __forceinline__ int perm32(int rho) { const int n = rho >> 4, i = rho & 15; return 8 * (i >> 2) + 4 * n + (i & 3); }

struct Unit { int pm, pn, e; };
__device__ __forceinline__ bool static_next(int i, int G, int c, int nM, int nN, Unit& u) {
    const int nwg = nM * nN; const long L = (long)i * G + c; if (L >= nwg) return false;
    int wgid = (int)L; { const int q = nwg / NXCD, r = nwg % NXCD, xcd = wgid % NXCD, off = wgid / NXCD; wgid = (xcd < r ? xcd * (q + 1) : r * (q + 1) + (xcd - r) * q) + off; }
    const int nig = WGM * nN, gid = wgid / nig, fm = gid * WGM, gsz = (nM - fm) < WGM ? (nM - fm) : WGM;
    u.pm = fm + ((wgid % nig) % gsz); u.pn = (wgid % nig) / gsz; u.e = 0; return true;
}
struct DenseSched {
    const char* A; const char* Bt; int K, nM, nN, G, c, i0, ni, pair;
    __device__ __forceinline__ void init(const void* A_, const void* Bt_, int M, int N, int K_, int G_, int c_, int i0_ = 0, int ni_ = 1 << 30, int pair_ = 0) { A = (const char*)A_; Bt = (const char*)Bt_; K = K_; nM = M / BM; nN = N / BM; G = G_; c = c_; i0 = i0_; ni = ni_; pair = pair_; }
    __device__ __forceinline__ bool next(int i, Unit& u) const { if (pair) { if (i >= 2 * ni) return false; return static_next(i0 + (i >> 1), G, c - (i & 1) * pair, nM, nN, u); } if (i >= ni) return false; if (!static_next(i0 + i, G, c, nM, nN, u)) return false; if (ks) { u.e = u.pn / (nN >> 1); u.pn -= u.e * (nN >> 1); } return true; }
    int ks = 0;
    __device__ __forceinline__ const char* a_base() const { return A; }
    __device__ __forceinline__ size_t a_off(const Unit& u) const { return ks ? (size_t)u.e * K : 0; }
    __device__ __forceinline__ const char* b_base(const Unit& u) const { return Bt + (size_t)u.pn * BM * K * 2 + (ks ? (size_t)u.e * K : 0); }
    __device__ __forceinline__ unsigned a_src_row(const Unit& u, int r) const { return (unsigned)(u.pm * BM + r); }
    __device__ __forceinline__ int koff(const Unit& u, int nt) const { return 0; }
    __device__ __forceinline__ int nkt(int bk) const { return (ks ? K / 2 : K) / bk; }
};
constexpr int LAY_OFF = 131072, LAY_CNT = 64, LAY_TILE = 128;
__device__ __forceinline__ void moe_layout(LAS unsigned char* lds, const unsigned* cnt) {
    LAS int* lay = (LAS int*)(lds + LAY_OFF);
    __syncthreads();
    if (threadIdx.x < NE) lay[LAY_CNT + threadIdx.x] = (int)__hip_atomic_load(cnt + 64 * threadIdx.x, RLX_AGENT);
    __syncthreads();
    if (threadIdx.x == 0) { int o = 0; for (int e = 0; e < NE; ++e) { lay[e] = o; o += (lay[LAY_CNT + e] + 255) / 256 * 256; } lay[NE] = o; }
    __syncthreads();
    for (int tl = threadIdx.x; tl < lay[NE] / 256; tl += NTHR) { int e = 0; for (int q = 1; q < NE; ++q) e = (tl * 256 >= lay[q]) ? q : e; lay[LAY_TILE + tl] = e; }
    __syncthreads();
}
struct GroupSched {
    const char* A; const char* Bt; int K, N, nM, nN, G, c, eb; const LAS int* lay; const int* rte;
    __device__ __forceinline__ void init(const void* A_, const void* Bt_, int ntiles, int N_, int K_, int G_, int c_, const LAS int* lay_, const int* rte_, int eb_ = 2) { A = (const char*)A_; Bt = (const char*)Bt_; eb = eb_; K = K_; N = N_; nM = ntiles; nN = N_ / BM; G = G_; c = c_; lay = lay_; rte = rte_; }
    __device__ __forceinline__ bool next(int i, Unit& u) const { if (!static_next(i, G, c, nM, nN, u)) return false; u.e = __builtin_amdgcn_readfirstlane(lay[LAY_TILE + u.pm]); return true; }
    __device__ __forceinline__ const char* a_base() const { return A; }
    __device__ __forceinline__ const char* b_base(const Unit& u) const { return eb == 1 ? Bt + ((size_t)u.e * nN + (size_t)u.pn) * (size_t)(K / 128) * 32768 : Bt + ((size_t)u.e * N + (size_t)u.pn * BM) * K * eb; }
    __device__ __forceinline__ int koff(const Unit& u, int nt) const { return (2 * u.pm) & (nt - 1); }
    __device__ __forceinline__ size_t a_off(const Unit& u) const { return 0; }
    __device__ __forceinline__ int nkt(int bk) const { return K / bk; }
    __device__ __forceinline__ unsigned a_src_row(const Unit& u, int r) const { if (!rte) return (unsigned)(u.pm * BM + r); const int pos = u.pm * BM + r - lay[u.e]; return pos < lay[LAY_CNT + u.e] ? (unsigned)ld_agent_i(rte + (size_t)u.e * T + pos) : (unsigned)T; }
};

template <class Epi, class Sched>
__device__ __forceinline__ void gemm_ref(LAS unsigned char* lds, const Sched& S, const Epi& E) {
    const int tid = threadIdx.x, tx = tid & 15, ty = tid >> 4, K = S.K;
    LAS float* As = (LAS float*)lds; LAS float* Bs = As + 16 * 260;
    const int lr = tid >> 1, kh = tid & 1;
    for (int i = 0;; ++i) {
        Unit u; if (!S.next(i, u)) break;
        float acc[8][16];
#pragma unroll
        for (int j = 0; j < 8; ++j)
#pragma unroll
            for (int q = 0; q < 16; ++q) acc[j][q] = 0.f;
        const char* Ab = S.a_base() + S.a_off(u) + ((size_t)S.a_src_row(u, lr) * K + 8 * kh) * 2;
        const char* Bb = S.b_base(u) + ((size_t)lr * K + 8 * kh) * 2;
        for (int k0 = 0; k0 < 16 * S.nkt(16); k0 += 16) {
            const bf16x8 av = *(const bf16x8*)(Ab + (size_t)k0 * 2), bv = *(const bf16x8*)(Bb + (size_t)k0 * 2);
            __syncthreads();
#pragma unroll
            for (int j = 0; j < 8; ++j) { As[(8 * kh + j) * 260 + lr] = bf2f((unsigned short)av[j]); Bs[(8 * kh + j) * 260 + lr] = bf2f((unsigned short)bv[j]); }
            __syncthreads();
#pragma unroll 4
            for (int kk = 0; kk < 16; ++kk) {
                float a[8], b[16];
#pragma unroll
                for (int j = 0; j < 8; ++j) a[j] = As[kk * 260 + ty + 32 * j];
                const f32x4 b0 = *(const LAS f32x4*)(Bs + kk * 260 + 8 * tx), b1 = *(const LAS f32x4*)(Bs + kk * 260 + 8 * tx + 4);
                const f32x4 b2 = *(const LAS f32x4*)(Bs + kk * 260 + 128 + 8 * tx), b3 = *(const LAS f32x4*)(Bs + kk * 260 + 128 + 8 * tx + 4);
#pragma unroll
                for (int q = 0; q < 4; ++q) { b[q] = b0[q]; b[4 + q] = b1[q]; b[8 + q] = b2[q]; b[12 + q] = b3[q]; }
#pragma unroll
                for (int j = 0; j < 8; ++j)
#pragma unroll
                    for (int q = 0; q < 16; ++q) acc[j][q] += a[j] * b[q];
            }
        }
#pragma unroll 8
        for (int j = 0; j < 8; ++j) {
            const f32x4 a0 = {acc[j][0], acc[j][1], acc[j][2], acc[j][3]}, a1 = {acc[j][4], acc[j][5], acc[j][6], acc[j][7]};
            const f32x4 b0 = {acc[j][8], acc[j][9], acc[j][10], acc[j][11]}, b1 = {acc[j][12], acc[j][13], acc[j][14], acc[j][15]};
            typename Epi::Ctx cx; E.load(u.pm * BM + ty + 32 * j, u, 8 * tx, cx); E.template fin<false>(u.pm * BM + ty + 32 * j, u, 8 * tx, cx, a0, a1, b0, b1);
        }
    }
    __syncthreads();
}

__device__ __forceinline__ void glds16s(const void* sbase, unsigned voff, unsigned lds_dst) {
    asm volatile("s_mov_b32 m0, %2\n\ts_nop 0\n\tglobal_load_lds_dwordx4 %1, %0" :: "s"(sbase), "v"(voff), "s"(lds_dst) : "memory", "m0");
}
typedef int i32x8 __attribute__((ext_vector_type(8)));
typedef int i32x4_t __attribute__((ext_vector_type(4)));
template <class Epi, class Sched, bool FP8 = false>
__device__ __forceinline__ void gemm_mfma(LAS unsigned char* lds, const Sched& S, const Epi& E, const bool do_epi = true) {
    const int tid = threadIdx.x, wid = __builtin_amdgcn_readfirstlane(tid >> 6), lane = tid & 63, wr = wid >> 2, wc = wid & 3, fr = lane & 15, fq = lane >> 4;
    const int K = S.K, nt = S.nkt(FP8 ? 128 : BK); const unsigned rowb = (unsigned)K * (FP8 ? 1u : 2u), rowbB = FP8 ? 128u : rowb;
    unsigned voffB[2];
#pragma unroll
    for (int i = 0; i < 2; ++i) { int R_, C_; if constexpr (FP8) stage_rc8(tid * 16 + i * 8192, R_, C_); else stage_rc(tid * 16 + i * 8192, R_, C_); const int Rb = (R_ & ~31) + perm32(R_ & 31); voffB[i] = (unsigned)Rb * rowbB + (unsigned)C_ * 2u; }
    const size_t kstep = (size_t)(BK * 2);
    const size_t kstepB = FP8 ? (size_t)32768 : kstep, hstep = (size_t)HALF * rowbB;
    const unsigned ldsw = (unsigned)wid * 1024u, lds0 = (unsigned)(uintptr_t)lds;
    const int aoff = FP8 ? lds_byte8(wr * 64 + fr, 2 * fq) : lds_byte(wr * 64 + fr, fq * 8), boff = FP8 ? lds_byte8(wc * 32 + fr, 2 * fq) : lds_byte(wc * 32 + fr, fq * 8);
    const int aoff1 = FP8 ? lds_byte8(wr * 64 + fr, 2 * fq + 1) : 0, boff1 = FP8 ? lds_byte8(wc * 32 + fr, 2 * fq + 1) : 0;

#define PG8_SA(b, h) (((b) * 2 + (h)) * HTB)
#define PG8_SB(b, h) ((4 + (b) * 2 + (h)) * HTB)
#define PG8_STAGE(bufoff, gbase, voff) do { _Pragma("unroll") for (int _i = 0; _i < 2; ++_i) \
        glds16s((const void*)(gbase), (voff)[_i], (unsigned)__builtin_amdgcn_readfirstlane((int)(lds0 + (unsigned)(bufoff) + ldsw + (unsigned)_i * 8192u))); } while (0)
#define PG8_LDA(dst, b, h) do { _Pragma("unroll") for (int m = 0; m < 4; ++m) { if constexpr (FP8) { const LAS unsigned char* _p = lds + PG8_SA(b, h) + m * 2048; \
            dst##8[m] = __builtin_shufflevector(*(const LAS i32x4_t*)(_p + aoff), *(const LAS i32x4_t*)(_p + aoff1), 0, 1, 2, 3, 4, 5, 6, 7); } \
        else { _Pragma("unroll") for (int k = 0; k < 2; ++k) dst[m][k] = *(const LAS bf16x8*)(lds + PG8_SA(b, h) + aoff + m * 2048 + k * 1024); } } } while (0)
#define PG8_LDB(dst, b, h) do { _Pragma("unroll") for (int n = 0; n < 2; ++n) { if constexpr (FP8) { const LAS unsigned char* _p = lds + PG8_SB(b, h) + n * 2048; \
            dst##8[n] = __builtin_shufflevector(*(const LAS i32x4_t*)(_p + boff), *(const LAS i32x4_t*)(_p + boff1), 0, 1, 2, 3, 4, 5, 6, 7); } \
        else { _Pragma("unroll") for (int k = 0; k < 2; ++k) dst[n][k] = *(const LAS bf16x8*)(lds + PG8_SB(b, h) + boff + n * 2048 + k * 1024); } } } while (0)
#define PG8_MMA(ai, bj, At, Bt) do { __builtin_amdgcn_s_setprio(1); _Pragma("unroll") for (int m = 0; m < 4; ++m) _Pragma("unroll") for (int n = 0; n < 2; ++n) { \
        if constexpr (FP8) { asm volatile("v_mfma_f32_16x16x128_f8f6f4 %0, %1, %2, %0" : "+v"(acc[ai][bj][m][n]) : "v"(Bt##8[n]), "v"(At##8[m])); } \
        else { _Pragma("unroll") for (int k = 0; k < 2; ++k) acc[ai][bj][m][n] = __builtin_amdgcn_mfma_f32_16x16x32_bf16(Bt[n][k], At[m][k], acc[ai][bj][m][n], 0, 0, 0); } } \
        __builtin_amdgcn_s_setprio(0); } while (0)
#define PG8_WAIT_V(n) asm volatile("s_waitcnt vmcnt(" #n ")" ::: "memory")
#define PG8_WAIT_L(n) asm volatile("s_waitcnt lgkmcnt(" #n ")" ::: "memory")
#define PG8_BAR __builtin_amdgcn_s_barrier()
#define PG8_SCHED __builtin_amdgcn_sched_barrier(0)
#define PG8_AOFF(dst, uu) do { _Pragma("unroll") for (int _i = 0; _i < 2; ++_i) { int _R, _C; if constexpr (FP8) stage_rc8(tid * 16 + _i * 8192, _R, _C); else stage_rc(tid * 16 + _i * 8192, _R, _C); _Pragma("unroll") for (int _h = 0; _h < 2; ++_h) dst[_h][_i] = S.a_src_row(uu, _h * HALF + _R) * rowb + (unsigned)_C * 2u; } } while (0)
    Unit cur, nxt; int ui = 0;
    if (!S.next(0, cur)) return;
    f32x4 acc[2][2][4][2];
#pragma unroll
    for (int a = 0; a < 2; ++a)
#pragma unroll
        for (int b = 0; b < 2; ++b)
#pragma unroll
            for (int m = 0; m < 4; ++m)
#pragma unroll
                for (int n = 0; n < 2; ++n) acc[a][b][m][n] = (f32x4){0.f, 0.f, 0.f, 0.f};
    bf16x8 At[4][2], B0[2][2], B1[2][2]; i32x8 At8[4], B08[2], B18[2];
    unsigned coff[2][2], noff[2][2];
    PG8_AOFF(coff, cur);
    const char* cA = S.a_base() + S.a_off(cur); const char* cB = S.b_base(cur);
    int ck = S.koff(cur, nt), nk = 0;
    PG8_STAGE(PG8_SB(0, 0), cB + ck * kstepB, voffB); PG8_STAGE(PG8_SB(0, 1), cB + hstep + ck * kstepB, voffB); PG8_STAGE(PG8_SA(0, 0), cA + ck * kstep, coff[0]); PG8_STAGE(PG8_SA(0, 1), cA + ck * kstep, coff[1]);
    if (wr == 1) PG8_BAR;
    PG8_WAIT_V(2); PG8_BAR;
    PG8_STAGE(PG8_SB(1, 0), cB + (ck + 1) * kstepB, voffB); PG8_STAGE(PG8_SA(1, 0), cA + (ck + 1) * kstep, coff[0]); PG8_STAGE(PG8_SB(1, 1), cB + hstep + (ck + 1) * kstepB, voffB);
    PG8_WAIT_V(6); PG8_BAR;
    for (;;) {
        const bool has_next = S.next(ui + 1, nxt);
        const char* nB = cB; const char* nA = cA;
#pragma unroll
        for (int _h = 0; _h < 2; ++_h)
#pragma unroll
            for (int _i = 0; _i < 2; ++_i) noff[_h][_i] = coff[_h][_i];
        nk = ck;
        if (has_next) { nB = S.b_base(nxt); nA = S.a_base() + S.a_off(nxt); PG8_AOFF(noff, nxt); nk = S.koff(nxt, nt); }
        for (int t = 0; t < nt; t += 2) {
            const bool last = (t == nt - 2);
            const int k1 = (t + 1 + ck) & (nt - 1), k2 = last ? nk : ((t + 2 + ck) & (nt - 1));
            const char* a1 = cA + (size_t)k1 * kstep;
            const char* a2 = (last ? nA : cA) + (size_t)k2 * kstep; const char* b2 = (last ? nB : cB) + (size_t)k2 * kstepB;
            const char* a3 = a2 + kstep; const char* b3 = b2 + kstepB;
            unsigned o2[2][2];
#pragma unroll
            for (int _h = 0; _h < 2; ++_h)
#pragma unroll
                for (int _i = 0; _i < 2; ++_i) o2[_h][_i] = last ? noff[_h][_i] : coff[_h][_i];
            PG8_LDB(B0, 0, 0); PG8_LDB(B1, 0, 1); PG8_SCHED; PG8_LDA(At, 0, 0); PG8_STAGE(PG8_SA(1, 1), a1, coff[1]);
            PG8_WAIT_V(8); PG8_WAIT_L(0); PG8_BAR; PG8_MMA(0, 0, At, B0); PG8_MMA(0, 1, At, B1); PG8_BAR; PG8_SCHED;
            PG8_LDA(At, 0, 1); PG8_STAGE(PG8_SB(0, 0), b2, voffB); PG8_STAGE(PG8_SB(0, 1), b2 + hstep, voffB); PG8_STAGE(PG8_SA(0, 0), a2, o2[0]);
            PG8_WAIT_V(8); PG8_WAIT_L(0); PG8_BAR; PG8_MMA(1, 0, At, B0); PG8_MMA(1, 1, At, B1); PG8_BAR; PG8_SCHED;
            PG8_LDB(B0, 1, 0); PG8_LDB(B1, 1, 1); PG8_SCHED; PG8_LDA(At, 1, 0); PG8_STAGE(PG8_SA(0, 1), a2, o2[1]);
            PG8_WAIT_V(8); PG8_WAIT_L(0); PG8_BAR; PG8_MMA(0, 0, At, B0); PG8_MMA(0, 1, At, B1); PG8_BAR; PG8_SCHED;
            PG8_LDA(At, 1, 1); PG8_STAGE(PG8_SB(1, 0), b3, voffB); PG8_STAGE(PG8_SB(1, 1), b3 + hstep, voffB); PG8_STAGE(PG8_SA(1, 0), a3, o2[0]);
            PG8_WAIT_V(8); PG8_WAIT_L(0); PG8_BAR; PG8_MMA(1, 0, At, B0); PG8_MMA(1, 1, At, B1); PG8_BAR; PG8_SCHED;
        }
#ifndef ALIGN_EPI
#define ALIGN_EPI 1
#endif
        if (ALIGN_EPI && wr == 0) PG8_BAR;
        if constexpr (FP8) asm volatile("s_nop 15\n\ts_nop 15" ::: "memory");
        if (do_epi) {
            constexpr int NB = Epi::NB; const int rbase = cur.pm * BM + wr * 64 + fr, c0 = wc * 32 + 8 * fq;
#pragma unroll
            for (int g0 = 0; g0 < 8; g0 += NB) {
                typename Epi::Ctx cx[NB];
#pragma unroll
                for (int i = 0; i < NB; ++i) E.load(rbase + ((g0 + i) >> 2) * HALF + ((g0 + i) & 3) * 16, cur, c0, cx[i]);
#pragma unroll
                for (int i = 0; i < NB; ++i) { const int ai = (g0 + i) >> 2, m = (g0 + i) & 3;
                    E.template fin<true>(rbase + ai * HALF + m * 16, cur, c0, cx[i], acc[ai][0][m][0], acc[ai][0][m][1], acc[ai][1][m][0], acc[ai][1][m][1]); }
            }
        }
        if (!has_next) break;
#pragma unroll
        for (int a = 0; a < 2; ++a)
#pragma unroll
            for (int b = 0; b < 2; ++b)
#pragma unroll
                for (int m = 0; m < 4; ++m)
#pragma unroll
                    for (int n = 0; n < 2; ++n) acc[a][b][m][n] = (f32x4){0.f, 0.f, 0.f, 0.f};
        cur = nxt; cB = nB; cA = nA; ck = nk;
#pragma unroll
        for (int _h = 0; _h < 2; ++_h)
#pragma unroll
            for (int _i = 0; _i < 2; ++_i) coff[_h][_i] = noff[_h][_i];
        ++ui;
        if (ALIGN_EPI && wr == 1) PG8_BAR;
    }
    PG8_WAIT_V(0);
    if (!ALIGN_EPI && wr == 0) PG8_BAR;
    PG8_BAR;
#undef PG8_SA
#undef PG8_SB
#undef PG8_STAGE
#undef PG8_LDA
#undef PG8_LDB
#undef PG8_MMA
#undef PG8_WAIT_V
#undef PG8_WAIT_L
#undef PG8_BAR
#undef PG8_SCHED
#undef PG8_AOFF
}
#ifndef SKEW_TICKS
#define SKEW_TICKS 0
#endif
__device__ __forceinline__ void phase_skew(int bid) {
    if (SKEW_TICKS > 0 && (bid & 1)) { const unsigned long long t0 = __builtin_amdgcn_s_memrealtime(); while (__builtin_amdgcn_s_memrealtime() - t0 < (unsigned long long)SKEW_TICKS) __builtin_amdgcn_s_sleep(8); }
}
template <class Epi, class Sched, bool FP8 = false>
__device__ __forceinline__ void gemm_any(LAS unsigned char* lds, const Sched& S, const Epi& E, const bool do_epi = true) {
#if OPT_GEMM
    gemm_mfma<Epi, Sched, FP8>(lds, S, E, do_epi);
#else
    gemm_ref<Epi, Sched>(lds, S, E);
#endif
}

__device__ __forceinline__ void st_bf8(bf16* p, f32x4 a, f32x4 b) { *(u32x4*)p = pack8(a, b); }
__device__ __forceinline__ void ld_bf8(const bf16* p, f32x4& a, f32x4& b) { unpack8(*(const u32x4*)p, a, b); }
constexpr float W8_SCALE = 128.0f, H8_SCALE = 8.0f, A8_SCALE = 4.0f;

struct EpiInProj {
    static constexpr int NB = 1; struct Ctx { int dummy; };
    bf16 *Q, *Kk, *V, *SR, *CB, *U, *SGA, *SGB;
    __device__ __forceinline__ void load(int row, const Unit& u, int c0, Ctx& c) const {}
    template <bool MF> __device__ __forceinline__ void fin(int row, const Unit& u, int c0, const Ctx& c, f32x4 a0, f32x4 a1, f32x4 b0, f32x4 b1) const {
        const int pn = u.pn;
        if (pn >= TN_U && pn < TN_GA) { st_bf8(U + (size_t)row * D + (pn - TN_U) * 128 + c0, a0 * b0, a1 * b1); return; }
        bf16* base; int ld, ct, mode = 0; float sc = 1.0f;
        if (pn < TN_K) { base = Q; ld = QK; ct = pn - TN_Q; sc = 0.0625f; }
        else if (pn < TN_V) { base = Kk; ld = QK; ct = pn - TN_K; }
        else if (pn < TN_R) { base = V; ld = VD; ct = pn - TN_V; }
        else if (pn < TN_CB) { base = SR; ld = VD; ct = pn - TN_R; mode = 1; }
        else if (pn < TN_U) { base = CB; ld = D; ct = pn - TN_CB; }
        else if (pn < TN_GB) { base = SGA; ld = D; ct = pn - TN_GA; mode = 2; }
        else { base = SGB; ld = D; ct = pn - TN_GB; mode = 2; }
        if (mode) {
#pragma unroll
            for (int j = 0; j < 4; ++j) { const float s0 = sigmoidf_(a0[j]), s1 = sigmoidf_(a1[j]), s2 = sigmoidf_(b0[j]), s3 = sigmoidf_(b1[j]);
                a0[j] = (mode == 1) ? a0[j] * s0 : s0; a1[j] = (mode == 1) ? a1[j] * s1 : s1; b0[j] = (mode == 1) ? b0[j] * s2 : s2; b1[j] = (mode == 1) ? b1[j] * s3 : s3; }
        } else { a0 *= sc; a1 *= sc; b0 *= sc; b1 *= sc; }
        bf16* p = base + (size_t)row * ld + ct * 256 + c0; st_bf8(p, a0, a1); st_bf8(p + 128, b0, b1);
    }
};
struct EpiGateA {
    static constexpr int NB = 4; struct Ctx { u32x4 s0, s1; };
    bf16* T1; const bf16* SGA;
    __device__ __forceinline__ void load(int row, const Unit& u, int c0, Ctx& c) const { const size_t o = (size_t)row * D + u.pn * 256 + c0; c.s0 = *(const u32x4*)(SGA + o); c.s1 = *(const u32x4*)(SGA + o + 128); }
    template <bool MF> __device__ __forceinline__ void fin(int row, const Unit& u, int c0, const Ctx& c, f32x4 a0, f32x4 a1, f32x4 b0, f32x4 b1) const {
        const size_t o = (size_t)row * D + u.pn * 256 + c0; f32x4 g0, g1, g2, g3; unpack8(c.s0, g0, g1); unpack8(c.s1, g2, g3);
        st_bf8(T1 + o, a0 * g0, a1 * g1); st_bf8(T1 + o + 128, b0 * g2, b1 * g3);
    }
};
struct EpiGateB {
    static constexpr int NB = 2; struct Ctx { u32x4 s0, s1, t0, t1; };
    const bf16* T1; const bf16* SGB; bf16* MG;
    __device__ __forceinline__ void load(int row, const Unit& u, int c0, Ctx& c) const { const size_t o = (size_t)row * D + u.pn * 256 + c0; c.s0 = *(const u32x4*)(SGB + o); c.s1 = *(const u32x4*)(SGB + o + 128); c.t0 = *(const u32x4*)(T1 + o); c.t1 = *(const u32x4*)(T1 + o + 128); }
    template <bool MF> __device__ __forceinline__ void fin(int row, const Unit& u, int c0, const Ctx& c, f32x4 a0, f32x4 a1, f32x4 b0, f32x4 b1) const {
        const size_t o = (size_t)row * D + u.pn * 256 + c0; f32x4 g0, g1, g2, g3, t0, t1, t2, t3; unpack8(c.s0, g0, g1); unpack8(c.s1, g2, g3); unpack8(c.t0, t0, t1); unpack8(c.t1, t2, t3);
        st_bf8(MG + o, t0 + a0 * g0, t1 + a1 * g1); st_bf8(MG + o + 128, t2 + b0 * g2, t3 + b1 * g3);
    }
};
#if OPT_GEMM
constexpr int SSP_N = 32;
#else
constexpr int SSP_N = 128;
#endif
struct EpiResid1 {
    static constexpr int NB = 4; struct Ctx { f32x4 x0, x1, x2, x3; };
    const float* X; bf16* XB; float* SSP;
    __device__ __forceinline__ void load(int row, const Unit& u, int c0, Ctx& c) const { const size_t o = (size_t)row * D + u.pn * 256 + c0; c.x0 = *(const f32x4*)(X + o); c.x1 = *(const f32x4*)(X + o + 4); c.x2 = *(const f32x4*)(X + o + 128); c.x3 = *(const f32x4*)(X + o + 132); }
    template <bool MF> __device__ __forceinline__ void fin(int row, const Unit& u, int c0, const Ctx& c, f32x4 a0, f32x4 a1, f32x4 b0, f32x4 b1) const {
        const size_t o = (size_t)row * D + u.pn * 256 + c0;
        a0 += c.x0; a1 += c.x1; b0 += c.x2; b1 += c.x3;
        st_bf8(XB + o, a0, a1); st_bf8(XB + o + 128, b0, b1);
        float s = 0.f;
#pragma unroll
        for (int j = 0; j < 4; ++j) s += a0[j] * a0[j] + a1[j] * a1[j] + b0[j] * b0[j] + b1[j] * b1[j];
        if (MF) { s += __shfl_xor(s, 16); s += __shfl_xor(s, 32); if ((threadIdx.x & 63) < 16) SSP[(size_t)row * SSP_N + 4 * u.pn + (c0 >> 5)] = s; }
        else SSP[(size_t)row * SSP_N + 16 * u.pn + (c0 >> 3)] = s;
    }
};
constexpr ptrdiff_t QX_HALF = ((ptrdiff_t)WS_O32 - (ptrdiff_t)WS_QX) / 2;
struct EpiXQ {
    static constexpr int NB = 8; struct Ctx { float r; };
    bf16* QX; const float* SSP;
    __device__ __forceinline__ void load(int row, const Unit& u, int c0, Ctx& c) const {
        const float* sp = SSP + (size_t)row * SSP_N; f32x4 t = *(const f32x4*)sp;
#pragma unroll
        for (int j = 1; j < SSP_N / 4; ++j) t += *(const f32x4*)(sp + 4 * j);
        c.r = rsqrtf(((t[0] + t[1]) + (t[2] + t[3])) * (1.0f / D) + EPS);
    }
    template <bool MF> __device__ __forceinline__ void fin(int row, const Unit& u, int c0, const Ctx& c, f32x4 a0, f32x4 a1, f32x4 b0, f32x4 b1) const {
        bf16* p = QX + (ptrdiff_t)u.e * QX_HALF + (size_t)row * XA + u.pn * 256 + c0; st_bf8(p, a0 * c.r, a1 * c.r); st_bf8(p + 128, b0 * c.r, b1 * c.r);
    }
};
struct EpiResid2 {
    static constexpr int NB = 8; struct Ctx { u32x4 x0, x1; };
    bf16* XB;
    __device__ __forceinline__ void load(int row, const Unit& u, int c0, Ctx& c) const { const bf16* p = XB + (size_t)row * D + u.pn * 256 + c0; c.x0 = *(const u32x4*)p; c.x1 = *(const u32x4*)(p + 128); }
    template <bool MF> __device__ __forceinline__ void fin(int row, const Unit& u, int c0, const Ctx& c, f32x4 a0, f32x4 a1, f32x4 b0, f32x4 b1) const {
        bf16* p = XB + (size_t)row * D + u.pn * 256 + c0; f32x4 x0, x1, x2, x3; unpack8(c.x0, x0, x1); unpack8(c.x1, x2, x3);
        st_bf8(p, x0 + a0, x1 + a1); st_bf8(p + 128, x2 + b0, x3 + b1);
    }
};
struct EpiGU8 {
    static constexpr int NB = 8; struct Ctx { f32x4 g0, g1, u0, u1; };
    unsigned char* ACT8; const float* gub;
    __device__ __forceinline__ void load(int row, const Unit& u, int c0, Ctx& c) const { const float* bg = gub + (size_t)u.e * (2 * FF) + u.pn * 128 + c0; c.g0 = *(const f32x4*)bg; c.g1 = *(const f32x4*)(bg + 4); c.u0 = *(const f32x4*)(bg + FF); c.u1 = *(const f32x4*)(bg + FF + 4); }
    template <bool MF> __device__ __forceinline__ void fin(int row, const Unit& u, int c0, const Ctx& c, f32x4 a0, f32x4 a1, f32x4 b0, f32x4 b1) const {
        const int f = u.pn * 128 + c0; const float is = 1.0f / (W8_SCALE * H8_SCALE);
        f32x4 r0, r1;
#pragma unroll
        for (int j = 0; j < 4; ++j) {
            float g = fminf(a0[j] * is + c.g0[j], 7.0f), up = fminf(fmaxf(b0[j] * is + c.u0[j], -7.0f), 7.0f); r0[j] = (up + 1.0f) * g * sigmoidf_(1.702f * g) * A8_SCALE;
            g = fminf(a1[j] * is + c.g1[j], 7.0f); up = fminf(fmaxf(b1[j] * is + c.u1[j], -7.0f), 7.0f); r1[j] = (up + 1.0f) * g * sigmoidf_(1.702f * g) * A8_SCALE;
        }
        u32x2 o; o.x = pk4_fp8(r0[0], r0[1], r0[2], r0[3]); o.y = pk4_fp8(r1[0], r1[1], r1[2], r1[3]);
        *(u32x2*)(ACT8 + (size_t)row * FF + f) = o;
    }
};
constexpr float Y8_SCALE = 16.0f;
struct EpiDown8 {
    static constexpr int NB = 8; struct Ctx { f32x4 b0, b1, b2, b3; };
    unsigned char* YS; const float* dnb;
    __device__ __forceinline__ void load(int row, const Unit& u, int c0, Ctx& c) const { const float* bb = dnb + (size_t)u.e * D + u.pn * 256 + c0; c.b0 = *(const f32x4*)bb; c.b1 = *(const f32x4*)(bb + 4); c.b2 = *(const f32x4*)(bb + 128); c.b3 = *(const f32x4*)(bb + 132); }
    template <bool MF> __device__ __forceinline__ void fin(int row, const Unit& u, int c0, const Ctx& c, f32x4 a0, f32x4 a1, f32x4 b0, f32x4 b1) const {
        unsigned char* p = YS + (size_t)row * D + u.pn * 256 + c0; const float is = Y8_SCALE / (W8_SCALE * A8_SCALE);
        a0 = a0 * is + c.b0 * Y8_SCALE; a1 = a1 * is + c.b1 * Y8_SCALE; b0 = b0 * is + c.b2 * Y8_SCALE; b1 = b1 * is + c.b3 * Y8_SCALE;
        u32x2 o; o.x = pk4_fp8(a0[0], a0[1], a0[2], a0[3]); o.y = pk4_fp8(a1[0], a1[1], a1[2], a1[3]); *(u32x2*)p = o;
        o.x = pk4_fp8(b0[0], b0[1], b0[2], b0[3]); o.y = pk4_fp8(b1[0], b1[1], b1[2], b1[3]); *(u32x2*)(p + 128) = o;
    }
};

__device__ __forceinline__ void tr_item_fp8(const float* W, int ldw, int K, int srccol0, unsigned char* WT, int dstrow0, LAS float* scr, int kb, int lane) {
    const int k0 = 128 * kb;
#pragma unroll 8
    for (int i = 0; i < 64; ++i) { const int kk = 2 * i + (lane >> 5); scr[kk * 33 + (lane & 31)] = W[(size_t)(k0 + kk) * ldw + srccol0 + (lane & 31)] * W8_SCALE; }
    LDS_WAIT(); asm volatile("" ::: "memory");
    const int c = lane & 7;
#pragma unroll
    for (int j = 0; j < 4; ++j) { const int n = (lane >> 3) + 8 * j; const LAS float* s = scr + (16 * c) * 33 + n;
        u32x4 o; o.x = pk4_fp8(s[0 * 33], s[1 * 33], s[2 * 33], s[3 * 33]); o.y = pk4_fp8(s[4 * 33], s[5 * 33], s[6 * 33], s[7 * 33]);
        o.z = pk4_fp8(s[8 * 33], s[9 * 33], s[10 * 33], s[11 * 33]); o.w = pk4_fp8(s[12 * 33], s[13 * 33], s[14 * 33], s[15 * 33]);
        *(u32x4*)(WT + (size_t)(dstrow0 + n) * K + k0 + 16 * c) = o; }
    LDS_WAIT(); asm volatile("" ::: "memory");
}
__device__ __forceinline__ void tr_item(const float* W, int ldw, int K, int srccol0, bf16* WT, int dstrow0, const float* ksc, LAS float* scr, int kb, int lane) {
    const int k0 = 64 * kb;
    float v[32];
#pragma unroll
    for (int i = 0; i < 32; ++i) v[i] = __builtin_nontemporal_load(W + (size_t)(k0 + 2 * i + (lane >> 5)) * ldw + srccol0 + (lane & 31));
#pragma unroll
    for (int i = 0; i < 32; ++i) { const int kk = 2 * i + (lane >> 5); scr[kk * 33 + (lane & 31)] = ksc ? v[i] * ksc[k0 + kk] : v[i]; }
    LDS_WAIT(); asm volatile("" ::: "memory");
    const int c = lane & 7;
#pragma unroll
    for (int j = 0; j < 4; ++j) { const int n = (lane >> 3) + 8 * j; const LAS float* s = scr + (8 * c) * 33 + n;
        u32x4 o; o.x = pk2(s[0 * 33], s[1 * 33]); o.y = pk2(s[2 * 33], s[3 * 33]); o.z = pk2(s[4 * 33], s[5 * 33]); o.w = pk2(s[6 * 33], s[7 * 33]);
        *(u32x4*)(WT + (size_t)(dstrow0 + n) * K + k0 + 8 * c) = o; }
    LDS_WAIT(); asm volatile("" ::: "memory");
}
__device__ __forceinline__ void tr8_load(const float* W, int ldw, int srccol0, int kb32, int lane, f32x4 (&v)[8]) {
    const char* base = (const char*)(W + (size_t)(32 * kb32) * ldw + srccol0);
    const unsigned voff = (unsigned)((lane >> 4) * ldw + 4 * (lane & 15)) * 4u;
#pragma unroll
    for (int i = 0; i < 8; ++i) v[i] = __builtin_nontemporal_load((const f32x4*)(base + (size_t)(4 * i) * ldw * 4 + voff));
}
__device__ __forceinline__ void tr8_quarter(const f32x4 (&v)[8], LAS float* scr, int lane, u32x4 (&o)[2]) {
    LAS float* w = scr + (lane >> 4) * 68 + 4 * (lane & 15);
#pragma unroll
    for (int i = 0; i < 8; ++i) *(LAS f32x4*)(w + 4 * i * 68) = v[i] * W8_SCALE;
    LDS_WAIT(); asm volatile("" ::: "memory");
    const LAS float* s = scr + lane;
    o[0].x = pk4_fp8(s[0 * 68], s[1 * 68], s[2 * 68], s[3 * 68]); o[0].y = pk4_fp8(s[4 * 68], s[5 * 68], s[6 * 68], s[7 * 68]);
    o[0].z = pk4_fp8(s[8 * 68], s[9 * 68], s[10 * 68], s[11 * 68]); o[0].w = pk4_fp8(s[12 * 68], s[13 * 68], s[14 * 68], s[15 * 68]);
    o[1].x = pk4_fp8(s[16 * 68], s[17 * 68], s[18 * 68], s[19 * 68]); o[1].y = pk4_fp8(s[20 * 68], s[21 * 68], s[22 * 68], s[23 * 68]);
    o[1].z = pk4_fp8(s[24 * 68], s[25 * 68], s[26 * 68], s[27 * 68]); o[1].w = pk4_fp8(s[28 * 68], s[29 * 68], s[30 * 68], s[31 * 68]);
    LDS_WAIT(); asm volatile("" ::: "memory");
}
__device__ __forceinline__ void tr8_store(const u32x4 (&pc)[4][2], unsigned char* WT, int K, int dstrow0, int kb, LAS float* scr, int lane) {
    LAS unsigned* t = (LAS unsigned*)scr;
    LAS unsigned* wl = t + lane * 33;
#pragma unroll
    for (int q = 0; q < 4; ++q)
#pragma unroll
        for (int j = 0; j < 2; ++j) { LAS unsigned* d = wl + 8 * q + 4 * j; const u32x4 x = pc[q][j]; d[0] = x.x; d[1] = x.y; d[2] = x.z; d[3] = x.w; }
    LDS_WAIT(); asm volatile("" ::: "memory");
    const LAS unsigned* rl = t + (lane >> 3) * 33 + 4 * (lane & 7);
    unsigned char* gb = WT + ((size_t)((dstrow0 >> 8) * (K >> 7) + kb) * 256 + (dstrow0 & 255)) * 128;
    const unsigned gvo = (unsigned)((lane >> 3) * 128 + 16 * (lane & 7));
#pragma unroll
    for (int j = 0; j < 8; ++j) { const LAS unsigned* sdw = rl + 8 * 33 * j;
        const u32x4 x = {sdw[0], sdw[1], sdw[2], sdw[3]};
        __builtin_nontemporal_store(x, (u32x4*)(gb + 1024 * j + gvo)); }
    LDS_WAIT(); asm volatile("" ::: "memory");
}
__device__ __forceinline__ void ex8_decode(const Frame& F, int sup, const float*& W, int& ldw, int& src, unsigned char*& WT, int& K, int& dst, int& kb) {
    if (sup < NE * 1024) { const int e = sup / 1024, r = sup % 1024, nb = r % 64, p = nb >> 2, w = (nb & 3) * 64; kb = r / 64;
        W = F.in[I_GUW] + (size_t)e * D * (2 * FF); ldw = 2 * FF; src = (w < 128) ? 128 * p + w : FF + 128 * p + (w - 128); WT = WSP(unsigned char, WS_WGU) + (size_t)e * (2 * FF) * D; K = D; dst = 64 * nb; }
    else { const int s2 = sup - NE * 1024, e = s2 / 512, r = s2 % 512, nb = r % 32; kb = r / 32;
        W = F.in[I_DNW] + (size_t)e * FF * D; ldw = D; src = 64 * nb; WT = WSP(unsigned char, WS_WDN) + (size_t)e * D * FF; K = FF; dst = 64 * nb; }
}
__device__ __forceinline__ void rms_row_to_bf16(const float* xrow, const float* g, bf16* orow, int lane) {
    f32x4 v[8]; float s = 0.f;
#pragma unroll
    for (int j = 0; j < 8; ++j) { v[j] = *(const f32x4*)(xrow + 4 * lane + 256 * j); s += (v[j][0] * v[j][0] + v[j][1] * v[j][1]) + (v[j][2] * v[j][2] + v[j][3] * v[j][3]); }
    const float r = rsqrtf(wave_sum(s) * (1.0f / D) + EPS);
#pragma unroll
    for (int j = 0; j < 8; ++j) { const f32x4 gg = *(const f32x4*)(g + 4 * lane + 256 * j); u32x2 o; o.x = pk2(v[j][0] * r * gg[0], v[j][1] * r * gg[1]); o.y = pk2(v[j][2] * r * gg[2], v[j][3] * r * gg[3]); *(u32x2*)(orow + 4 * lane + 256 * j) = o; }
}
__device__ __forceinline__ void p0_prologue(Frame& F, const int part, const int cb, const int CNG) {
    LAS float* scr = (LAS float*)(F.lds + F.wave * 16896);
    const int gw = cb * NWAVES + F.wave, NGW = CNG * NWAVES, lane = F.lane, gt = cb * NTHR + F.tid, NGT = CNG * NTHR;
    const float* Win = F.in[I_WIN];
    bf16* WIN = WSP(bf16, WS_WIN);
    if (part == 0) {
    for (int it = gw; it < 512 * 32; it += NGW) {
        const int nb = it % 512, kb = it / 512, n0 = 32 * nb;
        int src;
        if (n0 < TN_CB * 256) src = n0;
        else if (n0 < TN_U * 256) src = SRC_CB + (n0 - TN_CB * 256);
        else if (n0 < TN_GA * 256) { const int rel = n0 - TN_U * 256, p = rel >> 8, w = rel & 255; src = (w < 128) ? SRC_CC + 128 * p + w : SRC_CHH + 128 * p + (w - 128); }
        else if (n0 < TN_GB * 256) src = SRC_GA + (n0 - TN_GA * 256);
        else src = SRC_GB + (n0 - TN_GB * 256);
        tr_item(Win, NIN_SRC, D, src, WIN, n0, nullptr, scr, kb, lane);
    }
    for (int it = gw; it < 32; it += NGW) tr_item(Win, NIN_SRC, D, SRC_ALOW, WSP(bf16, WS_WAL), 0, nullptr, scr, it, lane);
    { const float* GW = F.in[I_GGW]; bf16* WGW = WSP(bf16, WS_WGW); for (int i = gt; i < QK * 32; i += NGT) { const int n = i >> 5, k = i & 31; WGW[i] = (k < 16) ? (bf16)f2bf(GW[k * QK + n]) : (bf16)0; } }
    }
    if (part == 1) {
    for (int it = gw; it < 3 * 2048; it += NGW) { const int w = it / 2048, r = it % 2048, nb = r % 64, kb = r / 64;
        const float* W = F.in[w == 0 ? I_GOW : (w == 1 ? I_COW : I_MXW)]; bf16* WT = WSP(bf16, w == 0 ? WS_WGO : (w == 1 ? WS_WCO : WS_WMX));
        tr_item(W, D, D, 32 * nb, WT, 32 * nb, nullptr, scr, kb, lane); }
    for (int it = gw; it < 3 * 512; it += NGW) { const int w = it / 512, r = it % 512, nb = r % 16, kb = r / 16;
        if (w == 0) tr_item(F.in[I_XQ], XA, D, 32 * nb, WSP(bf16, WS_WXQ), 32 * nb, F.in[I_NXG], scr, kb, lane);
        else tr_item(F.in[w == 1 ? I_XK : I_XV], XA, D, 32 * nb, WSP(bf16, WS_WXKV), (w - 1) * XA + 32 * nb, nullptr, scr, kb, lane); }
    for (int it = gw; it < 512; it += NGW) { const int nb = it % 64, kb = it / 64; tr_item(F.in[I_XO], D, XA, 32 * nb, WSP(bf16, WS_WXO), 32 * nb, nullptr, scr, kb, lane); }
#if MOE_FP8
    { LAS float* scr8 = (LAS float*)(F.lds + F.wave * 16896);
      constexpr int NSUP = NE * 1024 + NE * 512;
      f32x4 va[8], vb[8]; u32x4 pc[4][2];
      const float* W; int ldw, src, K, dst, kb; unsigned char* WT;
      if (gw < NSUP) { ex8_decode(F, gw, W, ldw, src, WT, K, dst, kb); tr8_load(W, ldw, src, 4 * kb + 0, lane, va); }
      for (int sup = gw; sup < NSUP; sup += NGW) {
          tr8_load(W, ldw, src, 4 * kb + 1, lane, vb); tr8_quarter(va, scr8, lane, pc[0]);
          tr8_load(W, ldw, src, 4 * kb + 2, lane, va); tr8_quarter(vb, scr8, lane, pc[1]);
          tr8_load(W, ldw, src, 4 * kb + 3, lane, vb); tr8_quarter(va, scr8, lane, pc[2]);
          const float* W1 = W; int ldw1 = ldw, src1 = src, K1 = K, dst1 = dst, kb1 = kb; unsigned char* WT1 = WT;
          if (sup + NGW < NSUP) { ex8_decode(F, sup + NGW, W1, ldw1, src1, WT1, K1, dst1, kb1); tr8_load(W1, ldw1, src1, 4 * kb1 + 0, lane, va); }
          tr8_quarter(vb, scr8, lane, pc[3]);
          tr8_store(pc, WT, K, dst, kb, scr8, lane);
          W = W1; ldw = ldw1; src = src1; K = K1; dst = dst1; kb = kb1; WT = WT1;
      } }
#endif
    { const float* rw = F.in[I_RW]; const float* g = F.in[I_NMOEG]; float* WR = WSP(float, WS_WR);
      for (int i = gt; i < NE * D; i += NGT) { const int e = i / D, k = i % D; WR[i] = rw[k * NE + e] * g[k]; } }
    }
    if (part == 0) {
    for (int m = gw; m < T; m += 2 * NGW) {
        const float* x0 = F.in[I_X] + (size_t)m * D; const bool two = (m + NGW < T); const float* x1 = F.in[I_X] + (size_t)(two ? m + NGW : m) * D; const float* gmix = F.in[I_NMIXG];
        f32x4 v0[8], v1[8]; float s0 = 0.f, s1 = 0.f;
#pragma unroll
        for (int j = 0; j < 8; ++j) { v0[j] = *(const f32x4*)(x0 + 4 * lane + 256 * j); v1[j] = *(const f32x4*)(x1 + 4 * lane + 256 * j); }
#pragma unroll
        for (int j = 0; j < 8; ++j) { s0 += (v0[j][0] * v0[j][0] + v0[j][1] * v0[j][1]) + (v0[j][2] * v0[j][2] + v0[j][3] * v0[j][3]); s1 += (v1[j][0] * v1[j][0] + v1[j][1] * v1[j][1]) + (v1[j][2] * v1[j][2] + v1[j][3] * v1[j][3]); }
        const float r0 = rsqrtf(wave_sum(s0) * (1.0f / D) + EPS), r1 = rsqrtf(wave_sum(s1) * (1.0f / D) + EPS);
        bf16* o0 = WSP(bf16, WS_XN) + (size_t)m * D; bf16* o1 = WSP(bf16, WS_XN) + (size_t)(m + NGW) * D;
#pragma unroll
        for (int j = 0; j < 8; ++j) { const f32x4 gg = *(const f32x4*)(gmix + 4 * lane + 256 * j);
            u32x2 a; a.x = pk2(v0[j][0] * r0 * gg[0], v0[j][1] * r0 * gg[1]); a.y = pk2(v0[j][2] * r0 * gg[2], v0[j][3] * r0 * gg[3]); *(u32x2*)(o0 + 4 * lane + 256 * j) = a;
            if (two) { u32x2 b; b.x = pk2(v1[j][0] * r1 * gg[0], v1[j][1] * r1 * gg[1]); b.y = pk2(v1[j][2] * r1 * gg[2], v1[j][3] * r1 * gg[3]); *(u32x2*)(o1 + 4 * lane + 256 * j) = b; } }
    }
    }
    if (part == 1) {
    for (int m = gw; m < MEM; m += NGW) rms_row_to_bf16(F.in[I_MEM] + (size_t)m * D, F.in[I_NMG], WSP(bf16, WS_MEMN) + (size_t)m * D, lane);
    { u32x4* z = (u32x4*)(WSP(bf16, WS_H3) + (size_t)T * D); u32x4* z8 = (u32x4*)(WSP(unsigned char, WS_H3) + (size_t)T * D); for (int i = gt; i < 256; i += NGT) { z[i] = (u32x4){0u, 0u, 0u, 0u}; z8[i] = (u32x4){0u, 0u, 0u, 0u}; } }
    }
}

__device__ __forceinline__ void p_memkv(Frame& F) {
    const bf16* A = WSP(bf16, WS_MEMN); const bf16* B = WSP(bf16, WS_WXKV); bf16* KM = WSP(bf16, WS_KM); bf16* VMT = WSP(bf16, WS_VMT);
    LAS f32x4* red = (LAS f32x4*)F.lds;
    const int lane = F.lane, w = F.wave, lr = lane & 15, lg = lane >> 4;
    for (int unit = F.bid; unit < (MEM / 16) * (2 * XA / 64); unit += F.G) {
        const int mt = unit & 15, nt = unit >> 4; const bool isk = nt < 8;
        const bf16* ap = A + (size_t)(16 * mt + lr) * D + 256 * w + 8 * lg; const bf16* bp = B + (size_t)(64 * nt + lr) * D + 256 * w + 8 * lg;
        bf16x8 af[8], bf[4][8];
#pragma unroll
        for (int s = 0; s < 8; ++s) { af[s] = *(const bf16x8*)(ap + 32 * s);
#pragma unroll
            for (int j = 0; j < 4; ++j) bf[j][s] = *(const bf16x8*)(bp + (size_t)(16 * j) * D + 32 * s); }
        f32x4 acc[4];
#pragma unroll
        for (int j = 0; j < 4; ++j) { acc[j] = (f32x4){0.f, 0.f, 0.f, 0.f};
#pragma unroll
            for (int s = 0; s < 8; ++s) acc[j] = isk ? MFMA16(bf[j][s], af[s], acc[j]) : MFMA16(af[s], bf[j][s], acc[j]); }
        __syncthreads();
#pragma unroll
        for (int j = 0; j < 4; ++j) red[(w * 4 + j) * 64 + lane] = acc[j];
        __syncthreads();
        if (w < 4) { f32x4 t = red[w * 64 + lane];
#pragma unroll
            for (int ww = 1; ww < 8; ++ww) t += red[(ww * 4 + w) * 64 + lane];
            u32x2 o; o.x = pk2(t[0], t[1]); o.y = pk2(t[2], t[3]);
            if (isk) *(u32x2*)(KM + (size_t)(16 * mt + lr) * XA + 64 * nt + 16 * w + 4 * lg) = o;
            else *(u32x2*)(VMT + (size_t)(64 * nt - XA + 16 * w + lr) * MEM + 16 * mt + 4 * lg) = o;
        }
    }
    __syncthreads();
}

__device__ __forceinline__ void p_alow(Frame& F) {
    const bf16* XN = WSP(bf16, WS_XN); const bf16* WAL = WSP(bf16, WS_WAL); const bf16* WGW = WSP(bf16, WS_WGW); const float* GB = F.in[I_GGB]; float* LA = WSP(float, WS_LA);
    LAS f32x4* red = (LAS f32x4*)F.lds;
    const int lane = F.lane, lr = lane & 15, lg = lane >> 4, tk = F.wave >> 1, kh = F.wave & 1;
    for (int t4 = F.bid; t4 < T / 64; t4 += F.G) {
        const int task = 4 * t4 + tk;
        const bf16* ap = WAL + (size_t)lr * D + 1024 * kh + 8 * lg; const bf16* bp = XN + (size_t)(16 * task + lr) * D + 1024 * kh + 8 * lg;
        f32x4 acc = {0.f, 0.f, 0.f, 0.f};
#pragma unroll 16
        for (int s = 0; s < 32; ++s) acc = MFMA16(*(const bf16x8*)(ap + 32 * s), *(const bf16x8*)(bp + 32 * s), acc);
        __syncthreads();
        red[(tk * 2 + kh) * 64 + lane] = acc;
        __syncthreads();
#if OPT_GLA
        if (kh == 0) *(f32x4*)(WSP(float, WS_ALOW) + (size_t)(16 * task + lr) * 16 + 4 * lg) = red[(tk * 2) * 64 + lane] + red[(tk * 2 + 1) * 64 + lane];
        continue;
#endif
        u32x4 bw = {0u, 0u, 0u, 0u};
        if (lg < 2) { const f32x4 x0 = red[(tk * 2) * 64 + lr + 32 * lg] + red[(tk * 2 + 1) * 64 + lr + 32 * lg], x1 = red[(tk * 2) * 64 + lr + 32 * lg + 16] + red[(tk * 2 + 1) * 64 + lr + 32 * lg + 16];
            bw = (u32x4){pk2(x0[0], x0[1]), pk2(x0[2], x0[3]), pk2(x1[0], x1[1]), pk2(x1[2], x1[3])}; }
        const bf16x8 bfr = as_bf8(bw);
#pragma unroll 4
        for (int q = 0; q < 32; ++q) { const int nt = 32 * kh + q;
            const bf16x8 afr = *(const bf16x8*)(WGW + (size_t)(16 * nt + lr) * 32 + 8 * lg);
            f32x4 z = MFMA16(afr, bfr, ((f32x4){0.f, 0.f, 0.f, 0.f}));
            const f32x4 gb = *(const f32x4*)(GB + 16 * nt + 4 * lg);
#pragma unroll
            for (int r = 0; r < 4; ++r) z[r] = logsigmoidf_(z[r] + gb[r]) * 0.0625f;
            *(f32x4*)(LA + (size_t)(16 * task + lr) * QK + 16 * nt + 4 * lg) = z; }
    }
    __syncthreads();
}

__device__ __forceinline__ void p_conv(Frame& F) {
    const bf16* U = WSP(bf16, WS_U); const bf16* CB = WSP(bf16, WS_CB); bf16* Z = WSP(bf16, WS_Z);
    const float* cw = F.in[I_CW]; const float* cb = F.in[I_CBIAS];
    for (int task = F.bid * NTHR + F.tid; task < (T / 64) * (D / 8); task += F.G * NTHR) {
        const int cg = task & 255, tb = task >> 8, c = 8 * cg, t0 = 64 * tb;
        f32x4 w0a = *(const f32x4*)(cw + c), w0b = *(const f32x4*)(cw + c + 4), w1a = *(const f32x4*)(cw + D + c), w1b = *(const f32x4*)(cw + D + c + 4);
        f32x4 w2a = *(const f32x4*)(cw + 2 * D + c), w2b = *(const f32x4*)(cw + 2 * D + c + 4), ba = *(const f32x4*)(cb + c), bb = *(const f32x4*)(cb + c + 4);
        f32x4 p2a = {0.f, 0.f, 0.f, 0.f}, p2b = p2a, p1a = p2a, p1b = p2a;
        if (t0 >= 2) { ld_bf8(U + (size_t)(t0 - 2) * D + c, p2a, p2b); ld_bf8(U + (size_t)(t0 - 1) * D + c, p1a, p1b); }
        for (int t = t0; t < t0 + 64; ++t) {
            f32x4 ua, ub, ca, cbv; ld_bf8(U + (size_t)t * D + c, ua, ub); ld_bf8(CB + (size_t)t * D + c, ca, cbv);
            const f32x4 ya = ca * (w0a * p2a + w1a * p1a + w2a * ua + ba), yb = cbv * (w0b * p2b + w1b * p1b + w2b * ub + bb);
            st_bf8(Z + (size_t)t * D + c, ya, yb);
            p2a = p1a; p2b = p1b; p1a = ua; p1b = ub;
        }
    }
}
__device__ __forceinline__ void p_glaprep(Frame& F) {
    const bf16* Q = WSP(bf16, WS_Q); const bf16* Kk = WSP(bf16, WS_K); const float* ALOW = WSP(float, WS_ALOW); const float* GW = F.in[I_GGW]; const float* GB = F.in[I_GGB];
    bf16* QT = WSP(bf16, WS_QT); bf16* KH = WSP(bf16, WS_KH); bf16* KHT = WSP(bf16, WS_KHT); bf16* QG = WSP(bf16, WS_QG);
    float* DL = WSP(float, WS_DL); float* DG = WSP(float, WS_DG);
    LAS float* part = (LAS float*)F.lds;
    LAS float* sal = part + 512;
    const int col = F.tid & 63, sub = F.tid >> 6;
    for (int unit = F.bid; unit < NG * 16; unit += F.G) {
        const int g = unit >> 4, cs = unit & 15, gc = cs * 64 + col, h = gc >> 8, kc = gc & 255;
        float gw[16];
#pragma unroll
        for (int r = 0; r < 16; ++r) gw[r] = GW[r * QK + gc];
        const float gbv = GB[gc];
        float carry = 0.f;
        bf16 qr[8], kr[8]; f32x4 av = {0.f, 0.f, 0.f, 0.f};
#define PREP_LOAD(chunk_) do { const int _t0 = (chunk_) * CH + 8 * sub; \
        _Pragma("unroll") for (int j = 0; j < 8; ++j) { qr[j] = Q[(size_t)(_t0 + j) * QK + gc]; kr[j] = Kk[(size_t)(_t0 + j) * QK + gc]; } \
        if (F.tid < 256) av = *(const f32x4*)(ALOW + (size_t)(chunk_) * CH * 16 + 4 * F.tid); } while (0)
        PREP_LOAD(g * GC);
        for (int c = 0; c < GC; ++c) {
            const int chunk = g * GC + c, t0 = chunk * CH + 8 * sub;
            float la[8], qv[8], kv[8];
#pragma unroll
            for (int j = 0; j < 8; ++j) { qv[j] = bf2f(qr[j]); kv[j] = bf2f(kr[j]); }
            if (F.tid < 256) *(LAS f32x4*)(sal + 4 * F.tid) = av;
            __syncthreads();
            if (c + 1 < GC) PREP_LOAD(chunk + 1);
#pragma unroll
            for (int j = 0; j < 8; ++j) { const LAS f32x4* ar = (const LAS f32x4*)(sal + (8 * sub + j) * 16); const f32x4 a0 = ar[0], a1 = ar[1], a2 = ar[2], a3 = ar[3];
                float z = gbv;
#pragma unroll
                for (int r = 0; r < 4; ++r) z += a0[r] * gw[r];
#pragma unroll
                for (int r = 0; r < 4; ++r) z += a1[r] * gw[4 + r];
#pragma unroll
                for (int r = 0; r < 4; ++r) z += a2[r] * gw[8 + r];
#pragma unroll
                for (int r = 0; r < 4; ++r) z += a3[r] * gw[12 + r];
                la[j] = logsigmoidf_(z) * 0.0625f; }
#pragma unroll
            for (int j = 1; j < 8; ++j) la[j] += la[j - 1];
            part[sub * 64 + col] = la[7];
            __syncthreads();
            float off = 0.f, tot = 0.f;
#pragma unroll
            for (int s = 0; s < 8; ++s) { const float p = part[s * 64 + col]; off += (s < sub) ? p : 0.f; tot += p; }
            unsigned kt[4];
#pragma unroll
            for (int j = 0; j < 8; ++j) { const float b = off + la[j], eb = __expf(b), enb = __expf(-b), eg = __expf(carry + b);
                QT[(size_t)(t0 + j) * QK + gc] = (bf16)f2bf(qv[j] * eb); const unsigned khv = f2bf(kv[j] * enb); KH[(size_t)(t0 + j) * QK + gc] = (bf16)khv;
                QG[(size_t)(t0 + j) * QK + gc] = (bf16)f2bf(qv[j] * eg);
                if (j & 1) kt[j >> 1] |= khv << 16; else kt[j >> 1] = khv; }
            *(u32x4*)(KHT + ((size_t)(chunk * GH + h) * DK + kc) * CH + 8 * sub) = (u32x4){kt[0], kt[1], kt[2], kt[3]};
            if (sub == 0) DL[(size_t)chunk * QK + gc] = __expf(tot);
            carry += tot;
        }
#undef PREP_LOAD
        if (sub == 0) DG[(size_t)g * QK + gc] = __expf(carry);
    }
}

__device__ __forceinline__ void p_gla_ref(Frame& F) {
    const bf16* Q = WSP(bf16, WS_Q); const bf16* Kk = WSP(bf16, WS_K); const bf16* V = WSP(bf16, WS_V); const float* LA = WSP(float, WS_LA); float* O32 = WSP(float, WS_O32);
    LAS float* red = (LAS float*)F.lds;
    const int k = F.tid & 255, vh = F.tid >> 8;
    for (int unit = F.bid; unit < GH * 64; unit += F.G) {
        const int h = unit >> 6, vb = unit & 63, vcol = h * DV + vb * 8 + vh * 4;
        float s0 = 0.f, s1 = 0.f, s2 = 0.f, s3 = 0.f;
        for (int tb = 0; tb < T; tb += 8) {
            LAS float* rb = red + ((tb >> 3) & 1) * 256;
#pragma unroll
            for (int j = 0; j < 8; ++j) {
                const int t = tb + j; const float a = __expf(LA[(size_t)t * QK + h * DK + k]), kk = bf2f(Kk[(size_t)t * QK + h * DK + k]), qq = bf2f(Q[(size_t)t * QK + h * DK + k]);
                const u32x2 vv = *(const u32x2*)(V + (size_t)t * VD + vcol);
                const float v0 = __uint_as_float(vv.x << 16), v1 = __uint_as_float(vv.x & 0xffff0000u), v2 = __uint_as_float(vv.y << 16), v3 = __uint_as_float(vv.y & 0xffff0000u);
                s0 = a * s0 + kk * v0; s1 = a * s1 + kk * v1; s2 = a * s2 + kk * v2; s3 = a * s3 + kk * v3;
                const float p0 = wave_sum(qq * s0), p1 = wave_sum(qq * s1), p2 = wave_sum(qq * s2), p3 = wave_sum(qq * s3);
                if (F.lane == 0) *(LAS f32x4*)(rb + (j * 8 + F.wave) * 4) = (f32x4){p0, p1, p2, p3};
            }
            __syncthreads();
            if (F.tid < 64) { const int j = F.tid >> 3, vhh = (F.tid >> 2) & 1, q = F.tid & 3; float s = 0.f;
#pragma unroll
                for (int w = 0; w < 4; ++w) s += rb[(j * 8 + vhh * 4 + w) * 4 + q];
                O32[(size_t)(tb + j) * VD + h * DV + vb * 8 + vhh * 4 + q] = s; }
        }
        __syncthreads();
    }
}
__device__ __forceinline__ void p_gla_norm_ref(Frame& F) {
    const float* O32 = WSP(float, WS_O32); const bf16* SR = WSP(bf16, WS_SR); bf16* OA = WSP(bf16, WS_OA); const float* g = F.in[I_GNG];
    const int gw = F.bid * NWAVES + F.wave, NGW = F.G * NWAVES;
    for (int it = gw; it < T * GH; it += NGW) {
        const size_t o = (size_t)it * DV + 8 * F.lane;
        const f32x4 a = *(const f32x4*)(O32 + o), b = *(const f32x4*)(O32 + o + 4);
        float s = 0.f;
#pragma unroll
        for (int j = 0; j < 4; ++j) s += a[j] * a[j] + b[j] * b[j];
        const float r = rsqrtf(wave_sum(s) * (1.0f / DV) + EPS);
        f32x4 s0, s1; ld_bf8(SR + o, s0, s1);
        const f32x4 g0 = *(const f32x4*)(g + 8 * F.lane), g1 = *(const f32x4*)(g + 8 * F.lane + 4);
        st_bf8(OA + o, a * r * g0 * s0, b * r * g1 * s1);
    }
}

__device__ __forceinline__ void p_gla_a(Frame& F) {
    const bf16* QT = WSP(bf16, WS_QT); const bf16* KH = WSP(bf16, WS_KH); const bf16* KHT = WSP(bf16, WS_KHT); const bf16* V = WSP(bf16, WS_V); const float* DL = WSP(float, WS_DL);
    bf16* OL = WSP(bf16, WS_OL); float* SLOC = WSP(float, WS_SLOC);
    constexpr int QS = 528, KQ = 544, KS = 160;
    LAS unsigned char* sQ = F.lds; LAS unsigned char* sK = sQ + 64 * QS; LAS unsigned char* sKT = sK + 64 * KQ; LAS unsigned char* sVT = sKT + 256 * KS; LAS unsigned char* sP = sVT + 128 * KS;
    LAS float* sDL = (LAS float*)(sP + 64 * KS);
    static_assert(64 * QS + 64 * KQ + 256 * KS + 128 * KS + 64 * KS + 1024 <= MISC_OFF, "gla lds");
    const int tid = F.tid, lane = F.lane, w = F.wave, lr = lane & 15, lg = lane >> 4;
    for (int unit0 = F.bid; unit0 < NG * GH * 4; unit0 += F.G) {
        const int unit = (F.G == NG * GH * 4) ? ((((unit0 & 7) + 8 * (unit0 >> 5)) << 2) | ((unit0 >> 3) & 3)) : unit0;
        const int g = unit >> 4, h = (unit >> 2) & 3, vs = unit & 3;
        f32x4 S[16];
#pragma unroll
        for (int kt = 0; kt < 16; ++kt) S[kt] = (f32x4){0.f, 0.f, 0.f, 0.f};
        u32x4 rq[4], rk[4], rt[4], rv[2], rd = {0u, 0u, 0u, 0u};
#define GLA_LOAD(chunk_) do { const int _t0 = (chunk_) * CH; \
        _Pragma("unroll") for (int q = 0; q < 4; ++q) { const int p = tid + 512 * q, row = p >> 5, c16 = p & 31; \
            rq[q] = *(const u32x4*)(QT + (size_t)(_t0 + row) * QK + h * DK + c16 * 8); rk[q] = *(const u32x4*)(KH + (size_t)(_t0 + row) * QK + h * DK + c16 * 8); \
            rt[q] = *(const u32x4*)(KHT + (size_t)((chunk_) * GH + h) * DK * CH + (size_t)p * 8); } \
        _Pragma("unroll") for (int q = 0; q < 2; ++q) rv[q] = *(const u32x4*)(V + (size_t)(_t0 + lane) * VD + h * DV + vs * 128 + 8 * (2 * w + q)); \
        if (tid < 64) rd = *(const u32x4*)(DL + (size_t)(chunk_) * QK + h * DK + 4 * tid); } while (0)
        GLA_LOAD(g * GC);
        for (int c = 0; c < GC; ++c) {
            const int chunk = g * GC + c, t0 = chunk * CH;
#pragma unroll
            for (int q = 0; q < 4; ++q) { const int p = tid + 512 * q; *(LAS u32x4*)(sQ + (p >> 5) * QS + (p & 31) * 16) = rq[q]; *(LAS u32x4*)(sK + (p >> 5) * KQ + (p & 31) * 16) = rk[q]; *(LAS u32x4*)(sKT + (p >> 3) * KS + (p & 7) * 16) = rt[q]; }
#pragma unroll
            for (int q = 0; q < 2; ++q) { LAS unsigned char* vp = sVT + (8 * (2 * w + q)) * KS + 2 * lane;
                *(LAS unsigned short*)(vp) = (unsigned short)rv[q].x; *(LAS unsigned short*)(vp + KS) = (unsigned short)(rv[q].x >> 16); *(LAS unsigned short*)(vp + 2 * KS) = (unsigned short)rv[q].y; *(LAS unsigned short*)(vp + 3 * KS) = (unsigned short)(rv[q].y >> 16);
                *(LAS unsigned short*)(vp + 4 * KS) = (unsigned short)rv[q].z; *(LAS unsigned short*)(vp + 5 * KS) = (unsigned short)(rv[q].z >> 16); *(LAS unsigned short*)(vp + 6 * KS) = (unsigned short)rv[q].w; *(LAS unsigned short*)(vp + 7 * KS) = (unsigned short)(rv[q].w >> 16); }
            if (tid < 64) *(LAS u32x4*)(sDL + 4 * tid) = rd;
            __syncthreads();
            if (c + 1 < GC) GLA_LOAD(chunk + 1);
            { const int ti = w >> 1;
#pragma unroll
              for (int jj = 0; jj < 2; ++jj) { const int tj = 2 * (w & 1) + jj; f32x4 pa = {0.f, 0.f, 0.f, 0.f};
                if (tj <= ti) {
#pragma unroll
                    for (int s = 0; s < 8; ++s) { const bf16x8 a = *(const LAS bf16x8*)(sK + (16 * tj + lr) * KQ + (32 * s + 8 * lg) * 2), b = *(const LAS bf16x8*)(sQ + (16 * ti + lr) * QS + (32 * s + 8 * lg) * 2); pa = MFMA16(a, b, pa); }
                    const int i = 16 * ti + lr, j0 = 16 * tj + 4 * lg;
#pragma unroll
                    for (int r = 0; r < 4; ++r) pa[r] = (j0 + r <= i) ? pa[r] : 0.f;
                }
                u32x2 pw; pw.x = pk2(pa[0], pa[1]); pw.y = pk2(pa[2], pa[3]);
                *(LAS u32x2*)(sP + (16 * ti + lr) * KS + (16 * tj + 4 * lg) * 2) = pw; } }
            f32x4 oacc[4];
#pragma unroll
            for (int ti = 0; ti < 4; ++ti) oacc[ti] = (f32x4){0.f, 0.f, 0.f, 0.f};
#pragma unroll
            for (int s = 0; s < 8; ++s) {
                u32x4 sw; sw.x = pk2(S[2 * s][0], S[2 * s][1]); sw.y = pk2(S[2 * s][2], S[2 * s][3]); sw.z = pk2(S[2 * s + 1][0], S[2 * s + 1][1]); sw.w = pk2(S[2 * s + 1][2], S[2 * s + 1][3]);
                const bf16x8 a = as_bf8(sw);
#pragma unroll
                for (int ti = 0; ti < 4; ++ti) { const LAS unsigned char* qp = sQ + (16 * ti + lr) * QS + (32 * s + 4 * lg) * 2; const u32x2 lo = *(const LAS u32x2*)qp, hi = *(const LAS u32x2*)(qp + 32);
                    oacc[ti] = MFMA16(a, as_bf8((u32x4){lo.x, lo.y, hi.x, hi.y}), oacc[ti]); }
            }
            __syncthreads();
            bf16x8 vf[2];
#pragma unroll
            for (int s2 = 0; s2 < 2; ++s2) vf[s2] = *(const LAS bf16x8*)(sVT + (16 * w + lr) * KS + (32 * s2 + 8 * lg) * 2);
#pragma unroll
            for (int s2 = 0; s2 < 2; ++s2)
#pragma unroll
                for (int ti = 0; ti < 4; ++ti) { const bf16x8 b = *(const LAS bf16x8*)(sP + (16 * ti + lr) * KS + (32 * s2 + 8 * lg) * 2); oacc[ti] = MFMA16(vf[s2], b, oacc[ti]); }
#pragma unroll
            for (int ti = 0; ti < 4; ++ti) { u32x2 ow; ow.x = pk2(oacc[ti][0], oacc[ti][1]); ow.y = pk2(oacc[ti][2], oacc[ti][3]);
                *(u32x2*)(OL + (size_t)(t0 + 16 * ti + lr) * VD + h * DV + vs * 128 + 16 * w + 4 * lg) = ow; }
#pragma unroll
            for (int kt = 0; kt < 16; ++kt) {
#pragma unroll
                for (int s2 = 0; s2 < 2; ++s2) { const bf16x8 a = *(const LAS bf16x8*)(sKT + (16 * kt + lr) * KS + (32 * s2 + 8 * lg) * 2); S[kt] = MFMA16(a, vf[s2], S[kt]); }
                S[kt] *= *(const LAS f32x4*)(sDL + 16 * kt + 4 * lg);
            }
            __syncthreads();
        }
#undef GLA_LOAD
#pragma unroll
        for (int kt = 0; kt < 16; ++kt)
#pragma unroll
            for (int r = 0; r < 4; ++r) SLOC[((size_t)(g * GH + h) * DK + 16 * kt + 4 * lg + r) * DV + vs * 128 + 16 * w + lr] = S[kt][r];
    }
}
__device__ __forceinline__ void p_gla_b(Frame& F) {
    const float* SLOC = WSP(float, WS_SLOC); const float* DG = WSP(float, WS_DG); bf16* SG0 = WSP(bf16, WS_SG0);
    for (int idx = F.bid * NTHR + F.tid; idx < GH * DV * (DK / 4); idx += F.G * NTHR) {
        const int v = idx & 511, k4 = (idx >> 9) & 63, h = idx >> 15;
        float x[NG - 1][4]; f32x4 d[NG - 1];
#pragma unroll
        for (int g = 0; g < NG - 1; ++g) { d[g] = *(const f32x4*)(DG + (size_t)g * QK + h * DK + 4 * k4);
#pragma unroll
            for (int j = 0; j < 4; ++j) x[g][j] = SLOC[((size_t)(g * GH + h) * DK + 4 * k4 + j) * DV + v]; }
        float s[4] = {0.f, 0.f, 0.f, 0.f};
#pragma unroll
        for (int g = 0; g < NG; ++g) {
            *(u32x2*)(SG0 + ((size_t)(g * GH + h) * DV + v) * DK + 4 * k4) = (u32x2){pk2(s[0], s[1]), pk2(s[2], s[3])};
            if (g < NG - 1) {
#pragma unroll
                for (int j = 0; j < 4; ++j) s[j] = d[g][j] * s[j] + x[g][j]; }
        }
    }
}
__device__ __forceinline__ void p_gla_c(Frame& F) {
    const bf16* QG = WSP(bf16, WS_QG); const bf16* SG0 = WSP(bf16, WS_SG0); const bf16* OL = WSP(bf16, WS_OL); const bf16* SR = WSP(bf16, WS_SR); bf16* OA = WSP(bf16, WS_OA); const float* gn = F.in[I_GNG];
    LAS float* red = (LAS float*)F.lds;
    const int lane = F.lane, w = F.wave, lr = lane & 15, lg = lane >> 4;
    for (int unit = F.bid; unit < (T / 128) * GH; unit += F.G) {
        const int rt = unit >> 2, h = unit & 3, g = rt >> 3, row0 = rt * 128;
        f32x4 o[8][4];
#pragma unroll
        for (int it = 0; it < 8; ++it)
#pragma unroll
            for (int vt = 0; vt < 4; ++vt) o[it][vt] = (f32x4){0.f, 0.f, 0.f, 0.f};
        if (g > 0) {
            const bf16* sg = SG0 + ((size_t)(g * GH + h) * DV + 64 * w + 8 * (lr >> 2) + (lr & 3)) * DK + 8 * lg; const bf16* qg = QG + (size_t)(row0 + lr) * QK + h * DK + 8 * lg;
            bf16x8 a0[4], b0[8], a1[4], b1[8];
#define GLC_LOAD(A_, B_, s_) do { _Pragma("unroll") for (int vt = 0; vt < 4; ++vt) A_[vt] = *(const bf16x8*)(sg + (size_t)(32 * (vt >> 1) + 4 * (vt & 1)) * DK + 32 * (s_)); \
            _Pragma("unroll") for (int it = 0; it < 8; ++it) B_[it] = *(const bf16x8*)(qg + (size_t)(16 * it) * QK + 32 * (s_)); } while (0)
#define GLC_MMA(A_, B_) do { _Pragma("unroll") for (int it = 0; it < 8; ++it) _Pragma("unroll") for (int vt = 0; vt < 4; ++vt) o[it][vt] = MFMA16(A_[vt], B_[it], o[it][vt]); } while (0)
            GLC_LOAD(a0, b0, 0);
#pragma unroll
            for (int s = 0; s < 8; s += 2) {
                GLC_LOAD(a1, b1, s + 1);
                GLC_MMA(a0, b0);
                if (s + 2 < 8) GLC_LOAD(a0, b0, s + 2);
                GLC_MMA(a1, b1);
            }
#undef GLC_LOAD
#undef GLC_MMA
        }
        asm volatile("" ::: "memory");
        const size_t ob = (size_t)(row0 + lr) * VD + h * DV + 64 * w + 8 * lg;
        float ss[8];
#pragma unroll
        for (int it = 0; it < 8; ++it) { ss[it] = 0.f;
#pragma unroll
            for (int p = 0; p < 2; ++p) { const u32x4 ol4 = *(const u32x4*)(OL + ob + (size_t)(16 * it) * VD + 32 * p);
#pragma unroll
              for (int q = 0; q < 2; ++q) { const int vt = 2 * p + q; u32x2 ol; ol.x = q ? ol4.z : ol4.x; ol.y = q ? ol4.w : ol4.y;
                o[it][vt][0] += __uint_as_float(ol.x << 16); o[it][vt][1] += __uint_as_float(ol.x & 0xffff0000u); o[it][vt][2] += __uint_as_float(ol.y << 16); o[it][vt][3] += __uint_as_float(ol.y & 0xffff0000u);
                ss[it] += (o[it][vt][0] * o[it][vt][0] + o[it][vt][1] * o[it][vt][1]) + (o[it][vt][2] * o[it][vt][2] + o[it][vt][3] * o[it][vt][3]); } }
            ss[it] += __shfl_xor(ss[it], 16); ss[it] += __shfl_xor(ss[it], 32); }
        __syncthreads();
        if (lg == 0) {
#pragma unroll
            for (int it = 0; it < 8; ++it) red[w * 128 + 16 * it + lr] = ss[it]; }
        __syncthreads();
#pragma unroll
        for (int it = 0; it < 8; ++it) { float t = 0.f;
#pragma unroll
            for (int ww = 0; ww < 8; ++ww) t += red[ww * 128 + 16 * it + lr];
            const float r = rsqrtf(t * (1.0f / DV) + EPS);
#pragma unroll
            for (int p = 0; p < 2; ++p) { const size_t oo = ob + (size_t)(16 * it) * VD + 32 * p; const u32x4 sr4 = *(const u32x4*)(SR + oo); u32x4 ow4;
#pragma unroll
              for (int q = 0; q < 2; ++q) { const int vt = 2 * p + q; u32x2 sr; sr.x = q ? sr4.z : sr4.x; sr.y = q ? sr4.w : sr4.y; const f32x4 gg = *(const f32x4*)(gn + 64 * w + 32 * p + 8 * lg + 4 * q);
                u32x2 ow; ow.x = pk2(o[it][vt][0] * r * gg[0] * __uint_as_float(sr.x << 16), o[it][vt][1] * r * gg[1] * __uint_as_float(sr.x & 0xffff0000u));
                ow.y = pk2(o[it][vt][2] * r * gg[2] * __uint_as_float(sr.y << 16), o[it][vt][3] * r * gg[3] * __uint_as_float(sr.y & 0xffff0000u));
                if (q) { ow4.z = ow.x; ow4.w = ow.y; } else { ow4.x = ow.x; ow4.y = ow.y; } }
              *(u32x4*)(OA + oo) = ow4; } }
    }
    __syncthreads();
}

__device__ __forceinline__ void p_attn_ref(Frame& F) {
    const bf16* QX = WSP(bf16, WS_QX); const bf16* KM = WSP(bf16, WS_KM); const bf16* VMT = WSP(bf16, WS_VMT); bf16* OX = WSP(bf16, WS_OX);
    LAS float* pbuf = (LAS float*)F.lds + F.wave * 256;
    const int gw = F.bid * NWAVES + F.wave, NGW = F.G * NWAVES, lane = F.lane;
    for (int it = gw; it < T * XH; it += NGW) {
        const int t = it >> 2, h = it & 3; const bf16* q = QX + (size_t)t * XA + h * XD;
        float s[4] = {0.f, 0.f, 0.f, 0.f};
        for (int d = 0; d < XD; d += 8) { f32x4 q0, q1, q2, q3; ld_bf8(q + d, q0, q1); ld_bf8(q + d + QX_HALF, q2, q3); q0 += q2; q1 += q3;
#pragma unroll
            for (int c = 0; c < 4; ++c) { f32x4 k0, k1; ld_bf8(KM + (size_t)(lane + 64 * c) * XA + h * XD + d, k0, k1);
#pragma unroll
                for (int j = 0; j < 4; ++j) s[c] += q0[j] * k0[j] + q1[j] * k1[j]; } }
        const float sc = 0.08838834764831845f;
        float mx = fmaxf(fmaxf(s[0], s[1]), fmaxf(s[2], s[3])) * sc; mx = wave_max(mx);
        float e[4], sum = 0.f;
#pragma unroll
        for (int c = 0; c < 4; ++c) { e[c] = __expf(s[c] * sc - mx); sum += e[c]; }
        sum = wave_sum(sum); const float inv = 1.0f / sum;
#pragma unroll
        for (int c = 0; c < 4; ++c) pbuf[lane + 64 * c] = bf2f((unsigned short)f2bf(e[c] * inv));
        LDS_WAIT(); asm volatile("" ::: "memory");
        float o0 = 0.f, o1 = 0.f; const bf16* v0 = VMT + (size_t)(h * XD + 2 * lane) * MEM; const bf16* v1 = v0 + MEM;
        for (int m = 0; m < MEM; m += 8) { f32x4 a0, a1, b0, b1; ld_bf8(v0 + m, a0, a1); ld_bf8(v1 + m, b0, b1); const f32x4 p0 = *(const LAS f32x4*)(pbuf + m), p1 = *(const LAS f32x4*)(pbuf + m + 4);
#pragma unroll
            for (int j = 0; j < 4; ++j) { o0 += p0[j] * a0[j] + p1[j] * a1[j]; o1 += p0[j] * b0[j] + p1[j] * b1[j]; } }
        *(unsigned*)(OX + (size_t)t * XA + h * XD + 2 * lane) = pk2(o0, o1);
        LDS_WAIT(); asm volatile("" ::: "memory");
    }
}

__device__ __forceinline__ void p_attn(Frame& F) {
    const bf16* QX = WSP(bf16, WS_QX); const bf16* KM = WSP(bf16, WS_KM); const bf16* VMT = WSP(bf16, WS_VMT); bf16* OX = WSP(bf16, WS_OX);
    constexpr int KSt = 288, VSt = 528;
    LAS unsigned char* sK = F.lds; LAS unsigned char* sV = sK + 256 * KSt;
    static_assert(256 * KSt + 128 * VSt <= MISC_OFF, "attn lds");
    const int tid = F.tid, lane = F.lane, w = F.wave, lr = lane & 15, lg = lane >> 4;
    int curh = -1;
    for (int unit = F.bid; unit < (T / 128) * XH; unit += F.G) {
        const int h = unit & 3, rt = unit >> 2;
        if (h != curh) {
            __syncthreads();
#pragma unroll
            for (int q = 0; q < 8; ++q) { const int p = tid + 512 * q;
                *(LAS u32x4*)(sK + (p >> 4) * KSt + (p & 15) * 16) = *(const u32x4*)(KM + (size_t)(p >> 4) * XA + h * XD + (p & 15) * 8);
                *(LAS u32x4*)(sV + (p >> 5) * VSt + (p & 31) * 16) = *(const u32x4*)(VMT + (size_t)(h * XD + (p >> 5)) * MEM + (p & 31) * 8); }
            __syncthreads();
            curh = h;
        }
        const int row = rt * 128 + 16 * w + lr;
        bf16x8 qf[4];
#pragma unroll
        for (int s = 0; s < 4; ++s) { const bf16* qp = QX + (size_t)row * XA + h * XD + 32 * s + 8 * lg;
            f32x4 a0, a1, b0, b1; unpack8(*(const u32x4*)qp, a0, a1); unpack8(*(const u32x4*)(qp + QX_HALF), b0, b1); qf[s] = as_bf8(pack8(a0 + b0, a1 + b1)); }
        f32x4 sc[16];
#pragma unroll
        for (int kt = 0; kt < 16; ++kt) { sc[kt] = (f32x4){0.f, 0.f, 0.f, 0.f};
#pragma unroll
            for (int s = 0; s < 4; ++s) { const bf16x8 a = *(const LAS bf16x8*)(sK + (16 * kt + lr) * KSt + (32 * s + 8 * lg) * 2); sc[kt] = MFMA16(a, qf[s], sc[kt]); } }
        float m = -3.0e38f;
#pragma unroll
        for (int kt = 0; kt < 16; ++kt) m = fmaxf(m, fmaxf(fmaxf(sc[kt][0], sc[kt][1]), fmaxf(sc[kt][2], sc[kt][3])));
        m = fmaxf(m, __shfl_xor(m, 16)); m = fmaxf(m, __shfl_xor(m, 32));
        const float c = 0.08838834764831845f * 1.4426950408889634f;
        float sum = 0.f;
#pragma unroll
        for (int kt = 0; kt < 16; ++kt)
#pragma unroll
            for (int r = 0; r < 4; ++r) { const float p = exp2f((sc[kt][r] - m) * c); sc[kt][r] = p; sum += p; }
        sum += __shfl_xor(sum, 16); sum += __shfl_xor(sum, 32);
        const float inv = 1.0f / sum;
        f32x4 oa[8];
#pragma unroll
        for (int dt = 0; dt < 8; ++dt) oa[dt] = (f32x4){0.f, 0.f, 0.f, 0.f};
#pragma unroll
        for (int s = 0; s < 8; ++s) {
            u32x4 pw; pw.x = pk2(sc[2 * s][0], sc[2 * s][1]); pw.y = pk2(sc[2 * s][2], sc[2 * s][3]); pw.z = pk2(sc[2 * s + 1][0], sc[2 * s + 1][1]); pw.w = pk2(sc[2 * s + 1][2], sc[2 * s + 1][3]);
            const bf16x8 b = as_bf8(pw);
#pragma unroll
            for (int dt = 0; dt < 8; ++dt) { const LAS unsigned char* vp = sV + (16 * dt + lr) * VSt + (32 * s + 4 * lg) * 2; const u32x2 lo = *(const LAS u32x2*)vp, hi = *(const LAS u32x2*)(vp + 32);
                oa[dt] = MFMA16(as_bf8((u32x4){lo.x, lo.y, hi.x, hi.y}), b, oa[dt]); }
        }
#pragma unroll
        for (int dt = 0; dt < 8; ++dt) { u32x2 ow; ow.x = pk2(oa[dt][0] * inv, oa[dt][1] * inv); ow.y = pk2(oa[dt][2] * inv, oa[dt][3] * inv);
            *(u32x2*)(OX + (size_t)row * XA + h * XD + 16 * dt + 4 * lg) = ow; }
    }
    __syncthreads();
}

typedef float f32x16 __attribute__((ext_vector_type(16)));
__device__ __forceinline__ void p_router(Frame& F) {
    const bf16* X2 = WSP(bf16, WS_X1B); bf16* H3 = WSP(bf16, WS_H3); const float* WR = WSP(float, WS_WR); const float* g = F.in[I_NMOEG]; const float* rb = F.in[I_RB];
    int* TKE = WSP(int, WS_TKE); int* TKP = WSP(int, WS_TKP); float* TKW = WSP(float, WS_TKW); unsigned* cnt = F.ctl + CW_CNT; int* RTE = WSP(int, WS_RTE);
    LAS unsigned* lcnt = (LAS unsigned*)F.lds;
    LAS int* le = (LAS int*)(F.lds + 256);
    LAS int* lp = (LAS int*)(F.lds + 256 + 1024);
    LAS float* P = (LAS float*)(F.lds + 4096);
    LAS float* SSQ = (LAS float*)(F.lds + 4096 + 8 * 32 * 33 * 4);
    const int lane = F.lane, th = F.wave & 1, kq = F.wave >> 1, li = lane & 31, hh = lane >> 5;
    for (int blk = F.bid; blk < T / 64; blk += F.G) {
        __syncthreads();
        if (F.tid < 64) lcnt[F.tid] = 0u;
        const bf16* xr = X2 + (size_t)(blk * 64 + th * 32 + li) * D + kq * 512 + 4 * hh;
        const float* wr = WR + (size_t)li * D + kq * 512 + 4 * hh;
        f32x16 acc;
#pragma unroll
        for (int r = 0; r < 16; ++r) acc[r] = 0.f;
        float ss = 0.f;
#pragma unroll 4
        for (int q = 0; q < 64; ++q) {
            const u32x2 aw = *(const u32x2*)(xr + 8 * q); const f32x4 a = {__uint_as_float(aw.x << 16), __uint_as_float(aw.x & 0xffff0000u), __uint_as_float(aw.y << 16), __uint_as_float(aw.y & 0xffff0000u)}, b = *(const f32x4*)(wr + 8 * q);
            ss += (a[0] * a[0] + a[1] * a[1]) + (a[2] * a[2] + a[3] * a[3]);
#pragma unroll
            for (int s = 0; s < 4; ++s) acc = __builtin_amdgcn_mfma_f32_32x32x2f32(a[s], b[s], acc, 0, 0, 0);
        }
        ss += __shfl_xor(ss, 32);
#pragma unroll
        for (int r = 0; r < 16; ++r) P[(F.wave * 32 + (r & 3) + 8 * (r >> 2) + 4 * hh) * 33 + li] = acc[r];
        if (lane < 32) SSQ[F.wave * 32 + lane] = ss;
        __syncthreads();
        if (F.tid < 64) {
            const int tl = F.tid, th2 = tl >> 5, ti = tl & 31, t = blk * 64 + tl;
            float ssq = 0.f;
#pragma unroll
            for (int k4 = 0; k4 < 4; ++k4) ssq += SSQ[(k4 * 2 + th2) * 32 + ti];
            const float r = rsqrtf(ssq * (1.0f / D) + EPS);
            float v0 = -3.0e38f, v1 = -3.0e38f, v2 = -3.0e38f, v3 = -3.0e38f; int i0 = 0, i1 = 0, i2 = 0, i3 = 0;
            for (int e = 0; e < NE; ++e) {
                float x = 0.f;
#pragma unroll
                for (int k4 = 0; k4 < 4; ++k4) x += P[((k4 * 2 + th2) * 32 + ti) * 33 + e];
                x = x * r + rb[e];
                if (x > v3) {
                    if (x > v2) { v3 = v2; i3 = i2;
                        if (x > v1) { v2 = v1; i2 = i1;
                            if (x > v0) { v1 = v0; i1 = i0; v0 = x; i0 = e; } else { v1 = x; i1 = e; } }
                        else { v2 = x; i2 = e; } }
                    else { v3 = x; i3 = e; } }
            }
            const float e1 = __expf(v1 - v0), e2 = __expf(v2 - v0), e3 = __expf(v3 - v0), inv = 1.0f / (1.0f + e1 + e2 + e3);
            const unsigned p0 = __hip_atomic_fetch_add(lcnt + i0, 1u, __ATOMIC_RELAXED, __HIP_MEMORY_SCOPE_WORKGROUP);
            const unsigned p1 = __hip_atomic_fetch_add(lcnt + i1, 1u, __ATOMIC_RELAXED, __HIP_MEMORY_SCOPE_WORKGROUP);
            const unsigned p2 = __hip_atomic_fetch_add(lcnt + i2, 1u, __ATOMIC_RELAXED, __HIP_MEMORY_SCOPE_WORKGROUP);
            const unsigned p3 = __hip_atomic_fetch_add(lcnt + i3, 1u, __ATOMIC_RELAXED, __HIP_MEMORY_SCOPE_WORKGROUP);
            le[tl * 4 + 0] = i0; le[tl * 4 + 1] = i1; le[tl * 4 + 2] = i2; le[tl * 4 + 3] = i3;
            lp[tl * 4 + 0] = (int)p0; lp[tl * 4 + 1] = (int)p1; lp[tl * 4 + 2] = (int)p2; lp[tl * 4 + 3] = (int)p3;
            *(int4*)(TKE + t * 4) = make_int4(i0, i1, i2, i3);
            *(f32x4*)(TKW + t * 4) = (f32x4){inv, e1 * inv, e2 * inv, e3 * inv};
        }
        __syncthreads();
        if (F.tid < NE) lcnt[32 + F.tid] = __hip_atomic_fetch_add(cnt + 64 * F.tid, lcnt[F.tid], RLX_AGENT);
        __syncthreads();
        if (F.tid < 256) { const int tl = F.tid >> 2, k = F.tid & 3, ee = le[tl * 4 + k], pos = lp[tl * 4 + k] + (int)lcnt[32 + ee]; TKP[(blk * 64 + tl) * 4 + k] = pos; RTE[(size_t)ee * T + pos] = blk * 64 + tl; }
#if MOE_FP8
        for (int tt = 0; tt < 8; ++tt) { const int t = blk * 64 + F.wave * 8 + tt; const bf16* xr2 = X2 + (size_t)t * D; unsigned char* o8 = (unsigned char*)H3 + (size_t)t * D;
            f32x4 v[8]; float s2 = 0.f;
#pragma unroll
            for (int j = 0; j < 8; ++j) { const u32x2 xw = *(const u32x2*)(xr2 + 4 * lane + 256 * j); v[j] = (f32x4){__uint_as_float(xw.x << 16), __uint_as_float(xw.x & 0xffff0000u), __uint_as_float(xw.y << 16), __uint_as_float(xw.y & 0xffff0000u)}; s2 += (v[j][0] * v[j][0] + v[j][1] * v[j][1]) + (v[j][2] * v[j][2] + v[j][3] * v[j][3]); }
            const float r2 = rsqrtf(wave_sum(s2) * (1.0f / D) + EPS) * H8_SCALE;
#pragma unroll
            for (int j = 0; j < 8; ++j) { const f32x4 gg = *(const f32x4*)(g + 4 * lane + 256 * j); *(unsigned*)(o8 + 4 * lane + 256 * j) = pk4_fp8(v[j][0] * r2 * gg[0], v[j][1] * r2 * gg[1], v[j][2] * r2 * gg[2], v[j][3] * r2 * gg[3]); } }
#else
        for (int tt = 0; tt < 8; ++tt) { const int t = blk * 64 + F.wave * 8 + tt; rms_row_to_bf16(X2 + (size_t)t * D, g, H3 + (size_t)t * D, lane); }
#endif
    }
}
__device__ __forceinline__ void p_lists(Frame& F) {
    unsigned* cnt = F.ctl + CW_CNT; int* TKE = WSP(int, WS_TKE); int* TKP = WSP(int, WS_TKP); int* ROWTOK = WSP(int, WS_ROWTOK); int* TILE = WSP(int, WS_TILE);
    LAS int* poff = (LAS int*)F.lds;
    LAS int* lc = (LAS int*)(F.lds + 256);
    __syncthreads();
    if (F.tid < NE) lc[F.tid] = (int)__hip_atomic_load(cnt + 64 * F.tid, RLX_AGENT);
    __syncthreads();
    if (F.tid == 0) { int o = 0; for (int e = 0; e < NE; ++e) { poff[e] = o; o += (lc[e] + 255) / 256 * 256; } poff[NE] = o; }
    __syncthreads();
    for (int i = F.bid * NTHR + F.tid; i < T * TOPK; i += F.G * NTHR) { const int e = TKE[i], slot = poff[e] + TKP[i]; TKP[i] = slot; ROWTOK[slot] = i >> 2; }
    if (F.bid == 0) {
        for (int e = 0; e < NE; ++e) for (int s = poff[e] + lc[e] + F.tid; s < poff[e + 1]; s += NTHR) ROWTOK[s] = T;
        for (int e = 0; e < NE; ++e) for (int tl = poff[e] / 256 + F.tid; tl < poff[e + 1] / 256; tl += NTHR) TILE[tl] = e;
        if (F.tid == 0) TILE[512] = poff[NE] / 256;
    }
    __syncthreads();
}
__device__ __forceinline__ void p_combine(Frame& F) {
    const bf16* X2 = WSP(bf16, WS_X1B); const unsigned char* YS = WSP(unsigned char, WS_YS); const int* TKP = WSP(int, WS_TKP); const float* TKW = WSP(float, WS_TKW); const float* g = F.in[I_NFG];
    const int gw = F.bid * NWAVES + F.wave, NGW = F.G * NWAVES, lane = F.lane;
    moe_layout(F.lds, F.ctl + CW_CNT); const LAS int* lay = (const LAS int*)(F.lds + LAY_OFF); const int* TKE = WSP(int, WS_TKE);
    int sl[4]; float w[4];
    if (gw < T) {
#pragma unroll
        for (int k = 0; k < 4; ++k) { sl[k] = lay[TKE[gw * 4 + k]] + TKP[gw * 4 + k]; w[k] = TKW[gw * 4 + k] * (1.0f / Y8_SCALE); } }
    for (int t = gw; t < T; t += NGW) {
        int sn[4] = {0, 0, 0, 0}; float wn[4] = {0.f, 0.f, 0.f, 0.f};
        if (t + NGW < T) {
#pragma unroll
            for (int k = 0; k < 4; ++k) { sn[k] = lay[TKE[(t + NGW) * 4 + k]] + TKP[(t + NGW) * 4 + k]; wn[k] = TKW[(t + NGW) * 4 + k] * (1.0f / Y8_SCALE); } }
        f32x4 v[8]; float s = 0.f;
#pragma unroll
        for (int j = 0; j < 8; ++j) { { const u32x2 xw = *(const u32x2*)(X2 + (size_t)t * D + 4 * lane + 256 * j); v[j] = (f32x4){__uint_as_float(xw.x << 16), __uint_as_float(xw.x & 0xffff0000u), __uint_as_float(xw.y << 16), __uint_as_float(xw.y & 0xffff0000u)}; }
#pragma unroll
            for (int k = 0; k < 4; ++k) { const int y = __builtin_nontemporal_load((const int*)(YS + (size_t)sl[k] * D + 4 * lane + 256 * j)); const f32x2 y01 = __builtin_amdgcn_cvt_pk_f32_fp8(y, false), y23 = __builtin_amdgcn_cvt_pk_f32_fp8(y, true);
                v[j][0] += w[k] * y01[0]; v[j][1] += w[k] * y01[1]; v[j][2] += w[k] * y23[0]; v[j][3] += w[k] * y23[1]; }
            s += (v[j][0] * v[j][0] + v[j][1] * v[j][1]) + (v[j][2] * v[j][2] + v[j][3] * v[j][3]); }
        const float r = rsqrtf(wave_sum(s) * (1.0f / D) + EPS);
#pragma unroll
        for (int j = 0; j < 8; ++j) { const f32x4 gg = *(const f32x4*)(g + 4 * lane + 256 * j); __builtin_nontemporal_store(v[j] * r * gg, (f32x4*)(F.out + (size_t)t * D + 4 * lane + 256 * j)); }
#pragma unroll
        for (int k = 0; k < 4; ++k) { sl[k] = sn[k]; w[k] = wn[k]; }
    }
}

constexpr int NPHASE = 16;
__global__ void __launch_bounds__(NTHR, 2) hybrid_fwd(Args args) {
    extern __shared__ __attribute__((aligned(16))) unsigned char lds_raw[];
    Frame F;
    F.lds = (LAS unsigned char*)lds_raw; F.ws = args.ws; F.ctl = (unsigned*)(args.ws + WS_CTL);
    F.tid = threadIdx.x; F.lane = F.tid & 63; F.wave = __builtin_amdgcn_readfirstlane(F.tid >> 6); F.G = gridDim.x; F.bid = blockIdx.x;
    F.in = args.in; F.out = args.out;
    volatile LAS unsigned* MISC = (volatile LAS unsigned*)(F.lds + MISC_OFF);
    if (F.tid < 32) MISC[F.tid] = 0u;
    __syncthreads();
#if MK_ONE_LAUNCH
    XcdBarrier bar = xcd_barrier_post(F.ctl + CW_BAR, MISC + 8);
#define GRID_BAR() xcd_barrier(bar)
#else
#define GRID_BAR() do {} while (0)
#endif
    const int lo = args.ph_lo, hi = args.ph_hi;
#ifndef ONLY_PHASE
#define ONLY_PHASE -1
#endif
#define IN(k) (lo <= (k) && (k) < hi && (ONLY_PHASE < 0 || ONLY_PHASE == (k)))
#define SEAM(k) do { if (IN(k) && IN((k) + 1)) GRID_BAR(); } while (0)

#ifndef DUP_PHASE
#define DUP_PHASE -1
#endif
#ifndef DUP_NOEPI
#define DUP_NOEPI 0
#endif
    bool do_epi = true, do_epi_flag = true;
#define PHASE(k, ...) do { if (IN(k)) { __VA_ARGS__ if (DUP_PHASE == (k)) { GRID_BAR(); do_epi = (DUP_NOEPI == 1) ? (args.probe != 0) : true; do_epi_flag = false; __VA_ARGS__ do_epi = true; do_epi_flag = true; } } SEAM(k); } while (0)
    constexpr int MAIN_ROUNDS = 4;
    const bool split = (F.G == 256);
    const int sgrp = F.bid >> 3;
    const bool conv_role = !split || (sgrp & 3) == 0;
    PHASE(0, p0_prologue(F, 0, F.bid, F.G););
    PHASE(12,
        if (conv_role) { p0_prologue(F, 1, split ? ((sgrp >> 2) * 8 + (F.bid & 7)) : F.bid, split ? 64 : F.G); }
        else { const int j = (sgrp - (sgrp >> 2) - 1) * 8 + (F.bid & 7);
          DenseSched S; S.init(WSP(bf16, WS_XN), WSP(bf16, WS_WIN), T, NIN, D, 192, MAIN_ROUNDS * 256 + j);
          EpiInProj E{WSP(bf16, WS_Q), WSP(bf16, WS_K), WSP(bf16, WS_V), WSP(bf16, WS_SR), WSP(bf16, WS_CB), WSP(bf16, WS_U), WSP(bf16, WS_SGA), WSP(bf16, WS_SGB)};
          gemm_any(F.lds, S, E, do_epi); });
    PHASE(1,
        { DenseSched S; S.init(WSP(bf16, WS_XN), WSP(bf16, WS_WIN), T, NIN, D, F.G, F.bid, 0, split ? MAIN_ROUNDS : (1 << 30));
          EpiInProj E{WSP(bf16, WS_Q), WSP(bf16, WS_K), WSP(bf16, WS_V), WSP(bf16, WS_SR), WSP(bf16, WS_CB), WSP(bf16, WS_U), WSP(bf16, WS_SGA), WSP(bf16, WS_SGB)};
          gemm_any(F.lds, S, E, do_epi); }
        p_alow(F););
    PHASE(2, p_memkv(F); p_conv(F); p_glaprep(F););
#if OPT_GLA
    PHASE(3, p_gla_a(F););
    PHASE(4, p_gla_b(F););
    PHASE(5, p_gla_c(F););
#else
    PHASE(3, p_gla_ref(F););
    PHASE(4, ;);
    PHASE(5, p_gla_norm_ref(F););
#endif
    PHASE(6,
        { DenseSched S; S.init(WSP(bf16, WS_OA), WSP(bf16, WS_WGO), T, D, D, F.G, F.bid); EpiGateA E{WSP(bf16, WS_T1), WSP(bf16, WS_SGA)}; gemm_any(F.lds, S, E, do_epi); }
        VM_WAIT(); __syncthreads();
        { DenseSched S; S.init(WSP(bf16, WS_Z), WSP(bf16, WS_WCO), T, D, D, F.G, F.bid); EpiGateB E{WSP(bf16, WS_T1), WSP(bf16, WS_SGB), WSP(bf16, WS_MG)}; gemm_any(F.lds, S, E, do_epi); });
    PHASE(7, { DenseSched S; S.init(WSP(bf16, WS_MG), WSP(bf16, WS_WMX), T, D, D, F.G, F.bid); EpiResid1 E{F.in[I_X], WSP(bf16, WS_X1B), WSP(float, WS_SSP)}; gemm_any(F.lds, S, E, do_epi); });
    PHASE(8, { DenseSched S; S.init(WSP(bf16, WS_X1B), WSP(bf16, WS_WXQ), T, 2 * XA, D, F.G, F.bid); S.ks = 1; EpiXQ E{WSP(bf16, WS_QX), WSP(float, WS_SSP)}; gemm_any(F.lds, S, E, do_epi); });
#if OPT_ATT
    PHASE(9, p_attn(F););
#else
    PHASE(9, p_attn_ref(F););
#endif
    PHASE(10, { DenseSched S; S.init(WSP(bf16, WS_OX), WSP(bf16, WS_WXO), T, D, XA, F.G, F.bid); EpiResid2 E{WSP(bf16, WS_X1B)}; gemm_any(F.lds, S, E, do_epi); });
    PHASE(11, p_router(F););
#if MOE_FP8
    PHASE(13, { moe_layout(F.lds, F.ctl + CW_CNT); const LAS int* lay = (const LAS int*)(F.lds + LAY_OFF); const int ntiles = __builtin_amdgcn_readfirstlane(lay[NE]) / 256;
        GroupSched S; S.init(WSP(unsigned char, WS_H3), WSP(unsigned char, WS_WGU), ntiles, 2 * FF, D, F.G, F.bid, lay, WSP(int, WS_RTE), 1); EpiGU8 E{WSP(unsigned char, WS_ACT), F.in[I_GUB]};
        gemm_any<EpiGU8, GroupSched, true>(F.lds, S, E, do_epi); });
    PHASE(14, { moe_layout(F.lds, F.ctl + CW_CNT); const LAS int* lay = (const LAS int*)(F.lds + LAY_OFF); const int ntiles = __builtin_amdgcn_readfirstlane(lay[NE]) / 256;
        GroupSched S; S.init(WSP(unsigned char, WS_ACT), WSP(unsigned char, WS_WDN), ntiles, D, FF, F.G, F.bid, lay, nullptr, 1); EpiDown8 E{WSP(unsigned char, WS_YS), F.in[I_DNB]};
        gemm_any<EpiDown8, GroupSched, true>(F.lds, S, E, do_epi); });
#endif
    PHASE(15, p_combine(F););
#undef PHASE
#undef IN
#undef SEAM
}

extern "C" void kernel_launch(void* const* d_in, const int* in_sizes, int n_in, void* d_out, int out_size, void* d_ws, size_t ws_size, hipStream_t stream) {
    static int grid = 0;
    if (grid == 0) {
        if (n_in != 26 || out_size != T * D || ws_size < WS_END) { fprintf(stderr, "kernel_launch: unexpected problem (n_in %d, out %d, ws %zu < %zu)\n", n_in, out_size, ws_size, (size_t)WS_END); grid = -1; return; }
        int dev = 0, cus = 0, per_cu = 0;
        if (hipGetDevice(&dev) != hipSuccess || hipDeviceGetAttribute(&cus, hipDeviceAttributeMultiprocessorCount, dev) != hipSuccess) { grid = -1; return; }
        if (hipFuncSetAttribute((const void*)hybrid_fwd, hipFuncAttributeMaxDynamicSharedMemorySize, LDS_BYTES) != hipSuccess) { fprintf(stderr, "kernel_launch: hipFuncSetAttribute failed\n"); grid = -1; return; }
        if (hipOccupancyMaxActiveBlocksPerMultiprocessor(&per_cu, (const void*)hybrid_fwd, NTHR, LDS_BYTES) != hipSuccess || per_cu < 1) fprintf(stderr, "kernel_launch: occupancy query says %d\n", per_cu);
        (void)hipGetLastError();
        grid = cus;
    }
    if (grid < 0) return;
    (void)hipMemsetAsync((char*)d_ws + WS_CTL, 0, CTL_ZERO_BYTES, stream);
    Args a{};
    for (int i = 0; i < 26; ++i) a.in[i] = (const float*)d_in[i];
    a.out = (float*)d_out; a.ws = (unsigned char*)d_ws;
#if MK_ONE_LAUNCH
    a.ph_lo = 0; a.ph_hi = NPHASE;
    hipLaunchKernelGGL(hybrid_fwd, dim3(grid), dim3(NTHR), LDS_BYTES, stream, a);
#else
    for (int p = 0; p < NPHASE; ++p) { a.ph_lo = p; a.ph_hi = p + 1; hipLaunchKernelGGL(hybrid_fwd, dim3(grid), dim3(NTHR), LDS_BYTES, stream, a); }
#endif
}
```

```cpp
#include <hip/hip_runtime.h>
#include <cstdio>
#include <cstdint>

#ifndef MK_ONE_LAUNCH
#define MK_ONE_LAUNCH 1
#endif
#ifndef OPT_GEMM
#define OPT_GEMM 1
#endif
#ifndef OPT_GLA
#define OPT_GLA 1
#endif
#ifndef MOE_FP8
#define MOE_FP8 1
#endif
#ifndef OPT_ATT
#define OPT_ATT 1
#endif

#define GAS __attribute__((address_space(1)))
#define LAS __attribute__((address_space(3)))
typedef unsigned short bf16;
typedef short bf16x8 __attribute__((ext_vector_type(8)));
typedef short bf16x4 __attribute__((ext_vector_type(4)));
typedef float f32x4 __attribute__((ext_vector_type(4)));
typedef float f32x2 __attribute__((ext_vector_type(2)));
typedef unsigned u32x4 __attribute__((ext_vector_type(4)));
typedef unsigned u32x2 __attribute__((ext_vector_type(2)));
#define RLX_AGENT __ATOMIC_RELAXED, __HIP_MEMORY_SCOPE_AGENT
#define LDS_WAIT() asm volatile("s_waitcnt lgkmcnt(0)" ::: "memory")
#define VM_WAIT() asm volatile("s_waitcnt vmcnt(0)" ::: "memory")

constexpr int T = 16384, D = 2048, MEM = 256;
constexpr int GH = 4, DK = 256, DV = 512, QK = GH * DK  , VD = GH * DV  ;
constexpr int CH = 64, NCH = T / CH  , NG = 16, GC = NCH / NG  , GT = GC * CH  ;
constexpr int XH = 4, XD = 128, XA = XH * XD  ;
constexpr int NE = 32, TOPK = 4, FF = 2048;
constexpr int NIN_SRC = 16400, NIN = 16384;
constexpr float EPS = 1e-5f;
constexpr int PROWS = T * TOPK + NE * 256;
constexpr int MAXTILES = PROWS / 256;

constexpr int SRC_ALOW = 6144, SRC_CB = 6160, SRC_CC = 8208, SRC_CHH = 10256, SRC_GA = 12304, SRC_GB = 14352;
constexpr int TN_Q = 0, TN_K = 4, TN_V = 8, TN_R = 16, TN_CB = 24, TN_U = 32, TN_GA = 48, TN_GB = 56, TN_END = 64;

constexpr size_t MiB = 1u << 20;
constexpr size_t WS_CTL = 0, CTL_ZERO_BYTES = 1 * MiB;
constexpr size_t WS_WIN = 1 * MiB;
constexpr size_t WS_WGO = WS_WIN + 68 * MiB;
constexpr size_t WS_WCO = WS_WGO + 8 * MiB;
constexpr size_t WS_WMX = WS_WCO + 8 * MiB;
constexpr size_t WS_WXQ = WS_WMX + 8 * MiB;
constexpr size_t WS_WXKV = WS_WXQ + 2 * MiB;
constexpr size_t WS_WXO = WS_WXKV + 4 * MiB;
constexpr size_t WS_WR = WS_WXO + 2 * MiB;
constexpr size_t WS_WGU = WS_WR + 1 * MiB;
constexpr size_t WS_WDN = WS_WGU + 512 * MiB;
constexpr size_t WS_XN = WS_WDN + 256 * MiB;
constexpr size_t WS_Q = WS_XN + 64 * MiB;
constexpr size_t WS_K = WS_Q + 32 * MiB;
constexpr size_t WS_V = WS_K + 32 * MiB;
constexpr size_t WS_SR = WS_V + 64 * MiB;
constexpr size_t WS_LA = WS_SR + 64 * MiB;
constexpr size_t WS_CB = WS_LA + 64 * MiB;
constexpr size_t WS_U = WS_CB + 64 * MiB;
constexpr size_t WS_SGA = WS_U + 64 * MiB;
constexpr size_t WS_SGB = WS_SGA + 64 * MiB;
constexpr size_t WS_QT = WS_SGB + 64 * MiB;
constexpr size_t WS_KH = WS_QT + 32 * MiB;
constexpr size_t WS_KHT = WS_KH + 32 * MiB;
constexpr size_t WS_QG = WS_KHT + 32 * MiB;
constexpr size_t WS_VT = WS_QG + 32 * MiB;
constexpr size_t WS_DL = WS_VT + 64 * MiB;
constexpr size_t WS_DG = WS_DL + 1 * MiB;
constexpr size_t WS_Z = WS_DG + 1 * MiB;
constexpr size_t WS_OL = WS_Z + 64 * MiB;
constexpr size_t WS_SLOC = WS_OL + 64 * MiB;
constexpr size_t WS_SG0 = WS_SLOC + 32 * MiB;
constexpr size_t WS_O32 = WS_SG0 + 16 * MiB;
constexpr size_t WS_OA = WS_O32 + 128 * MiB;
constexpr size_t WS_T1 = WS_OA + 64 * MiB;
constexpr size_t WS_MG = WS_T1 + 128 * MiB;
constexpr size_t WS_X1 = WS_MG + 64 * MiB;
constexpr size_t WS_X1B = WS_X1 + 128 * MiB;
constexpr size_t WS_QX = WS_X1B + 64 * MiB;
constexpr size_t WS_OX = WS_QX + 16 * MiB;
constexpr size_t WS_MEMN = WS_OX + 16 * MiB;
constexpr size_t WS_KM = WS_MEMN + 1 * MiB;
constexpr size_t WS_VMT = WS_KM + 1 * MiB;
constexpr size_t WS_H3 = WS_VMT + 1 * MiB;
constexpr size_t WS_TKE = WS_H3 + 65 * MiB;
constexpr size_t WS_TKP = WS_TKE + 1 * MiB;
constexpr size_t WS_TKW = WS_TKP + 1 * MiB;
constexpr size_t WS_ROWTOK = WS_TKW + 1 * MiB;
constexpr size_t WS_TILE = WS_ROWTOK + 1 * MiB;
constexpr size_t WS_SSP = WS_TILE + 1 * MiB;
constexpr size_t WS_WAL = WS_SSP + 8 * MiB;
constexpr size_t WS_ALOW = WS_WAL + 1 * MiB;
constexpr size_t WS_WGW = WS_ALOW + 1 * MiB;
constexpr size_t WS_RTE = WS_WGW + 1 * MiB;
constexpr size_t WS_ACT = WS_RTE + 2 * MiB;
constexpr size_t WS_YS = WS_ACT + 288 * MiB;
constexpr size_t WS_END = WS_YS + 288 * MiB;
constexpr int CW_BAR = 4096;
constexpr int CW_CNT = 16384;
constexpr int CW_SS1 = 65536;
static_assert((CW_SS1 + T) * 4 <= (int)CTL_ZERO_BYTES, "ctl");

constexpr int NWAVES = 8, NTHR = 512;
constexpr int LDS_BYTES = 147456;
constexpr int MISC_OFF = 147200;

__device__ __forceinline__ float bf2f(unsigned short b) { return __uint_as_float(((unsigned)b) << 16); }
typedef __bf16 bf16x2_t __attribute__((ext_vector_type(2)));
__device__ __forceinline__ unsigned pk2(float lo, float hi) { const f32x2 v = {lo, hi}; return __builtin_bit_cast(unsigned, __builtin_convertvector(v, bf16x2_t)); }
__device__ __forceinline__ unsigned f2bf(float f) { return pk2(f, 0.f) & 0xffffu; }
__device__ __forceinline__ float wave_sum(float v) {
#pragma unroll
    for (int o = 1; o < 64; o <<= 1) v += __shfl_xor(v, o);
    return v;
}
__device__ __forceinline__ float wave_max(float v) {
#pragma unroll
    for (int o = 1; o < 64; o <<= 1) v = fmaxf(v, __shfl_xor(v, o));
    return v;
}
__device__ __forceinline__ float sigmoidf_(float x) { return __builtin_amdgcn_rcpf(1.0f + __builtin_amdgcn_exp2f(x * -1.4426950408889634f)); }
__device__ __forceinline__ float logsigmoidf_(float z) { return fminf(z, 0.f) - 0.6931471805599453f * __builtin_amdgcn_logf(1.0f + __builtin_amdgcn_exp2f(fabsf(z) * -1.4426950408889634f)); }
__device__ __forceinline__ u32x4 pack8(f32x4 a, f32x4 b) { u32x4 w; w.x = pk2(a[0], a[1]); w.y = pk2(a[2], a[3]); w.z = pk2(b[0], b[1]); w.w = pk2(b[2], b[3]); return w; }
__device__ __forceinline__ void unpack8(u32x4 w, f32x4& a, f32x4& b) {
    a[0] = __uint_as_float(w.x << 16); a[1] = __uint_as_float(w.x & 0xffff0000u); a[2] = __uint_as_float(w.y << 16); a[3] = __uint_as_float(w.y & 0xffff0000u);
    b[0] = __uint_as_float(w.z << 16); b[1] = __uint_as_float(w.z & 0xffff0000u); b[2] = __uint_as_float(w.w << 16); b[3] = __uint_as_float(w.w & 0xffff0000u);
}
__device__ __forceinline__ unsigned pk4_fp8(float a, float b, float c, float d) {
    a = fminf(fmaxf(a, -448.f), 448.f); b = fminf(fmaxf(b, -448.f), 448.f); c = fminf(fmaxf(c, -448.f), 448.f); d = fminf(fmaxf(d, -448.f), 448.f);
    int w = 0; w = __builtin_amdgcn_cvt_pk_fp8_f32(a, b, w, false); w = __builtin_amdgcn_cvt_pk_fp8_f32(c, d, w, true); return (unsigned)w; }
__device__ __forceinline__ bf16x8 as_bf8(u32x4 w) { return __builtin_bit_cast(bf16x8, w); }
#define MFMA16(A, B, C) __builtin_amdgcn_mfma_f32_16x16x32_bf16((A), (B), (C), 0, 0, 0)
__device__ __forceinline__ int ld_agent_i(const int* p) { return (int)__hip_atomic_load((const unsigned*)p, RLX_AGENT); }

#define XB_TMO      128
#define XB_XCNT(j)  (256  + 64 * (j))
#define XB_XSUB(j)  (1280 + 64 * (j))
#define XB_XGEN(j)  (2304 + 64 * (j))
#define XB_TOP      3328
#define XB_TOPGEN   3392
#define XCD_BAR_WORDS 3456
#define XB_SPIN_CAP (1u << 22)
__device__ __forceinline__ unsigned xb_ld(unsigned* p)              { return __hip_atomic_load(p, __ATOMIC_RELAXED, __HIP_MEMORY_SCOPE_AGENT); }
__device__ __forceinline__ unsigned xb_add(unsigned* p, unsigned v) { return __hip_atomic_fetch_add(p, v, __ATOMIC_RELAXED, __HIP_MEMORY_SCOPE_AGENT); }
__device__ __forceinline__ unsigned xb_xcc_id() { return (unsigned)__builtin_amdgcn_s_getreg((3 << 11) | 20) & 0xFu; }
#define XB_SPIN(cond, bar) do { unsigned _sp = 0; while (cond) { __builtin_amdgcn_s_sleep(1); \
    if ((++_sp & 255u) == 0u) { if (xb_ld(&(bar)[XB_TMO])) break; if (_sp > XB_SPIN_CAP) { atomicAdd(&(bar)[XB_TMO], 1u); break; } } } } while (0)
struct XcdBarrier { unsigned* bar; unsigned x; volatile LAS unsigned* st; };
__device__ __forceinline__ XcdBarrier xcd_barrier_post(unsigned* bar, volatile LAS unsigned* st) {
    XcdBarrier b; b.bar = bar; b.x = xb_xcc_id(); b.st = st;
    if (threadIdx.x == 0) (void)xb_add(&bar[XB_XCNT(b.x)], 1u);
    return b;
}
__device__ __forceinline__ void xcd_barrier_complete(unsigned* bar, unsigned x, unsigned& nloc, unsigned& nx) {
    const unsigned G = gridDim.x * gridDim.y * gridDim.z;
    unsigned sum, cnt, mine, sp = 0u;
    for (;;) {
        sum = 0u; cnt = 0u; mine = 0u;
#pragma unroll
        for (unsigned j = 0; j < 16; ++j) { const unsigned c = xb_ld(&bar[XB_XCNT(j)]); sum += c; cnt += (c > 0u) ? 1u : 0u; mine = (j == x) ? c : mine; }
        if (sum == G) break;
        __builtin_amdgcn_s_sleep(1);
        if ((++sp & 255u) == 0u) { if (xb_ld(&bar[XB_TMO])) break; if (sp > XB_SPIN_CAP) { atomicAdd(&bar[XB_TMO], 1u); break; } }
    }
    nloc = mine > 0u ? mine : 1u; nx = cnt > 0u ? cnt : 1u;
}
__device__ __forceinline__ void xcd_barrier(const XcdBarrier& b) {
    asm volatile("s_waitcnt vmcnt(0)" ::: "memory");
    __syncthreads();
    if (threadIdx.x == 0) {
        unsigned* bar = b.bar;
        __builtin_amdgcn_s_waitcnt(0);
        unsigned nloc = b.st[0], nx = b.st[1];
        if (nloc == 0u) { xcd_barrier_complete(bar, b.x, nloc, nx); b.st[0] = nloc; b.st[1] = nx; }
        const unsigned old = xb_add(&bar[XB_XSUB(b.x)], 1u);
        const unsigned gen = old / nloc;
        if (old + 1u == (gen + 1u) * nloc) {
            __builtin_amdgcn_fence(__ATOMIC_RELEASE, "agent");
            asm volatile("s_waitcnt vmcnt(0)" ::: "memory");
            const unsigned og = xb_add(&bar[XB_TOP], 1u);
            const unsigned tg = og / nx;
            if (og + 1u == (tg + 1u) * nx) xb_add(&bar[XB_TOPGEN], 1u);
            else XB_SPIN(xb_ld(&bar[XB_TOPGEN]) == tg, bar);
            __builtin_amdgcn_fence(__ATOMIC_ACQUIRE, "agent");
            xb_add(&bar[XB_XGEN(b.x)], 1u);
            asm volatile("s_waitcnt vmcnt(0)" ::: "memory");
        } else {
            XB_SPIN(xb_ld(&bar[XB_XGEN(b.x)]) == gen, bar);
            __builtin_amdgcn_fence(__ATOMIC_ACQUIRE, "agent");
            asm volatile("s_waitcnt vmcnt(0)" ::: "memory");
        }
    }
    __syncthreads();
}

struct Args { const float* in[26]; float* out; unsigned char* ws; int ph_lo, ph_hi, probe, pad; };
struct Frame {
    LAS unsigned char* lds; unsigned char* ws; unsigned* ctl;
    int tid, lane, wave, G, bid;
    const float* const* in;
    float* out;
};
#define WSP(type, off) ((type*)(F.ws + (off)))
enum { I_X = 0, I_MEM, I_NMIXG, I_WIN, I_GGW, I_GGB, I_GNG, I_GOW, I_CW, I_CBIAS, I_COW, I_MXW, I_NXG, I_NMG, I_XQ, I_XK, I_XV, I_XO, I_NMOEG, I_RW, I_RB, I_GUW, I_GUB, I_DNW, I_DNB, I_NFG };

constexpr int BM = 256, BK = 64, HALF = 128, HTB = HALF * BK * 2, NXCD = 8, WGM = 8;
__device__ __forceinline__ int lds_byte(int r, int c) { const int st = (r >> 4) * 2 + (c >> 5), rr = r & 15, cc = c & 31, ob = rr * 64 + cc * 2; return st * 1024 + (ob ^ (((ob >> 9) & 1) << 5)); }
__device__ __forceinline__ void stage_rc(int b, int& R, int& C) { const int st = b / 1024, sb = b % 1024, swz = sb ^ (((sb >> 9) & 1) << 5); R = (st >> 1) * 16 + swz / 64; C = (st & 1) * 32 + (swz % 64) / 2; }
__device__ __forceinline__ int g8(int rr) { return ((rr >> 3) & 1) * 4 + ((rr >> 1) & 1); }
__device__ __forceinline__ int lds_byte8(int r, int c) { return (r >> 4) * 2048 + (r & 15) * 128 + ((c ^ g8(r & 15)) << 4); }
__device__ __forceinline__ void stage_rc8(int b, int& R, int& C) { const int s = b >> 4, rr = (s >> 3) & 15; R = (s >> 7) * 16 + rr; C = 8 * ((s & 7) ^ g8(rr)); }
__device__ __forceinline__ int perm32(int rho) { const int n = rho >> 4, i = rho & 15; return 8 * (i >> 2) + 4 * n + (i & 3); }

struct Unit { int pm, pn, e; };
__device__ __forceinline__ bool static_next(int i, int G, int c, int nM, int nN, Unit& u) {
    const int nwg = nM * nN; const long L = (long)i * G + c; if (L >= nwg) return false;
    int wgid = (int)L; { const int q = nwg / NXCD, r = nwg % NXCD, xcd = wgid % NXCD, off = wgid / NXCD; wgid = (xcd < r ? xcd * (q + 1) : r * (q + 1) + (xcd - r) * q) + off; }
    const int nig = WGM * nN, gid = wgid / nig, fm = gid * WGM, gsz = (nM - fm) < WGM ? (nM - fm) : WGM;
    u.pm = fm + ((wgid % nig) % gsz); u.pn = (wgid % nig) / gsz; u.e = 0; return true;
}
struct DenseSched {
    const char* A; const char* Bt; int K, nM, nN, G, c, i0, ni, pair;
    __device__ __forceinline__ void init(const void* A_, const void* Bt_, int M, int N, int K_, int G_, int c_, int i0_ = 0, int ni_ = 1 << 30, int pair_ = 0) { A = (const char*)A_; Bt = (const char*)Bt_; K = K_; nM = M / BM; nN = N / BM; G = G_; c = c_; i0 = i0_; ni = ni_; pair = pair_; }
    __device__ __forceinline__ bool next(int i, Unit& u) const { if (pair) { if (i >= 2 * ni) return false; return static_next(i0 + (i >> 1), G, c - (i & 1) * pair, nM, nN, u); } if (i >= ni) return false; if (!static_next(i0 + i, G, c, nM, nN, u)) return false; if (ks) { u.e = u.pn / (nN >> 1); u.pn -= u.e * (nN >> 1); } return true; }
    int ks = 0;
    __device__ __forceinline__ const char* a_base() const { return A; }
    __device__ __forceinline__ size_t a_off(const Unit& u) const { return ks ? (size_t)u.e * K : 0; }
    __device__ __forceinline__ const char* b_base(const Unit& u) const { return Bt + (size_t)u.pn * BM * K * 2 + (ks ? (size_t)u.e * K : 0); }
    __device__ __forceinline__ unsigned a_src_row(const Unit& u, int r) const { return (unsigned)(u.pm * BM + r); }
    __device__ __forceinline__ int koff(const Unit& u, int nt) const { return 0; }
    __device__ __forceinline__ int nkt(int bk) const { return (ks ? K / 2 : K) / bk; }
};
constexpr int LAY_OFF = 131072, LAY_CNT = 64, LAY_TILE = 128;
__device__ __forceinline__ void moe_layout(LAS unsigned char* lds, const unsigned* cnt) {
    LAS int* lay = (LAS int*)(lds + LAY_OFF);
    __syncthreads();
    if (threadIdx.x < NE) lay[LAY_CNT + threadIdx.x] = (int)__hip_atomic_load(cnt + 64 * threadIdx.x, RLX_AGENT);
    __syncthreads();
    if (threadIdx.x == 0) { int o = 0; for (int e = 0; e < NE; ++e) { lay[e] = o; o += (lay[LAY_CNT + e] + 255) / 256 * 256; } lay[NE] = o; }
    __syncthreads();
    for (int tl = threadIdx.x; tl < lay[NE] / 256; tl += NTHR) { int e = 0; for (int q = 1; q < NE; ++q) e = (tl * 256 >= lay[q]) ? q : e; lay[LAY_TILE + tl] = e; }
    __syncthreads();
}
struct GroupSched {
    const char* A; const char* Bt; int K, N, nM, nN, G, c, eb; const LAS int* lay; const int* rte;
    __device__ __forceinline__ void init(const void* A_, const void* Bt_, int ntiles, int N_, int K_, int G_, int c_, const LAS int* lay_, const int* rte_, int eb_ = 2) { A = (const char*)A_; Bt = (const char*)Bt_; eb = eb_; K = K_; N = N_; nM = ntiles; nN = N_ / BM; G = G_; c = c_; lay = lay_; rte = rte_; }
    __device__ __forceinline__ bool next(int i, Unit& u) const { if (!static_next(i, G, c, nM, nN, u)) return false; u.e = __builtin_amdgcn_readfirstlane(lay[LAY_TILE + u.pm]); return true; }
    __device__ __forceinline__ const char* a_base() const { return A; }
    __device__ __forceinline__ const char* b_base(const Unit& u) const { return eb == 1 ? Bt + ((size_t)u.e * nN + (size_t)u.pn) * (size_t)(K / 128) * 32768 : Bt + ((size_t)u.e * N + (size_t)u.pn * BM) * K * eb; }
    __device__ __forceinline__ int koff(const Unit& u, int nt) const { return (2 * u.pm) & (nt - 1); }
    __device__ __forceinline__ size_t a_off(const Unit& u) const { return 0; }
    __device__ __forceinline__ int nkt(int bk) const { return K / bk; }
    __device__ __forceinline__ unsigned a_src_row(const Unit& u, int r) const { if (!rte) return (unsigned)(u.pm * BM + r); const int pos = u.pm * BM + r - lay[u.e]; return pos < lay[LAY_CNT + u.e] ? (unsigned)ld_agent_i(rte + (size_t)u.e * T + pos) : (unsigned)T; }
};

template <class Epi, class Sched>
__device__ __forceinline__ void gemm_ref(LAS unsigned char* lds, const Sched& S, const Epi& E) {
    const int tid = threadIdx.x, tx = tid & 15, ty = tid >> 4, K = S.K;
    LAS float* As = (LAS float*)lds; LAS float* Bs = As + 16 * 260;
    const int lr = tid >> 1, kh = tid & 1;
    for (int i = 0;; ++i) {
        Unit u; if (!S.next(i, u)) break;
        float acc[8][16];
#pragma unroll
        for (int j = 0; j < 8; ++j)
#pragma unroll
            for (int q = 0; q < 16; ++q) acc[j][q] = 0.f;
        const char* Ab = S.a_base() + S.a_off(u) + ((size_t)S.a_src_row(u, lr) * K + 8 * kh) * 2;
        const char* Bb = S.b_base(u) + ((size_t)lr * K + 8 * kh) * 2;
        for (int k0 = 0; k0 < 16 * S.nkt(16); k0 += 16) {
            const bf16x8 av = *(const bf16x8*)(Ab + (size_t)k0 * 2), bv = *(const bf16x8*)(Bb + (size_t)k0 * 2);
            __syncthreads();
#pragma unroll
            for (int j = 0; j < 8; ++j) { As[(8 * kh + j) * 260 + lr] = bf2f((unsigned short)av[j]); Bs[(8 * kh + j) * 260 + lr] = bf2f((unsigned short)bv[j]); }
            __syncthreads();
#pragma unroll 4
            for (int kk = 0; kk < 16; ++kk) {
                float a[8], b[16];
#pragma unroll
                for (int j = 0; j < 8; ++j) a[j] = As[kk * 260 + ty + 32 * j];
                const f32x4 b0 = *(const LAS f32x4*)(Bs + kk * 260 + 8 * tx), b1 = *(const LAS f32x4*)(Bs + kk * 260 + 8 * tx + 4);
                const f32x4 b2 = *(const LAS f32x4*)(Bs + kk * 260 + 128 + 8 * tx), b3 = *(const LAS f32x4*)(Bs + kk * 260 + 128 + 8 * tx + 4);
#pragma unroll
                for (int q = 0; q < 4; ++q) { b[q] = b0[q]; b[4 + q] = b1[q]; b[8 + q] = b2[q]; b[12 + q] = b3[q]; }
#pragma unroll
                for (int j = 0; j < 8; ++j)
#pragma unroll
                    for (int q = 0; q < 16; ++q) acc[j][q] += a[j] * b[q];
            }
        }
#pragma unroll 8
        for (int j = 0; j < 8; ++j) {
            const f32x4 a0 = {acc[j][0], acc[j][1], acc[j][2], acc[j][3]}, a1 = {acc[j][4], acc[j][5], acc[j][6], acc[j][7]};
            const f32x4 b0 = {acc[j][8], acc[j][9], acc[j][10], acc[j][11]}, b1 = {acc[j][12], acc[j][13], acc[j][14], acc[j][15]};
            typename Epi::Ctx cx; E.load(u.pm * BM + ty + 32 * j, u, 8 * tx, cx); E.template fin<false>(u.pm * BM + ty + 32 * j, u, 8 * tx, cx, a0, a1, b0, b1);
        }
    }
    __syncthreads();
}

__device__ __forceinline__ void glds16s(const void* sbase, unsigned voff, unsigned lds_dst) {
    asm volatile("s_mov_b32 m0, %2\n\ts_nop 0\n\tglobal_load_lds_dwordx4 %1, %0" :: "s"(sbase), "v"(voff), "s"(lds_dst) : "memory", "m0");
}
typedef int i32x8 __attribute__((ext_vector_type(8)));
typedef int i32x4_t __attribute__((ext_vector_type(4)));
template <class Epi, class Sched, bool FP8 = false>
__device__ __forceinline__ void gemm_mfma(LAS unsigned char* lds, const Sched& S, const Epi& E, const bool do_epi = true) {
    const int tid = threadIdx.x, wid = __builtin_amdgcn_readfirstlane(tid >> 6), lane = tid & 63, wr = wid >> 2, wc = wid & 3, fr = lane & 15, fq = lane >> 4;
    const int K = S.K, nt = S.nkt(FP8 ? 128 : BK); const unsigned rowb = (unsigned)K * (FP8 ? 1u : 2u), rowbB = FP8 ? 128u : rowb;
    unsigned voffB[2];
#pragma unroll
    for (int i = 0; i < 2; ++i) { int R_, C_; if constexpr (FP8) stage_rc8(tid * 16 + i * 8192, R_, C_); else stage_rc(tid * 16 + i * 8192, R_, C_); const int Rb = (R_ & ~31) + perm32(R_ & 31); voffB[i] = (unsigned)Rb * rowbB + (unsigned)C_ * 2u; }
    const size_t kstep = (size_t)(BK * 2);
    const size_t kstepB = FP8 ? (size_t)32768 : kstep, hstep = (size_t)HALF * rowbB;
    const unsigned ldsw = (unsigned)wid * 1024u, lds0 = (unsigned)(uintptr_t)lds;
    const int aoff = FP8 ? lds_byte8(wr * 64 + fr, 2 * fq) : lds_byte(wr * 64 + fr, fq * 8), boff = FP8 ? lds_byte8(wc * 32 + fr, 2 * fq) : lds_byte(wc * 32 + fr, fq * 8);
    const int aoff1 = FP8 ? lds_byte8(wr * 64 + fr, 2 * fq + 1) : 0, boff1 = FP8 ? lds_byte8(wc * 32 + fr, 2 * fq + 1) : 0;

#define PG8_SA(b, h) (((b) * 2 + (h)) * HTB)
#define PG8_SB(b, h) ((4 + (b) * 2 + (h)) * HTB)
#define PG8_STAGE(bufoff, gbase, voff) do { _Pragma("unroll") for (int _i = 0; _i < 2; ++_i) \
        glds16s((const void*)(gbase), (voff)[_i], (unsigned)__builtin_amdgcn_readfirstlane((int)(lds0 + (unsigned)(bufoff) + ldsw + (unsigned)_i * 8192u))); } while (0)
#define PG8_LDA(dst, b, h) do { _Pragma("unroll") for (int m = 0; m < 4; ++m) { if constexpr (FP8) { const LAS unsigned char* _p = lds + PG8_SA(b, h) + m * 2048; \
            dst##8[m] = __builtin_shufflevector(*(const LAS i32x4_t*)(_p + aoff), *(const LAS i32x4_t*)(_p + aoff1), 0, 1, 2, 3, 4, 5, 6, 7); } \
        else { _Pragma("unroll") for (int k = 0; k < 2; ++k) dst[m][k] = *(const LAS bf16x8*)(lds + PG8_SA(b, h) + aoff + m * 2048 + k * 1024); } } } while (0)
#define PG8_LDB(dst, b, h) do { _Pragma("unroll") for (int n = 0; n < 2; ++n) { if constexpr (FP8) { const LAS unsigned char* _p = lds + PG8_SB(b, h) + n * 2048; \
            dst##8[n] = __builtin_shufflevector(*(const LAS i32x4_t*)(_p + boff), *(const LAS i32x4_t*)(_p + boff1), 0, 1, 2, 3, 4, 5, 6, 7); } \
        else { _Pragma("unroll") for (int k = 0; k < 2; ++k) dst[n][k] = *(const LAS bf16x8*)(lds + PG8_SB(b, h) + boff + n * 2048 + k * 1024); } } } while (0)
#define PG8_MMA(ai, bj, At, Bt) do { __builtin_amdgcn_s_setprio(1); _Pragma("unroll") for (int m = 0; m < 4; ++m) _Pragma("unroll") for (int n = 0; n < 2; ++n) { \
        if constexpr (FP8) { asm volatile("v_mfma_f32_16x16x128_f8f6f4 %0, %1, %2, %0" : "+v"(acc[ai][bj][m][n]) : "v"(Bt##8[n]), "v"(At##8[m])); } \
        else { _Pragma("unroll") for (int k = 0; k < 2; ++k) acc[ai][bj][m][n] = __builtin_amdgcn_mfma_f32_16x16x32_bf16(Bt[n][k], At[m][k], acc[ai][bj][m][n], 0, 0, 0); } } \
        __builtin_amdgcn_s_setprio(0); } while (0)
#define PG8_WAIT_V(n) asm volatile("s_waitcnt vmcnt(" #n ")" ::: "memory")
#define PG8_WAIT_L(n) asm volatile("s_waitcnt lgkmcnt(" #n ")" ::: "memory")
#define PG8_BAR __builtin_amdgcn_s_barrier()
#define PG8_SCHED __builtin_amdgcn_sched_barrier(0)
#define PG8_AOFF(dst, uu) do { _Pragma("unroll") for (int _i = 0; _i < 2; ++_i) { int _R, _C; if constexpr (FP8) stage_rc8(tid * 16 + _i * 8192, _R, _C); else stage_rc(tid * 16 + _i * 8192, _R, _C); _Pragma("unroll") for (int _h = 0; _h < 2; ++_h) dst[_h][_i] = S.a_src_row(uu, _h * HALF + _R) * rowb + (unsigned)_C * 2u; } } while (0)
    Unit cur, nxt; int ui = 0;
    if (!S.next(0, cur)) return;
    f32x4 acc[2][2][4][2];
#pragma unroll
    for (int a = 0; a < 2; ++a)
#pragma unroll
        for (int b = 0; b < 2; ++b)
#pragma unroll
            for (int m = 0; m < 4; ++m)
#pragma unroll
                for (int n = 0; n < 2; ++n) acc[a][b][m][n] = (f32x4){0.f, 0.f, 0.f, 0.f};
    bf16x8 At[4][2], B0[2][2], B1[2][2]; i32x8 At8[4], B08[2], B18[2];
    unsigned coff[2][2], noff[2][2];
    PG8_AOFF(coff, cur);
    const char* cA = S.a_base() + S.a_off(cur); const char* cB = S.b_base(cur);
    int ck = S.koff(cur, nt), nk = 0;
    PG8_STAGE(PG8_SB(0, 0), cB + ck * kstepB, voffB); PG8_STAGE(PG8_SB(0, 1), cB + hstep + ck * kstepB, voffB); PG8_STAGE(PG8_SA(0, 0), cA + ck * kstep, coff[0]); PG8_STAGE(PG8_SA(0, 1), cA + ck * kstep, coff[1]);
    if (wr == 1) PG8_BAR;
    PG8_WAIT_V(2); PG8_BAR;
    PG8_STAGE(PG8_SB(1, 0), cB + (ck + 1) * kstepB, voffB); PG8_STAGE(PG8_SA(1, 0), cA + (ck + 1) * kstep, coff[0]); PG8_STAGE(PG8_SB(1, 1), cB + hstep + (ck + 1) * kstepB, voffB);
    PG8_WAIT_V(6); PG8_BAR;
    for (;;) {
        const bool has_next = S.next(ui + 1, nxt);
        const char* nB = cB; const char* nA = cA;
#pragma unroll
        for (int _h = 0; _h < 2; ++_h)
#pragma unroll
            for (int _i = 0; _i < 2; ++_i) noff[_h][_i] = coff[_h][_i];
        nk = ck;
        if (has_next) { nB = S.b_base(nxt); nA = S.a_base() + S.a_off(nxt); PG8_AOFF(noff, nxt); nk = S.koff(nxt, nt); }
        for (int t = 0; t < nt; t += 2) {
            const bool last = (t == nt - 2);
            const int k1 = (t + 1 + ck) & (nt - 1), k2 = last ? nk : ((t + 2 + ck) & (nt - 1));
            const char* a1 = cA + (size_t)k1 * kstep;
            const char* a2 = (last ? nA : cA) + (size_t)k2 * kstep; const char* b2 = (last ? nB : cB) + (size_t)k2 * kstepB;
            const char* a3 = a2 + kstep; const char* b3 = b2 + kstepB;
            unsigned o2[2][2];
#pragma unroll
            for (int _h = 0; _h < 2; ++_h)
#pragma unroll
                for (int _i = 0; _i < 2; ++_i) o2[_h][_i] = last ? noff[_h][_i] : coff[_h][_i];
            PG8_LDB(B0, 0, 0); PG8_LDB(B1, 0, 1); PG8_SCHED; PG8_LDA(At, 0, 0); PG8_STAGE(PG8_SA(1, 1), a1, coff[1]);
            PG8_WAIT_V(8); PG8_WAIT_L(0); PG8_BAR; PG8_MMA(0, 0, At, B0); PG8_MMA(0, 1, At, B1); PG8_BAR; PG8_SCHED;
            PG8_LDA(At, 0, 1); PG8_STAGE(PG8_SB(0, 0), b2, voffB); PG8_STAGE(PG8_SB(0, 1), b2 + hstep, voffB); PG8_STAGE(PG8_SA(0, 0), a2, o2[0]);
            PG8_WAIT_V(8); PG8_WAIT_L(0); PG8_BAR; PG8_MMA(1, 0, At, B0); PG8_MMA(1, 1, At, B1); PG8_BAR; PG8_SCHED;
            PG8_LDB(B0, 1, 0); PG8_LDB(B1, 1, 1); PG8_SCHED; PG8_LDA(At, 1, 0); PG8_STAGE(PG8_SA(0, 1), a2, o2[1]);
            PG8_WAIT_V(8); PG8_WAIT_L(0); PG8_BAR; PG8_MMA(0, 0, At, B0); PG8_MMA(0, 1, At, B1); PG8_BAR; PG8_SCHED;
            PG8_LDA(At, 1, 1); PG8_STAGE(PG8_SB(1, 0), b3, voffB); PG8_STAGE(PG8_SB(1, 1), b3 + hstep, voffB); PG8_STAGE(PG8_SA(1, 0), a3, o2[0]);
            PG8_WAIT_V(8); PG8_WAIT_L(0); PG8_BAR; PG8_MMA(1, 0, At, B0); PG8_MMA(1, 1, At, B1); PG8_BAR; PG8_SCHED;
        }
#ifndef ALIGN_EPI
#define ALIGN_EPI 1
#endif
        if (ALIGN_EPI && wr == 0) PG8_BAR;
        if constexpr (FP8) asm volatile("s_nop 15\n\ts_nop 15" ::: "memory");
        if (do_epi) {
            constexpr int NB = Epi::NB; const int rbase = cur.pm * BM + wr * 64 + fr, c0 = wc * 32 + 8 * fq;
#pragma unroll
            for (int g0 = 0; g0 < 8; g0 += NB) {
                typename Epi::Ctx cx[NB];
#pragma unroll
                for (int i = 0; i < NB; ++i) E.load(rbase + ((g0 + i) >> 2) * HALF + ((g0 + i) & 3) * 16, cur, c0, cx[i]);
#pragma unroll
                for (int i = 0; i < NB; ++i) { const int ai = (g0 + i) >> 2, m = (g0 + i) & 3;
                    E.template fin<true>(rbase + ai * HALF + m * 16, cur, c0, cx[i], acc[ai][0][m][0], acc[ai][0][m][1], acc[ai][1][m][0], acc[ai][1][m][1]); }
            }
        }
        if (!has_next) break;
#pragma unroll
        for (int a = 0; a < 2; ++a)
#pragma unroll
            for (int b = 0; b < 2; ++b)
#pragma unroll
                for (int m = 0; m < 4; ++m)
#pragma unroll
                    for (int n = 0; n < 2; ++n) acc[a][b][m][n] = (f32x4){0.f, 0.f, 0.f, 0.f};
        cur = nxt; cB = nB; cA = nA; ck = nk;
#pragma unroll
        for (int _h = 0; _h < 2; ++_h)
#pragma unroll
            for (int _i = 0; _i < 2; ++_i) coff[_h][_i] = noff[_h][_i];
        ++ui;
        if (ALIGN_EPI && wr == 1) PG8_BAR;
    }
    PG8_WAIT_V(0);
    if (!ALIGN_EPI && wr == 0) PG8_BAR;
    PG8_BAR;
#undef PG8_SA
#undef PG8_SB
#undef PG8_STAGE
#undef PG8_LDA
#undef PG8_LDB
#undef PG8_MMA
#undef PG8_WAIT_V
#undef PG8_WAIT_L
#undef PG8_BAR
#undef PG8_SCHED
#undef PG8_AOFF
}
#ifndef SKEW_TICKS
#define SKEW_TICKS 0
#endif
__device__ __forceinline__ void phase_skew(int bid) {
    if (SKEW_TICKS > 0 && (bid & 1)) { const unsigned long long t0 = __builtin_amdgcn_s_memrealtime(); while (__builtin_amdgcn_s_memrealtime() - t0 < (unsigned long long)SKEW_TICKS) __builtin_amdgcn_s_sleep(8); }
}
template <class Epi, class Sched, bool FP8 = false>
__device__ __forceinline__ void gemm_any(LAS unsigned char* lds, const Sched& S, const Epi& E, const bool do_epi = true) {
#if OPT_GEMM
    gemm_mfma<Epi, Sched, FP8>(lds, S, E, do_epi);
#else
    gemm_ref<Epi, Sched>(lds, S, E);
#endif
}

__device__ __forceinline__ void st_bf8(bf16* p, f32x4 a, f32x4 b) { *(u32x4*)p = pack8(a, b); }
__device__ __forceinline__ void ld_bf8(const bf16* p, f32x4& a, f32x4& b) { unpack8(*(const u32x4*)p, a, b); }
constexpr float W8_SCALE = 128.0f, H8_SCALE = 8.0f, A8_SCALE = 4.0f;

struct EpiInProj {
    static constexpr int NB = 1; struct Ctx { int dummy; };
    bf16 *Q, *Kk, *V, *SR, *CB, *U, *SGA, *SGB;
    __device__ __forceinline__ void load(int row, const Unit& u, int c0, Ctx& c) const {}
    template <bool MF> __device__ __forceinline__ void fin(int row, const Unit& u, int c0, const Ctx& c, f32x4 a0, f32x4 a1, f32x4 b0, f32x4 b1) const {
        const int pn = u.pn;
        if (pn >= TN_U && pn < TN_GA) { st_bf8(U + (size_t)row * D + (pn - TN_U) * 128 + c0, a0 * b0, a1 * b1); return; }
        bf16* base; int ld, ct, mode = 0; float sc = 1.0f;
        if (pn < TN_K) { base = Q; ld = QK; ct = pn - TN_Q; sc = 0.0625f; }
        else if (pn < TN_V) { base = Kk; ld = QK; ct = pn - TN_K; }
        else if (pn < TN_R) { base = V; ld = VD; ct = pn - TN_V; }
        else if (pn < TN_CB) { base = SR; ld = VD; ct = pn - TN_R; mode = 1; }
        else if (pn < TN_U) { base = CB; ld = D; ct = pn - TN_CB; }
        else if (pn < TN_GB) { base = SGA; ld = D; ct = pn - TN_GA; mode = 2; }
        else { base = SGB; ld = D; ct = pn - TN_GB; mode = 2; }
        if (mode) {
#pragma unroll
            for (int j = 0; j < 4; ++j) { const float s0 = sigmoidf_(a0[j]), s1 = sigmoidf_(a1[j]), s2 = sigmoidf_(b0[j]), s3 = sigmoidf_(b1[j]);
                a0[j] = (mode == 1) ? a0[j] * s0 : s0; a1[j] = (mode == 1) ? a1[j] * s1 : s1; b0[j] = (mode == 1) ? b0[j] * s2 : s2; b1[j] = (mode == 1) ? b1[j] * s3 : s3; }
        } else { a0 *= sc; a1 *= sc; b0 *= sc; b1 *= sc; }
        bf16* p = base + (size_t)row * ld + ct * 256 + c0; st_bf8(p, a0, a1); st_bf8(p + 128, b0, b1);
    }
};
struct EpiGateA {
    static constexpr int NB = 4; struct Ctx { u32x4 s0, s1; };
    bf16* T1; const bf16* SGA;
    __device__ __forceinline__ void load(int row, const Unit& u, int c0, Ctx& c) const { const size_t o = (size_t)row * D + u.pn * 256 + c0; c.s0 = *(const u32x4*)(SGA + o); c.s1 = *(const u32x4*)(SGA + o + 128); }
    template <bool MF> __device__ __forceinline__ void fin(int row, const Unit& u, int c0, const Ctx& c, f32x4 a0, f32x4 a1, f32x4 b0, f32x4 b1) const {
        const size_t o = (size_t)row * D + u.pn * 256 + c0; f32x4 g0, g1, g2, g3; unpack8(c.s0, g0, g1); unpack8(c.s1, g2, g3);
        st_bf8(T1 + o, a0 * g0, a1 * g1); st_bf8(T1 + o + 128, b0 * g2, b1 * g3);
    }
};
struct EpiGateB {
    static constexpr int NB = 2; struct Ctx { u32x4 s0, s1, t0, t1; };
    const bf16* T1; const bf16* SGB; bf16* MG;
    __device__ __forceinline__ void load(int row, const Unit& u, int c0, Ctx& c) const { const size_t o = (size_t)row * D + u.pn * 256 + c0; c.s0 = *(const u32x4*)(SGB + o); c.s1 = *(const u32x4*)(SGB + o + 128); c.t0 = *(const u32x4*)(T1 + o); c.t1 = *(const u32x4*)(T1 + o + 128); }
    template <bool MF> __device__ __forceinline__ void fin(int row, const Unit& u, int c0, const Ctx& c, f32x4 a0, f32x4 a1, f32x4 b0, f32x4 b1) const {
        const size_t o = (size_t)row * D + u.pn * 256 + c0; f32x4 g0, g1, g2, g3, t0, t1, t2, t3; unpack8(c.s0, g0, g1); unpack8(c.s1, g2, g3); unpack8(c.t0, t0, t1); unpack8(c.t1, t2, t3);
        st_bf8(MG + o, t0 + a0 * g0, t1 + a1 * g1); st_bf8(MG + o + 128, t2 + b0 * g2, t3 + b1 * g3);
    }
};
#if OPT_GEMM
constexpr int SSP_N = 32;
#else
constexpr int SSP_N = 128;
#endif
struct EpiResid1 {
    static constexpr int NB = 4; struct Ctx { f32x4 x0, x1, x2, x3; };
    const float* X; bf16* XB; float* SSP;
    __device__ __forceinline__ void load(int row, const Unit& u, int c0, Ctx& c) const { const size_t o = (size_t)row * D + u.pn * 256 + c0; c.x0 = *(const f32x4*)(X + o); c.x1 = *(const f32x4*)(X + o + 4); c.x2 = *(const f32x4*)(X + o + 128); c.x3 = *(const f32x4*)(X + o + 132); }
    template <bool MF> __device__ __forceinline__ void fin(int row, const Unit& u, int c0, const Ctx& c, f32x4 a0, f32x4 a1, f32x4 b0, f32x4 b1) const {
        const size_t o = (size_t)row * D + u.pn * 256 + c0;
        a0 += c.x0; a1 += c.x1; b0 += c.x2; b1 += c.x3;
        st_bf8(XB + o, a0, a1); st_bf8(XB + o + 128, b0, b1);
        float s = 0.f;
#pragma unroll
        for (int j = 0; j < 4; ++j) s += a0[j] * a0[j] + a1[j] * a1[j] + b0[j] * b0[j] + b1[j] * b1[j];
        if (MF) { s += __shfl_xor(s, 16); s += __shfl_xor(s, 32); if ((threadIdx.x & 63) < 16) SSP[(size_t)row * SSP_N + 4 * u.pn + (c0 >> 5)] = s; }
        else SSP[(size_t)row * SSP_N + 16 * u.pn + (c0 >> 3)] = s;
    }
};
constexpr ptrdiff_t QX_HALF = ((ptrdiff_t)WS_O32 - (ptrdiff_t)WS_QX) / 2;
struct EpiXQ {
    static constexpr int NB = 8; struct Ctx { float r; };
    bf16* QX; const float* SSP;
    __device__ __forceinline__ void load(int row, const Unit& u, int c0, Ctx& c) const {
        const float* sp = SSP + (size_t)row * SSP_N; f32x4 t = *(const f32x4*)sp;
#pragma unroll
        for (int j = 1; j < SSP_N / 4; ++j) t += *(const f32x4*)(sp + 4 * j);
        c.r = rsqrtf(((t[0] + t[1]) + (t[2] + t[3])) * (1.0f / D) + EPS);
    }
    template <bool MF> __device__ __forceinline__ void fin(int row, const Unit& u, int c0, const Ctx& c, f32x4 a0, f32x4 a1, f32x4 b0, f32x4 b1) const {
        bf16* p = QX + (ptrdiff_t)u.e * QX_HALF + (size_t)row * XA + u.pn * 256 + c0; st_bf8(p, a0 * c.r, a1 * c.r); st_bf8(p + 128, b0 * c.r, b1 * c.r);
    }
};
struct EpiResid2 {
    static constexpr int NB = 8; struct Ctx { u32x4 x0, x1; };
    bf16* XB;
    __device__ __forceinline__ void load(int row, const Unit& u, int c0, Ctx& c) const { const bf16* p = XB + (size_t)row * D + u.pn * 256 + c0; c.x0 = *(const u32x4*)p; c.x1 = *(const u32x4*)(p + 128); }
    template <bool MF> __device__ __forceinline__ void fin(int row, const Unit& u, int c0, const Ctx& c, f32x4 a0, f32x4 a1, f32x4 b0, f32x4 b1) const {
        bf16* p = XB + (size_t)row * D + u.pn * 256 + c0; f32x4 x0, x1, x2, x3; unpack8(c.x0, x0, x1); unpack8(c.x1, x2, x3);
        st_bf8(p, x0 + a0, x1 + a1); st_bf8(p + 128, x2 + b0, x3 + b1);
    }
};
struct EpiGU8 {
    static constexpr int NB = 8; struct Ctx { f32x4 g0, g1, u0, u1; };
    unsigned char* ACT8; const float* gub;
    __device__ __forceinline__ void load(int row, const Unit& u, int c0, Ctx& c) const { const float* bg = gub + (size_t)u.e * (2 * FF) + u.pn * 128 + c0; c.g0 = *(const f32x4*)bg; c.g1 = *(const f32x4*)(bg + 4); c.u0 = *(const f32x4*)(bg + FF); c.u1 = *(const f32x4*)(bg + FF + 4); }
    template <bool MF> __device__ __forceinline__ void fin(int row, const Unit& u, int c0, const Ctx& c, f32x4 a0, f32x4 a1, f32x4 b0, f32x4 b1) const {
        const int f = u.pn * 128 + c0; const float is = 1.0f / (W8_SCALE * H8_SCALE);
        f32x4 r0, r1;
#pragma unroll
        for (int j = 0; j < 4; ++j) {
            float g = fminf(a0[j] * is + c.g0[j], 7.0f), up = fminf(fmaxf(b0[j] * is + c.u0[j], -7.0f), 7.0f); r0[j] = (up + 1.0f) * g * sigmoidf_(1.702f * g) * A8_SCALE;
            g = fminf(a1[j] * is + c.g1[j], 7.0f); up = fminf(fmaxf(b1[j] * is + c.u1[j], -7.0f), 7.0f); r1[j] = (up + 1.0f) * g * sigmoidf_(1.702f * g) * A8_SCALE;
        }
        u32x2 o; o.x = pk4_fp8(r0[0], r0[1], r0[2], r0[3]); o.y = pk4_fp8(r1[0], r1[1], r1[2], r1[3]);
        *(u32x2*)(ACT8 + (size_t)row * FF + f) = o;
    }
};
constexpr float Y8_SCALE = 16.0f;
struct EpiDown8 {
    static constexpr int NB = 8; struct Ctx { f32x4 b0, b1, b2, b3; };
    unsigned char* YS; const float* dnb;
    __device__ __forceinline__ void load(int row, const Unit& u, int c0, Ctx& c) const { const float* bb = dnb + (size_t)u.e * D + u.pn * 256 + c0; c.b0 = *(const f32x4*)bb; c.b1 = *(const f32x4*)(bb + 4); c.b2 = *(const f32x4*)(bb + 128); c.b3 = *(const f32x4*)(bb + 132); }
    template <bool MF> __device__ __forceinline__ void fin(int row, const Unit& u, int c0, const Ctx& c, f32x4 a0, f32x4 a1, f32x4 b0, f32x4 b1) const {
        unsigned char* p = YS + (size_t)row * D + u.pn * 256 + c0; const float is = Y8_SCALE / (W8_SCALE * A8_SCALE);
        a0 = a0 * is + c.b0 * Y8_SCALE; a1 = a1 * is + c.b1 * Y8_SCALE; b0 = b0 * is + c.b2 * Y8_SCALE; b1 = b1 * is + c.b3 * Y8_SCALE;
        u32x2 o; o.x = pk4_fp8(a0[0], a0[1], a0[2], a0[3]); o.y = pk4_fp8(a1[0], a1[1], a1[2], a1[3]); *(u32x2*)p = o;
        o.x = pk4_fp8(b0[0], b0[1], b0[2], b0[3]); o.y = pk4_fp8(b1[0], b1[1], b1[2], b1[3]); *(u32x2*)(p + 128) = o;
    }
};

__device__ __forceinline__ void tr_item_fp8(const float* W, int ldw, int K, int srccol0, unsigned char* WT, int dstrow0, LAS float* scr, int kb, int lane) {
    const int k0 = 128 * kb;
#pragma unroll 8
    for (int i = 0; i < 64; ++i) { const int kk = 2 * i + (lane >> 5); scr[kk * 33 + (lane & 31)] = W[(size_t)(k0 + kk) * ldw + srccol0 + (lane & 31)] * W8_SCALE; }
    LDS_WAIT(); asm volatile("" ::: "memory");
    const int c = lane & 7;
#pragma unroll
    for (int j = 0; j < 4; ++j) { const int n = (lane >> 3) + 8 * j; const LAS float* s = scr + (16 * c) * 33 + n;
        u32x4 o; o.x = pk4_fp8(s[0 * 33], s[1 * 33], s[2 * 33], s[3 * 33]); o.y = pk4_fp8(s[4 * 33], s[5 * 33], s[6 * 33], s[7 * 33]);
        o.z = pk4_fp8(s[8 * 33], s[9 * 33], s[10 * 33], s[11 * 33]); o.w = pk4_fp8(s[12 * 33], s[13 * 33], s[14 * 33], s[15 * 33]);
        *(u32x4*)(WT + (size_t)(dstrow0 + n) * K + k0 + 16 * c) = o; }
    LDS_WAIT(); asm volatile("" ::: "memory");
}
__device__ __forceinline__ void tr_item(const float* W, int ldw, int K, int srccol0, bf16* WT, int dstrow0, const float* ksc, LAS float* scr, int kb, int lane) {
    const int k0 = 64 * kb;
    float v[32];
#pragma unroll
    for (int i = 0; i < 32; ++i) v[i] = __builtin_nontemporal_load(W + (size_t)(k0 + 2 * i + (lane >> 5)) * ldw + srccol0 + (lane & 31));
#pragma unroll
    for (int i = 0; i < 32; ++i) { const int kk = 2 * i + (lane >> 5); scr[kk * 33 + (lane & 31)] = ksc ? v[i] * ksc[k0 + kk] : v[i]; }
    LDS_WAIT(); asm volatile("" ::: "memory");
    const int c = lane & 7;
#pragma unroll
    for (int j = 0; j < 4; ++j) { const int n = (lane >> 3) + 8 * j; const LAS float* s = scr + (8 * c) * 33 + n;
        u32x4 o; o.x = pk2(s[0 * 33], s[1 * 33]); o.y = pk2(s[2 * 33], s[3 * 33]); o.z = pk2(s[4 * 33], s[5 * 33]); o.w = pk2(s[6 * 33], s[7 * 33]);
        *(u32x4*)(WT + (size_t)(dstrow0 + n) * K + k0 + 8 * c) = o; }
    LDS_WAIT(); asm volatile("" ::: "memory");
}
__device__ __forceinline__ void tr8_load(const float* W, int ldw, int srccol0, int kb32, int lane, f32x4 (&v)[8]) {
    const char* base = (const char*)(W + (size_t)(32 * kb32) * ldw + srccol0);
    const unsigned voff = (unsigned)((lane >> 4) * ldw + 4 * (lane & 15)) * 4u;
#pragma unroll
    for (int i = 0; i < 8; ++i) v[i] = __builtin_nontemporal_load((const f32x4*)(base + (size_t)(4 * i) * ldw * 4 + voff));
}
__device__ __forceinline__ void tr8_quarter(const f32x4 (&v)[8], LAS float* scr, int lane, u32x4 (&o)[2]) {
    LAS float* w = scr + (lane >> 4) * 68 + 4 * (lane & 15);
#pragma unroll
    for (int i = 0; i < 8; ++i) *(LAS f32x4*)(w + 4 * i * 68) = v[i] * W8_SCALE;
    LDS_WAIT(); asm volatile("" ::: "memory");
    const LAS float* s = scr + lane;
    o[0].x = pk4_fp8(s[0 * 68], s[1 * 68], s[2 * 68], s[3 * 68]); o[0].y = pk4_fp8(s[4 * 68], s[5 * 68], s[6 * 68], s[7 * 68]);
    o[0].z = pk4_fp8(s[8 * 68], s[9 * 68], s[10 * 68], s[11 * 68]); o[0].w = pk4_fp8(s[12 * 68], s[13 * 68], s[14 * 68], s[15 * 68]);
    o[1].x = pk4_fp8(s[16 * 68], s[17 * 68], s[18 * 68], s[19 * 68]); o[1].y = pk4_fp8(s[20 * 68], s[21 * 68], s[22 * 68], s[23 * 68]);
    o[1].z = pk4_fp8(s[24 * 68], s[25 * 68], s[26 * 68], s[27 * 68]); o[1].w = pk4_fp8(s[28 * 68], s[29 * 68], s[30 * 68], s[31 * 68]);
    LDS_WAIT(); asm volatile("" ::: "memory");
}
__device__ __forceinline__ void tr8_store(const u32x4 (&pc)[4][2], unsigned char* WT, int K, int dstrow0, int kb, LAS float* scr, int lane) {
    LAS unsigned* t = (LAS unsigned*)scr;
    LAS unsigned* wl = t + lane * 33;
#pragma unroll
    for (int q = 0; q < 4; ++q)
#pragma unroll
        for (int j = 0; j < 2; ++j) { LAS unsigned* d = wl + 8 * q + 4 * j; const u32x4 x = pc[q][j]; d[0] = x.x; d[1] = x.y; d[2] = x.z; d[3] = x.w; }
    LDS_WAIT(); asm volatile("" ::: "memory");
    const LAS unsigned* rl = t + (lane >> 3) * 33 + 4 * (lane & 7);
    unsigned char* gb = WT + ((size_t)((dstrow0 >> 8) * (K >> 7) + kb) * 256 + (dstrow0 & 255)) * 128;
    const unsigned gvo = (unsigned)((lane >> 3) * 128 + 16 * (lane & 7));
#pragma unroll
    for (int j = 0; j < 8; ++j) { const LAS unsigned* sdw = rl + 8 * 33 * j;
        const u32x4 x = {sdw[0], sdw[1], sdw[2], sdw[3]};
        __builtin_nontemporal_store(x, (u32x4*)(gb + 1024 * j + gvo)); }
    LDS_WAIT(); asm volatile("" ::: "memory");
}
__device__ __forceinline__ void ex8_decode(const Frame& F, int sup, const float*& W, int& ldw, int& src, unsigned char*& WT, int& K, int& dst, int& kb) {
    if (sup < NE * 1024) { const int e = sup / 1024, r = sup % 1024, nb = r % 64, p = nb >> 2, w = (nb & 3) * 64; kb = r / 64;
        W = F.in[I_GUW] + (size_t)e * D * (2 * FF); ldw = 2 * FF; src = (w < 128) ? 128 * p + w : FF + 128 * p + (w - 128); WT = WSP(unsigned char, WS_WGU) + (size_t)e * (2 * FF) * D; K = D; dst = 64 * nb; }
    else { const int s2 = sup - NE * 1024, e = s2 / 512, r = s2 % 512, nb = r % 32; kb = r / 32;
        W = F.in[I_DNW] + (size_t)e * FF * D; ldw = D; src = 64 * nb; WT = WSP(unsigned char, WS_WDN) + (size_t)e * D * FF; K = FF; dst = 64 * nb; }
}
__device__ __forceinline__ void rms_row_to_bf16(const float* xrow, const float* g, bf16* orow, int lane) {
    f32x4 v[8]; float s = 0.f;
#pragma unroll
    for (int j = 0; j < 8; ++j) { v[j] = *(const f32x4*)(xrow + 4 * lane + 256 * j); s += (v[j][0] * v[j][0] + v[j][1] * v[j][1]) + (v[j][2] * v[j][2] + v[j][3] * v[j][3]); }
    const float r = rsqrtf(wave_sum(s) * (1.0f / D) + EPS);
#pragma unroll
    for (int j = 0; j < 8; ++j) { const f32x4 gg = *(const f32x4*)(g + 4 * lane + 256 * j); u32x2 o; o.x = pk2(v[j][0] * r * gg[0], v[j][1] * r * gg[1]); o.y = pk2(v[j][2] * r * gg[2], v[j][3] * r * gg[3]); *(u32x2*)(orow + 4 * lane + 256 * j) = o; }
}
__device__ __forceinline__ void p0_prologue(Frame& F, const int part, const int cb, const int CNG) {
    LAS float* scr = (LAS float*)(F.lds + F.wave * 16896);
    const int gw = cb * NWAVES + F.wave, NGW = CNG * NWAVES, lane = F.lane, gt = cb * NTHR + F.tid, NGT = CNG * NTHR;
    const float* Win = F.in[I_WIN];
    bf16* WIN = WSP(bf16, WS_WIN);
    if (part == 0) {
    for (int it = gw; it < 512 * 32; it += NGW) {
        const int nb = it % 512, kb = it / 512, n0 = 32 * nb;
        int src;
        if (n0 < TN_CB * 256) src = n0;
        else if (n0 < TN_U * 256) src = SRC_CB + (n0 - TN_CB * 256);
        else if (n0 < TN_GA * 256) { const int rel = n0 - TN_U * 256, p = rel >> 8, w = rel & 255; src = (w < 128) ? SRC_CC + 128 * p + w : SRC_CHH + 128 * p + (w - 128); }
        else if (n0 < TN_GB * 256) src = SRC_GA + (n0 - TN_GA * 256);
        else src = SRC_GB + (n0 - TN_GB * 256);
        tr_item(Win, NIN_SRC, D, src, WIN, n0, nullptr, scr, kb, lane);
    }
    for (int it = gw; it < 32; it += NGW) tr_item(Win, NIN_SRC, D, SRC_ALOW, WSP(bf16, WS_WAL), 0, nullptr, scr, it, lane);
    { const float* GW = F.in[I_GGW]; bf16* WGW = WSP(bf16, WS_WGW); for (int i = gt; i < QK * 32; i += NGT) { const int n = i >> 5, k = i & 31; WGW[i] = (k < 16) ? (bf16)f2bf(GW[k * QK + n]) : (bf16)0; } }
    }
    if (part == 1) {
    for (int it = gw; it < 3 * 2048; it += NGW) { const int w = it / 2048, r = it % 2048, nb = r % 64, kb = r / 64;
        const float* W = F.in[w == 0 ? I_GOW : (w == 1 ? I_COW : I_MXW)]; bf16* WT = WSP(bf16, w == 0 ? WS_WGO : (w == 1 ? WS_WCO : WS_WMX));
        tr_item(W, D, D, 32 * nb, WT, 32 * nb, nullptr, scr, kb, lane); }
    for (int it = gw; it < 3 * 512; it += NGW) { const int w = it / 512, r = it % 512, nb = r % 16, kb = r / 16;
        if (w == 0) tr_item(F.in[I_XQ], XA, D, 32 * nb, WSP(bf16, WS_WXQ), 32 * nb, F.in[I_NXG], scr, kb, lane);
        else tr_item(F.in[w == 1 ? I_XK : I_XV], XA, D, 32 * nb, WSP(bf16, WS_WXKV), (w - 1) * XA + 32 * nb, nullptr, scr, kb, lane); }
    for (int it = gw; it < 512; it += NGW) { const int nb = it % 64, kb = it / 64; tr_item(F.in[I_XO], D, XA, 32 * nb, WSP(bf16, WS_WXO), 32 * nb, nullptr, scr, kb, lane); }
#if MOE_FP8
    { LAS float* scr8 = (LAS float*)(F.lds + F.wave * 16896);
      constexpr int NSUP = NE * 1024 + NE * 512;
      f32x4 va[8], vb[8]; u32x4 pc[4][2];
      const float* W; int ldw, src, K, dst, kb; unsigned char* WT;
      if (gw < NSUP) { ex8_decode(F, gw, W, ldw, src, WT, K, dst, kb); tr8_load(W, ldw, src, 4 * kb + 0, lane, va); }
      for (int sup = gw; sup < NSUP; sup += NGW) {
          tr8_load(W, ldw, src, 4 * kb + 1, lane, vb); tr8_quarter(va, scr8, lane, pc[0]);
          tr8_load(W, ldw, src, 4 * kb + 2, lane, va); tr8_quarter(vb, scr8, lane, pc[1]);
          tr8_load(W, ldw, src, 4 * kb + 3, lane, vb); tr8_quarter(va, scr8, lane, pc[2]);
          const float* W1 = W; int ldw1 = ldw, src1 = src, K1 = K, dst1 = dst, kb1 = kb; unsigned char* WT1 = WT;
          if (sup + NGW < NSUP) { ex8_decode(F, sup + NGW, W1, ldw1, src1, WT1, K1, dst1, kb1); tr8_load(W1, ldw1, src1, 4 * kb1 + 0, lane, va); }
          tr8_quarter(vb, scr8, lane, pc[3]);
          tr8_store(pc, WT, K, dst, kb, scr8, lane);
          W = W1; ldw = ldw1; src = src1; K = K1; dst = dst1; kb = kb1; WT = WT1;
      } }
#endif
    { const float* rw = F.in[I_RW]; const float* g = F.in[I_NMOEG]; float* WR = WSP(float, WS_WR);
      for (int i = gt; i < NE * D; i += NGT) { const int e = i / D, k = i % D; WR[i] = rw[k * NE + e] * g[k]; } }
    }
    if (part == 0) {
    for (int m = gw; m < T; m += 2 * NGW) {
        const float* x0 = F.in[I_X] + (size_t)m * D; const bool two = (m + NGW < T); const float* x1 = F.in[I_X] + (size_t)(two ? m + NGW : m) * D; const float* gmix = F.in[I_NMIXG];
        f32x4 v0[8], v1[8]; float s0 = 0.f, s1 = 0.f;
#pragma unroll
        for (int j = 0; j < 8; ++j) { v0[j] = *(const f32x4*)(x0 + 4 * lane + 256 * j); v1[j] = *(const f32x4*)(x1 + 4 * lane + 256 * j); }
#pragma unroll
        for (int j = 0; j < 8; ++j) { s0 += (v0[j][0] * v0[j][0] + v0[j][1] * v0[j][1]) + (v0[j][2] * v0[j][2] + v0[j][3] * v0[j][3]); s1 += (v1[j][0] * v1[j][0] + v1[j][1] * v1[j][1]) + (v1[j][2] * v1[j][2] + v1[j][3] * v1[j][3]); }
        const float r0 = rsqrtf(wave_sum(s0) * (1.0f / D) + EPS), r1 = rsqrtf(wave_sum(s1) * (1.0f / D) + EPS);
        bf16* o0 = WSP(bf16, WS_XN) + (size_t)m * D; bf16* o1 = WSP(bf16, WS_XN) + (size_t)(m + NGW) * D;
#pragma unroll
        for (int j = 0; j < 8; ++j) { const f32x4 gg = *(const f32x4*)(gmix + 4 * lane + 256 * j);
            u32x2 a; a.x = pk2(v0[j][0] * r0 * gg[0], v0[j][1] * r0 * gg[1]); a.y = pk2(v0[j][2] * r0 * gg[2], v0[j][3] * r0 * gg[3]); *(u32x2*)(o0 + 4 * lane + 256 * j) = a;
            if (two) { u32x2 b; b.x = pk2(v1[j][0] * r1 * gg[0], v1[j][1] * r1 * gg[1]); b.y = pk2(v1[j][2] * r1 * gg[2], v1[j][3] * r1 * gg[3]); *(u32x2*)(o1 + 4 * lane + 256 * j) = b; } }
    }
    }
    if (part == 1) {
    for (int m = gw; m < MEM; m += NGW) rms_row_to_bf16(F.in[I_MEM] + (size_t)m * D, F.in[I_NMG], WSP(bf16, WS_MEMN) + (size_t)m * D, lane);
    { u32x4* z = (u32x4*)(WSP(bf16, WS_H3) + (size_t)T * D); u32x4* z8 = (u32x4*)(WSP(unsigned char, WS_H3) + (size_t)T * D); for (int i = gt; i < 256; i += NGT) { z[i] = (u32x4){0u, 0u, 0u, 0u}; z8[i] = (u32x4){0u, 0u, 0u, 0u}; } }
    }
}

__device__ __forceinline__ void p_memkv(Frame& F) {
    const bf16* A = WSP(bf16, WS_MEMN); const bf16* B = WSP(bf16, WS_WXKV); bf16* KM = WSP(bf16, WS_KM); bf16* VMT = WSP(bf16, WS_VMT);
    LAS f32x4* red = (LAS f32x4*)F.lds;
    const int lane = F.lane, w = F.wave, lr = lane & 15, lg = lane >> 4;
    for (int unit = F.bid; unit < (MEM / 16) * (2 * XA / 64); unit += F.G) {
        const int mt = unit & 15, nt = unit >> 4; const bool isk = nt < 8;
        const bf16* ap = A + (size_t)(16 * mt + lr) * D + 256 * w + 8 * lg; const bf16* bp = B + (size_t)(64 * nt + lr) * D + 256 * w + 8 * lg;
        bf16x8 af[8], bf[4][8];
#pragma unroll
        for (int s = 0; s < 8; ++s) { af[s] = *(const bf16x8*)(ap + 32 * s);
#pragma unroll
            for (int j = 0; j < 4; ++j) bf[j][s] = *(const bf16x8*)(bp + (size_t)(16 * j) * D + 32 * s); }
        f32x4 acc[4];
#pragma unroll
        for (int j = 0; j < 4; ++j) { acc[j] = (f32x4){0.f, 0.f, 0.f, 0.f};
#pragma unroll
            for (int s = 0; s < 8; ++s) acc[j] = isk ? MFMA16(bf[j][s], af[s], acc[j]) : MFMA16(af[s], bf[j][s], acc[j]); }
        __syncthreads();
#pragma unroll
        for (int j = 0; j < 4; ++j) red[(w * 4 + j) * 64 + lane] = acc[j];
        __syncthreads();
        if (w < 4) { f32x4 t = red[w * 64 + lane];
#pragma unroll
            for (int ww = 1; ww < 8; ++ww) t += red[(ww * 4 + w) * 64 + lane];
            u32x2 o; o.x = pk2(t[0], t[1]); o.y = pk2(t[2], t[3]);
            if (isk) *(u32x2*)(KM + (size_t)(16 * mt + lr) * XA + 64 * nt + 16 * w + 4 * lg) = o;
            else *(u32x2*)(VMT + (size_t)(64 * nt - XA + 16 * w + lr) * MEM + 16 * mt + 4 * lg) = o;
        }
    }
    __syncthreads();
}

__device__ __forceinline__ void p_alow(Frame& F) {
    const bf16* XN = WSP(bf16, WS_XN); const bf16* WAL = WSP(bf16, WS_WAL); const bf16* WGW = WSP(bf16, WS_WGW); const float* GB = F.in[I_GGB]; float* LA = WSP(float, WS_LA);
    LAS f32x4* red = (LAS f32x4*)F.lds;
    const int lane = F.lane, lr = lane & 15, lg = lane >> 4, tk = F.wave >> 1, kh = F.wave & 1;
    for (int t4 = F.bid; t4 < T / 64; t4 += F.G) {
        const int task = 4 * t4 + tk;
        const bf16* ap = WAL + (size_t)lr * D + 1024 * kh + 8 * lg; const bf16* bp = XN + (size_t)(16 * task + lr) * D + 1024 * kh + 8 * lg;
        f32x4 acc = {0.f, 0.f, 0.f, 0.f};
#pragma unroll 16
        for (int s = 0; s < 32; ++s) acc = MFMA16(*(const bf16x8*)(ap + 32 * s), *(const bf16x8*)(bp + 32 * s), acc);
        __syncthreads();
        red[(tk * 2 + kh) * 64 + lane] = acc;
        __syncthreads();
#if OPT_GLA
        if (kh == 0) *(f32x4*)(WSP(float, WS_ALOW) + (size_t)(16 * task + lr) * 16 + 4 * lg) = red[(tk * 2) * 64 + lane] + red[(tk * 2 + 1) * 64 + lane];
        continue;
#endif
        u32x4 bw = {0u, 0u, 0u, 0u};
        if (lg < 2) { const f32x4 x0 = red[(tk * 2) * 64 + lr + 32 * lg] + red[(tk * 2 + 1) * 64 + lr + 32 * lg], x1 = red[(tk * 2) * 64 + lr + 32 * lg + 16] + red[(tk * 2 + 1) * 64 + lr + 32 * lg + 16];
            bw = (u32x4){pk2(x0[0], x0[1]), pk2(x0[2], x0[3]), pk2(x1[0], x1[1]), pk2(x1[2], x1[3])}; }
        const bf16x8 bfr = as_bf8(bw);
#pragma unroll 4
        for (int q = 0; q < 32; ++q) { const int nt = 32 * kh + q;
            const bf16x8 afr = *(const bf16x8*)(WGW + (size_t)(16 * nt + lr) * 32 + 8 * lg);
            f32x4 z = MFMA16(afr, bfr, ((f32x4){0.f, 0.f, 0.f, 0.f}));
            const f32x4 gb = *(const f32x4*)(GB + 16 * nt + 4 * lg);
#pragma unroll
            for (int r = 0; r < 4; ++r) z[r] = logsigmoidf_(z[r] + gb[r]) * 0.0625f;
            *(f32x4*)(LA + (size_t)(16 * task + lr) * QK + 16 * nt + 4 * lg) = z; }
    }
    __syncthreads();
}

__device__ __forceinline__ void p_conv(Frame& F) {
    const bf16* U = WSP(bf16, WS_U); const bf16* CB = WSP(bf16, WS_CB); bf16* Z = WSP(bf16, WS_Z);
    const float* cw = F.in[I_CW]; const float* cb = F.in[I_CBIAS];
    for (int task = F.bid * NTHR + F.tid; task < (T / 64) * (D / 8); task += F.G * NTHR) {
        const int cg = task & 255, tb = task >> 8, c = 8 * cg, t0 = 64 * tb;
        f32x4 w0a = *(const f32x4*)(cw + c), w0b = *(const f32x4*)(cw + c + 4), w1a = *(const f32x4*)(cw + D + c), w1b = *(const f32x4*)(cw + D + c + 4);
        f32x4 w2a = *(const f32x4*)(cw + 2 * D + c), w2b = *(const f32x4*)(cw + 2 * D + c + 4), ba = *(const f32x4*)(cb + c), bb = *(const f32x4*)(cb + c + 4);
        f32x4 p2a = {0.f, 0.f, 0.f, 0.f}, p2b = p2a, p1a = p2a, p1b = p2a;
        if (t0 >= 2) { ld_bf8(U + (size_t)(t0 - 2) * D + c, p2a, p2b); ld_bf8(U + (size_t)(t0 - 1) * D + c, p1a, p1b); }
        for (int t = t0; t < t0 + 64; ++t) {
            f32x4 ua, ub, ca, cbv; ld_bf8(U + (size_t)t * D + c, ua, ub); ld_bf8(CB + (size_t)t * D + c, ca, cbv);
            const f32x4 ya = ca * (w0a * p2a + w1a * p1a + w2a * ua + ba), yb = cbv * (w0b * p2b + w1b * p1b + w2b * ub + bb);
            st_bf8(Z + (size_t)t * D + c, ya, yb);
            p2a = p1a; p2b = p1b; p1a = ua; p1b = ub;
        }
    }
}
__device__ __forceinline__ void p_glaprep(Frame& F) {
    const bf16* Q = WSP(bf16, WS_Q); const bf16* Kk = WSP(bf16, WS_K); const float* ALOW = WSP(float, WS_ALOW); const float* GW = F.in[I_GGW]; const float* GB = F.in[I_GGB];
    bf16* QT = WSP(bf16, WS_QT); bf16* KH = WSP(bf16, WS_KH); bf16* KHT = WSP(bf16, WS_KHT); bf16* QG = WSP(bf16, WS_QG);
    float* DL = WSP(float, WS_DL); float* DG = WSP(float, WS_DG);
    LAS float* part = (LAS float*)F.lds;
    LAS float* sal = part + 512;
    const int col = F.tid & 63, sub = F.tid >> 6;
    for (int unit = F.bid; unit < NG * 16; unit += F.G) {
        const int g = unit >> 4, cs = unit & 15, gc = cs * 64 + col, h = gc >> 8, kc = gc & 255;
        float gw[16];
#pragma unroll
        for (int r = 0; r < 16; ++r) gw[r] = GW[r * QK + gc];
        const float gbv = GB[gc];
        float carry = 0.f;
        bf16 qr[8], kr[8]; f32x4 av = {0.f, 0.f, 0.f, 0.f};
#define PREP_LOAD(chunk_) do { const int _t0 = (chunk_) * CH + 8 * sub; \
        _Pragma("unroll") for (int j = 0; j < 8; ++j) { qr[j] = Q[(size_t)(_t0 + j) * QK + gc]; kr[j] = Kk[(size_t)(_t0 + j) * QK + gc]; } \
        if (F.tid < 256) av = *(const f32x4*)(ALOW + (size_t)(chunk_) * CH * 16 + 4 * F.tid); } while (0)
        PREP_LOAD(g * GC);
        for (int c = 0; c < GC; ++c) {
            const int chunk = g * GC + c, t0 = chunk * CH + 8 * sub;
            float la[8], qv[8], kv[8];
#pragma unroll
            for (int j = 0; j < 8; ++j) { qv[j] = bf2f(qr[j]); kv[j] = bf2f(kr[j]); }
            if (F.tid < 256) *(LAS f32x4*)(sal + 4 * F.tid) = av;
            __syncthreads();
            if (c + 1 < GC) PREP_LOAD(chunk + 1);
#pragma unroll
            for (int j = 0; j < 8; ++j) { const LAS f32x4* ar = (const LAS f32x4*)(sal + (8 * sub + j) * 16); const f32x4 a0 = ar[0], a1 = ar[1], a2 = ar[2], a3 = ar[3];
                float z = gbv;
#pragma unroll
                for (int r = 0; r < 4; ++r) z += a0[r] * gw[r];
#pragma unroll
                for (int r = 0; r < 4; ++r) z += a1[r] * gw[4 + r];
#pragma unroll
                for (int r = 0; r < 4; ++r) z += a2[r] * gw[8 + r];
#pragma unroll
                for (int r = 0; r < 4; ++r) z += a3[r] * gw[12 + r];
                la[j] = logsigmoidf_(z) * 0.0625f; }
#pragma unroll
            for (int j = 1; j < 8; ++j) la[j] += la[j - 1];
            part[sub * 64 + col] = la[7];
            __syncthreads();
            float off = 0.f, tot = 0.f;
#pragma unroll
            for (int s = 0; s < 8; ++s) { const float p = part[s * 64 + col]; off += (s < sub) ? p : 0.f; tot += p; }
            unsigned kt[4];
#pragma unroll
            for (int j = 0; j < 8; ++j) { const float b = off + la[j], eb = __expf(b), enb = __expf(-b), eg = __expf(carry + b);
                QT[(size_t)(t0 + j) * QK + gc] = (bf16)f2bf(qv[j] * eb); const unsigned khv = f2bf(kv[j] * enb); KH[(size_t)(t0 + j) * QK + gc] = (bf16)khv;
                QG[(size_t)(t0 + j) * QK + gc] = (bf16)f2bf(qv[j] * eg);
                if (j & 1) kt[j >> 1] |= khv << 16; else kt[j >> 1] = khv; }
            *(u32x4*)(KHT + ((size_t)(chunk * GH + h) * DK + kc) * CH + 8 * sub) = (u32x4){kt[0], kt[1], kt[2], kt[3]};
            if (sub == 0) DL[(size_t)chunk * QK + gc] = __expf(tot);
            carry += tot;
        }
#undef PREP_LOAD
        if (sub == 0) DG[(size_t)g * QK + gc] = __expf(carry);
    }
}

__device__ __forceinline__ void p_gla_ref(Frame& F) {
    const bf16* Q = WSP(bf16, WS_Q); const bf16* Kk = WSP(bf16, WS_K); const bf16* V = WSP(bf16, WS_V); const float* LA = WSP(float, WS_LA); float* O32 = WSP(float, WS_O32);
    LAS float* red = (LAS float*)F.lds;
    const int k = F.tid & 255, vh = F.tid >> 8;
    for (int unit = F.bid; unit < GH * 64; unit += F.G) {
        const int h = unit >> 6, vb = unit & 63, vcol = h * DV + vb * 8 + vh * 4;
        float s0 = 0.f, s1 = 0.f, s2 = 0.f, s3 = 0.f;
        for (int tb = 0; tb < T; tb += 8) {
            LAS float* rb = red + ((tb >> 3) & 1) * 256;
#pragma unroll
            for (int j = 0; j < 8; ++j) {
                const int t = tb + j; const float a = __expf(LA[(size_t)t * QK + h * DK + k]), kk = bf2f(Kk[(size_t)t * QK + h * DK + k]), qq = bf2f(Q[(size_t)t * QK + h * DK + k]);
                const u32x2 vv = *(const u32x2*)(V + (size_t)t * VD + vcol);
                const float v0 = __uint_as_float(vv.x << 16), v1 = __uint_as_float(vv.x & 0xffff0000u), v2 = __uint_as_float(vv.y << 16), v3 = __uint_as_float(vv.y & 0xffff0000u);
                s0 = a * s0 + kk * v0; s1 = a * s1 + kk * v1; s2 = a * s2 + kk * v2; s3 = a * s3 + kk * v3;
                const float p0 = wave_sum(qq * s0), p1 = wave_sum(qq * s1), p2 = wave_sum(qq * s2), p3 = wave_sum(qq * s3);
                if (F.lane == 0) *(LAS f32x4*)(rb + (j * 8 + F.wave) * 4) = (f32x4){p0, p1, p2, p3};
            }
            __syncthreads();
            if (F.tid < 64) { const int j = F.tid >> 3, vhh = (F.tid >> 2) & 1, q = F.tid & 3; float s = 0.f;
#pragma unroll
                for (int w = 0; w < 4; ++w) s += rb[(j * 8 + vhh * 4 + w) * 4 + q];
                O32[(size_t)(tb + j) * VD + h * DV + vb * 8 + vhh * 4 + q] = s; }
        }
        __syncthreads();
    }
}
__device__ __forceinline__ void p_gla_norm_ref(Frame& F) {
    const float* O32 = WSP(float, WS_O32); const bf16* SR = WSP(bf16, WS_SR); bf16* OA = WSP(bf16, WS_OA); const float* g = F.in[I_GNG];
    const int gw = F.bid * NWAVES + F.wave, NGW = F.G * NWAVES;
    for (int it = gw; it < T * GH; it += NGW) {
        const size_t o = (size_t)it * DV + 8 * F.lane;
        const f32x4 a = *(const f32x4*)(O32 + o), b = *(const f32x4*)(O32 + o + 4);
        float s = 0.f;
#pragma unroll
        for (int j = 0; j < 4; ++j) s += a[j] * a[j] + b[j] * b[j];
        const float r = rsqrtf(wave_sum(s) * (1.0f / DV) + EPS);
        f32x4 s0, s1; ld_bf8(SR + o, s0, s1);
        const f32x4 g0 = *(const f32x4*)(g + 8 * F.lane), g1 = *(const f32x4*)(g + 8 * F.lane + 4);
        st_bf8(OA + o, a * r * g0 * s0, b * r * g1 * s1);
    }
}

__device__ __forceinline__ void p_gla_a(Frame& F) {
    const bf16* QT = WSP(bf16, WS_QT); const bf16* KH = WSP(bf16, WS_KH); const bf16* KHT = WSP(bf16, WS_KHT); const bf16* V = WSP(bf16, WS_V); const float* DL = WSP(float, WS_DL);
    bf16* OL = WSP(bf16, WS_OL); float* SLOC = WSP(float, WS_SLOC);
    constexpr int QS = 528, KQ = 544, KS = 160;
    LAS unsigned char* sQ = F.lds; LAS unsigned char* sK = sQ + 64 * QS; LAS unsigned char* sKT = sK + 64 * KQ; LAS unsigned char* sVT = sKT + 256 * KS; LAS unsigned char* sP = sVT + 128 * KS;
    LAS float* sDL = (LAS float*)(sP + 64 * KS);
    static_assert(64 * QS + 64 * KQ + 256 * KS + 128 * KS + 64 * KS + 1024 <= MISC_OFF, "gla lds");
    const int tid = F.tid, lane = F.lane, w = F.wave, lr = lane & 15, lg = lane >> 4;
    for (int unit0 = F.bid; unit0 < NG * GH * 4; unit0 += F.G) {
        const int unit = (F.G == NG * GH * 4) ? ((((unit0 & 7) + 8 * (unit0 >> 5)) << 2) | ((unit0 >> 3) & 3)) : unit0;
        const int g = unit >> 4, h = (unit >> 2) & 3, vs = unit & 3;
        f32x4 S[16];
#pragma unroll
        for (int kt = 0; kt < 16; ++kt) S[kt] = (f32x4){0.f, 0.f, 0.f, 0.f};
        u32x4 rq[4], rk[4], rt[4], rv[2], rd = {0u, 0u, 0u, 0u};
#define GLA_LOAD(chunk_) do { const int _t0 = (chunk_) * CH; \
        _Pragma("unroll") for (int q = 0; q < 4; ++q) { const int p = tid + 512 * q, row = p >> 5, c16 = p & 31; \
            rq[q] = *(const u32x4*)(QT + (size_t)(_t0 + row) * QK + h * DK + c16 * 8); rk[q] = *(const u32x4*)(KH + (size_t)(_t0 + row) * QK + h * DK + c16 * 8); \
            rt[q] = *(const u32x4*)(KHT + (size_t)((chunk_) * GH + h) * DK * CH + (size_t)p * 8); } \
        _Pragma("unroll") for (int q = 0; q < 2; ++q) rv[q] = *(const u32x4*)(V + (size_t)(_t0 + lane) * VD + h * DV + vs * 128 + 8 * (2 * w + q)); \
        if (tid < 64) rd = *(const u32x4*)(DL + (size_t)(chunk_) * QK + h * DK + 4 * tid); } while (0)
        GLA_LOAD(g * GC);
        for (int c = 0; c < GC; ++c) {
            const int chunk = g * GC + c, t0 = chunk * CH;
#pragma unroll
            for (int q = 0; q < 4; ++q) { const int p = tid + 512 * q; *(LAS u32x4*)(sQ + (p >> 5) * QS + (p & 31) * 16) = rq[q]; *(LAS u32x4*)(sK + (p >> 5) * KQ + (p & 31) * 16) = rk[q]; *(LAS u32x4*)(sKT + (p >> 3) * KS + (p & 7) * 16) = rt[q]; }
#pragma unroll
            for (int q = 0; q < 2; ++q) { LAS unsigned char* vp = sVT + (8 * (2 * w + q)) * KS + 2 * lane;
                *(LAS unsigned short*)(vp) = (unsigned short)rv[q].x; *(LAS unsigned short*)(vp + KS) = (unsigned short)(rv[q].x >> 16); *(LAS unsigned short*)(vp + 2 * KS) = (unsigned short)rv[q].y; *(LAS unsigned short*)(vp + 3 * KS) = (unsigned short)(rv[q].y >> 16);
                *(LAS unsigned short*)(vp + 4 * KS) = (unsigned short)rv[q].z; *(LAS unsigned short*)(vp + 5 * KS) = (unsigned short)(rv[q].z >> 16); *(LAS unsigned short*)(vp + 6 * KS) = (unsigned short)rv[q].w; *(LAS unsigned short*)(vp + 7 * KS) = (unsigned short)(rv[q].w >> 16); }
            if (tid < 64) *(LAS u32x4*)(sDL + 4 * tid) = rd;
            __syncthreads();
            if (c + 1 < GC) GLA_LOAD(chunk + 1);
            { const int ti = w >> 1;
#pragma unroll
              for (int jj = 0; jj < 2; ++jj) { const int tj = 2 * (w & 1) + jj; f32x4 pa = {0.f, 0.f, 0.f, 0.f};
                if (tj <= ti) {
#pragma unroll
                    for (int s = 0; s < 8; ++s) { const bf16x8 a = *(const LAS bf16x8*)(sK + (16 * tj + lr) * KQ + (32 * s + 8 * lg) * 2), b = *(const LAS bf16x8*)(sQ + (16 * ti + lr) * QS + (32 * s + 8 * lg) * 2); pa = MFMA16(a, b, pa); }
                    const int i = 16 * ti + lr, j0 = 16 * tj + 4 * lg;
#pragma unroll
                    for (int r = 0; r < 4; ++r) pa[r] = (j0 + r <= i) ? pa[r] : 0.f;
                }
                u32x2 pw; pw.x = pk2(pa[0], pa[1]); pw.y = pk2(pa[2], pa[3]);
                *(LAS u32x2*)(sP + (16 * ti + lr) * KS + (16 * tj + 4 * lg) * 2) = pw; } }
            f32x4 oacc[4];
#pragma unroll
            for (int ti = 0; ti < 4; ++ti) oacc[ti] = (f32x4){0.f, 0.f, 0.f, 0.f};
#pragma unroll
            for (int s = 0; s < 8; ++s) {
                u32x4 sw; sw.x = pk2(S[2 * s][0], S[2 * s][1]); sw.y = pk2(S[2 * s][2], S[2 * s][3]); sw.z = pk2(S[2 * s + 1][0], S[2 * s + 1][1]); sw.w = pk2(S[2 * s + 1][2], S[2 * s + 1][3]);
                const bf16x8 a = as_bf8(sw);
#pragma unroll
                for (int ti = 0; ti < 4; ++ti) { const LAS unsigned char* qp = sQ + (16 * ti + lr) * QS + (32 * s + 4 * lg) * 2; const u32x2 lo = *(const LAS u32x2*)qp, hi = *(const LAS u32x2*)(qp + 32);
                    oacc[ti] = MFMA16(a, as_bf8((u32x4){lo.x, lo.y, hi.x, hi.y}), oacc[ti]); }
            }
            __syncthreads();
            bf16x8 vf[2];
#pragma unroll
            for (int s2 = 0; s2 < 2; ++s2) vf[s2] = *(const LAS bf16x8*)(sVT + (16 * w + lr) * KS + (32 * s2 + 8 * lg) * 2);
#pragma unroll
            for (int s2 = 0; s2 < 2; ++s2)
#pragma unroll
                for (int ti = 0; ti < 4; ++ti) { const bf16x8 b = *(const LAS bf16x8*)(sP + (16 * ti + lr) * KS + (32 * s2 + 8 * lg) * 2); oacc[ti] = MFMA16(vf[s2], b, oacc[ti]); }
#pragma unroll
            for (int ti = 0; ti < 4; ++ti) { u32x2 ow; ow.x = pk2(oacc[ti][0], oacc[ti][1]); ow.y = pk2(oacc[ti][2], oacc[ti][3]);
                *(u32x2*)(OL + (size_t)(t0 + 16 * ti + lr) * VD + h * DV + vs * 128 + 16 * w + 4 * lg) = ow; }
#pragma unroll
            for (int kt = 0; kt < 16; ++kt) {
#pragma unroll
                for (int s2 = 0; s2 < 2; ++s2) { const bf16x8 a = *(const LAS bf16x8*)(sKT + (16 * kt + lr) * KS + (32 * s2 + 8 * lg) * 2); S[kt] = MFMA16(a, vf[s2], S[kt]); }
                S[kt] *= *(const LAS f32x4*)(sDL + 16 * kt + 4 * lg);
            }
            __syncthreads();
        }
#undef GLA_LOAD
#pragma unroll
        for (int kt = 0; kt < 16; ++kt)
#pragma unroll
            for (int r = 0; r < 4; ++r) SLOC[((size_t)(g * GH + h) * DK + 16 * kt + 4 * lg + r) * DV + vs * 128 + 16 * w + lr] = S[kt][r];
    }
}
__device__ __forceinline__ void p_gla_b(Frame& F) {
    const float* SLOC = WSP(float, WS_SLOC); const float* DG = WSP(float, WS_DG); bf16* SG0 = WSP(bf16, WS_SG0);
    for (int idx = F.bid * NTHR + F.tid; idx < GH * DV * (DK / 4); idx += F.G * NTHR) {
        const int v = idx & 511, k4 = (idx >> 9) & 63, h = idx >> 15;
        float x[NG - 1][4]; f32x4 d[NG - 1];
#pragma unroll
        for (int g = 0; g < NG - 1; ++g) { d[g] = *(const f32x4*)(DG + (size_t)g * QK + h * DK + 4 * k4);
#pragma unroll
            for (int j = 0; j < 4; ++j) x[g][j] = SLOC[((size_t)(g * GH + h) * DK + 4 * k4 + j) * DV + v]; }
        float s[4] = {0.f, 0.f, 0.f, 0.f};
#pragma unroll
        for (int g = 0; g < NG; ++g) {
            *(u32x2*)(SG0 + ((size_t)(g * GH + h) * DV + v) * DK + 4 * k4) = (u32x2){pk2(s[0], s[1]), pk2(s[2], s[3])};
            if (g < NG - 1) {
#pragma unroll
                for (int j = 0; j < 4; ++j) s[j] = d[g][j] * s[j] + x[g][j]; }
        }
    }
}
__device__ __forceinline__ void p_gla_c(Frame& F) {
    const bf16* QG = WSP(bf16, WS_QG); const bf16* SG0 = WSP(bf16, WS_SG0); const bf16* OL = WSP(bf16, WS_OL); const bf16* SR = WSP(bf16, WS_SR); bf16* OA = WSP(bf16, WS_OA); const float* gn = F.in[I_GNG];
    LAS float* red = (LAS float*)F.lds;
    const int lane = F.lane, w = F.wave, lr = lane & 15, lg = lane >> 4;
    for (int unit = F.bid; unit < (T / 128) * GH; unit += F.G) {
        const int rt = unit >> 2, h = unit & 3, g = rt >> 3, row0 = rt * 128;
        f32x4 o[8][4];
#pragma unroll
        for (int it = 0; it < 8; ++it)
#pragma unroll
            for (int vt = 0; vt < 4; ++vt) o[it][vt] = (f32x4){0.f, 0.f, 0.f, 0.f};
        if (g > 0) {
            const bf16* sg = SG0 + ((size_t)(g * GH + h) * DV + 64 * w + 8 * (lr >> 2) + (lr & 3)) * DK + 8 * lg; const bf16* qg = QG + (size_t)(row0 + lr) * QK + h * DK + 8 * lg;
            bf16x8 a0[4], b0[8], a1[4], b1[8];
#define GLC_LOAD(A_, B_, s_) do { _Pragma("unroll") for (int vt = 0; vt < 4; ++vt) A_[vt] = *(const bf16x8*)(sg + (size_t)(32 * (vt >> 1) + 4 * (vt & 1)) * DK + 32 * (s_)); \
            _Pragma("unroll") for (int it = 0; it < 8; ++it) B_[it] = *(const bf16x8*)(qg + (size_t)(16 * it) * QK + 32 * (s_)); } while (0)
#define GLC_MMA(A_, B_) do { _Pragma("unroll") for (int it = 0; it < 8; ++it) _Pragma("unroll") for (int vt = 0; vt < 4; ++vt) o[it][vt] = MFMA16(A_[vt], B_[it], o[it][vt]); } while (0)
            GLC_LOAD(a0, b0, 0);
#pragma unroll
            for (int s = 0; s < 8; s += 2) {
                GLC_LOAD(a1, b1, s + 1);
                GLC_MMA(a0, b0);
                if (s + 2 < 8) GLC_LOAD(a0, b0, s + 2);
                GLC_MMA(a1, b1);
            }
#undef GLC_LOAD
#undef GLC_MMA
        }
        asm volatile("" ::: "memory");
        const size_t ob = (size_t)(row0 + lr) * VD + h * DV + 64 * w + 8 * lg;
        float ss[8];
#pragma unroll
        for (int it = 0; it < 8; ++it) { ss[it] = 0.f;
#pragma unroll
            for (int p = 0; p < 2; ++p) { const u32x4 ol4 = *(const u32x4*)(OL + ob + (size_t)(16 * it) * VD + 32 * p);
#pragma unroll
              for (int q = 0; q < 2; ++q) { const int vt = 2 * p + q; u32x2 ol; ol.x = q ? ol4.z : ol4.x; ol.y = q ? ol4.w : ol4.y;
                o[it][vt][0] += __uint_as_float(ol.x << 16); o[it][vt][1] += __uint_as_float(ol.x & 0xffff0000u); o[it][vt][2] += __uint_as_float(ol.y << 16); o[it][vt][3] += __uint_as_float(ol.y & 0xffff0000u);
                ss[it] += (o[it][vt][0] * o[it][vt][0] + o[it][vt][1] * o[it][vt][1]) + (o[it][vt][2] * o[it][vt][2] + o[it][vt][3] * o[it][vt][3]); } }
            ss[it] += __shfl_xor(ss[it], 16); ss[it] += __shfl_xor(ss[it], 32); }
        __syncthreads();
        if (lg == 0) {
#pragma unroll
            for (int it = 0; it < 8; ++it) red[w * 128 + 16 * it + lr] = ss[it]; }
        __syncthreads();
#pragma unroll
        for (int it = 0; it < 8; ++it) { float t = 0.f;
#pragma unroll
            for (int ww = 0; ww < 8; ++ww) t += red[ww * 128 + 16 * it + lr];
            const float r = rsqrtf(t * (1.0f / DV) + EPS);
#pragma unroll
            for (int p = 0; p < 2; ++p) { const size_t oo = ob + (size_t)(16 * it) * VD + 32 * p; const u32x4 sr4 = *(const u32x4*)(SR + oo); u32x4 ow4;
#pragma unroll
              for (int q = 0; q < 2; ++q) { const int vt = 2 * p + q; u32x2 sr; sr.x = q ? sr4.z : sr4.x; sr.y = q ? sr4.w : sr4.y; const f32x4 gg = *(const f32x4*)(gn + 64 * w + 32 * p + 8 * lg + 4 * q);
                u32x2 ow; ow.x = pk2(o[it][vt][0] * r * gg[0] * __uint_as_float(sr.x << 16), o[it][vt][1] * r * gg[1] * __uint_as_float(sr.x & 0xffff0000u));
                ow.y = pk2(o[it][vt][2] * r * gg[2] * __uint_as_float(sr.y << 16), o[it][vt][3] * r * gg[3] * __uint_as_float(sr.y & 0xffff0000u));
                if (q) { ow4.z = ow.x; ow4.w = ow.y; } else { ow4.x = ow.x; ow4.y = ow.y; } }
              *(u32x4*)(OA + oo) = ow4; } }
    }
    __syncthreads();
}

__device__ __forceinline__ void p_attn_ref(Frame& F) {
    const bf16* QX = WSP(bf16, WS_QX); const bf16* KM = WSP(bf16, WS_KM); const bf16* VMT = WSP(bf16, WS_VMT); bf16* OX = WSP(bf16, WS_OX);
    LAS float* pbuf = (LAS float*)F.lds + F.wave * 256;
    const int gw = F.bid * NWAVES + F.wave, NGW = F.G * NWAVES, lane = F.lane;
    for (int it = gw; it < T * XH; it += NGW) {
        const int t = it >> 2, h = it & 3; const bf16* q = QX + (size_t)t * XA + h * XD;
        float s[4] = {0.f, 0.f, 0.f, 0.f};
        for (int d = 0; d < XD; d += 8) { f32x4 q0, q1, q2, q3; ld_bf8(q + d, q0, q1); ld_bf8(q + d + QX_HALF, q2, q3); q0 += q2; q1 += q3;
#pragma unroll
            for (int c = 0; c < 4; ++c) { f32x4 k0, k1; ld_bf8(KM + (size_t)(lane + 64 * c) * XA + h * XD + d, k0, k1);
#pragma unroll
                for (int j = 0; j < 4; ++j) s[c] += q0[j] * k0[j] + q1[j] * k1[j]; } }
        const float sc = 0.08838834764831845f;
        float mx = fmaxf(fmaxf(s[0], s[1]), fmaxf(s[2], s[3])) * sc; mx = wave_max(mx);
        float e[4], sum = 0.f;
#pragma unroll
        for (int c = 0; c < 4; ++c) { e[c] = __expf(s[c] * sc - mx); sum += e[c]; }
        sum = wave_sum(sum); const float inv = 1.0f / sum;
#pragma unroll
        for (int c = 0; c < 4; ++c) pbuf[lane + 64 * c] = bf2f((unsigned short)f2bf(e[c] * inv));
        LDS_WAIT(); asm volatile("" ::: "memory");
        float o0 = 0.f, o1 = 0.f; const bf16* v0 = VMT + (size_t)(h * XD + 2 * lane) * MEM; const bf16* v1 = v0 + MEM;
        for (int m = 0; m < MEM; m += 8) { f32x4 a0, a1, b0, b1; ld_bf8(v0 + m, a0, a1); ld_bf8(v1 + m, b0, b1); const f32x4 p0 = *(const LAS f32x4*)(pbuf + m), p1 = *(const LAS f32x4*)(pbuf + m + 4);
#pragma unroll
            for (int j = 0; j < 4; ++j) { o0 += p0[j] * a0[j] + p1[j] * a1[j]; o1 += p0[j] * b0[j] + p1[j] * b1[j]; } }
        *(unsigned*)(OX + (size_t)t * XA + h * XD + 2 * lane) = pk2(o0, o1);
        LDS_WAIT(); asm volatile("" ::: "memory");
    }
}

__device__ __forceinline__ void p_attn(Frame& F) {
    const bf16* QX = WSP(bf16, WS_QX); const bf16* KM = WSP(bf16, WS_KM); const bf16* VMT = WSP(bf16, WS_VMT); bf16* OX = WSP(bf16, WS_OX);
    constexpr int KSt = 288, VSt = 528;
    LAS unsigned char* sK = F.lds; LAS unsigned char* sV = sK + 256 * KSt;
    static_assert(256 * KSt + 128 * VSt <= MISC_OFF, "attn lds");
    const int tid = F.tid, lane = F.lane, w = F.wave, lr = lane & 15, lg = lane >> 4;
    int curh = -1;
    for (int unit = F.bid; unit < (T / 128) * XH; unit += F.G) {
        const int h = unit & 3, rt = unit >> 2;
        if (h != curh) {
            __syncthreads();
#pragma unroll
            for (int q = 0; q < 8; ++q) { const int p = tid + 512 * q;
                *(LAS u32x4*)(sK + (p >> 4) * KSt + (p & 15) * 16) = *(const u32x4*)(KM + (size_t)(p >> 4) * XA + h * XD + (p & 15) * 8);
                *(LAS u32x4*)(sV + (p >> 5) * VSt + (p & 31) * 16) = *(const u32x4*)(VMT + (size_t)(h * XD + (p >> 5)) * MEM + (p & 31) * 8); }
            __syncthreads();
            curh = h;
        }
        const int row = rt * 128 + 16 * w + lr;
        bf16x8 qf[4];
#pragma unroll
        for (int s = 0; s < 4; ++s) { const bf16* qp = QX + (size_t)row * XA + h * XD + 32 * s + 8 * lg;
            f32x4 a0, a1, b0, b1; unpack8(*(const u32x4*)qp, a0, a1); unpack8(*(const u32x4*)(qp + QX_HALF), b0, b1); qf[s] = as_bf8(pack8(a0 + b0, a1 + b1)); }
        f32x4 sc[16];
#pragma unroll
        for (int kt = 0; kt < 16; ++kt) { sc[kt] = (f32x4){0.f, 0.f, 0.f, 0.f};
#pragma unroll
            for (int s = 0; s < 4; ++s) { const bf16x8 a = *(const LAS bf16x8*)(sK + (16 * kt + lr) * KSt + (32 * s + 8 * lg) * 2); sc[kt] = MFMA16(a, qf[s], sc[kt]); } }
        float m = -3.0e38f;
#pragma unroll
        for (int kt = 0; kt < 16; ++kt) m = fmaxf(m, fmaxf(fmaxf(sc[kt][0], sc[kt][1]), fmaxf(sc[kt][2], sc[kt][3])));
        m = fmaxf(m, __shfl_xor(m, 16)); m = fmaxf(m, __shfl_xor(m, 32));
        const float c = 0.08838834764831845f * 1.4426950408889634f;
        float sum = 0.f;
#pragma unroll
        for (int kt = 0; kt < 16; ++kt)
#pragma unroll
            for (int r = 0; r < 4; ++r) { const float p = exp2f((sc[kt][r] - m) * c); sc[kt][r] = p; sum += p; }
        sum += __shfl_xor(sum, 16); sum += __shfl_xor(sum, 32);
        const float inv = 1.0f / sum;
        f32x4 oa[8];
#pragma unroll
        for (int dt = 0; dt < 8; ++dt) oa[dt] = (f32x4){0.f, 0.f, 0.f, 0.f};
#pragma unroll
        for (int s = 0; s < 8; ++s) {
            u32x4 pw; pw.x = pk2(sc[2 * s][0], sc[2 * s][1]); pw.y = pk2(sc[2 * s][2], sc[2 * s][3]); pw.z = pk2(sc[2 * s + 1][0], sc[2 * s + 1][1]); pw.w = pk2(sc[2 * s + 1][2], sc[2 * s + 1][3]);
            const bf16x8 b = as_bf8(pw);
#pragma unroll
            for (int dt = 0; dt < 8; ++dt) { const LAS unsigned char* vp = sV + (16 * dt + lr) * VSt + (32 * s + 4 * lg) * 2; const u32x2 lo = *(const LAS u32x2*)vp, hi = *(const LAS u32x2*)(vp + 32);
                oa[dt] = MFMA16(as_bf8((u32x4){lo.x, lo.y, hi.x, hi.y}), b, oa[dt]); }
        }
#pragma unroll
        for (int dt = 0; dt < 8; ++dt) { u32x2 ow; ow.x = pk2(oa[dt][0] * inv, oa[dt][1] * inv); ow.y = pk2(oa[dt][2] * inv, oa[dt][3] * inv);
            *(u32x2*)(OX + (size_t)row * XA + h * XD + 16 * dt + 4 * lg) = ow; }
    }
    __syncthreads();
}

typedef float f32x16 __attribute__((ext_vector_type(16)));
__device__ __forceinline__ void p_router(Frame& F) {
    const bf16* X2 = WSP(bf16, WS_X1B); bf16* H3 = WSP(bf16, WS_H3); const float* WR = WSP(float, WS_WR); const float* g = F.in[I_NMOEG]; const float* rb = F.in[I_RB];
    int* TKE = WSP(int, WS_TKE); int* TKP = WSP(int, WS_TKP); float* TKW = WSP(float, WS_TKW); unsigned* cnt = F.ctl + CW_CNT; int* RTE = WSP(int, WS_RTE);
    LAS unsigned* lcnt = (LAS unsigned*)F.lds;
    LAS int* le = (LAS int*)(F.lds + 256);
    LAS int* lp = (LAS int*)(F.lds + 256 + 1024);
    LAS float* P = (LAS float*)(F.lds + 4096);
    LAS float* SSQ = (LAS float*)(F.lds + 4096 + 8 * 32 * 33 * 4);
    const int lane = F.lane, th = F.wave & 1, kq = F.wave >> 1, li = lane & 31, hh = lane >> 5;
    for (int blk = F.bid; blk < T / 64; blk += F.G) {
        __syncthreads();
        if (F.tid < 64) lcnt[F.tid] = 0u;
        const bf16* xr = X2 + (size_t)(blk * 64 + th * 32 + li) * D + kq * 512 + 4 * hh;
        const float* wr = WR + (size_t)li * D + kq * 512 + 4 * hh;
        f32x16 acc;
#pragma unroll
        for (int r = 0; r < 16; ++r) acc[r] = 0.f;
        float ss = 0.f;
#pragma unroll 16
        for (int q = 0; q < 64; ++q) {
            const u32x2 aw = *(const u32x2*)(xr + 8 * q); const f32x4 a = {__uint_as_float(aw.x << 16), __uint_as_float(aw.x & 0xffff0000u), __uint_as_float(aw.y << 16), __uint_as_float(aw.y & 0xffff0000u)}, b = *(const f32x4*)(wr + 8 * q);
            ss += (a[0] * a[0] + a[1] * a[1]) + (a[2] * a[2] + a[3] * a[3]);
#pragma unroll
            for (int s = 0; s < 4; ++s) acc = __builtin_amdgcn_mfma_f32_32x32x2f32(a[s], b[s], acc, 0, 0, 0);
        }
        ss += __shfl_xor(ss, 32);
#pragma unroll
        for (int r = 0; r < 16; ++r) P[(F.wave * 32 + (r & 3) + 8 * (r >> 2) + 4 * hh) * 33 + li] = acc[r];
        if (lane < 32) SSQ[F.wave * 32 + lane] = ss;
        __syncthreads();
        if (F.tid < 64) {
            const int tl = F.tid, th2 = tl >> 5, ti = tl & 31, t = blk * 64 + tl;
            float ssq = 0.f;
#pragma unroll
            for (int k4 = 0; k4 < 4; ++k4) ssq += SSQ[(k4 * 2 + th2) * 32 + ti];
            const float r = rsqrtf(ssq * (1.0f / D) + EPS);
            float v0 = -3.0e38f, v1 = -3.0e38f, v2 = -3.0e38f, v3 = -3.0e38f; int i0 = 0, i1 = 0, i2 = 0, i3 = 0;
            for (int e = 0; e < NE; ++e) {
                float x = 0.f;
#pragma unroll
                for (int k4 = 0; k4 < 4; ++k4) x += P[((k4 * 2 + th2) * 32 + ti) * 33 + e];
                x = x * r + rb[e];
                if (x > v3) {
                    if (x > v2) { v3 = v2; i3 = i2;
                        if (x > v1) { v2 = v1; i2 = i1;
                            if (x > v0) { v1 = v0; i1 = i0; v0 = x; i0 = e; } else { v1 = x; i1 = e; } }
                        else { v2 = x; i2 = e; } }
                    else { v3 = x; i3 = e; } }
            }
            const float e1 = __expf(v1 - v0), e2 = __expf(v2 - v0), e3 = __expf(v3 - v0), inv = 1.0f / (1.0f + e1 + e2 + e3);
            const unsigned p0 = __hip_atomic_fetch_add(lcnt + i0, 1u, __ATOMIC_RELAXED, __HIP_MEMORY_SCOPE_WORKGROUP);
            const unsigned p1 = __hip_atomic_fetch_add(lcnt + i1, 1u, __ATOMIC_RELAXED, __HIP_MEMORY_SCOPE_WORKGROUP);
            const unsigned p2 = __hip_atomic_fetch_add(lcnt + i2, 1u, __ATOMIC_RELAXED, __HIP_MEMORY_SCOPE_WORKGROUP);
            const unsigned p3 = __hip_atomic_fetch_add(lcnt + i3, 1u, __ATOMIC_RELAXED, __HIP_MEMORY_SCOPE_WORKGROUP);
            le[tl * 4 + 0] = i0; le[tl * 4 + 1] = i1; le[tl * 4 + 2] = i2; le[tl * 4 + 3] = i3;
            lp[tl * 4 + 0] = (int)p0; lp[tl * 4 + 1] = (int)p1; lp[tl * 4 + 2] = (int)p2; lp[tl * 4 + 3] = (int)p3;
            *(int4*)(TKE + t * 4) = make_int4(i0, i1, i2, i3);
            *(f32x4*)(TKW + t * 4) = (f32x4){inv, e1 * inv, e2 * inv, e3 * inv};
        }
        __syncthreads();
        if (F.tid < NE) lcnt[32 + F.tid] = __hip_atomic_fetch_add(cnt + 64 * F.tid, lcnt[F.tid], RLX_AGENT);
        __syncthreads();
        if (F.tid < 256) { const int tl = F.tid >> 2, k = F.tid & 3, ee = le[tl * 4 + k], pos = lp[tl * 4 + k] + (int)lcnt[32 + ee]; TKP[(blk * 64 + tl) * 4 + k] = pos; RTE[(size_t)ee * T + pos] = blk * 64 + tl; }
#if MOE_FP8
        for (int tt = 0; tt < 8; ++tt) { const int t = blk * 64 + F.wave * 8 + tt; const bf16* xr2 = X2 + (size_t)t * D; unsigned char* o8 = (unsigned char*)H3 + (size_t)t * D;
            f32x4 v[8]; float s2 = 0.f;
#pragma unroll
            for (int j = 0; j < 8; ++j) { const u32x2 xw = *(const u32x2*)(xr2 + 4 * lane + 256 * j); v[j] = (f32x4){__uint_as_float(xw.x << 16), __uint_as_float(xw.x & 0xffff0000u), __uint_as_float(xw.y << 16), __uint_as_float(xw.y & 0xffff0000u)}; s2 += (v[j][0] * v[j][0] + v[j][1] * v[j][1]) + (v[j][2] * v[j][2] + v[j][3] * v[j][3]); }
            const float r2 = rsqrtf(wave_sum(s2) * (1.0f / D) + EPS) * H8_SCALE;
#pragma unroll
            for (int j = 0; j < 8; ++j) { const f32x4 gg = *(const f32x4*)(g + 4 * lane + 256 * j); *(unsigned*)(o8 + 4 * lane + 256 * j) = pk4_fp8(v[j][0] * r2 * gg[0], v[j][1] * r2 * gg[1], v[j][2] * r2 * gg[2], v[j][3] * r2 * gg[3]); } }
#else
        for (int tt = 0; tt < 8; ++tt) { const int t = blk * 64 + F.wave * 8 + tt; rms_row_to_bf16(X2 + (size_t)t * D, g, H3 + (size_t)t * D, lane); }
#endif
    }
}
__device__ __forceinline__ void p_lists(Frame& F) {
    unsigned* cnt = F.ctl + CW_CNT; int* TKE = WSP(int, WS_TKE); int* TKP = WSP(int, WS_TKP); int* ROWTOK = WSP(int, WS_ROWTOK); int* TILE = WSP(int, WS_TILE);
    LAS int* poff = (LAS int*)F.lds;
    LAS int* lc = (LAS int*)(F.lds + 256);
    __syncthreads();
    if (F.tid < NE) lc[F.tid] = (int)__hip_atomic_load(cnt + 64 * F.tid, RLX_AGENT);
    __syncthreads();
    if (F.tid == 0) { int o = 0; for (int e = 0; e < NE; ++e) { poff[e] = o; o += (lc[e] + 255) / 256 * 256; } poff[NE] = o; }
    __syncthreads();
    for (int i = F.bid * NTHR + F.tid; i < T * TOPK; i += F.G * NTHR) { const int e = TKE[i], slot = poff[e] + TKP[i]; TKP[i] = slot; ROWTOK[slot] = i >> 2; }
    if (F.bid == 0) {
        for (int e = 0; e < NE; ++e) for (int s = poff[e] + lc[e] + F.tid; s < poff[e + 1]; s += NTHR) ROWTOK[s] = T;
        for (int e = 0; e < NE; ++e) for (int tl = poff[e] / 256 + F.tid; tl < poff[e + 1] / 256; tl += NTHR) TILE[tl] = e;
        if (F.tid == 0) TILE[512] = poff[NE] / 256;
    }
    __syncthreads();
}
__device__ __forceinline__ void p_combine(Frame& F) {
    const bf16* X2 = WSP(bf16, WS_X1B); const unsigned char* YS = WSP(unsigned char, WS_YS); const int* TKP = WSP(int, WS_TKP); const float* TKW = WSP(float, WS_TKW); const float* g = F.in[I_NFG];
    const int gw = F.bid * NWAVES + F.wave, NGW = F.G * NWAVES, lane = F.lane;
    moe_layout(F.lds, F.ctl + CW_CNT); const LAS int* lay = (const LAS int*)(F.lds + LAY_OFF); const int* TKE = WSP(int, WS_TKE);
    int sl[4]; float w[4];
    if (gw < T) {
#pragma unroll
        for (int k = 0; k < 4; ++k) { sl[k] = lay[TKE[gw * 4 + k]] + TKP[gw * 4 + k]; w[k] = TKW[gw * 4 + k] * (1.0f / Y8_SCALE); } }
    for (int t = gw; t < T; t += NGW) {
        int sn[4] = {0, 0, 0, 0}; float wn[4] = {0.f, 0.f, 0.f, 0.f};
        if (t + NGW < T) {
#pragma unroll
            for (int k = 0; k < 4; ++k) { sn[k] = lay[TKE[(t + NGW) * 4 + k]] + TKP[(t + NGW) * 4 + k]; wn[k] = TKW[(t + NGW) * 4 + k] * (1.0f / Y8_SCALE); } }
        f32x4 v[8]; float s = 0.f;
#pragma unroll
        for (int j = 0; j < 8; ++j) { { const u32x2 xw = *(const u32x2*)(X2 + (size_t)t * D + 4 * lane + 256 * j); v[j] = (f32x4){__uint_as_float(xw.x << 16), __uint_as_float(xw.x & 0xffff0000u), __uint_as_float(xw.y << 16), __uint_as_float(xw.y & 0xffff0000u)}; }
#pragma unroll
            for (int k = 0; k < 4; ++k) { const int y = __builtin_nontemporal_load((const int*)(YS + (size_t)sl[k] * D + 4 * lane + 256 * j)); const f32x2 y01 = __builtin_amdgcn_cvt_pk_f32_fp8(y, false), y23 = __builtin_amdgcn_cvt_pk_f32_fp8(y, true);
                v[j][0] += w[k] * y01[0]; v[j][1] += w[k] * y01[1]; v[j][2] += w[k] * y23[0]; v[j][3] += w[k] * y23[1]; }
            s += (v[j][0] * v[j][0] + v[j][1] * v[j][1]) + (v[j][2] * v[j][2] + v[j][3] * v[j][3]); }
        const float r = rsqrtf(wave_sum(s) * (1.0f / D) + EPS);
#pragma unroll
        for (int j = 0; j < 8; ++j) { const f32x4 gg = *(const f32x4*)(g + 4 * lane + 256 * j); __builtin_nontemporal_store(v[j] * r * gg, (f32x4*)(F.out + (size_t)t * D + 4 * lane + 256 * j)); }
#pragma unroll
        for (int k = 0; k < 4; ++k) { sl[k] = sn[k]; w[k] = wn[k]; }
    }
}

constexpr int NPHASE = 16;
__global__ void __launch_bounds__(NTHR, 2) hybrid_fwd(Args args) {
    extern __shared__ __attribute__((aligned(16))) unsigned char lds_raw[];
    Frame F;
    F.lds = (LAS unsigned char*)lds_raw; F.ws = args.ws; F.ctl = (unsigned*)(args.ws + WS_CTL);
    F.tid = threadIdx.x; F.lane = F.tid & 63; F.wave = __builtin_amdgcn_readfirstlane(F.tid >> 6); F.G = gridDim.x; F.bid = blockIdx.x;
    F.in = args.in; F.out = args.out;
    volatile LAS unsigned* MISC = (volatile LAS unsigned*)(F.lds + MISC_OFF);
    if (F.tid < 32) MISC[F.tid] = 0u;
    __syncthreads();
#if MK_ONE_LAUNCH
    XcdBarrier bar = xcd_barrier_post(F.ctl + CW_BAR, MISC + 8);
#define GRID_BAR() xcd_barrier(bar)
#else
#define GRID_BAR() do {} while (0)
#endif
    const int lo = args.ph_lo, hi = args.ph_hi;
#ifndef ONLY_PHASE
#define ONLY_PHASE -1
#endif
#define IN(k) (lo <= (k) && (k) < hi && (ONLY_PHASE < 0 || ONLY_PHASE == (k)))
#define SEAM(k) do { if (IN(k) && IN((k) + 1)) GRID_BAR(); } while (0)

#ifndef DUP_PHASE
#define DUP_PHASE -1
#endif
#ifndef DUP_NOEPI
#define DUP_NOEPI 0
#endif
    bool do_epi = true, do_epi_flag = true;
#define PHASE(k, ...) do { if (IN(k)) { __VA_ARGS__ if (DUP_PHASE == (k)) { GRID_BAR(); do_epi = (DUP_NOEPI == 1) ? (args.probe != 0) : true; do_epi_flag = false; __VA_ARGS__ do_epi = true; do_epi_flag = true; } } SEAM(k); } while (0)
    constexpr int MAIN_ROUNDS = 4;
    const bool split = (F.G == 256);
    const int sgrp = F.bid >> 3;
    const bool conv_role = !split || (sgrp & 3) == 0;
    PHASE(0, p0_prologue(F, 0, F.bid, F.G););
    PHASE(12,
        if (conv_role) { p0_prologue(F, 1, split ? ((sgrp >> 2) * 8 + (F.bid & 7)) : F.bid, split ? 64 : F.G); }
        else { const int j = (sgrp - (sgrp >> 2) - 1) * 8 + (F.bid & 7);
          DenseSched S; S.init(WSP(bf16, WS_XN), WSP(bf16, WS_WIN), T, NIN, D, 192, MAIN_ROUNDS * 256 + j);
          EpiInProj E{WSP(bf16, WS_Q), WSP(bf16, WS_K), WSP(bf16, WS_V), WSP(bf16, WS_SR), WSP(bf16, WS_CB), WSP(bf16, WS_U), WSP(bf16, WS_SGA), WSP(bf16, WS_SGB)};
          gemm_any(F.lds, S, E, do_epi); });
    PHASE(1,
        { DenseSched S; S.init(WSP(bf16, WS_XN), WSP(bf16, WS_WIN), T, NIN, D, F.G, F.bid, 0, split ? MAIN_ROUNDS : (1 << 30));
          EpiInProj E{WSP(bf16, WS_Q), WSP(bf16, WS_K), WSP(bf16, WS_V), WSP(bf16, WS_SR), WSP(bf16, WS_CB), WSP(bf16, WS_U), WSP(bf16, WS_SGA), WSP(bf16, WS_SGB)};
          gemm_any(F.lds, S, E, do_epi); }
        p_alow(F););
    PHASE(2, p_memkv(F); p_conv(F); p_glaprep(F););
#if OPT_GLA
    PHASE(3, p_gla_a(F););
    PHASE(4, p_gla_b(F););
    PHASE(5, p_gla_c(F););
#else
    PHASE(3, p_gla_ref(F););
    PHASE(4, ;);
    PHASE(5, p_gla_norm_ref(F););
#endif
    PHASE(6,
        { DenseSched S; S.init(WSP(bf16, WS_OA), WSP(bf16, WS_WGO), T, D, D, F.G, F.bid); EpiGateA E{WSP(bf16, WS_T1), WSP(bf16, WS_SGA)}; gemm_any(F.lds, S, E, do_epi); }
        VM_WAIT(); __syncthreads();
        { DenseSched S; S.init(WSP(bf16, WS_Z), WSP(bf16, WS_WCO), T, D, D, F.G, F.bid); EpiGateB E{WSP(bf16, WS_T1), WSP(bf16, WS_SGB), WSP(bf16, WS_MG)}; gemm_any(F.lds, S, E, do_epi); });
    PHASE(7, { DenseSched S; S.init(WSP(bf16, WS_MG), WSP(bf16, WS_WMX), T, D, D, F.G, F.bid); EpiResid1 E{F.in[I_X], WSP(bf16, WS_X1B), WSP(float, WS_SSP)}; gemm_any(F.lds, S, E, do_epi); });
    PHASE(8, { DenseSched S; S.init(WSP(bf16, WS_X1B), WSP(bf16, WS_WXQ), T, 2 * XA, D, F.G, F.bid); S.ks = 1; EpiXQ E{WSP(bf16, WS_QX), WSP(float, WS_SSP)}; gemm_any(F.lds, S, E, do_epi); });
#if OPT_ATT
    PHASE(9, p_attn(F););
#else
    PHASE(9, p_attn_ref(F););
#endif
    PHASE(10, { DenseSched S; S.init(WSP(bf16, WS_OX), WSP(bf16, WS_WXO), T, D, XA, F.G, F.bid); EpiResid2 E{WSP(bf16, WS_X1B)}; gemm_any(F.lds, S, E, do_epi); });
    PHASE(11, p_router(F););
#if MOE_FP8
    PHASE(13, { moe_layout(F.lds, F.ctl + CW_CNT); const LAS int* lay = (const LAS int*)(F.lds + LAY_OFF); const int ntiles = __builtin_amdgcn_readfirstlane(lay[NE]) / 256;
        GroupSched S; S.init(WSP(unsigned char, WS_H3), WSP(unsigned char, WS_WGU), ntiles, 2 * FF, D, F.G, F.bid, lay, WSP(int, WS_RTE), 1); EpiGU8 E{WSP(unsigned char, WS_ACT), F.in[I_GUB]};
        gemm_any<EpiGU8, GroupSched, true>(F.lds, S, E, do_epi); });
    PHASE(14, { moe_layout(F.lds, F.ctl + CW_CNT); const LAS int* lay = (const LAS int*)(F.lds + LAY_OFF); const int ntiles = __builtin_amdgcn_readfirstlane(lay[NE]) / 256;
        GroupSched S; S.init(WSP(unsigned char, WS_ACT), WSP(unsigned char, WS_WDN), ntiles, D, FF, F.G, F.bid, lay, nullptr, 1); EpiDown8 E{WSP(unsigned char, WS_YS), F.in[I_DNB]};
        gemm_any<EpiDown8, GroupSched, true>(F.lds, S, E, do_epi); });
#endif
    PHASE(15, p_combine(F););
#undef PHASE
#undef IN
#undef SEAM
}

extern "C" void kernel_launch(void* const* d_in, const int* in_sizes, int n_in, void* d_out, int out_size, void* d_ws, size_t ws_size, hipStream_t stream) {
    static int grid = 0;
    if (grid == 0) {
        if (n_in != 26 || out_size != T * D || ws_size < WS_END) { fprintf(stderr, "kernel_launch: unexpected problem (n_in %d, out %d, ws %zu < %zu)\n", n_in, out_size, ws_size, (size_t)WS_END); grid = -1; return; }
        int dev = 0, cus = 0, per_cu = 0;
        if (hipGetDevice(&dev) != hipSuccess || hipDeviceGetAttribute(&cus, hipDeviceAttributeMultiprocessorCount, dev) != hipSuccess) { grid = -1; return; }
        if (hipFuncSetAttribute((const void*)hybrid_fwd, hipFuncAttributeMaxDynamicSharedMemorySize, LDS_BYTES) != hipSuccess) { fprintf(stderr, "kernel_launch: hipFuncSetAttribute failed\n"); grid = -1; return; }
        if (hipOccupancyMaxActiveBlocksPerMultiprocessor(&per_cu, (const void*)hybrid_fwd, NTHR, LDS_BYTES) != hipSuccess || per_cu < 1) fprintf(stderr, "kernel_launch: occupancy query says %d\n", per_cu);
        (void)hipGetLastError();
        grid = cus;
    }
    if (grid < 0) return;
    (void)hipMemsetAsync((char*)d_ws + WS_CTL, 0, CTL_ZERO_BYTES, stream);
    Args a{};
    for (int i = 0; i < 26; ++i) a.in[i] = (const float*)d_in[i];
    a.out = (float*)d_out; a.ws = (unsigned char*)d_ws;
#if MK_ONE_LAUNCH
    a.ph_lo = 0; a.ph_hi = NPHASE;
    hipLaunchKernelGGL(hybrid_fwd, dim3(grid), dim3(NTHR), LDS_BYTES, stream, a);
#else
    for (int p = 0; p < NPHASE; ++p) { a.ph_lo = p; a.ph_hi = p + 1; hipLaunchKernelGGL(hybrid_fwd, dim3(grid), dim3(NTHR), LDS_BYTES, stream, a); }
#endif
}
```

```cpp
#include <hip/hip_runtime.h>
#include <cstdio>
#include <cstdint>

#ifndef MK_ONE_LAUNCH
#define MK_ONE_LAUNCH 1
#endif
#ifndef OPT_GEMM
#define OPT_GEMM 1
#endif
#ifndef OPT_GLA
#define OPT_GLA 1
#endif
#ifndef MOE_FP8
#define MOE_FP8 1
#endif
#ifndef OPT_ATT
#define OPT_ATT 1
#endif

#define GAS __attribute__((address_space(1)))
#define LAS __attribute__((address_space(3)))
typedef unsigned short bf16;
typedef short bf16x8 __attribute__((ext_vector_type(8)));
typedef short bf16x4 __attribute__((ext_vector_type(4)));
typedef float f32x4 __attribute__((ext_vector_type(4)));
typedef float f32x2 __attribute__((ext_vector_type(2)));
typedef unsigned u32x4 __attribute__((ext_vector_type(4)));
typedef unsigned u32x2 __attribute__((ext_vector_type(2)));
#define RLX_AGENT __ATOMIC_RELAXED, __HIP_MEMORY_SCOPE_AGENT
#define LDS_WAIT() asm volatile("s_waitcnt lgkmcnt(0)" ::: "memory")
#define VM_WAIT() asm volatile("s_waitcnt vmcnt(0)" ::: "memory")

constexpr int T = 16384, D = 2048, MEM = 256;
constexpr int GH = 4, DK = 256, DV = 512, QK = GH * DK  , VD = GH * DV  ;
constexpr int CH = 64, NCH = T / CH  , NG = 16, GC = NCH / NG  , GT = GC * CH  ;
constexpr int XH = 4, XD = 128, XA = XH * XD  ;
constexpr int NE = 32, TOPK = 4, FF = 2048;
constexpr int NIN_SRC = 16400, NIN = 16384;
constexpr float EPS = 1e-5f;
constexpr int PROWS = T * TOPK + NE * 256;
constexpr int MAXTILES = PROWS / 256;

constexpr int SRC_ALOW = 6144, SRC_CB = 6160, SRC_CC = 8208, SRC_CHH = 10256, SRC_GA = 12304, SRC_GB = 14352;
constexpr int TN_Q = 0, TN_K = 4, TN_V = 8, TN_R = 16, TN_CB = 24, TN_U = 32, TN_GA = 48, TN_GB = 56, TN_END = 64;

constexpr size_t MiB = 1u << 20;
constexpr size_t WS_CTL = 0, CTL_ZERO_BYTES = 1 * MiB;
constexpr size_t WS_WIN = 1 * MiB;
constexpr size_t WS_WGO = WS_WIN + 68 * MiB;
constexpr size_t WS_WCO = WS_WGO + 8 * MiB;
constexpr size_t WS_WMX = WS_WCO + 8 * MiB;
constexpr size_t WS_WXQ = WS_WMX + 8 * MiB;
constexpr size_t WS_WXKV = WS_WXQ + 2 * MiB;
constexpr size_t WS_WXO = WS_WXKV + 4 * MiB;
constexpr size_t WS_WR = WS_WXO + 2 * MiB;
constexpr size_t WS_WGU = WS_WR + 1 * MiB;
constexpr size_t WS_WDN = WS_WGU + 512 * MiB;
constexpr size_t WS_XN = WS_WDN + 256 * MiB;
constexpr size_t WS_Q = WS_XN + 64 * MiB;
constexpr size_t WS_K = WS_Q + 32 * MiB;
constexpr size_t WS_V = WS_K + 32 * MiB;
constexpr size_t WS_SR = WS_V + 64 * MiB;
constexpr size_t WS_LA = WS_SR + 64 * MiB;
constexpr size_t WS_CB = WS_LA + 64 * MiB;
constexpr size_t WS_U = WS_CB + 64 * MiB;
constexpr size_t WS_SGA = WS_U + 64 * MiB;
constexpr size_t WS_SGB = WS_SGA + 64 * MiB;
constexpr size_t WS_QT = WS_SGB + 64 * MiB;
constexpr size_t WS_KH = WS_QT + 32 * MiB;
constexpr size_t WS_KHT = WS_KH + 32 * MiB;
constexpr size_t WS_QG = WS_KHT + 32 * MiB;
constexpr size_t WS_VT = WS_QG + 32 * MiB;
constexpr size_t WS_DL = WS_VT + 64 * MiB;
constexpr size_t WS_DG = WS_DL + 1 * MiB;
constexpr size_t WS_Z = WS_DG + 1 * MiB;
constexpr size_t WS_OL = WS_Z + 64 * MiB;
constexpr size_t WS_SLOC = WS_OL + 64 * MiB;
constexpr size_t WS_SG0 = WS_SLOC + 32 * MiB;
constexpr size_t WS_O32 = WS_SG0 + 16 * MiB;
constexpr size_t WS_OA = WS_O32 + 128 * MiB;
constexpr size_t WS_T1 = WS_OA + 64 * MiB;
constexpr size_t WS_MG = WS_T1 + 128 * MiB;
constexpr size_t WS_X1 = WS_MG + 64 * MiB;
constexpr size_t WS_X1B = WS_X1 + 128 * MiB;
constexpr size_t WS_QX = WS_X1B + 64 * MiB;
constexpr size_t WS_OX = WS_QX + 16 * MiB;
constexpr size_t WS_MEMN = WS_OX + 16 * MiB;
constexpr size_t WS_KM = WS_MEMN + 1 * MiB;
constexpr size_t WS_VMT = WS_KM + 1 * MiB;
constexpr size_t WS_H3 = WS_VMT + 1 * MiB;
constexpr size_t WS_TKE = WS_H3 + 65 * MiB;
constexpr size_t WS_TKP = WS_TKE + 1 * MiB;
constexpr size_t WS_TKW = WS_TKP + 1 * MiB;
constexpr size_t WS_ROWTOK = WS_TKW + 1 * MiB;
constexpr size_t WS_TILE = WS_ROWTOK + 1 * MiB;
constexpr size_t WS_SSP = WS_TILE + 1 * MiB;
constexpr size_t WS_WAL = WS_SSP + 8 * MiB;
constexpr size_t WS_ALOW = WS_WAL + 1 * MiB;
constexpr size_t WS_WGW = WS_ALOW + 1 * MiB;
constexpr size_t WS_RTE = WS_WGW + 1 * MiB;
constexpr size_t WS_ACT = WS_RTE + 2 * MiB;
constexpr size_t WS_YS = WS_ACT + 288 * MiB;
constexpr size_t WS_END = WS_YS + 288 * MiB;
constexpr int CW_BAR = 4096;
constexpr int CW_CNT = 16384;
constexpr int CW_SS1 = 65536;
static_assert((CW_SS1 + T) * 4 <= (int)CTL_ZERO_BYTES, "ctl");

constexpr int NWAVES = 8, NTHR = 512;
constexpr int LDS_BYTES = 147456;
constexpr int MISC_OFF = 147200;

__device__ __forceinline__ float bf2f(unsigned short b) { return __uint_as_float(((unsigned)b) << 16); }
typedef __bf16 bf16x2_t __attribute__((ext_vector_type(2)));
__device__ __forceinline__ unsigned pk2(float lo, float hi) { const f32x2 v = {lo, hi}; return __builtin_bit_cast(unsigned, __builtin_convertvector(v, bf16x2_t)); }
__device__ __forceinline__ unsigned f2bf(float f) { return pk2(f, 0.f) & 0xffffu; }
__device__ __forceinline__ float wave_sum(float v) {
#pragma unroll
    for (int o = 1; o < 64; o <<= 1) v += __shfl_xor(v, o);
    return v;
}
__device__ __forceinline__ float wave_max(float v) {
#pragma unroll
    for (int o = 1; o < 64; o <<= 1) v = fmaxf(v, __shfl_xor(v, o));
    return v;
}
__device__ __forceinline__ float sigmoidf_(float x) { return __builtin_amdgcn_rcpf(1.0f + __builtin_amdgcn_exp2f(x * -1.4426950408889634f)); }
__device__ __forceinline__ float logsigmoidf_(float z) { return fminf(z, 0.f) - 0.6931471805599453f * __builtin_amdgcn_logf(1.0f + __builtin_amdgcn_exp2f(fabsf(z) * -1.4426950408889634f)); }
__device__ __forceinline__ u32x4 pack8(f32x4 a, f32x4 b) { u32x4 w; w.x = pk2(a[0], a[1]); w.y = pk2(a[2], a[3]); w.z = pk2(b[0], b[1]); w.w = pk2(b[2], b[3]); return w; }
__device__ __forceinline__ void unpack8(u32x4 w, f32x4& a, f32x4& b) {
    a[0] = __uint_as_float(w.x << 16); a[1] = __uint_as_float(w.x & 0xffff0000u); a[2] = __uint_as_float(w.y << 16); a[3] = __uint_as_float(w.y & 0xffff0000u);
    b[0] = __uint_as_float(w.z << 16); b[1] = __uint_as_float(w.z & 0xffff0000u); b[2] = __uint_as_float(w.w << 16); b[3] = __uint_as_float(w.w & 0xffff0000u);
}
__device__ __forceinline__ unsigned pk4_fp8(float a, float b, float c, float d) {
    a = fminf(fmaxf(a, -448.f), 448.f); b = fminf(fmaxf(b, -448.f), 448.f); c = fminf(fmaxf(c, -448.f), 448.f); d = fminf(fmaxf(d, -448.f), 448.f);
    int w = 0; w = __builtin_amdgcn_cvt_pk_fp8_f32(a, b, w, false); w = __builtin_amdgcn_cvt_pk_fp8_f32(c, d, w, true); return (unsigned)w; }
__device__ __forceinline__ bf16x8 as_bf8(u32x4 w) { return __builtin_bit_cast(bf16x8, w); }
#define MFMA16(A, B, C) __builtin_amdgcn_mfma_f32_16x16x32_bf16((A), (B), (C), 0, 0, 0)
__device__ __forceinline__ int ld_agent_i(const int* p) { return (int)__hip_atomic_load((const unsigned*)p, RLX_AGENT); }

#define XB_TMO      128
#define XB_XCNT(j)  (256  + 64 * (j))
#define XB_XSUB(j)  (1280 + 64 * (j))
#define XB_XGEN(j)  (2304 + 64 * (j))
#define XB_TOP      3328
#define XB_TOPGEN   3392
#define XCD_BAR_WORDS 3456
#define XB_SPIN_CAP (1u << 22)
__device__ __forceinline__ unsigned xb_ld(unsigned* p)              { return __hip_atomic_load(p, __ATOMIC_RELAXED, __HIP_MEMORY_SCOPE_AGENT); }
__device__ __forceinline__ unsigned xb_add(unsigned* p, unsigned v) { return __hip_atomic_fetch_add(p, v, __ATOMIC_RELAXED, __HIP_MEMORY_SCOPE_AGENT); }
__device__ __forceinline__ unsigned xb_xcc_id() { return (unsigned)__builtin_amdgcn_s_getreg((3 << 11) | 20) & 0xFu; }
#define XB_SPIN(cond, bar) do { unsigned _sp = 0; while (cond) { __builtin_amdgcn_s_sleep(1); \
    if ((++_sp & 255u) == 0u) { if (xb_ld(&(bar)[XB_TMO])) break; if (_sp > XB_SPIN_CAP) { atomicAdd(&(bar)[XB_TMO], 1u); break; } } } } while (0)
struct XcdBarrier { unsigned* bar; unsigned x; volatile LAS unsigned* st; };
__device__ __forceinline__ XcdBarrier xcd_barrier_post(unsigned* bar, volatile LAS unsigned* st) {
    XcdBarrier b; b.bar = bar; b.x = xb_xcc_id(); b.st = st;
    if (threadIdx.x == 0) (void)xb_add(&bar[XB_XCNT(b.x)], 1u);
    return b;
}
__device__ __forceinline__ void xcd_barrier_complete(unsigned* bar, unsigned x, unsigned& nloc, unsigned& nx) {
    const unsigned G = gridDim.x * gridDim.y * gridDim.z;
    unsigned sum, cnt, mine, sp = 0u;
    for (;;) {
        sum = 0u; cnt = 0u; mine = 0u;
#pragma unroll
        for (unsigned j = 0; j < 16; ++j) { const unsigned c = xb_ld(&bar[XB_XCNT(j)]); sum += c; cnt += (c > 0u) ? 1u : 0u; mine = (j == x) ? c : mine; }
        if (sum == G) break;
        __builtin_amdgcn_s_sleep(1);
        if ((++sp & 255u) == 0u) { if (xb_ld(&bar[XB_TMO])) break; if (sp > XB_SPIN_CAP) { atomicAdd(&bar[XB_TMO], 1u); break; } }
    }
    nloc = mine > 0u ? mine : 1u; nx = cnt > 0u ? cnt : 1u;
}
__device__ __forceinline__ void xcd_barrier(const XcdBarrier& b) {
    asm volatile("s_waitcnt vmcnt(0)" ::: "memory");
    __syncthreads();
    if (threadIdx.x == 0) {
        unsigned* bar = b.bar;
        __builtin_amdgcn_s_waitcnt(0);
        unsigned nloc = b.st[0], nx = b.st[1];
        if (nloc == 0u) { xcd_barrier_complete(bar, b.x, nloc, nx); b.st[0] = nloc; b.st[1] = nx; }
        const unsigned old = xb_add(&bar[XB_XSUB(b.x)], 1u);
        const unsigned gen = old / nloc;
        if (old + 1u == (gen + 1u) * nloc) {
            __builtin_amdgcn_fence(__ATOMIC_RELEASE, "agent");
            asm volatile("s_waitcnt vmcnt(0)" ::: "memory");
            const unsigned og = xb_add(&bar[XB_TOP], 1u);
            const unsigned tg = og / nx;
            if (og + 1u == (tg + 1u) * nx) xb_add(&bar[XB_TOPGEN], 1u);
            else XB_SPIN(xb_ld(&bar[XB_TOPGEN]) == tg, bar);
            __builtin_amdgcn_fence(__ATOMIC_ACQUIRE, "agent");
            xb_add(&bar[XB_XGEN(b.x)], 1u);
            asm volatile("s_waitcnt vmcnt(0)" ::: "memory");
        } else {
            XB_SPIN(xb_ld(&bar[XB_XGEN(b.x)]) == gen, bar);
            __builtin_amdgcn_fence(__ATOMIC_ACQUIRE, "agent");
            asm volatile("s_waitcnt vmcnt(0)" ::: "memory");
        }
    }
    __syncthreads();
}

struct Args { const float* in[26]; float* out; unsigned char* ws; int ph_lo, ph_hi, probe, pad; };
struct Frame {
    LAS unsigned char* lds; unsigned char* ws; unsigned* ctl;
    int tid, lane, wave, G, bid;
    const float* const* in;
    float* out;
};
#define WSP(type, off) ((type*)(F.ws + (off)))
enum { I_X = 0, I_MEM, I_NMIXG, I_WIN, I_GGW, I_GGB, I_GNG, I_GOW, I_CW, I_CBIAS, I_COW, I_MXW, I_NXG, I_NMG, I_XQ, I_XK, I_XV, I_XO, I_NMOEG, I_RW, I_RB, I_GUW, I_GUB, I_DNW, I_DNB, I_NFG };

constexpr int BM = 256, BK = 64, HALF = 128, HTB = HALF * BK * 2, NXCD = 8, WGM = 8;
__device__ __forceinline__ int lds_byte(int r, int c) { const int st = (r >> 4) * 2 + (c >> 5), rr = r & 15, cc = c & 31, ob = rr * 64 + cc * 2; return st * 1024 + (ob ^ (((ob >> 9) & 1) << 5)); }
__device__ __forceinline__ void stage_rc(int b, int& R, int& C) { const int st = b / 1024, sb = b % 1024, swz = sb ^ (((sb >> 9) & 1) << 5); R = (st >> 1) * 16 + swz / 64; C = (st & 1) * 32 + (swz % 64) / 2; }
__device__ __forceinline__ int g8(int rr) { return ((rr >> 3) & 1) * 4 + ((rr >> 1) & 1); }
__device__ __forceinline__ int lds_byte8(int r, int c) { return (r >> 4) * 2048 + (r & 15) * 128 + ((c ^ g8(r & 15)) << 4); }
__device__ __forceinline__ void stage_rc8(int b, int& R, int& C) { const int s = b >> 4, rr = (s >> 3) & 15; R = (s >> 7) * 16 + rr; C = 8 * ((s & 7) ^ g8(rr)); }
__device__ __forceinline__ int perm32(int rho) { const int n = rho >> 4, i = rho & 15; return 8 * (i >> 2) + 4 * n + (i & 3); }

struct Unit { int pm, pn, e; };
__device__ __forceinline__ bool static_next(int i, int G, int c, int nM, int nN, Unit& u) {
    const int nwg = nM * nN; const long L = (long)i * G + c; if (L >= nwg) return false;
    int wgid = (int)L; { const int q = nwg / NXCD, r = nwg % NXCD, xcd = wgid % NXCD, off = wgid / NXCD; wgid = (xcd < r ? xcd * (q + 1) : r * (q + 1) + (xcd - r) * q) + off; }
    const int nig = WGM * nN, gid = wgid / nig, fm = gid * WGM, gsz = (nM - fm) < WGM ? (nM - fm) : WGM;
    u.pm = fm + ((wgid % nig) % gsz); u.pn = (wgid % nig) / gsz; u.e = 0; return true;
}
struct DenseSched {
    const char* A; const char* Bt; int K, nM, nN, G, c, i0, ni, pair;
    __device__ __forceinline__ void init(const void* A_, const void* Bt_, int M, int N, int K_, int G_, int c_, int i0_ = 0, int ni_ = 1 << 30, int pair_ = 0) { A = (const char*)A_; Bt = (const char*)Bt_; K = K_; nM = M / BM; nN = N / BM; G = G_; c = c_; i0 = i0_; ni = ni_; pair = pair_; }
    __device__ __forceinline__ bool next(int i, Unit& u) const { if (pair) { if (i >= 2 * ni) return false; return static_next(i0 + (i >> 1), G, c - (i & 1) * pair, nM, nN, u); } if (i >= ni) return false; if (!static_next(i0 + i, G, c, nM, nN, u)) return false; if (ks) { u.e = u.pn / (nN >> 1); u.pn -= u.e * (nN >> 1); } return true; }
    int ks = 0;
    __device__ __forceinline__ const char* a_base() const { return A; }
    __device__ __forceinline__ size_t a_off(const Unit& u) const { return ks ? (size_t)u.e * K : 0; }
    __device__ __forceinline__ const char* b_base(const Unit& u) const { return Bt + (size_t)u.pn * BM * K * 2 + (ks ? (size_t)u.e * K : 0); }
    __device__ __forceinline__ unsigned a_src_row(const Unit& u, int r) const { return (unsigned)(u.pm * BM + r); }
    __device__ __forceinline__ int koff(const Unit& u, int nt) const { return 0; }
    __device__ __forceinline__ int nkt(int bk) const { return (ks ? K / 2 : K) / bk; }
};
constexpr int LAY_OFF = 131072, LAY_CNT = 64, LAY_TILE = 128;
__device__ __forceinline__ void moe_layout(LAS unsigned char* lds, const unsigned* cnt) {
    LAS int* lay = (LAS int*)(lds + LAY_OFF);
    __syncthreads();
    if (threadIdx.x < NE) lay[LAY_CNT + threadIdx.x] = (int)__hip_atomic_load(cnt + 64 * threadIdx.x, RLX_AGENT);
    __syncthreads();
    if (threadIdx.x == 0) { int o = 0; for (int e = 0; e < NE; ++e) { lay[e] = o; o += (lay[LAY_CNT + e] + 255) / 256 * 256; } lay[NE] = o; }
    __syncthreads();
    for (int tl = threadIdx.x; tl < lay[NE] / 256; tl += NTHR) { int e = 0; for (int q = 1; q < NE; ++q) e = (tl * 256 >= lay[q]) ? q : e; lay[LAY_TILE + tl] = e; }
    __syncthreads();
}
struct GroupSched {
    const char* A; const char* Bt; int K, N, nM, nN, G, c, eb; const LAS int* lay; const int* rte;
    __device__ __forceinline__ void init(const void* A_, const void* Bt_, int ntiles, int N_, int K_, int G_, int c_, const LAS int* lay_, const int* rte_, int eb_ = 2) { A = (const char*)A_; Bt = (const char*)Bt_; eb = eb_; K = K_; N = N_; nM = ntiles; nN = N_ / BM; G = G_; c = c_; lay = lay_; rte = rte_; }
    __device__ __forceinline__ bool next(int i, Unit& u) const { if (!static_next(i, G, c, nM, nN, u)) return false; u.e = __builtin_amdgcn_readfirstlane(lay[LAY_TILE + u.pm]); return true; }
    __device__ __forceinline__ const char* a_base() const { return A; }
    __device__ __forceinline__ const char* b_base(const Unit& u) const { return eb == 1 ? Bt + ((size_t)u.e * nN + (size_t)u.pn) * (size_t)(K / 128) * 32768 : Bt + ((size_t)u.e * N + (size_t)u.pn * BM) * K * eb; }
    __device__ __forceinline__ int koff(const Unit& u, int nt) const { return (2 * u.pm) & (nt - 1); }
    __device__ __forceinline__ size_t a_off(const Unit& u) const { return 0; }
    __device__ __forceinline__ int nkt(int bk) const { return K / bk; }
    __device__ __forceinline__ unsigned a_src_row(const Unit& u, int r) const { if (!rte) return (unsigned)(u.pm * BM + r); const int pos = u.pm * BM + r - lay[u.e]; return pos < lay[LAY_CNT + u.e] ? (unsigned)ld_agent_i(rte + (size_t)u.e * T + pos) : (unsigned)T; }
};

template <class Epi, class Sched>
__device__ __forceinline__ void gemm_ref(LAS unsigned char* lds, const Sched& S, const Epi& E) {
    const int tid = threadIdx.x, tx = tid & 15, ty = tid >> 4, K = S.K;
    LAS float* As = (LAS float*)lds; LAS float* Bs = As + 16 * 260;
    const int lr = tid >> 1, kh = tid & 1;
    for (int i = 0;; ++i) {
        Unit u; if (!S.next(i, u)) break;
        float acc[8][16];
#pragma unroll
        for (int j = 0; j < 8; ++j)
#pragma unroll
            for (int q = 0; q < 16; ++q) acc[j][q] = 0.f;
        const char* Ab = S.a_base() + S.a_off(u) + ((size_t)S.a_src_row(u, lr) * K + 8 * kh) * 2;
        const char* Bb = S.b_base(u) + ((size_t)lr * K + 8 * kh) * 2;
        for (int k0 = 0; k0 < 16 * S.nkt(16); k0 += 16) {
            const bf16x8 av = *(const bf16x8*)(Ab + (size_t)k0 * 2), bv = *(const bf16x8*)(Bb + (size_t)k0 * 2);
            __syncthreads();
#pragma unroll
            for (int j = 0; j < 8; ++j) { As[(8 * kh + j) * 260 + lr] = bf2f((unsigned short)av[j]); Bs[(8 * kh + j) * 260 + lr] = bf2f((unsigned short)bv[j]); }
            __syncthreads();
#pragma unroll 4
            for (int kk = 0; kk < 16; ++kk) {
                float a[8], b[16];
#pragma unroll
                for (int j = 0; j < 8; ++j) a[j] = As[kk * 260 + ty + 32 * j];
                const f32x4 b0 = *(const LAS f32x4*)(Bs + kk * 260 + 8 * tx), b1 = *(const LAS f32x4*)(Bs + kk * 260 + 8 * tx + 4);
                const f32x4 b2 = *(const LAS f32x4*)(Bs + kk * 260 + 128 + 8 * tx), b3 = *(const LAS f32x4*)(Bs + kk * 260 + 128 + 8 * tx + 4);
#pragma unroll
                for (int q = 0; q < 4; ++q) { b[q] = b0[q]; b[4 + q] = b1[q]; b[8 + q] = b2[q]; b[12 + q] = b3[q]; }
#pragma unroll
                for (int j = 0; j < 8; ++j)
#pragma unroll
                    for (int q = 0; q < 16; ++q) acc[j][q] += a[j] * b[q];
            }
        }
#pragma unroll 8
        for (int j = 0; j < 8; ++j) {
            const f32x4 a0 = {acc[j][0], acc[j][1], acc[j][2], acc[j][3]}, a1 = {acc[j][4], acc[j][5], acc[j][6], acc[j][7]};
            const f32x4 b0 = {acc[j][8], acc[j][9], acc[j][10], acc[j][11]}, b1 = {acc[j][12], acc[j][13], acc[j][14], acc[j][15]};
            typename Epi::Ctx cx; E.load(u.pm * BM + ty + 32 * j, u, 8 * tx, cx); E.template fin<false>(u.pm * BM + ty + 32 * j, u, 8 * tx, cx, a0, a1, b0, b1);
        }
    }
    __syncthreads();
}

__device__ __forceinline__ void glds16s(const void* sbase, unsigned voff, unsigned lds_dst) {
    asm volatile("s_mov_b32 m0, %2\n\ts_nop 0\n\tglobal_load_lds_dwordx4 %1, %0" :: "s"(sbase), "v"(voff), "s"(lds_dst) : "memory", "m0");
}
typedef int i32x8 __attribute__((ext_vector_type(8)));
typedef int i32x4_t __attribute__((ext_vector_type(4)));
template <class Epi, class Sched, bool FP8 = false>
__device__ __forceinline__ void gemm_mfma(LAS unsigned char* lds, const Sched& S, const Epi& E, const bool do_epi = true) {
    const int tid = threadIdx.x, wid = __builtin_amdgcn_readfirstlane(tid >> 6), lane = tid & 63, wr = wid >> 2, wc = wid & 3, fr = lane & 15, fq = lane >> 4;
    const int K = S.K, nt = S.nkt(FP8 ? 128 : BK); const unsigned rowb = (unsigned)K * (FP8 ? 1u : 2u), rowbB = FP8 ? 128u : rowb;
    unsigned voffB[2];
#pragma unroll
    for (int i = 0; i < 2; ++i) { int R_, C_; if constexpr (FP8) stage_rc8(tid * 16 + i * 8192, R_, C_); else stage_rc(tid * 16 + i * 8192, R_, C_); const int Rb = (R_ & ~31) + perm32(R_ & 31); voffB[i] = (unsigned)Rb * rowbB + (unsigned)C_ * 2u; }
    const size_t kstep = (size_t)(BK * 2);
    const size_t kstepB = FP8 ? (size_t)32768 : kstep, hstep = (size_t)HALF * rowbB;
    const unsigned ldsw = (unsigned)wid * 1024u, lds0 = (unsigned)(uintptr_t)lds;
    const int aoff = FP8 ? lds_byte8(wr * 64 + fr, 2 * fq) : lds_byte(wr * 64 + fr, fq * 8), boff = FP8 ? lds_byte8(wc * 32 + fr, 2 * fq) : lds_byte(wc * 32 + fr, fq * 8);
    const int aoff1 = FP8 ? lds_byte8(wr * 64 + fr, 2 * fq + 1) : 0, boff1 = FP8 ? lds_byte8(wc * 32 + fr, 2 * fq + 1) : 0;

#define PG8_SA(b, h) (((b) * 2 + (h)) * HTB)
#define PG8_SB(b, h) ((4 + (b) * 2 + (h)) * HTB)
#define PG8_STAGE(bufoff, gbase, voff) do { _Pragma("unroll") for (int _i = 0; _i < 2; ++_i) \
        glds16s((const void*)(gbase), (voff)[_i], (unsigned)__builtin_amdgcn_readfirstlane((int)(lds0 + (unsigned)(bufoff) + ldsw + (unsigned)_i * 8192u))); } while (0)
#define PG8_LDA(dst, b, h) do { _Pragma("unroll") for (int m = 0; m < 4; ++m) { if constexpr (FP8) { const LAS unsigned char* _p = lds + PG8_SA(b, h) + m * 2048; \
            dst##8[m] = __builtin_shufflevector(*(const LAS i32x4_t*)(_p + aoff), *(const LAS i32x4_t*)(_p + aoff1), 0, 1, 2, 3, 4, 5, 6, 7); } \
        else { _Pragma("unroll") for (int k = 0; k < 2; ++k) dst[m][k] = *(const LAS bf16x8*)(lds + PG8_SA(b, h) + aoff + m * 2048 + k * 1024); } } } while (0)
#define PG8_LDB(dst, b, h) do { _Pragma("unroll") for (int n = 0; n < 2; ++n) { if constexpr (FP8) { const LAS unsigned char* _p = lds + PG8_SB(b, h) + n * 2048; \
            dst##8[n] = __builtin_shufflevector(*(const LAS i32x4_t*)(_p + boff), *(const LAS i32x4_t*)(_p + boff1), 0, 1, 2, 3, 4, 5, 6, 7); } \
        else { _Pragma("unroll") for (int k = 0; k < 2; ++k) dst[n][k] = *(const LAS bf16x8*)(lds + PG8_SB(b, h) + boff + n * 2048 + k * 1024); } } } while (0)
#define PG8_MMA(ai, bj, At, Bt) do { __builtin_amdgcn_s_setprio(1); _Pragma("unroll") for (int m = 0; m < 4; ++m) _Pragma("unroll") for (int n = 0; n < 2; ++n) { \
        if constexpr (FP8) { asm volatile("v_mfma_f32_16x16x128_f8f6f4 %0, %1, %2, %0" : "+v"(acc[ai][bj][m][n]) : "v"(Bt##8[n]), "v"(At##8[m])); } \
        else { _Pragma("unroll") for (int k = 0; k < 2; ++k) acc[ai][bj][m][n] = __builtin_amdgcn_mfma_f32_16x16x32_bf16(Bt[n][k], At[m][k], acc[ai][bj][m][n], 0, 0, 0); } } \
        __builtin_amdgcn_s_setprio(0); } while (0)
#define PG8_WAIT_V(n) asm volatile("s_waitcnt vmcnt(" #n ")" ::: "memory")
#define PG8_WAIT_L(n) asm volatile("s_waitcnt lgkmcnt(" #n ")" ::: "memory")
#define PG8_BAR __builtin_amdgcn_s_barrier()
#define PG8_SCHED __builtin_amdgcn_sched_barrier(0)
#define PG8_AOFF(dst, uu) do { _Pragma("unroll") for (int _i = 0; _i < 2; ++_i) { int _R, _C; if constexpr (FP8) stage_rc8(tid * 16 + _i * 8192, _R, _C); else stage_rc(tid * 16 + _i * 8192, _R, _C); _Pragma("unroll") for (int _h = 0; _h < 2; ++_h) dst[_h][_i] = S.a_src_row(uu, _h * HALF + _R) * rowb + (unsigned)_C * 2u; } } while (0)
    Unit cur, nxt; int ui = 0;
    if (!S.next(0, cur)) return;
    f32x4 acc[2][2][4][2];
#pragma unroll
    for (int a = 0; a < 2; ++a)
#pragma unroll
        for (int b = 0; b < 2; ++b)
#pragma unroll
            for (int m = 0; m < 4; ++m)
#pragma unroll
                for (int n = 0; n < 2; ++n) acc[a][b][m][n] = (f32x4){0.f, 0.f, 0.f, 0.f};
    bf16x8 At[4][2], B0[2][2], B1[2][2]; i32x8 At8[4], B08[2], B18[2];
    unsigned coff[2][2], noff[2][2];
    PG8_AOFF(coff, cur);
    const char* cA = S.a_base() + S.a_off(cur); const char* cB = S.b_base(cur);
    int ck = S.koff(cur, nt), nk = 0;
    PG8_STAGE(PG8_SB(0, 0), cB + ck * kstepB, voffB); PG8_STAGE(PG8_SB(0, 1), cB + hstep + ck * kstepB, voffB); PG8_STAGE(PG8_SA(0, 0), cA + ck * kstep, coff[0]); PG8_STAGE(PG8_SA(0, 1), cA + ck * kstep, coff[1]);
    if (wr == 1) PG8_BAR;
    PG8_WAIT_V(2); PG8_BAR;
    PG8_STAGE(PG8_SB(1, 0), cB + (ck + 1) * kstepB, voffB); PG8_STAGE(PG8_SA(1, 0), cA + (ck + 1) * kstep, coff[0]); PG8_STAGE(PG8_SB(1, 1), cB + hstep + (ck + 1) * kstepB, voffB);
    PG8_WAIT_V(6); PG8_BAR;
    for (;;) {
        const bool has_next = S.next(ui + 1, nxt);
        const char* nB = cB; const char* nA = cA;
#pragma unroll
        for (int _h = 0; _h < 2; ++_h)
#pragma unroll
            for (int _i = 0; _i < 2; ++_i) noff[_h][_i] = coff[_h][_i];
        nk = ck;
        if (has_next) { nB = S.b_base(nxt); nA = S.a_base() + S.a_off(nxt); PG8_AOFF(noff, nxt); nk = S.koff(nxt, nt); }
        for (int t = 0; t < nt; t += 2) {
            const bool last = (t == nt - 2);
            const int k1 = (t + 1 + ck) & (nt - 1), k2 = last ? nk : ((t + 2 + ck) & (nt - 1));
            const char* a1 = cA + (size_t)k1 * kstep;
            const char* a2 = (last ? nA : cA) + (size_t)k2 * kstep; const char* b2 = (last ? nB : cB) + (size_t)k2 * kstepB;
            const char* a3 = a2 + kstep; const char* b3 = b2 + kstepB;
            unsigned o2[2][2];
#pragma unroll
            for (int _h = 0; _h < 2; ++_h)
#pragma unroll
                for (int _i = 0; _i < 2; ++_i) o2[_h][_i] = last ? noff[_h][_i] : coff[_h][_i];
            PG8_LDB(B0, 0, 0); PG8_LDB(B1, 0, 1); PG8_SCHED; PG8_LDA(At, 0, 0); PG8_STAGE(PG8_SA(1, 1), a1, coff[1]);
            PG8_WAIT_V(8); PG8_WAIT_L(0); PG8_BAR; PG8_MMA(0, 0, At, B0); PG8_MMA(0, 1, At, B1); PG8_BAR; PG8_SCHED;
            PG8_LDA(At, 0, 1); PG8_STAGE(PG8_SB(0, 0), b2, voffB); PG8_STAGE(PG8_SB(0, 1), b2 + hstep, voffB); PG8_STAGE(PG8_SA(0, 0), a2, o2[0]);
            PG8_WAIT_V(8); PG8_WAIT_L(0); PG8_BAR; PG8_MMA(1, 0, At, B0); PG8_MMA(1, 1, At, B1); PG8_BAR; PG8_SCHED;
            PG8_LDB(B0, 1, 0); PG8_LDB(B1, 1, 1); PG8_SCHED; PG8_LDA(At, 1, 0); PG8_STAGE(PG8_SA(0, 1), a2, o2[1]);
            PG8_WAIT_V(8); PG8_WAIT_L(0); PG8_BAR; PG8_MMA(0, 0, At, B0); PG8_MMA(0, 1, At, B1); PG8_BAR; PG8_SCHED;
            PG8_LDA(At, 1, 1); PG8_STAGE(PG8_SB(1, 0), b3, voffB); PG8_STAGE(PG8_SB(1, 1), b3 + hstep, voffB); PG8_STAGE(PG8_SA(1, 0), a3, o2[0]);
            PG8_WAIT_V(8); PG8_WAIT_L(0); PG8_BAR; PG8_MMA(1, 0, At, B0); PG8_MMA(1, 1, At, B1); PG8_BAR; PG8_SCHED;
        }
#ifndef ALIGN_EPI
#define ALIGN_EPI 1
#endif
        if (ALIGN_EPI && wr == 0) PG8_BAR;
        if constexpr (FP8) asm volatile("s_nop 15\n\ts_nop 15" ::: "memory");
        if (do_epi) {
            constexpr int NB = Epi::NB; const int rbase = cur.pm * BM + wr * 64 + fr, c0 = wc * 32 + 8 * fq;
#pragma unroll
            for (int g0 = 0; g0 < 8; g0 += NB) {
                typename Epi::Ctx cx[NB];
#pragma unroll
                for (int i = 0; i < NB; ++i) E.load(rbase + ((g0 + i) >> 2) * HALF + ((g0 + i) & 3) * 16, cur, c0, cx[i]);
#pragma unroll
                for (int i = 0; i < NB; ++i) { const int ai = (g0 + i) >> 2, m = (g0 + i) & 3;
                    E.template fin<true>(rbase + ai * HALF + m * 16, cur, c0, cx[i], acc[ai][0][m][0], acc[ai][0][m][1], acc[ai][1][m][0], acc[ai][1][m][1]); }
            }
        }
        if (!has_next) break;
#pragma unroll
        for (int a = 0; a < 2; ++a)
#pragma unroll
            for (int b = 0; b < 2; ++b)
#pragma unroll
                for (int m = 0; m < 4; ++m)
#pragma unroll
                    for (int n = 0; n < 2; ++n) acc[a][b][m][n] = (f32x4){0.f, 0.f, 0.f, 0.f};
        cur = nxt; cB = nB; cA = nA; ck = nk;
#pragma unroll
        for (int _h = 0; _h < 2; ++_h)
#pragma unroll
            for (int _i = 0; _i < 2; ++_i) coff[_h][_i] = noff[_h][_i];
        ++ui;
        if (ALIGN_EPI && wr == 1) PG8_BAR;
    }
    PG8_WAIT_V(0);
    if (!ALIGN_EPI && wr == 0) PG8_BAR;
    PG8_BAR;
#undef PG8_SA
#undef PG8_SB
#undef PG8_STAGE
#undef PG8_LDA
#undef PG8_LDB
#undef PG8_MMA
#undef PG8_WAIT_V
#undef PG8_WAIT_L
#undef PG8_BAR
#undef PG8_SCHED
#undef PG8_AOFF
}
#ifndef SKEW_TICKS
#define SKEW_TICKS 0
#endif
__device__ __forceinline__ void phase_skew(int bid) {
    if (SKEW_TICKS > 0 && (bid & 1)) { const unsigned long long t0 = __builtin_amdgcn_s_memrealtime(); while (__builtin_amdgcn_s_memrealtime() - t0 < (unsigned long long)SKEW_TICKS) __builtin_amdgcn_s_sleep(8); }
}
template <class Epi, class Sched, bool FP8 = false>
__device__ __forceinline__ void gemm_any(LAS unsigned char* lds, const Sched& S, const Epi& E, const bool do_epi = true) {
#if OPT_GEMM
    gemm_mfma<Epi, Sched, FP8>(lds, S, E, do_epi);
#else
    gemm_ref<Epi, Sched>(lds, S, E);
#endif
}

__device__ __forceinline__ void st_bf8(bf16* p, f32x4 a, f32x4 b) { *(u32x4*)p = pack8(a, b); }
__device__ __forceinline__ void ld_bf8(const bf16* p, f32x4& a, f32x4& b) { unpack8(*(const u32x4*)p, a, b); }
constexpr float W8_SCALE = 128.0f, H8_SCALE = 8.0f, A8_SCALE = 4.0f;

struct EpiInProj {
    static constexpr int NB = 1; struct Ctx { int dummy; };
    bf16 *Q, *Kk, *V, *SR, *CB, *U, *SGA, *SGB;
    __device__ __forceinline__ void load(int row, const Unit& u, int c0, Ctx& c) const {}
    template <bool MF> __device__ __forceinline__ void fin(int row, const Unit& u, int c0, const Ctx& c, f32x4 a0, f32x4 a1, f32x4 b0, f32x4 b1) const {
        const int pn = u.pn;
        if (pn >= TN_U && pn < TN_GA) { st_bf8(U + (size_t)row * D + (pn - TN_U) * 128 + c0, a0 * b0, a1 * b1); return; }
        bf16* base; int ld, ct, mode = 0; float sc = 1.0f;
        if (pn < TN_K) { base = Q; ld = QK; ct = pn - TN_Q; sc = 0.0625f; }
        else if (pn < TN_V) { base = Kk; ld = QK; ct = pn - TN_K; }
        else if (pn < TN_R) { base = V; ld = VD; ct = pn - TN_V; }
        else if (pn < TN_CB) { base = SR; ld = VD; ct = pn - TN_R; mode = 1; }
        else if (pn < TN_U) { base = CB; ld = D; ct = pn - TN_CB; }
        else if (pn < TN_GB) { base = SGA; ld = D; ct = pn - TN_GA; mode = 2; }
        else { base = SGB; ld = D; ct = pn - TN_GB; mode = 2; }
        if (mode) {
#pragma unroll
            for (int j = 0; j < 4; ++j) { const float s0 = sigmoidf_(a0[j]), s1 = sigmoidf_(a1[j]), s2 = sigmoidf_(b0[j]), s3 = sigmoidf_(b1[j]);
                a0[j] = (mode == 1) ? a0[j] * s0 : s0; a1[j] = (mode == 1) ? a1[j] * s1 : s1; b0[j] = (mode == 1) ? b0[j] * s2 : s2; b1[j] = (mode == 1) ? b1[j] * s3 : s3; }
        } else { a0 *= sc; a1 *= sc; b0 *= sc; b1 *= sc; }
        bf16* p = base + (size_t)row * ld + ct * 256 + c0; st_bf8(p, a0, a1); st_bf8(p + 128, b0, b1);
    }
};
struct EpiGateA {
    static constexpr int NB = 4; struct Ctx { u32x4 s0, s1; };
    bf16* T1; const bf16* SGA;
    __device__ __forceinline__ void load(int row, const Unit& u, int c0, Ctx& c) const { const size_t o = (size_t)row * D + u.pn * 256 + c0; c.s0 = *(const u32x4*)(SGA + o); c.s1 = *(const u32x4*)(SGA + o + 128); }
    template <bool MF> __device__ __forceinline__ void fin(int row, const Unit& u, int c0, const Ctx& c, f32x4 a0, f32x4 a1, f32x4 b0, f32x4 b1) const {
        const size_t o = (size_t)row * D + u.pn * 256 + c0; f32x4 g0, g1, g2, g3; unpack8(c.s0, g0, g1); unpack8(c.s1, g2, g3);
        st_bf8(T1 + o, a0 * g0, a1 * g1); st_bf8(T1 + o + 128, b0 * g2, b1 * g3);
    }
};
struct EpiGateB {
    static constexpr int NB = 2; struct Ctx { u32x4 s0, s1, t0, t1; };
    const bf16* T1; const bf16* SGB; bf16* MG;
    __device__ __forceinline__ void load(int row, const Unit& u, int c0, Ctx& c) const { const size_t o = (size_t)row * D + u.pn * 256 + c0; c.s0 = *(const u32x4*)(SGB + o); c.s1 = *(const u32x4*)(SGB + o + 128); c.t0 = *(const u32x4*)(T1 + o); c.t1 = *(const u32x4*)(T1 + o + 128); }
    template <bool MF> __device__ __forceinline__ void fin(int row, const Unit& u, int c0, const Ctx& c, f32x4 a0, f32x4 a1, f32x4 b0, f32x4 b1) const {
        const size_t o = (size_t)row * D + u.pn * 256 + c0; f32x4 g0, g1, g2, g3, t0, t1, t2, t3; unpack8(c.s0, g0, g1); unpack8(c.s1, g2, g3); unpack8(c.t0, t0, t1); unpack8(c.t1, t2, t3);
        st_bf8(MG + o, t0 + a0 * g0, t1 + a1 * g1); st_bf8(MG + o + 128, t2 + b0 * g2, t3 + b1 * g3);
    }
};
#if OPT_GEMM
constexpr int SSP_N = 32;
#else
constexpr int SSP_N = 128;
#endif
struct EpiResid1 {
    static constexpr int NB = 4; struct Ctx { f32x4 x0, x1, x2, x3; };
    const float* X; bf16* XB; float* SSP;
    __device__ __forceinline__ void load(int row, const Unit& u, int c0, Ctx& c) const { const size_t o = (size_t)row * D + u.pn * 256 + c0; c.x0 = *(const f32x4*)(X + o); c.x1 = *(const f32x4*)(X + o + 4); c.x2 = *(const f32x4*)(X + o + 128); c.x3 = *(const f32x4*)(X + o + 132); }
    template <bool MF> __device__ __forceinline__ void fin(int row, const Unit& u, int c0, const Ctx& c, f32x4 a0, f32x4 a1, f32x4 b0, f32x4 b1) const {
        const size_t o = (size_t)row * D + u.pn * 256 + c0;
        a0 += c.x0; a1 += c.x1; b0 += c.x2; b1 += c.x3;
        st_bf8(XB + o, a0, a1); st_bf8(XB + o + 128, b0, b1);
        float s = 0.f;
#pragma unroll
        for (int j = 0; j < 4; ++j) s += a0[j] * a0[j] + a1[j] * a1[j] + b0[j] * b0[j] + b1[j] * b1[j];
        if (MF) { s += __shfl_xor(s, 16); s += __shfl_xor(s, 32); if ((threadIdx.x & 63) < 16) SSP[(size_t)row * SSP_N + 4 * u.pn + (c0 >> 5)] = s; }
        else SSP[(size_t)row * SSP_N + 16 * u.pn + (c0 >> 3)] = s;
    }
};
constexpr ptrdiff_t QX_HALF = ((ptrdiff_t)WS_O32 - (ptrdiff_t)WS_QX) / 2;
struct EpiXQ {
    static constexpr int NB = 8; struct Ctx { float r; };
    bf16* QX; const float* SSP;
    __device__ __forceinline__ void load(int row, const Unit& u, int c0, Ctx& c) const {
        const float* sp = SSP + (size_t)row * SSP_N; f32x4 t = *(const f32x4*)sp;
#pragma unroll
        for (int j = 1; j < SSP_N / 4; ++j) t += *(const f32x4*)(sp + 4 * j);
        c.r = rsqrtf(((t[0] + t[1]) + (t[2] + t[3])) * (1.0f / D) + EPS);
    }
    template <bool MF> __device__ __forceinline__ void fin(int row, const Unit& u, int c0, const Ctx& c, f32x4 a0, f32x4 a1, f32x4 b0, f32x4 b1) const {
        bf16* p = QX + (ptrdiff_t)u.e * QX_HALF + (size_t)row * XA + u.pn * 256 + c0; st_bf8(p, a0 * c.r, a1 * c.r); st_bf8(p + 128, b0 * c.r, b1 * c.r);
    }
};
struct EpiResid2 {
    static constexpr int NB = 8; struct Ctx { u32x4 x0, x1; };
    bf16* XB;
    __device__ __forceinline__ void load(int row, const Unit& u, int c0, Ctx& c) const { const bf16* p = XB + (size_t)row * D + u.pn * 256 + c0; c.x0 = *(const u32x4*)p; c.x1 = *(const u32x4*)(p + 128); }
    template <bool MF> __device__ __forceinline__ void fin(int row, const Unit& u, int c0, const Ctx& c, f32x4 a0, f32x4 a1, f32x4 b0, f32x4 b1) const {
        bf16* p = XB + (size_t)row * D + u.pn * 256 + c0; f32x4 x0, x1, x2, x3; unpack8(c.x0, x0, x1); unpack8(c.x1, x2, x3);
        st_bf8(p, x0 + a0, x1 + a1); st_bf8(p + 128, x2 + b0, x3 + b1);
    }
};
struct EpiGU8 {
    static constexpr int NB = 8; struct Ctx { f32x4 g0, g1, u0, u1; };
    unsigned char* ACT8; const float* gub;
    __device__ __forceinline__ void load(int row, const Unit& u, int c0, Ctx& c) const { const float* bg = gub + (size_t)u.e * (2 * FF) + u.pn * 128 + c0; c.g0 = *(const f32x4*)bg; c.g1 = *(const f32x4*)(bg + 4); c.u0 = *(const f32x4*)(bg + FF); c.u1 = *(const f32x4*)(bg + FF + 4); }
    template <bool MF> __device__ __forceinline__ void fin(int row, const Unit& u, int c0, const Ctx& c, f32x4 a0, f32x4 a1, f32x4 b0, f32x4 b1) const {
        const int f = u.pn * 128 + c0; const float is = 1.0f / (W8_SCALE * H8_SCALE);
        f32x4 r0, r1;
#pragma unroll
        for (int j = 0; j < 4; ++j) {
            float g = fminf(a0[j] * is + c.g0[j], 7.0f), up = fminf(fmaxf(b0[j] * is + c.u0[j], -7.0f), 7.0f); r0[j] = (up + 1.0f) * g * sigmoidf_(1.702f * g) * A8_SCALE;
            g = fminf(a1[j] * is + c.g1[j], 7.0f); up = fminf(fmaxf(b1[j] * is + c.u1[j], -7.0f), 7.0f); r1[j] = (up + 1.0f) * g * sigmoidf_(1.702f * g) * A8_SCALE;
        }
        u32x2 o; o.x = pk4_fp8(r0[0], r0[1], r0[2], r0[3]); o.y = pk4_fp8(r1[0], r1[1], r1[2], r1[3]);
        *(u32x2*)(ACT8 + (size_t)row * FF + f) = o;
    }
};
constexpr float Y8_SCALE = 16.0f;
struct EpiDown8 {
    static constexpr int NB = 8; struct Ctx { f32x4 b0, b1, b2, b3; };
    unsigned char* YS; const float* dnb;
    __device__ __forceinline__ void load(int row, const Unit& u, int c0, Ctx& c) const { const float* bb = dnb + (size_t)u.e * D + u.pn * 256 + c0; c.b0 = *(const f32x4*)bb; c.b1 = *(const f32x4*)(bb + 4); c.b2 = *(const f32x4*)(bb + 128); c.b3 = *(const f32x4*)(bb + 132); }
    template <bool MF> __device__ __forceinline__ void fin(int row, const Unit& u, int c0, const Ctx& c, f32x4 a0, f32x4 a1, f32x4 b0, f32x4 b1) const {
        unsigned char* p = YS + (size_t)row * D + u.pn * 256 + c0; const float is = Y8_SCALE / (W8_SCALE * A8_SCALE);
        a0 = a0 * is + c.b0 * Y8_SCALE; a1 = a1 * is + c.b1 * Y8_SCALE; b0 = b0 * is + c.b2 * Y8_SCALE; b1 = b1 * is + c.b3 * Y8_SCALE;
        u32x2 o; o.x = pk4_fp8(a0[0], a0[1], a0[2], a0[3]); o.y = pk4_fp8(a1[0], a1[1], a1[2], a1[3]); *(u32x2*)p = o;
        o.x = pk4_fp8(b0[0], b0[1], b0[2], b0[3]); o.y = pk4_fp8(b1[0], b1[1], b1[2], b1[3]); *(u32x2*)(p + 128) = o;
    }
};

__device__ __forceinline__ void tr_item_fp8(const float* W, int ldw, int K, int srccol0, unsigned char* WT, int dstrow0, LAS float* scr, int kb, int lane) {
    const int k0 = 128 * kb;
#pragma unroll 8
    for (int i = 0; i < 64; ++i) { const int kk = 2 * i + (lane >> 5); scr[kk * 33 + (lane & 31)] = W[(size_t)(k0 + kk) * ldw + srccol0 + (lane & 31)] * W8_SCALE; }
    LDS_WAIT(); asm volatile("" ::: "memory");
    const int c = lane & 7;
#pragma unroll
    for (int j = 0; j < 4; ++j) { const int n = (lane >> 3) + 8 * j; const LAS float* s = scr + (16 * c) * 33 + n;
        u32x4 o; o.x = pk4_fp8(s[0 * 33], s[1 * 33], s[2 * 33], s[3 * 33]); o.y = pk4_fp8(s[4 * 33], s[5 * 33], s[6 * 33], s[7 * 33]);
        o.z = pk4_fp8(s[8 * 33], s[9 * 33], s[10 * 33], s[11 * 33]); o.w = pk4_fp8(s[12 * 33], s[13 * 33], s[14 * 33], s[15 * 33]);
        *(u32x4*)(WT + (size_t)(dstrow0 + n) * K + k0 + 16 * c) = o; }
    LDS_WAIT(); asm volatile("" ::: "memory");
}
__device__ __forceinline__ void tr_item(const float* W, int ldw, int K, int srccol0, bf16* WT, int dstrow0, const float* ksc, LAS float* scr, int kb, int lane) {
    const int k0 = 64 * kb;
    float v[32];
#pragma unroll
    for (int i = 0; i < 32; ++i) v[i] = __builtin_nontemporal_load(W + (size_t)(k0 + 2 * i + (lane >> 5)) * ldw + srccol0 + (lane & 31));
#pragma unroll
    for (int i = 0; i < 32; ++i) { const int kk = 2 * i + (lane >> 5); scr[kk * 33 + (lane & 31)] = ksc ? v[i] * ksc[k0 + kk] : v[i]; }
    LDS_WAIT(); asm volatile("" ::: "memory");
    const int c = lane & 7;
#pragma unroll
    for (int j = 0; j < 4; ++j) { const int n = (lane >> 3) + 8 * j; const LAS float* s = scr + (8 * c) * 33 + n;
        u32x4 o; o.x = pk2(s[0 * 33], s[1 * 33]); o.y = pk2(s[2 * 33], s[3 * 33]); o.z = pk2(s[4 * 33], s[5 * 33]); o.w = pk2(s[6 * 33], s[7 * 33]);
        *(u32x4*)(WT + (size_t)(dstrow0 + n) * K + k0 + 8 * c) = o; }
    LDS_WAIT(); asm volatile("" ::: "memory");
}
__device__ __forceinline__ void tr8_load(const float* W, int ldw, int srccol0, int kb32, int lane, f32x4 (&v)[8]) {
    const char* base = (const char*)(W + (size_t)(32 * kb32) * ldw + srccol0);
    const unsigned voff = (unsigned)((lane >> 4) * ldw + 4 * (lane & 15)) * 4u;
#pragma unroll
    for (int i = 0; i < 8; ++i) v[i] = __builtin_nontemporal_load((const f32x4*)(base + (size_t)(4 * i) * ldw * 4 + voff));
}
__device__ __forceinline__ void tr8_quarter(const f32x4 (&v)[8], LAS float* scr, int lane, u32x4 (&o)[2]) {
    LAS float* w = scr + (lane >> 4) * 68 + 4 * (lane & 15);
#pragma unroll
    for (int i = 0; i < 8; ++i) *(LAS f32x4*)(w + 4 * i * 68) = v[i] * W8_SCALE;
    LDS_WAIT(); asm volatile("" ::: "memory");
    const LAS float* s = scr + lane;
    o[0].x = pk4_fp8(s[0 * 68], s[1 * 68], s[2 * 68], s[3 * 68]); o[0].y = pk4_fp8(s[4 * 68], s[5 * 68], s[6 * 68], s[7 * 68]);
    o[0].z = pk4_fp8(s[8 * 68], s[9 * 68], s[10 * 68], s[11 * 68]); o[0].w = pk4_fp8(s[12 * 68], s[13 * 68], s[14 * 68], s[15 * 68]);
    o[1].x = pk4_fp8(s[16 * 68], s[17 * 68], s[18 * 68], s[19 * 68]); o[1].y = pk4_fp8(s[20 * 68], s[21 * 68], s[22 * 68], s[23 * 68]);
    o[1].z = pk4_fp8(s[24 * 68], s[25 * 68], s[26 * 68], s[27 * 68]); o[1].w = pk4_fp8(s[28 * 68], s[29 * 68], s[30 * 68], s[31 * 68]);
    LDS_WAIT(); asm volatile("" ::: "memory");
}
__device__ __forceinline__ void tr8_store(const u32x4 (&pc)[4][2], unsigned char* WT, int K, int dstrow0, int kb, LAS float* scr, int lane) {
    LAS unsigned* t = (LAS unsigned*)scr;
    LAS unsigned* wl = t + lane * 33;
#pragma unroll
    for (int q = 0; q < 4; ++q)
#pragma unroll
        for (int j = 0; j < 2; ++j) { LAS unsigned* d = wl + 8 * q + 4 * j; const u32x4 x = pc[q][j]; d[0] = x.x; d[1] = x.y; d[2] = x.z; d[3] = x.w; }
    LDS_WAIT(); asm volatile("" ::: "memory");
    const LAS unsigned* rl = t + (lane >> 3) * 33 + 4 * (lane & 7);
    unsigned char* gb = WT + ((size_t)((dstrow0 >> 8) * (K >> 7) + kb) * 256 + (dstrow0 & 255)) * 128;
    const unsigned gvo = (unsigned)((lane >> 3) * 128 + 16 * (lane & 7));
#pragma unroll
    for (int j = 0; j < 8; ++j) { const LAS unsigned* sdw = rl + 8 * 33 * j;
        const u32x4 x = {sdw[0], sdw[1], sdw[2], sdw[3]};
        __builtin_nontemporal_store(x, (u32x4*)(gb + 1024 * j + gvo)); }
    LDS_WAIT(); asm volatile("" ::: "memory");
}
__device__ __forceinline__ void ex8_decode(const Frame& F, int sup, const float*& W, int& ldw, int& src, unsigned char*& WT, int& K, int& dst, int& kb) {
    if (sup < NE * 1024) { const int e = sup / 1024, r = sup % 1024, nb = r % 64, p = nb >> 2, w = (nb & 3) * 64; kb = r / 64;
        W = F.in[I_GUW] + (size_t)e * D * (2 * FF); ldw = 2 * FF; src = (w < 128) ? 128 * p + w : FF + 128 * p + (w - 128); WT = WSP(unsigned char, WS_WGU) + (size_t)e * (2 * FF) * D; K = D; dst = 64 * nb; }
    else { const int s2 = sup - NE * 1024, e = s2 / 512, r = s2 % 512, nb = r % 32; kb = r / 32;
        W = F.in[I_DNW] + (size_t)e * FF * D; ldw = D; src = 64 * nb; WT = WSP(unsigned char, WS_WDN) + (size_t)e * D * FF; K = FF; dst = 64 * nb; }
}
__device__ __forceinline__ void rms_row_to_bf16(const float* xrow, const float* g, bf16* orow, int lane) {
    f32x4 v[8]; float s = 0.f;
#pragma unroll
    for (int j = 0; j < 8; ++j) { v[j] = *(const f32x4*)(xrow + 4 * lane + 256 * j); s += (v[j][0] * v[j][0] + v[j][1] * v[j][1]) + (v[j][2] * v[j][2] + v[j][3] * v[j][3]); }
    const float r = rsqrtf(wave_sum(s) * (1.0f / D) + EPS);
#pragma unroll
    for (int j = 0; j < 8; ++j) { const f32x4 gg = *(const f32x4*)(g + 4 * lane + 256 * j); u32x2 o; o.x = pk2(v[j][0] * r * gg[0], v[j][1] * r * gg[1]); o.y = pk2(v[j][2] * r * gg[2], v[j][3] * r * gg[3]); *(u32x2*)(orow + 4 * lane + 256 * j) = o; }
}
__device__ __forceinline__ void p0_prologue(Frame& F, const int part, const int cb, const int CNG) {
    LAS float* scr = (LAS float*)(F.lds + F.wave * 16896);
    const int gw = cb * NWAVES + F.wave, NGW = CNG * NWAVES, lane = F.lane, gt = cb * NTHR + F.tid, NGT = CNG * NTHR;
    const float* Win = F.in[I_WIN];
    bf16* WIN = WSP(bf16, WS_WIN);
    if (part == 0) {
    for (int it = gw; it < 512 * 32; it += NGW) {
        const int nb = it % 512, kb = it / 512, n0 = 32 * nb;
        int src;
        if (n0 < TN_CB * 256) src = n0;
        else if (n0 < TN_U * 256) src = SRC_CB + (n0 - TN_CB * 256);
        else if (n0 < TN_GA * 256) { const int rel = n0 - TN_U * 256, p = rel >> 8, w = rel & 255; src = (w < 128) ? SRC_CC + 128 * p + w : SRC_CHH + 128 * p + (w - 128); }
        else if (n0 < TN_GB * 256) src = SRC_GA + (n0 - TN_GA * 256);
        else src = SRC_GB + (n0 - TN_GB * 256);
        tr_item(Win, NIN_SRC, D, src, WIN, n0, nullptr, scr, kb, lane);
    }
    for (int it = gw; it < 32; it += NGW) tr_item(Win, NIN_SRC, D, SRC_ALOW, WSP(bf16, WS_WAL), 0, nullptr, scr, it, lane);
    { const float* GW = F.in[I_GGW]; bf16* WGW = WSP(bf16, WS_WGW); for (int i = gt; i < QK * 32; i += NGT) { const int n = i >> 5, k = i & 31; WGW[i] = (k < 16) ? (bf16)f2bf(GW[k * QK + n]) : (bf16)0; } }
    }
    if (part == 1) {
    for (int it = gw; it < 3 * 2048; it += NGW) { const int w = it / 2048, r = it % 2048, nb = r % 64, kb = r / 64;
        const float* W = F.in[w == 0 ? I_GOW : (w == 1 ? I_COW : I_MXW)]; bf16* WT = WSP(bf16, w == 0 ? WS_WGO : (w == 1 ? WS_WCO : WS_WMX));
        tr_item(W, D, D, 32 * nb, WT, 32 * nb, nullptr, scr, kb, lane); }
    for (int it = gw; it < 3 * 512; it += NGW) { const int w = it / 512, r = it % 512, nb = r % 16, kb = r / 16;
        if (w == 0) tr_item(F.in[I_XQ], XA, D, 32 * nb, WSP(bf16, WS_WXQ), 32 * nb, F.in[I_NXG], scr, kb, lane);
        else tr_item(F.in[w == 1 ? I_XK : I_XV], XA, D, 32 * nb, WSP(bf16, WS_WXKV), (w - 1) * XA + 32 * nb, nullptr, scr, kb, lane); }
    for (int it = gw; it < 512; it += NGW) { const int nb = it % 64, kb = it / 64; tr_item(F.in[I_XO], D, XA, 32 * nb, WSP(bf16, WS_WXO), 32 * nb, nullptr, scr, kb, lane); }
#if MOE_FP8
    { LAS float* scr8 = (LAS float*)(F.lds + F.wave * 16896);
      constexpr int NSUP = NE * 1024 + NE * 512;
      f32x4 va[8], vb[8]; u32x4 pc[4][2];
      const float* W; int ldw, src, K, dst, kb; unsigned char* WT;
      if (gw < NSUP) { ex8_decode(F, gw, W, ldw, src, WT, K, dst, kb); tr8_load(W, ldw, src, 4 * kb + 0, lane, va); }
      for (int sup = gw; sup < NSUP; sup += NGW) {
          tr8_load(W, ldw, src, 4 * kb + 1, lane, vb); tr8_quarter(va, scr8, lane, pc[0]);
          tr8_load(W, ldw, src, 4 * kb + 2, lane, va); tr8_quarter(vb, scr8, lane, pc[1]);
          tr8_load(W, ldw, src, 4 * kb + 3, lane, vb); tr8_quarter(va, scr8, lane, pc[2]);
          const float* W1 = W; int ldw1 = ldw, src1 = src, K1 = K, dst1 = dst, kb1 = kb; unsigned char* WT1 = WT;
          if (sup + NGW < NSUP) { ex8_decode(F, sup + NGW, W1, ldw1, src1, WT1, K1, dst1, kb1); tr8_load(W1, ldw1, src1, 4 * kb1 + 0, lane, va); }
          tr8_quarter(vb, scr8, lane, pc[3]);
          tr8_store(pc, WT, K, dst, kb, scr8, lane);
          W = W1; ldw = ldw1; src = src1; K = K1; dst = dst1; kb = kb1; WT = WT1;
      } }
#endif
    { const float* rw = F.in[I_RW]; const float* g = F.in[I_NMOEG]; float* WR = WSP(float, WS_WR);
      for (int i = gt; i < NE * D; i += NGT) { const int e = i / D, k = i % D; WR[i] = rw[k * NE + e] * g[k]; } }
    }
    if (part == 0) {
    for (int m = gw; m < T; m += 2 * NGW) {
        const float* x0 = F.in[I_X] + (size_t)m * D; const bool two = (m + NGW < T); const float* x1 = F.in[I_X] + (size_t)(two ? m + NGW : m) * D; const float* gmix = F.in[I_NMIXG];
        f32x4 v0[8], v1[8]; float s0 = 0.f, s1 = 0.f;
#pragma unroll
        for (int j = 0; j < 8; ++j) { v0[j] = *(const f32x4*)(x0 + 4 * lane + 256 * j); v1[j] = *(const f32x4*)(x1 + 4 * lane + 256 * j); }
#pragma unroll
        for (int j = 0; j < 8; ++j) { s0 += (v0[j][0] * v0[j][0] + v0[j][1] * v0[j][1]) + (v0[j][2] * v0[j][2] + v0[j][3] * v0[j][3]); s1 += (v1[j][0] * v1[j][0] + v1[j][1] * v1[j][1]) + (v1[j][2] * v1[j][2] + v1[j][3] * v1[j][3]); }
        const float r0 = rsqrtf(wave_sum(s0) * (1.0f / D) + EPS), r1 = rsqrtf(wave_sum(s1) * (1.0f / D) + EPS);
        bf16* o0 = WSP(bf16, WS_XN) + (size_t)m * D; bf16* o1 = WSP(bf16, WS_XN) + (size_t)(m + NGW) * D;
#pragma unroll
        for (int j = 0; j < 8; ++j) { const f32x4 gg = *(const f32x4*)(gmix + 4 * lane + 256 * j);
            u32x2 a; a.x = pk2(v0[j][0] * r0 * gg[0], v0[j][1] * r0 * gg[1]); a.y = pk2(v0[j][2] * r0 * gg[2], v0[j][3] * r0 * gg[3]); *(u32x2*)(o0 + 4 * lane + 256 * j) = a;
            if (two) { u32x2 b; b.x = pk2(v1[j][0] * r1 * gg[0], v1[j][1] * r1 * gg[1]); b.y = pk2(v1[j][2] * r1 * gg[2], v1[j][3] * r1 * gg[3]); *(u32x2*)(o1 + 4 * lane + 256 * j) = b; } }
    }
    }
    if (part == 1) {
    for (int m = gw; m < MEM; m += NGW) rms_row_to_bf16(F.in[I_MEM] + (size_t)m * D, F.in[I_NMG], WSP(bf16, WS_MEMN) + (size_t)m * D, lane);
    { u32x4* z = (u32x4*)(WSP(bf16, WS_H3) + (size_t)T * D); u32x4* z8 = (u32x4*)(WSP(unsigned char, WS_H3) + (size_t)T * D); for (int i = gt; i < 256; i += NGT) { z[i] = (u32x4){0u, 0u, 0u, 0u}; z8[i] = (u32x4){0u, 0u, 0u, 0u}; } }
    }
}

__device__ __forceinline__ void p_memkv(Frame& F) {
    const bf16* A = WSP(bf16, WS_MEMN); const bf16* B = WSP(bf16, WS_WXKV); bf16* KM = WSP(bf16, WS_KM); bf16* VMT = WSP(bf16, WS_VMT);
    LAS f32x4* red = (LAS f32x4*)F.lds;
    const int lane = F.lane, w = F.wave, lr = lane & 15, lg = lane >> 4;
    for (int unit = F.bid; unit < (MEM / 16) * (2 * XA / 64); unit += F.G) {
        const int mt = unit & 15, nt = unit >> 4; const bool isk = nt < 8;
        const bf16* ap = A + (size_t)(16 * mt + lr) * D + 256 * w + 8 * lg; const bf16* bp = B + (size_t)(64 * nt + lr) * D + 256 * w + 8 * lg;
        bf16x8 af[8], bf[4][8];
#pragma unroll
        for (int s = 0; s < 8; ++s) { af[s] = *(const bf16x8*)(ap + 32 * s);
#pragma unroll
            for (int j = 0; j < 4; ++j) bf[j][s] = *(const bf16x8*)(bp + (size_t)(16 * j) * D + 32 * s); }
        f32x4 acc[4];
#pragma unroll
        for (int j = 0; j < 4; ++j) { acc[j] = (f32x4){0.f, 0.f, 0.f, 0.f};
#pragma unroll
            for (int s = 0; s < 8; ++s) acc[j] = isk ? MFMA16(bf[j][s], af[s], acc[j]) : MFMA16(af[s], bf[j][s], acc[j]); }
        __syncthreads();
#pragma unroll
        for (int j = 0; j < 4; ++j) red[(w * 4 + j) * 64 + lane] = acc[j];
        __syncthreads();
        if (w < 4) { f32x4 t = red[w * 64 + lane];
#pragma unroll
            for (int ww = 1; ww < 8; ++ww) t += red[(ww * 4 + w) * 64 + lane];
            u32x2 o; o.x = pk2(t[0], t[1]); o.y = pk2(t[2], t[3]);
            if (isk) *(u32x2*)(KM + (size_t)(16 * mt + lr) * XA + 64 * nt + 16 * w + 4 * lg) = o;
            else *(u32x2*)(VMT + (size_t)(64 * nt - XA + 16 * w + lr) * MEM + 16 * mt + 4 * lg) = o;
        }
    }
    __syncthreads();
}

__device__ __forceinline__ void p_alow(Frame& F) {
    const bf16* XN = WSP(bf16, WS_XN); const bf16* WAL = WSP(bf16, WS_WAL); const bf16* WGW = WSP(bf16, WS_WGW); const float* GB = F.in[I_GGB]; float* LA = WSP(float, WS_LA);
    LAS f32x4* red = (LAS f32x4*)F.lds;
    const int lane = F.lane, lr = lane & 15, lg = lane >> 4, tk = F.wave >> 1, kh = F.wave & 1;
    for (int t4 = F.bid; t4 < T / 64; t4 += F.G) {
        const int task = 4 * t4 + tk;
        const bf16* ap = WAL + (size_t)lr * D + 1024 * kh + 8 * lg; const bf16* bp = XN + (size_t)(16 * task + lr) * D + 1024 * kh + 8 * lg;
        f32x4 acc = {0.f, 0.f, 0.f, 0.f};
#pragma unroll 16
        for (int s = 0; s < 32; ++s) acc = MFMA16(*(const bf16x8*)(ap + 32 * s), *(const bf16x8*)(bp + 32 * s), acc);
        __syncthreads();
        red[(tk * 2 + kh) * 64 + lane] = acc;
        __syncthreads();
#if OPT_GLA
        if (kh == 0) *(f32x4*)(WSP(float, WS_ALOW) + (size_t)(16 * task + lr) * 16 + 4 * lg) = red[(tk * 2) * 64 + lane] + red[(tk * 2 + 1) * 64 + lane];
        continue;
#endif
        u32x4 bw = {0u, 0u, 0u, 0u};
        if (lg < 2) { const f32x4 x0 = red[(tk * 2) * 64 + lr + 32 * lg] + red[(tk * 2 + 1) * 64 + lr + 32 * lg], x1 = red[(tk * 2) * 64 + lr + 32 * lg + 16] + red[(tk * 2 + 1) * 64 + lr + 32 * lg + 16];
            bw = (u32x4){pk2(x0[0], x0[1]), pk2(x0[2], x0[3]), pk2(x1[0], x1[1]), pk2(x1[2], x1[3])}; }
        const bf16x8 bfr = as_bf8(bw);
#pragma unroll 4
        for (int q = 0; q < 32; ++q) { const int nt = 32 * kh + q;
            const bf16x8 afr = *(const bf16x8*)(WGW + (size_t)(16 * nt + lr) * 32 + 8 * lg);
            f32x4 z = MFMA16(afr, bfr, ((f32x4){0.f, 0.f, 0.f, 0.f}));
            const f32x4 gb = *(const f32x4*)(GB + 16 * nt + 4 * lg);
#pragma unroll
            for (int r = 0; r < 4; ++r) z[r] = logsigmoidf_(z[r] + gb[r]) * 0.0625f;
            *(f32x4*)(LA + (size_t)(16 * task + lr) * QK + 16 * nt + 4 * lg) = z; }
    }
    __syncthreads();
}

__device__ __forceinline__ void p_conv(Frame& F) {
    const bf16* U = WSP(bf16, WS_U); const bf16* CB = WSP(bf16, WS_CB); bf16* Z = WSP(bf16, WS_Z);
    const float* cw = F.in[I_CW]; const float* cb = F.in[I_CBIAS];
    for (int task = F.bid * NTHR + F.tid; task < (T / 32) * (D / 8); task += F.G * NTHR) {
        const int cg = task & 255, tb = task >> 8, c = 8 * cg, t0 = 32 * tb;
        f32x4 w0a = *(const f32x4*)(cw + c), w0b = *(const f32x4*)(cw + c + 4), w1a = *(const f32x4*)(cw + D + c), w1b = *(const f32x4*)(cw + D + c + 4);
        f32x4 w2a = *(const f32x4*)(cw + 2 * D + c), w2b = *(const f32x4*)(cw + 2 * D + c + 4), ba = *(const f32x4*)(cb + c), bb = *(const f32x4*)(cb + c + 4);
        f32x4 p2a = {0.f, 0.f, 0.f, 0.f}, p2b = p2a, p1a = p2a, p1b = p2a;
        if (t0 >= 2) { ld_bf8(U + (size_t)(t0 - 2) * D + c, p2a, p2b); ld_bf8(U + (size_t)(t0 - 1) * D + c, p1a, p1b); }
        for (int tq = t0; tq < t0 + 32; tq += 8) {
            u32x4 ur[8], cr[8];
#pragma unroll
            for (int i = 0; i < 8; ++i) { ur[i] = *(const u32x4*)(U + (size_t)(tq + i) * D + c); cr[i] = *(const u32x4*)(CB + (size_t)(tq + i) * D + c); }
#pragma unroll
            for (int i = 0; i < 8; ++i) {
                f32x4 ua, ub, ca, cbv; unpack8(ur[i], ua, ub); unpack8(cr[i], ca, cbv);
                const f32x4 ya = ca * (w0a * p2a + w1a * p1a + w2a * ua + ba), yb = cbv * (w0b * p2b + w1b * p1b + w2b * ub + bb);
                st_bf8(Z + (size_t)(tq + i) * D + c, ya, yb);
                p2a = p1a; p2b = p1b; p1a = ua; p1b = ub;
            }
        }
    }
}
__device__ __forceinline__ void p_glaprep(Frame& F) {
    const bf16* Q = WSP(bf16, WS_Q); const bf16* Kk = WSP(bf16, WS_K); const float* ALOW = WSP(float, WS_ALOW); const float* GW = F.in[I_GGW]; const float* GB = F.in[I_GGB];
    bf16* QT = WSP(bf16, WS_QT); bf16* KH = WSP(bf16, WS_KH); bf16* KHT = WSP(bf16, WS_KHT); bf16* QG = WSP(bf16, WS_QG);
    float* DL = WSP(float, WS_DL); float* DG = WSP(float, WS_DG);
    LAS float* part = (LAS float*)F.lds;
    LAS float* sal = part + 512;
    const int col = F.tid & 63, sub = F.tid >> 6;
    for (int unit = F.bid; unit < NG * 16; unit += F.G) {
        const int g = unit >> 4, cs = unit & 15, gc = cs * 64 + col, h = gc >> 8, kc = gc & 255;
        float gw[16];
#pragma unroll
        for (int r = 0; r < 16; ++r) gw[r] = GW[r * QK + gc];
        const float gbv = GB[gc];
        float carry = 0.f;
        bf16 qr[8], kr[8]; f32x4 av = {0.f, 0.f, 0.f, 0.f};
#define PREP_LOAD(chunk_) do { const int _t0 = (chunk_) * CH + 8 * sub; \
        _Pragma("unroll") for (int j = 0; j < 8; ++j) { qr[j] = Q[(size_t)(_t0 + j) * QK + gc]; kr[j] = Kk[(size_t)(_t0 + j) * QK + gc]; } \
        if (F.tid < 256) av = *(const f32x4*)(ALOW + (size_t)(chunk_) * CH * 16 + 4 * F.tid); } while (0)
        PREP_LOAD(g * GC);
        for (int c = 0; c < GC; ++c) {
            const int chunk = g * GC + c, t0 = chunk * CH + 8 * sub;
            float la[8], qv[8], kv[8];
#pragma unroll
            for (int j = 0; j < 8; ++j) { qv[j] = bf2f(qr[j]); kv[j] = bf2f(kr[j]); }
            if (F.tid < 256) *(LAS f32x4*)(sal + 4 * F.tid) = av;
            __syncthreads();
            if (c + 1 < GC) PREP_LOAD(chunk + 1);
#pragma unroll
            for (int j = 0; j < 8; ++j) { const LAS f32x4* ar = (const LAS f32x4*)(sal + (8 * sub + j) * 16); const f32x4 a0 = ar[0], a1 = ar[1], a2 = ar[2], a3 = ar[3];
                float z = gbv;
#pragma unroll
                for (int r = 0; r < 4; ++r) z += a0[r] * gw[r];
#pragma unroll
                for (int r = 0; r < 4; ++r) z += a1[r] * gw[4 + r];
#pragma unroll
                for (int r = 0; r < 4; ++r) z += a2[r] * gw[8 + r];
#pragma unroll
                for (int r = 0; r < 4; ++r) z += a3[r] * gw[12 + r];
                la[j] = logsigmoidf_(z) * 0.0625f; }
#pragma unroll
            for (int j = 1; j < 8; ++j) la[j] += la[j - 1];
            part[sub * 64 + col] = la[7];
            __syncthreads();
            float off = 0.f, tot = 0.f;
#pragma unroll
            for (int s = 0; s < 8; ++s) { const float p = part[s * 64 + col]; off += (s < sub) ? p : 0.f; tot += p; }
            unsigned kt[4];
#pragma unroll
            for (int j = 0; j < 8; ++j) { const float b = off + la[j], eb = __expf(b), enb = __expf(-b), eg = __expf(carry + b);
                QT[(size_t)(t0 + j) * QK + gc] = (bf16)f2bf(qv[j] * eb); const unsigned khv = f2bf(kv[j] * enb); KH[(size_t)(t0 + j) * QK + gc] = (bf16)khv;
                QG[(size_t)(t0 + j) * QK + gc] = (bf16)f2bf(qv[j] * eg);
                if (j & 1) kt[j >> 1] |= khv << 16; else kt[j >> 1] = khv; }
            *(u32x4*)(KHT + ((size_t)(chunk * GH + h) * DK + kc) * CH + 8 * sub) = (u32x4){kt[0], kt[1], kt[2], kt[3]};
            if (sub == 0) DL[(size_t)chunk * QK + gc] = __expf(tot);
            carry += tot;
        }
#undef PREP_LOAD
        if (sub == 0) DG[(size_t)g * QK + gc] = __expf(carry);
    }
}

__device__ __forceinline__ void p_gla_ref(Frame& F) {
    const bf16* Q = WSP(bf16, WS_Q); const bf16* Kk = WSP(bf16, WS_K); const bf16* V = WSP(bf16, WS_V); const float* LA = WSP(float, WS_LA); float* O32 = WSP(float, WS_O32);
    LAS float* red = (LAS float*)F.lds;
    const int k = F.tid & 255, vh = F.tid >> 8;
    for (int unit = F.bid; unit < GH * 64; unit += F.G) {
        const int h = unit >> 6, vb = unit & 63, vcol = h * DV + vb * 8 + vh * 4;
        float s0 = 0.f, s1 = 0.f, s2 = 0.f, s3 = 0.f;
        for (int tb = 0; tb < T; tb += 8) {
            LAS float* rb = red + ((tb >> 3) & 1) * 256;
#pragma unroll
            for (int j = 0; j < 8; ++j) {
                const int t = tb + j; const float a = __expf(LA[(size_t)t * QK + h * DK + k]), kk = bf2f(Kk[(size_t)t * QK + h * DK + k]), qq = bf2f(Q[(size_t)t * QK + h * DK + k]);
                const u32x2 vv = *(const u32x2*)(V + (size_t)t * VD + vcol);
                const float v0 = __uint_as_float(vv.x << 16), v1 = __uint_as_float(vv.x & 0xffff0000u), v2 = __uint_as_float(vv.y << 16), v3 = __uint_as_float(vv.y & 0xffff0000u);
                s0 = a * s0 + kk * v0; s1 = a * s1 + kk * v1; s2 = a * s2 + kk * v2; s3 = a * s3 + kk * v3;
                const float p0 = wave_sum(qq * s0), p1 = wave_sum(qq * s1), p2 = wave_sum(qq * s2), p3 = wave_sum(qq * s3);
                if (F.lane == 0) *(LAS f32x4*)(rb + (j * 8 + F.wave) * 4) = (f32x4){p0, p1, p2, p3};
            }
            __syncthreads();
            if (F.tid < 64) { const int j = F.tid >> 3, vhh = (F.tid >> 2) & 1, q = F.tid & 3; float s = 0.f;
#pragma unroll
                for (int w = 0; w < 4; ++w) s += rb[(j * 8 + vhh * 4 + w) * 4 + q];
                O32[(size_t)(tb + j) * VD + h * DV + vb * 8 + vhh * 4 + q] = s; }
        }
        __syncthreads();
    }
}
__device__ __forceinline__ void p_gla_norm_ref(Frame& F) {
    const float* O32 = WSP(float, WS_O32); const bf16* SR = WSP(bf16, WS_SR); bf16* OA = WSP(bf16, WS_OA); const float* g = F.in[I_GNG];
    const int gw = F.bid * NWAVES + F.wave, NGW = F.G * NWAVES;
    for (int it = gw; it < T * GH; it += NGW) {
        const size_t o = (size_t)it * DV + 8 * F.lane;
        const f32x4 a = *(const f32x4*)(O32 + o), b = *(const f32x4*)(O32 + o + 4);
        float s = 0.f;
#pragma unroll
        for (int j = 0; j < 4; ++j) s += a[j] * a[j] + b[j] * b[j];
        const float r = rsqrtf(wave_sum(s) * (1.0f / DV) + EPS);
        f32x4 s0, s1; ld_bf8(SR + o, s0, s1);
        const f32x4 g0 = *(const f32x4*)(g + 8 * F.lane), g1 = *(const f32x4*)(g + 8 * F.lane + 4);
        st_bf8(OA + o, a * r * g0 * s0, b * r * g1 * s1);
    }
}

__device__ __forceinline__ void p_gla_a(Frame& F) {
    const bf16* QT = WSP(bf16, WS_QT); const bf16* KH = WSP(bf16, WS_KH); const bf16* KHT = WSP(bf16, WS_KHT); const bf16* V = WSP(bf16, WS_V); const float* DL = WSP(float, WS_DL);
    bf16* OL = WSP(bf16, WS_OL); float* SLOC = WSP(float, WS_SLOC);
    constexpr int QS = 528, KQ = 544, KS = 160;
    LAS unsigned char* sQ = F.lds; LAS unsigned char* sK = sQ + 64 * QS; LAS unsigned char* sKT = sK + 64 * KQ; LAS unsigned char* sVT = sKT + 256 * KS; LAS unsigned char* sP = sVT + 128 * KS;
    LAS float* sDL = (LAS float*)(sP + 64 * KS);
    static_assert(64 * QS + 64 * KQ + 256 * KS + 128 * KS + 64 * KS + 1024 <= MISC_OFF, "gla lds");
    const int tid = F.tid, lane = F.lane, w = F.wave, lr = lane & 15, lg = lane >> 4;
    for (int unit0 = F.bid; unit0 < NG * GH * 4; unit0 += F.G) {
        const int unit = (F.G == NG * GH * 4) ? ((((unit0 & 7) + 8 * (unit0 >> 5)) << 2) | ((unit0 >> 3) & 3)) : unit0;
        const int g = unit >> 4, h = (unit >> 2) & 3, vs = unit & 3;
        f32x4 S[16];
#pragma unroll
        for (int kt = 0; kt < 16; ++kt) S[kt] = (f32x4){0.f, 0.f, 0.f, 0.f};
        u32x4 rq[4], rk[4], rt[4], rv[2], rd = {0u, 0u, 0u, 0u};
#define GLA_LOAD(chunk_) do { const int _t0 = (chunk_) * CH; \
        _Pragma("unroll") for (int q = 0; q < 4; ++q) { const int p = tid + 512 * q, row = p >> 5, c16 = p & 31; \
            rq[q] = *(const u32x4*)(QT + (size_t)(_t0 + row) * QK + h * DK + c16 * 8); rk[q] = *(const u32x4*)(KH + (size_t)(_t0 + row) * QK + h * DK + c16 * 8); \
            rt[q] = *(const u32x4*)(KHT + (size_t)((chunk_) * GH + h) * DK * CH + (size_t)p * 8); } \
        _Pragma("unroll") for (int q = 0; q < 2; ++q) rv[q] = *(const u32x4*)(V + (size_t)(_t0 + lane) * VD + h * DV + vs * 128 + 8 * (2 * w + q)); \
        if (tid < 64) rd = *(const u32x4*)(DL + (size_t)(chunk_) * QK + h * DK + 4 * tid); } while (0)
        GLA_LOAD(g * GC);
        for (int c = 0; c < GC; ++c) {
            const int chunk = g * GC + c, t0 = chunk * CH;
#pragma unroll
            for (int q = 0; q < 4; ++q) { const int p = tid + 512 * q; *(LAS u32x4*)(sQ + (p >> 5) * QS + (p & 31) * 16) = rq[q]; *(LAS u32x4*)(sK + (p >> 5) * KQ + (p & 31) * 16) = rk[q]; *(LAS u32x4*)(sKT + (p >> 3) * KS + (p & 7) * 16) = rt[q]; }
#pragma unroll
            for (int q = 0; q < 2; ++q) { LAS unsigned char* vp = sVT + (8 * (2 * w + q)) * KS + 2 * lane;
                *(LAS unsigned short*)(vp) = (unsigned short)rv[q].x; *(LAS unsigned short*)(vp + KS) = (unsigned short)(rv[q].x >> 16); *(LAS unsigned short*)(vp + 2 * KS) = (unsigned short)rv[q].y; *(LAS unsigned short*)(vp + 3 * KS) = (unsigned short)(rv[q].y >> 16);
                *(LAS unsigned short*)(vp + 4 * KS) = (unsigned short)rv[q].z; *(LAS unsigned short*)(vp + 5 * KS) = (unsigned short)(rv[q].z >> 16); *(LAS unsigned short*)(vp + 6 * KS) = (unsigned short)rv[q].w; *(LAS unsigned short*)(vp + 7 * KS) = (unsigned short)(rv[q].w >> 16); }
            if (tid < 64) *(LAS u32x4*)(sDL + 4 * tid) = rd;
            __syncthreads();
            if (c + 1 < GC) GLA_LOAD(chunk + 1);
            { const int ti = w >> 1;
#pragma unroll
              for (int jj = 0; jj < 2; ++jj) { const int tj = 2 * (w & 1) + jj; f32x4 pa = {0.f, 0.f, 0.f, 0.f};
                if (tj <= ti) {
#pragma unroll
                    for (int s = 0; s < 8; ++s) { const bf16x8 a = *(const LAS bf16x8*)(sK + (16 * tj + lr) * KQ + (32 * s + 8 * lg) * 2), b = *(const LAS bf16x8*)(sQ + (16 * ti + lr) * QS + (32 * s + 8 * lg) * 2); pa = MFMA16(a, b, pa); }
                    const int i = 16 * ti + lr, j0 = 16 * tj + 4 * lg;
#pragma unroll
                    for (int r = 0; r < 4; ++r) pa[r] = (j0 + r <= i) ? pa[r] : 0.f;
                }
                u32x2 pw; pw.x = pk2(pa[0], pa[1]); pw.y = pk2(pa[2], pa[3]);
                *(LAS u32x2*)(sP + (16 * ti + lr) * KS + (16 * tj + 4 * lg) * 2) = pw; } }
            f32x4 oacc[4];
#pragma unroll
            for (int ti = 0; ti < 4; ++ti) oacc[ti] = (f32x4){0.f, 0.f, 0.f, 0.f};
#pragma unroll
            for (int s = 0; s < 8; ++s) {
                u32x4 sw; sw.x = pk2(S[2 * s][0], S[2 * s][1]); sw.y = pk2(S[2 * s][2], S[2 * s][3]); sw.z = pk2(S[2 * s + 1][0], S[2 * s + 1][1]); sw.w = pk2(S[2 * s + 1][2], S[2 * s + 1][3]);
                const bf16x8 a = as_bf8(sw);
#pragma unroll
                for (int ti = 0; ti < 4; ++ti) { const LAS unsigned char* qp = sQ + (16 * ti + lr) * QS + (32 * s + 4 * lg) * 2; const u32x2 lo = *(const LAS u32x2*)qp, hi = *(const LAS u32x2*)(qp + 32);
                    oacc[ti] = MFMA16(a, as_bf8((u32x4){lo.x, lo.y, hi.x, hi.y}), oacc[ti]); }
            }
            __syncthreads();
            bf16x8 vf[2];
#pragma unroll
            for (int s2 = 0; s2 < 2; ++s2) vf[s2] = *(const LAS bf16x8*)(sVT + (16 * w + lr) * KS + (32 * s2 + 8 * lg) * 2);
#pragma unroll
            for (int s2 = 0; s2 < 2; ++s2)
#pragma unroll
                for (int ti = 0; ti < 4; ++ti) { const bf16x8 b = *(const LAS bf16x8*)(sP + (16 * ti + lr) * KS + (32 * s2 + 8 * lg) * 2); oacc[ti] = MFMA16(vf[s2], b, oacc[ti]); }
#pragma unroll
            for (int ti = 0; ti < 4; ++ti) { u32x2 ow; ow.x = pk2(oacc[ti][0], oacc[ti][1]); ow.y = pk2(oacc[ti][2], oacc[ti][3]);
                *(u32x2*)(OL + (size_t)(t0 + 16 * ti + lr) * VD + h * DV + vs * 128 + 16 * w + 4 * lg) = ow; }
#pragma unroll
            for (int kt = 0; kt < 16; ++kt) {
#pragma unroll
                for (int s2 = 0; s2 < 2; ++s2) { const bf16x8 a = *(const LAS bf16x8*)(sKT + (16 * kt + lr) * KS + (32 * s2 + 8 * lg) * 2); S[kt] = MFMA16(a, vf[s2], S[kt]); }
                S[kt] *= *(const LAS f32x4*)(sDL + 16 * kt + 4 * lg);
            }
            __syncthreads();
        }
#undef GLA_LOAD
#pragma unroll
        for (int kt = 0; kt < 16; ++kt)
#pragma unroll
            for (int r = 0; r < 4; ++r) SLOC[((size_t)(g * GH + h) * DK + 16 * kt + 4 * lg + r) * DV + vs * 128 + 16 * w + lr] = S[kt][r];
    }
}
__device__ __forceinline__ void p_gla_b(Frame& F) {
    const float* SLOC = WSP(float, WS_SLOC); const float* DG = WSP(float, WS_DG); bf16* SG0 = WSP(bf16, WS_SG0);
    for (int idx = F.bid * NTHR + F.tid; idx < GH * DV * (DK / 4); idx += F.G * NTHR) {
        const int v = idx & 511, k4 = (idx >> 9) & 63, h = idx >> 15;
        float x[NG - 1][4]; f32x4 d[NG - 1];
#pragma unroll
        for (int g = 0; g < NG - 1; ++g) { d[g] = *(const f32x4*)(DG + (size_t)g * QK + h * DK + 4 * k4);
#pragma unroll
            for (int j = 0; j < 4; ++j) x[g][j] = SLOC[((size_t)(g * GH + h) * DK + 4 * k4 + j) * DV + v]; }
        float s[4] = {0.f, 0.f, 0.f, 0.f};
#pragma unroll
        for (int g = 0; g < NG; ++g) {
            *(u32x2*)(SG0 + ((size_t)(g * GH + h) * DV + v) * DK + 4 * k4) = (u32x2){pk2(s[0], s[1]), pk2(s[2], s[3])};
            if (g < NG - 1) {
#pragma unroll
                for (int j = 0; j < 4; ++j) s[j] = d[g][j] * s[j] + x[g][j]; }
        }
    }
}
__device__ __forceinline__ void p_gla_c(Frame& F) {
    const bf16* QG = WSP(bf16, WS_QG); const bf16* SG0 = WSP(bf16, WS_SG0); const bf16* OL = WSP(bf16, WS_OL); const bf16* SR = WSP(bf16, WS_SR); bf16* OA = WSP(bf16, WS_OA); const float* gn = F.in[I_GNG];
    LAS float* red = (LAS float*)F.lds;
    const int lane = F.lane, w = F.wave, lr = lane & 15, lg = lane >> 4;
    for (int unit = F.bid; unit < (T / 128) * GH; unit += F.G) {
        const int rt = unit >> 2, h = unit & 3, g = rt >> 3, row0 = rt * 128;
        f32x4 o[8][4];
#pragma unroll
        for (int it = 0; it < 8; ++it)
#pragma unroll
            for (int vt = 0; vt < 4; ++vt) o[it][vt] = (f32x4){0.f, 0.f, 0.f, 0.f};
        if (g > 0) {
            const bf16* sg = SG0 + ((size_t)(g * GH + h) * DV + 64 * w + 8 * (lr >> 2) + (lr & 3)) * DK + 8 * lg; const bf16* qg = QG + (size_t)(row0 + lr) * QK + h * DK + 8 * lg;
            bf16x8 a0[4], b0[8], a1[4], b1[8];
#define GLC_LOAD(A_, B_, s_) do { _Pragma("unroll") for (int vt = 0; vt < 4; ++vt) A_[vt] = *(const bf16x8*)(sg + (size_t)(32 * (vt >> 1) + 4 * (vt & 1)) * DK + 32 * (s_)); \
            _Pragma("unroll") for (int it = 0; it < 8; ++it) B_[it] = *(const bf16x8*)(qg + (size_t)(16 * it) * QK + 32 * (s_)); } while (0)
#define GLC_MMA(A_, B_) do { _Pragma("unroll") for (int it = 0; it < 8; ++it) _Pragma("unroll") for (int vt = 0; vt < 4; ++vt) o[it][vt] = MFMA16(A_[vt], B_[it], o[it][vt]); } while (0)
            GLC_LOAD(a0, b0, 0);
#pragma unroll
            for (int s = 0; s < 8; s += 2) {
                GLC_LOAD(a1, b1, s + 1);
                GLC_MMA(a0, b0);
                if (s + 2 < 8) GLC_LOAD(a0, b0, s + 2);
                GLC_MMA(a1, b1);
            }
#undef GLC_LOAD
#undef GLC_MMA
        }
        asm volatile("" ::: "memory");
        const size_t ob = (size_t)(row0 + lr) * VD + h * DV + 64 * w + 8 * lg;
        float ss[8];
#pragma unroll
        for (int it = 0; it < 8; ++it) { ss[it] = 0.f;
#pragma unroll
            for (int p = 0; p < 2; ++p) { const u32x4 ol4 = *(const u32x4*)(OL + ob + (size_t)(16 * it) * VD + 32 * p);
#pragma unroll
              for (int q = 0; q < 2; ++q) { const int vt = 2 * p + q; u32x2 ol; ol.x = q ? ol4.z : ol4.x; ol.y = q ? ol4.w : ol4.y;
                o[it][vt][0] += __uint_as_float(ol.x << 16); o[it][vt][1] += __uint_as_float(ol.x & 0xffff0000u); o[it][vt][2] += __uint_as_float(ol.y << 16); o[it][vt][3] += __uint_as_float(ol.y & 0xffff0000u);
                ss[it] += (o[it][vt][0] * o[it][vt][0] + o[it][vt][1] * o[it][vt][1]) + (o[it][vt][2] * o[it][vt][2] + o[it][vt][3] * o[it][vt][3]); } }
            ss[it] += __shfl_xor(ss[it], 16); ss[it] += __shfl_xor(ss[it], 32); }
        __syncthreads();
        if (lg == 0) {
#pragma unroll
            for (int it = 0; it < 8; ++it) red[w * 128 + 16 * it + lr] = ss[it]; }
        __syncthreads();
#pragma unroll
        for (int it = 0; it < 8; ++it) { float t = 0.f;
#pragma unroll
            for (int ww = 0; ww < 8; ++ww) t += red[ww * 128 + 16 * it + lr];
            const float r = rsqrtf(t * (1.0f / DV) + EPS);
#pragma unroll
            for (int p = 0; p < 2; ++p) { const size_t oo = ob + (size_t)(16 * it) * VD + 32 * p; const u32x4 sr4 = *(const u32x4*)(SR + oo); u32x4 ow4;
#pragma unroll
              for (int q = 0; q < 2; ++q) { const int vt = 2 * p + q; u32x2 sr; sr.x = q ? sr4.z : sr4.x; sr.y = q ? sr4.w : sr4.y; const f32x4 gg = *(const f32x4*)(gn + 64 * w + 32 * p + 8 * lg + 4 * q);
                u32x2 ow; ow.x = pk2(o[it][vt][0] * r * gg[0] * __uint_as_float(sr.x << 16), o[it][vt][1] * r * gg[1] * __uint_as_float(sr.x & 0xffff0000u));
                ow.y = pk2(o[it][vt][2] * r * gg[2] * __uint_as_float(sr.y << 16), o[it][vt][3] * r * gg[3] * __uint_as_float(sr.y & 0xffff0000u));
                if (q) { ow4.z = ow.x; ow4.w = ow.y; } else { ow4.x = ow.x; ow4.y = ow.y; } }
              *(u32x4*)(OA + oo) = ow4; } }
    }
    __syncthreads();
}

__device__ __forceinline__ void p_attn_ref(Frame& F) {
    const bf16* QX = WSP(bf16, WS_QX); const bf16* KM = WSP(bf16, WS_KM); const bf16* VMT = WSP(bf16, WS_VMT); bf16* OX = WSP(bf16, WS_OX);
    LAS float* pbuf = (LAS float*)F.lds + F.wave * 256;
    const int gw = F.bid * NWAVES + F.wave, NGW = F.G * NWAVES, lane = F.lane;
    for (int it = gw; it < T * XH; it += NGW) {
        const int t = it >> 2, h = it & 3; const bf16* q = QX + (size_t)t * XA + h * XD;
        float s[4] = {0.f, 0.f, 0.f, 0.f};
        for (int d = 0; d < XD; d += 8) { f32x4 q0, q1, q2, q3; ld_bf8(q + d, q0, q1); ld_bf8(q + d + QX_HALF, q2, q3); q0 += q2; q1 += q3;
#pragma unroll
            for (int c = 0; c < 4; ++c) { f32x4 k0, k1; ld_bf8(KM + (size_t)(lane + 64 * c) * XA + h * XD + d, k0, k1);
#pragma unroll
                for (int j = 0; j < 4; ++j) s[c] += q0[j] * k0[j] + q1[j] * k1[j]; } }
        const float sc = 0.08838834764831845f;
        float mx = fmaxf(fmaxf(s[0], s[1]), fmaxf(s[2], s[3])) * sc; mx = wave_max(mx);
        float e[4], sum = 0.f;
#pragma unroll
        for (int c = 0; c < 4; ++c) { e[c] = __expf(s[c] * sc - mx); sum += e[c]; }
        sum = wave_sum(sum); const float inv = 1.0f / sum;
#pragma unroll
        for (int c = 0; c < 4; ++c) pbuf[lane + 64 * c] = bf2f((unsigned short)f2bf(e[c] * inv));
        LDS_WAIT(); asm volatile("" ::: "memory");
        float o0 = 0.f, o1 = 0.f; const bf16* v0 = VMT + (size_t)(h * XD + 2 * lane) * MEM; const bf16* v1 = v0 + MEM;
        for (int m = 0; m < MEM; m += 8) { f32x4 a0, a1, b0, b1; ld_bf8(v0 + m, a0, a1); ld_bf8(v1 + m, b0, b1); const f32x4 p0 = *(const LAS f32x4*)(pbuf + m), p1 = *(const LAS f32x4*)(pbuf + m + 4);
#pragma unroll
            for (int j = 0; j < 4; ++j) { o0 += p0[j] * a0[j] + p1[j] * a1[j]; o1 += p0[j] * b0[j] + p1[j] * b1[j]; } }
        *(unsigned*)(OX + (size_t)t * XA + h * XD + 2 * lane) = pk2(o0, o1);
        LDS_WAIT(); asm volatile("" ::: "memory");
    }
}

__device__ __forceinline__ void p_attn(Frame& F) {
    const bf16* QX = WSP(bf16, WS_QX); const bf16* KM = WSP(bf16, WS_KM); const bf16* VMT = WSP(bf16, WS_VMT); bf16* OX = WSP(bf16, WS_OX);
    constexpr int KSt = 288, VSt = 528;
    LAS unsigned char* sK = F.lds; LAS unsigned char* sV = sK + 256 * KSt;
    static_assert(256 * KSt + 128 * VSt <= MISC_OFF, "attn lds");
    const int tid = F.tid, lane = F.lane, w = F.wave, lr = lane & 15, lg = lane >> 4;
    int curh = -1;
    for (int unit = F.bid; unit < (T / 128) * XH; unit += F.G) {
        const int h = unit & 3, rt = unit >> 2;
        if (h != curh) {
            __syncthreads();
#pragma unroll
            for (int q = 0; q < 8; ++q) { const int p = tid + 512 * q;
                *(LAS u32x4*)(sK + (p >> 4) * KSt + (p & 15) * 16) = *(const u32x4*)(KM + (size_t)(p >> 4) * XA + h * XD + (p & 15) * 8);
                *(LAS u32x4*)(sV + (p >> 5) * VSt + (p & 31) * 16) = *(const u32x4*)(VMT + (size_t)(h * XD + (p >> 5)) * MEM + (p & 31) * 8); }
            __syncthreads();
            curh = h;
        }
        const int row = rt * 128 + 16 * w + lr;
        bf16x8 qf[4];
#pragma unroll
        for (int s = 0; s < 4; ++s) { const bf16* qp = QX + (size_t)row * XA + h * XD + 32 * s + 8 * lg;
            f32x4 a0, a1, b0, b1; unpack8(*(const u32x4*)qp, a0, a1); unpack8(*(const u32x4*)(qp + QX_HALF), b0, b1); qf[s] = as_bf8(pack8(a0 + b0, a1 + b1)); }
        f32x4 sc[16];
#pragma unroll
        for (int kt = 0; kt < 16; ++kt) { sc[kt] = (f32x4){0.f, 0.f, 0.f, 0.f};
#pragma unroll
            for (int s = 0; s < 4; ++s) { const bf16x8 a = *(const LAS bf16x8*)(sK + (16 * kt + lr) * KSt + (32 * s + 8 * lg) * 2); sc[kt] = MFMA16(a, qf[s], sc[kt]); } }
        float m = -3.0e38f;
#pragma unroll
        for (int kt = 0; kt < 16; ++kt) m = fmaxf(m, fmaxf(fmaxf(sc[kt][0], sc[kt][1]), fmaxf(sc[kt][2], sc[kt][3])));
        m = fmaxf(m, __shfl_xor(m, 16)); m = fmaxf(m, __shfl_xor(m, 32));
        const float c = 0.08838834764831845f * 1.4426950408889634f;
        float sum = 0.f;
#pragma unroll
        for (int kt = 0; kt < 16; ++kt)
#pragma unroll
            for (int r = 0; r < 4; ++r) { const float p = exp2f((sc[kt][r] - m) * c); sc[kt][r] = p; sum += p; }
        sum += __shfl_xor(sum, 16); sum += __shfl_xor(sum, 32);
        const float inv = 1.0f / sum;
        f32x4 oa[8];
#pragma unroll
        for (int dt = 0; dt < 8; ++dt) oa[dt] = (f32x4){0.f, 0.f, 0.f, 0.f};
#pragma unroll
        for (int s = 0; s < 8; ++s) {
            u32x4 pw; pw.x = pk2(sc[2 * s][0], sc[2 * s][1]); pw.y = pk2(sc[2 * s][2], sc[2 * s][3]); pw.z = pk2(sc[2 * s + 1][0], sc[2 * s + 1][1]); pw.w = pk2(sc[2 * s + 1][2], sc[2 * s + 1][3]);
            const bf16x8 b = as_bf8(pw);
#pragma unroll
            for (int dt = 0; dt < 8; ++dt) { const LAS unsigned char* vp = sV + (16 * dt + lr) * VSt + (32 * s + 4 * lg) * 2; const u32x2 lo = *(const LAS u32x2*)vp, hi = *(const LAS u32x2*)(vp + 32);
                oa[dt] = MFMA16(as_bf8((u32x4){lo.x, lo.y, hi.x, hi.y}), b, oa[dt]); }
        }
#pragma unroll
        for (int dt = 0; dt < 8; ++dt) { u32x2 ow; ow.x = pk2(oa[dt][0] * inv, oa[dt][1] * inv); ow.y = pk2(oa[dt][2] * inv, oa[dt][3] * inv);
            *(u32x2*)(OX + (size_t)row * XA + h * XD + 16 * dt + 4 * lg) = ow; }
    }
    __syncthreads();
}

typedef float f32x16 __attribute__((ext_vector_type(16)));
__device__ __forceinline__ void p_router(Frame& F) {
    const bf16* X2 = WSP(bf16, WS_X1B); bf16* H3 = WSP(bf16, WS_H3); const float* WR = WSP(float, WS_WR); const float* g = F.in[I_NMOEG]; const float* rb = F.in[I_RB];
    int* TKE = WSP(int, WS_TKE); int* TKP = WSP(int, WS_TKP); float* TKW = WSP(float, WS_TKW); unsigned* cnt = F.ctl + CW_CNT; int* RTE = WSP(int, WS_RTE);
    LAS unsigned* lcnt = (LAS unsigned*)F.lds;
    LAS int* le = (LAS int*)(F.lds + 256);
    LAS int* lp = (LAS int*)(F.lds + 256 + 1024);
    LAS float* P = (LAS float*)(F.lds + 4096);
    LAS float* SSQ = (LAS float*)(F.lds + 4096 + 8 * 32 * 33 * 4);
    const int lane = F.lane, th = F.wave & 1, kq = F.wave >> 1, li = lane & 31, hh = lane >> 5;
    for (int blk = F.bid; blk < T / 64; blk += F.G) {
        __syncthreads();
        if (F.tid < 64) lcnt[F.tid] = 0u;
        const bf16* xr = X2 + (size_t)(blk * 64 + th * 32 + li) * D + kq * 512 + 4 * hh;
        const float* wr = WR + (size_t)li * D + kq * 512 + 4 * hh;
        f32x16 acc;
#pragma unroll
        for (int r = 0; r < 16; ++r) acc[r] = 0.f;
        float ss = 0.f;
#pragma unroll 16
        for (int q = 0; q < 64; ++q) {
            const u32x2 aw = *(const u32x2*)(xr + 8 * q); const f32x4 a = {__uint_as_float(aw.x << 16), __uint_as_float(aw.x & 0xffff0000u), __uint_as_float(aw.y << 16), __uint_as_float(aw.y & 0xffff0000u)}, b = *(const f32x4*)(wr + 8 * q);
            ss += (a[0] * a[0] + a[1] * a[1]) + (a[2] * a[2] + a[3] * a[3]);
#pragma unroll
            for (int s = 0; s < 4; ++s) acc = __builtin_amdgcn_mfma_f32_32x32x2f32(a[s], b[s], acc, 0, 0, 0);
        }
        ss += __shfl_xor(ss, 32);
#pragma unroll
        for (int r = 0; r < 16; ++r) P[(F.wave * 32 + (r & 3) + 8 * (r >> 2) + 4 * hh) * 33 + li] = acc[r];
        if (lane < 32) SSQ[F.wave * 32 + lane] = ss;
        __syncthreads();
        if (F.tid < 64) {
            const int tl = F.tid, th2 = tl >> 5, ti = tl & 31, t = blk * 64 + tl;
            float ssq = 0.f;
#pragma unroll
            for (int k4 = 0; k4 < 4; ++k4) ssq += SSQ[(k4 * 2 + th2) * 32 + ti];
            const float r = rsqrtf(ssq * (1.0f / D) + EPS);
            float v0 = -3.0e38f, v1 = -3.0e38f, v2 = -3.0e38f, v3 = -3.0e38f; int i0 = 0, i1 = 0, i2 = 0, i3 = 0;
            for (int e = 0; e < NE; ++e) {
                float x = 0.f;
#pragma unroll
                for (int k4 = 0; k4 < 4; ++k4) x += P[((k4 * 2 + th2) * 32 + ti) * 33 + e];
                x = x * r + rb[e];
                if (x > v3) {
                    if (x > v2) { v3 = v2; i3 = i2;
                        if (x > v1) { v2 = v1; i2 = i1;
                            if (x > v0) { v1 = v0; i1 = i0; v0 = x; i0 = e; } else { v1 = x; i1 = e; } }
                        else { v2 = x; i2 = e; } }
                    else { v3 = x; i3 = e; } }
            }
            const float e1 = __expf(v1 - v0), e2 = __expf(v2 - v0), e3 = __expf(v3 - v0), inv = 1.0f / (1.0f + e1 + e2 + e3);
            const unsigned p0 = __hip_atomic_fetch_add(lcnt + i0, 1u, __ATOMIC_RELAXED, __HIP_MEMORY_SCOPE_WORKGROUP);
            const unsigned p1 = __hip_atomic_fetch_add(lcnt + i1, 1u, __ATOMIC_RELAXED, __HIP_MEMORY_SCOPE_WORKGROUP);
            const unsigned p2 = __hip_atomic_fetch_add(lcnt + i2, 1u, __ATOMIC_RELAXED, __HIP_MEMORY_SCOPE_WORKGROUP);
            const unsigned p3 = __hip_atomic_fetch_add(lcnt + i3, 1u, __ATOMIC_RELAXED, __HIP_MEMORY_SCOPE_WORKGROUP);
            le[tl * 4 + 0] = i0; le[tl * 4 + 1] = i1; le[tl * 4 + 2] = i2; le[tl * 4 + 3] = i3;
            lp[tl * 4 + 0] = (int)p0; lp[tl * 4 + 1] = (int)p1; lp[tl * 4 + 2] = (int)p2; lp[tl * 4 + 3] = (int)p3;
            *(int4*)(TKE + t * 4) = make_int4(i0, i1, i2, i3);
            *(f32x4*)(TKW + t * 4) = (f32x4){inv, e1 * inv, e2 * inv, e3 * inv};
        }
        __syncthreads();
        if (F.tid < NE) lcnt[32 + F.tid] = __hip_atomic_fetch_add(cnt + 64 * F.tid, lcnt[F.tid], RLX_AGENT);
        __syncthreads();
        if (F.tid < 256) { const int tl = F.tid >> 2, k = F.tid & 3, ee = le[tl * 4 + k], pos = lp[tl * 4 + k] + (int)lcnt[32 + ee]; TKP[(blk * 64 + tl) * 4 + k] = pos; RTE[(size_t)ee * T + pos] = blk * 64 + tl; }
#if MOE_FP8
        for (int tq = 0; tq < 8; tq += 4) {
            u32x2 xw[4][8];
#pragma unroll
            for (int u = 0; u < 4; ++u)
#pragma unroll
                for (int j = 0; j < 8; ++j) xw[u][j] = *(const u32x2*)(X2 + (size_t)(blk * 64 + F.wave * 8 + tq + u) * D + 4 * lane + 256 * j);
#pragma unroll
            for (int u = 0; u < 4; ++u) { unsigned char* o8 = (unsigned char*)H3 + (size_t)(blk * 64 + F.wave * 8 + tq + u) * D;
                f32x4 v[8]; float s2 = 0.f;
#pragma unroll
                for (int j = 0; j < 8; ++j) { v[j] = (f32x4){__uint_as_float(xw[u][j].x << 16), __uint_as_float(xw[u][j].x & 0xffff0000u), __uint_as_float(xw[u][j].y << 16), __uint_as_float(xw[u][j].y & 0xffff0000u)}; s2 += (v[j][0] * v[j][0] + v[j][1] * v[j][1]) + (v[j][2] * v[j][2] + v[j][3] * v[j][3]); }
                const float r2 = rsqrtf(wave_sum(s2) * (1.0f / D) + EPS) * H8_SCALE;
#pragma unroll
                for (int j = 0; j < 8; ++j) { const f32x4 gg = *(const f32x4*)(g + 4 * lane + 256 * j); *(unsigned*)(o8 + 4 * lane + 256 * j) = pk4_fp8(v[j][0] * r2 * gg[0], v[j][1] * r2 * gg[1], v[j][2] * r2 * gg[2], v[j][3] * r2 * gg[3]); } } }
#else
        for (int tt = 0; tt < 8; ++tt) { const int t = blk * 64 + F.wave * 8 + tt; rms_row_to_bf16(X2 + (size_t)t * D, g, H3 + (size_t)t * D, lane); }
#endif
    }
}
__device__ __forceinline__ void p_lists(Frame& F) {
    unsigned* cnt = F.ctl + CW_CNT; int* TKE = WSP(int, WS_TKE); int* TKP = WSP(int, WS_TKP); int* ROWTOK = WSP(int, WS_ROWTOK); int* TILE = WSP(int, WS_TILE);
    LAS int* poff = (LAS int*)F.lds;
    LAS int* lc = (LAS int*)(F.lds + 256);
    __syncthreads();
    if (F.tid < NE) lc[F.tid] = (int)__hip_atomic_load(cnt + 64 * F.tid, RLX_AGENT);
    __syncthreads();
    if (F.tid == 0) { int o = 0; for (int e = 0; e < NE; ++e) { poff[e] = o; o += (lc[e] + 255) / 256 * 256; } poff[NE] = o; }
    __syncthreads();
    for (int i = F.bid * NTHR + F.tid; i < T * TOPK; i += F.G * NTHR) { const int e = TKE[i], slot = poff[e] + TKP[i]; TKP[i] = slot; ROWTOK[slot] = i >> 2; }
    if (F.bid == 0) {
        for (int e = 0; e < NE; ++e) for (int s = poff[e] + lc[e] + F.tid; s < poff[e + 1]; s += NTHR) ROWTOK[s] = T;
        for (int e = 0; e < NE; ++e) for (int tl = poff[e] / 256 + F.tid; tl < poff[e + 1] / 256; tl += NTHR) TILE[tl] = e;
        if (F.tid == 0) TILE[512] = poff[NE] / 256;
    }
    __syncthreads();
}
__device__ __forceinline__ void p_combine(Frame& F) {
    const bf16* X2 = WSP(bf16, WS_X1B); const unsigned char* YS = WSP(unsigned char, WS_YS); const int* TKP = WSP(int, WS_TKP); const float* TKW = WSP(float, WS_TKW); const float* g = F.in[I_NFG];
    const int gw = F.bid * NWAVES + F.wave, NGW = F.G * NWAVES, lane = F.lane;
    moe_layout(F.lds, F.ctl + CW_CNT); const LAS int* lay = (const LAS int*)(F.lds + LAY_OFF); const int* TKE = WSP(int, WS_TKE);
    int sl[4]; float w[4];
    if (gw < T) {
#pragma unroll
        for (int k = 0; k < 4; ++k) { sl[k] = lay[TKE[gw * 4 + k]] + TKP[gw * 4 + k]; w[k] = TKW[gw * 4 + k] * (1.0f / Y8_SCALE); } }
    for (int t = gw; t < T; t += NGW) {
        int sn[4] = {0, 0, 0, 0}; float wn[4] = {0.f, 0.f, 0.f, 0.f};
        if (t + NGW < T) {
#pragma unroll
            for (int k = 0; k < 4; ++k) { sn[k] = lay[TKE[(t + NGW) * 4 + k]] + TKP[(t + NGW) * 4 + k]; wn[k] = TKW[(t + NGW) * 4 + k] * (1.0f / Y8_SCALE); } }
        f32x4 v[8]; float s = 0.f;
#pragma unroll
        for (int j = 0; j < 8; ++j) { { const u32x2 xw = *(const u32x2*)(X2 + (size_t)t * D + 4 * lane + 256 * j); v[j] = (f32x4){__uint_as_float(xw.x << 16), __uint_as_float(xw.x & 0xffff0000u), __uint_as_float(xw.y << 16), __uint_as_float(xw.y & 0xffff0000u)}; }
#pragma unroll
            for (int k = 0; k < 4; ++k) { const int y = __builtin_nontemporal_load((const int*)(YS + (size_t)sl[k] * D + 4 * lane + 256 * j)); const f32x2 y01 = __builtin_amdgcn_cvt_pk_f32_fp8(y, false), y23 = __builtin_amdgcn_cvt_pk_f32_fp8(y, true);
                v[j][0] += w[k] * y01[0]; v[j][1] += w[k] * y01[1]; v[j][2] += w[k] * y23[0]; v[j][3] += w[k] * y23[1]; }
            s += (v[j][0] * v[j][0] + v[j][1] * v[j][1]) + (v[j][2] * v[j][2] + v[j][3] * v[j][3]); }
        const float r = rsqrtf(wave_sum(s) * (1.0f / D) + EPS);
#pragma unroll
        for (int j = 0; j < 8; ++j) { const f32x4 gg = *(const f32x4*)(g + 4 * lane + 256 * j); __builtin_nontemporal_store(v[j] * r * gg, (f32x4*)(F.out + (size_t)t * D + 4 * lane + 256 * j)); }
#pragma unroll
        for (int k = 0; k < 4; ++k) { sl[k] = sn[k]; w[k] = wn[k]; }
    }
}

constexpr int NPHASE = 16;
__global__ void __launch_bounds__(NTHR, 2) hybrid_fwd(Args args) {
    extern __shared__ __attribute__((aligned(16))) unsigned char lds_raw[];
    Frame F;
    F.lds = (LAS unsigned char*)lds_raw; F.ws = args.ws; F.ctl = (unsigned*)(args.ws + WS_CTL);
    F.tid = threadIdx.x; F.lane = F.tid & 63; F.wave = __builtin_amdgcn_readfirstlane(F.tid >> 6); F.G = gridDim.x; F.bid = blockIdx.x;
    F.in = args.in; F.out = args.out;
    volatile LAS unsigned* MISC = (volatile LAS unsigned*)(F.lds + MISC_OFF);
    if (F.tid < 32) MISC[F.tid] = 0u;
    __syncthreads();
#if MK_ONE_LAUNCH
    XcdBarrier bar = xcd_barrier_post(F.ctl + CW_BAR, MISC + 8);
#define GRID_BAR() xcd_barrier(bar)
#else
#define GRID_BAR() do {} while (0)
#endif
    const int lo = args.ph_lo, hi = args.ph_hi;
#ifndef ONLY_PHASE
#define ONLY_PHASE -1
#endif
#define IN(k) (lo <= (k) && (k) < hi && (ONLY_PHASE < 0 || ONLY_PHASE == (k)))
#define SEAM(k) do { if (IN(k) && IN((k) + 1)) GRID_BAR(); } while (0)

#ifndef DUP_PHASE
#define DUP_PHASE -1
#endif
#ifndef DUP_NOEPI
#define DUP_NOEPI 0
#endif
    bool do_epi = true, do_epi_flag = true;
#define PHASE(k, ...) do { if (IN(k)) { __VA_ARGS__ if (DUP_PHASE == (k)) { GRID_BAR(); do_epi = (DUP_NOEPI == 1) ? (args.probe != 0) : true; do_epi_flag = false; __VA_ARGS__ do_epi = true; do_epi_flag = true; } } SEAM(k); } while (0)
    constexpr int MAIN_ROUNDS = 4;
    const bool split = (F.G == 256);
    const int sgrp = F.bid >> 3;
    const bool conv_role = !split || (sgrp & 3) == 0;
    PHASE(0, p0_prologue(F, 0, F.bid, F.G););
    PHASE(12,
        if (conv_role) { p0_prologue(F, 1, split ? ((sgrp >> 2) * 8 + (F.bid & 7)) : F.bid, split ? 64 : F.G); }
        else { const int j = (sgrp - (sgrp >> 2) - 1) * 8 + (F.bid & 7);
          DenseSched S; S.init(WSP(bf16, WS_XN), WSP(bf16, WS_WIN), T, NIN, D, 192, MAIN_ROUNDS * 256 + j);
          EpiInProj E{WSP(bf16, WS_Q), WSP(bf16, WS_K), WSP(bf16, WS_V), WSP(bf16, WS_SR), WSP(bf16, WS_CB), WSP(bf16, WS_U), WSP(bf16, WS_SGA), WSP(bf16, WS_SGB)};
          gemm_any(F.lds, S, E, do_epi); });
    PHASE(1,
        { DenseSched S; S.init(WSP(bf16, WS_XN), WSP(bf16, WS_WIN), T, NIN, D, F.G, F.bid, 0, split ? MAIN_ROUNDS : (1 << 30));
          EpiInProj E{WSP(bf16, WS_Q), WSP(bf16, WS_K), WSP(bf16, WS_V), WSP(bf16, WS_SR), WSP(bf16, WS_CB), WSP(bf16, WS_U), WSP(bf16, WS_SGA), WSP(bf16, WS_SGB)};
          gemm_any(F.lds, S, E, do_epi); }
        p_alow(F););
    PHASE(2, p_memkv(F); p_conv(F); p_glaprep(F););
#if OPT_GLA
    PHASE(3, p_gla_a(F););
    PHASE(4, p_gla_b(F););
    PHASE(5, p_gla_c(F););
#else
    PHASE(3, p_gla_ref(F););
    PHASE(4, ;);
    PHASE(5, p_gla_norm_ref(F););
#endif
    PHASE(6,
        { DenseSched S; S.init(WSP(bf16, WS_OA), WSP(bf16, WS_WGO), T, D, D, F.G, F.bid); EpiGateA E{WSP(bf16, WS_T1), WSP(bf16, WS_SGA)}; gemm_any(F.lds, S, E, do_epi); }
        VM_WAIT(); __syncthreads();
        { DenseSched S; S.init(WSP(bf16, WS_Z), WSP(bf16, WS_WCO), T, D, D, F.G, F.bid); EpiGateB E{WSP(bf16, WS_T1), WSP(bf16, WS_SGB), WSP(bf16, WS_MG)}; gemm_any(F.lds, S, E, do_epi); });
    PHASE(7, { DenseSched S; S.init(WSP(bf16, WS_MG), WSP(bf16, WS_WMX), T, D, D, F.G, F.bid); EpiResid1 E{F.in[I_X], WSP(bf16, WS_X1B), WSP(float, WS_SSP)}; gemm_any(F.lds, S, E, do_epi); });
    PHASE(8, { DenseSched S; S.init(WSP(bf16, WS_X1B), WSP(bf16, WS_WXQ), T, 2 * XA, D, F.G, F.bid); S.ks = 1; EpiXQ E{WSP(bf16, WS_QX), WSP(float, WS_SSP)}; gemm_any(F.lds, S, E, do_epi); });
#if OPT_ATT
    PHASE(9, p_attn(F););
#else
    PHASE(9, p_attn_ref(F););
#endif
    PHASE(10, { DenseSched S; S.init(WSP(bf16, WS_OX), WSP(bf16, WS_WXO), T, D, XA, F.G, F.bid); EpiResid2 E{WSP(bf16, WS_X1B)}; gemm_any(F.lds, S, E, do_epi); });
    PHASE(11, p_router(F););
#if MOE_FP8
    PHASE(13, { moe_layout(F.lds, F.ctl + CW_CNT); const LAS int* lay = (const LAS int*)(F.lds + LAY_OFF); const int ntiles = __builtin_amdgcn_readfirstlane(lay[NE]) / 256;
        GroupSched S; S.init(WSP(unsigned char, WS_H3), WSP(unsigned char, WS_WGU), ntiles, 2 * FF, D, F.G, F.bid, lay, WSP(int, WS_RTE), 1); EpiGU8 E{WSP(unsigned char, WS_ACT), F.in[I_GUB]};
        gemm_any<EpiGU8, GroupSched, true>(F.lds, S, E, do_epi); });
    PHASE(14, { moe_layout(F.lds, F.ctl + CW_CNT); const LAS int* lay = (const LAS int*)(F.lds + LAY_OFF); const int ntiles = __builtin_amdgcn_readfirstlane(lay[NE]) / 256;
        GroupSched S; S.init(WSP(unsigned char, WS_ACT), WSP(unsigned char, WS_WDN), ntiles, D, FF, F.G, F.bid, lay, nullptr, 1); EpiDown8 E{WSP(unsigned char, WS_YS), F.in[I_DNB]};
        gemm_any<EpiDown8, GroupSched, true>(F.lds, S, E, do_epi); });
#endif
    PHASE(15, p_combine(F););
#undef PHASE
#undef IN
#undef SEAM
}

extern "C" void kernel_launch(void* const* d_in, const int* in_sizes, int n_in, void* d_out, int out_size, void* d_ws, size_t ws_size, hipStream_t stream) {
    static int grid = 0;
    if (grid == 0) {
        if (n_in != 26 || out_size != T * D || ws_size < WS_END) { fprintf(stderr, "kernel_launch: unexpected problem (n_in %d, out %d, ws %zu < %zu)\n", n_in, out_size, ws_size, (size_t)WS_END); grid = -1; return; }
        int dev = 0, cus = 0, per_cu = 0;
        if (hipGetDevice(&dev) != hipSuccess || hipDeviceGetAttribute(&cus, hipDeviceAttributeMultiprocessorCount, dev) != hipSuccess) { grid = -1; return; }
        if (hipFuncSetAttribute((const void*)hybrid_fwd, hipFuncAttributeMaxDynamicSharedMemorySize, LDS_BYTES) != hipSuccess) { fprintf(stderr, "kernel_launch: hipFuncSetAttribute failed\n"); grid = -1; return; }
        if (hipOccupancyMaxActiveBlocksPerMultiprocessor(&per_cu, (const void*)hybrid_fwd, NTHR, LDS_BYTES) != hipSuccess || per_cu < 1) fprintf(stderr, "kernel_launch: occupancy query says %d\n", per_cu);
        (void)hipGetLastError();
        grid = cus;
    }
    if (grid < 0) return;
    (void)hipMemsetAsync((char*)d_ws + WS_CTL, 0, CTL_ZERO_BYTES, stream);
    Args a{};
    for (int i = 0; i < 26; ++i) a.in[i] = (const float*)d_in[i];
    a.out = (float*)d_out; a.ws = (unsigned char*)d_ws;
#if MK_ONE_LAUNCH
    a.ph_lo = 0; a.ph_hi = NPHASE;
    hipLaunchKernelGGL(hybrid_fwd, dim3(grid), dim3(NTHR), LDS_BYTES, stream, a);
#else
    for (int p = 0; p < NPHASE; ++p) { a.ph_lo = p; a.ph_hi = p + 1; hipLaunchKernelGGL(hybrid_fwd, dim3(grid), dim3(NTHR), LDS_BYTES, stream, a); }
#endif
}
```

```cpp
#include <hip/hip_runtime.h>
#include <cstdio>
#include <cstdint>

#ifndef MK_ONE_LAUNCH
#define MK_ONE_LAUNCH 1
#endif
#ifndef OPT_GEMM
#define OPT_GEMM 1
#endif
#ifndef OPT_GLA
#define OPT_GLA 1
#endif
#ifndef MOE_FP8
#define MOE_FP8 1
#endif
#ifndef OPT_ATT
#define OPT_ATT 1
#endif

#define GAS __attribute__((address_space(1)))
#define LAS __attribute__((address_space(3)))
typedef unsigned short bf16;
typedef short bf16x8 __attribute__((ext_vector_type(8)));
typedef short bf16x4 __attribute__((ext_vector_type(4)));
typedef float f32x4 __attribute__((ext_vector_type(4)));
typedef float f32x2 __attribute__((ext_vector_type(2)));
typedef unsigned u32x4 __attribute__((ext_vector_type(4)));
typedef unsigned u32x2 __attribute__((ext_vector_type(2)));
#define RLX_AGENT __ATOMIC_RELAXED, __HIP_MEMORY_SCOPE_AGENT
#define LDS_WAIT() asm volatile("s_waitcnt lgkmcnt(0)" ::: "memory")
#define VM_WAIT() asm volatile("s_waitcnt vmcnt(0)" ::: "memory")

constexpr int T = 16384, D = 2048, MEM = 256;
constexpr int GH = 4, DK = 256, DV = 512, QK = GH * DK  , VD = GH * DV  ;
constexpr int CH = 64, NCH = T / CH  , NG = 16, GC = NCH / NG  , GT = GC * CH  ;
constexpr int XH = 4, XD = 128, XA = XH * XD  ;
constexpr int NE = 32, TOPK = 4, FF = 2048;
constexpr int NIN_SRC = 16400, NIN = 16384;
constexpr float EPS = 1e-5f;
constexpr int PROWS = T * TOPK + NE * 256;
constexpr int MAXTILES = PROWS / 256;

constexpr int SRC_ALOW = 6144, SRC_CB = 6160, SRC_CC = 8208, SRC_CHH = 10256, SRC_GA = 12304, SRC_GB = 14352;
constexpr int TN_Q = 0, TN_K = 4, TN_V = 8, TN_R = 16, TN_CB = 24, TN_U = 32, TN_GA = 48, TN_GB = 56, TN_END = 64;

constexpr size_t MiB = 1u << 20;
constexpr size_t WS_CTL = 0, CTL_ZERO_BYTES = 1 * MiB;
constexpr size_t WS_WIN = 1 * MiB;
constexpr size_t WS_WGO = WS_WIN + 68 * MiB;
constexpr size_t WS_WCO = WS_WGO + 8 * MiB;
constexpr size_t WS_WMX = WS_WCO + 8 * MiB;
constexpr size_t WS_WXQ = WS_WMX + 8 * MiB;
constexpr size_t WS_WXKV = WS_WXQ + 2 * MiB;
constexpr size_t WS_WXO = WS_WXKV + 4 * MiB;
constexpr size_t WS_WR = WS_WXO + 2 * MiB;
constexpr size_t WS_WGU = WS_WR + 1 * MiB;
constexpr size_t WS_WDN = WS_WGU + 512 * MiB;
constexpr size_t WS_XN = WS_WDN + 256 * MiB;
constexpr size_t WS_Q = WS_XN + 64 * MiB;
constexpr size_t WS_K = WS_Q + 32 * MiB;
constexpr size_t WS_V = WS_K + 32 * MiB;
constexpr size_t WS_SR = WS_V + 64 * MiB;
constexpr size_t WS_LA = WS_SR + 64 * MiB;
constexpr size_t WS_CB = WS_LA + 64 * MiB;
constexpr size_t WS_U = WS_CB + 64 * MiB;
constexpr size_t WS_SGA = WS_U + 64 * MiB;
constexpr size_t WS_SGB = WS_SGA + 64 * MiB;
constexpr size_t WS_QT = WS_SGB + 64 * MiB;
constexpr size_t WS_KH = WS_QT + 32 * MiB;
constexpr size_t WS_KHT = WS_KH + 32 * MiB;
constexpr size_t WS_QG = WS_KHT + 32 * MiB;
constexpr size_t WS_VT = WS_QG + 32 * MiB;
constexpr size_t WS_DL = WS_VT + 64 * MiB;
constexpr size_t WS_DG = WS_DL + 1 * MiB;
constexpr size_t WS_Z = WS_DG + 1 * MiB;
constexpr size_t WS_OL = WS_Z + 64 * MiB;
constexpr size_t WS_SLOC = WS_OL + 64 * MiB;
constexpr size_t WS_SG0 = WS_SLOC + 32 * MiB;
constexpr size_t WS_O32 = WS_SG0 + 16 * MiB;
constexpr size_t WS_OA = WS_O32 + 128 * MiB;
constexpr size_t WS_T1 = WS_OA + 64 * MiB;
constexpr size_t WS_MG = WS_T1 + 128 * MiB;
constexpr size_t WS_X1 = WS_MG + 64 * MiB;
constexpr size_t WS_X1B = WS_X1 + 128 * MiB;
constexpr size_t WS_QX = WS_X1B + 64 * MiB;
constexpr size_t WS_OX = WS_QX + 16 * MiB;
constexpr size_t WS_MEMN = WS_OX + 16 * MiB;
constexpr size_t WS_KM = WS_MEMN + 1 * MiB;
constexpr size_t WS_VMT = WS_KM + 1 * MiB;
constexpr size_t WS_H3 = WS_VMT + 1 * MiB;
constexpr size_t WS_TKE = WS_H3 + 65 * MiB;
constexpr size_t WS_TKP = WS_TKE + 1 * MiB;
constexpr size_t WS_TKW = WS_TKP + 1 * MiB;
constexpr size_t WS_ROWTOK = WS_TKW + 1 * MiB;
constexpr size_t WS_TILE = WS_ROWTOK + 1 * MiB;
constexpr size_t WS_SSP = WS_TILE + 1 * MiB;
constexpr size_t WS_WAL = WS_SSP + 8 * MiB;
constexpr size_t WS_ALOW = WS_WAL + 1 * MiB;
constexpr size_t WS_WGW = WS_ALOW + 1 * MiB;
constexpr size_t WS_RTE = WS_WGW + 1 * MiB;
constexpr size_t WS_ACT = WS_RTE + 2 * MiB;
constexpr size_t WS_YS = WS_ACT + 288 * MiB;
constexpr size_t WS_END = WS_YS + 288 * MiB;
constexpr int CW_BAR = 4096;
constexpr int CW_CNT = 16384;
constexpr int CW_SS1 = 65536;
static_assert((CW_SS1 + T) * 4 <= (int)CTL_ZERO_BYTES, "ctl");

constexpr int NWAVES = 8, NTHR = 512;
constexpr int LDS_BYTES = 147456;
constexpr int MISC_OFF = 147200;

__device__ __forceinline__ float bf2f(unsigned short b) { return __uint_as_float(((unsigned)b) << 16); }
typedef __bf16 bf16x2_t __attribute__((ext_vector_type(2)));
__device__ __forceinline__ unsigned pk2(float lo, float hi) { const f32x2 v = {lo, hi}; return __builtin_bit_cast(unsigned, __builtin_convertvector(v, bf16x2_t)); }
__device__ __forceinline__ unsigned f2bf(float f) { return pk2(f, 0.f) & 0xffffu; }
__device__ __forceinline__ float wave_sum(float v) {
#pragma unroll
    for (int o = 1; o < 64; o <<= 1) v += __shfl_xor(v, o);
    return v;
}
__device__ __forceinline__ float wave_max(float v) {
#pragma unroll
    for (int o = 1; o < 64; o <<= 1) v = fmaxf(v, __shfl_xor(v, o));
    return v;
}
__device__ __forceinline__ float sigmoidf_(float x) { return __builtin_amdgcn_rcpf(1.0f + __builtin_amdgcn_exp2f(x * -1.4426950408889634f)); }
__device__ __forceinline__ float logsigmoidf_(float z) { return fminf(z, 0.f) - 0.6931471805599453f * __builtin_amdgcn_logf(1.0f + __builtin_amdgcn_exp2f(fabsf(z) * -1.4426950408889634f)); }
__device__ __forceinline__ u32x4 pack8(f32x4 a, f32x4 b) { u32x4 w; w.x = pk2(a[0], a[1]); w.y = pk2(a[2], a[3]); w.z = pk2(b[0], b[1]); w.w = pk2(b[2], b[3]); return w; }
__device__ __forceinline__ void unpack8(u32x4 w, f32x4& a, f32x4& b) {
    a[0] = __uint_as_float(w.x << 16); a[1] = __uint_as_float(w.x & 0xffff0000u); a[2] = __uint_as_float(w.y << 16); a[3] = __uint_as_float(w.y & 0xffff0000u);
    b[0] = __uint_as_float(w.z << 16); b[1] = __uint_as_float(w.z & 0xffff0000u); b[2] = __uint_as_float(w.w << 16); b[3] = __uint_as_float(w.w & 0xffff0000u);
}
__device__ __forceinline__ unsigned pk4_fp8(float a, float b, float c, float d) {
    a = fminf(fmaxf(a, -448.f), 448.f); b = fminf(fmaxf(b, -448.f), 448.f); c = fminf(fmaxf(c, -448.f), 448.f); d = fminf(fmaxf(d, -448.f), 448.f);
    int w = 0; w = __builtin_amdgcn_cvt_pk_fp8_f32(a, b, w, false); w = __builtin_amdgcn_cvt_pk_fp8_f32(c, d, w, true); return (unsigned)w; }
__device__ __forceinline__ bf16x8 as_bf8(u32x4 w) { return __builtin_bit_cast(bf16x8, w); }
#define MFMA16(A, B, C) __builtin_amdgcn_mfma_f32_16x16x32_bf16((A), (B), (C), 0, 0, 0)
__device__ __forceinline__ int ld_agent_i(const int* p) { return (int)__hip_atomic_load((const unsigned*)p, RLX_AGENT); }

#define XB_TMO      128
#define XB_XCNT(j)  (256  + 64 * (j))
#define XB_XSUB(j)  (1280 + 64 * (j))
#define XB_XGEN(j)  (2304 + 64 * (j))
#define XB_TOP      3328
#define XB_TOPGEN   3392
#define XCD_BAR_WORDS 3456
#define XB_SPIN_CAP (1u << 22)
__device__ __forceinline__ unsigned xb_ld(unsigned* p)              { return __hip_atomic_load(p, __ATOMIC_RELAXED, __HIP_MEMORY_SCOPE_AGENT); }
__device__ __forceinline__ unsigned xb_add(unsigned* p, unsigned v) { return __hip_atomic_fetch_add(p, v, __ATOMIC_RELAXED, __HIP_MEMORY_SCOPE_AGENT); }
__device__ __forceinline__ unsigned xb_xcc_id() { return (unsigned)__builtin_amdgcn_s_getreg((3 << 11) | 20) & 0xFu; }
#define XB_SPIN(cond, bar) do { unsigned _sp = 0; while (cond) { __builtin_amdgcn_s_sleep(1); \
    if ((++_sp & 255u) == 0u) { if (xb_ld(&(bar)[XB_TMO])) break; if (_sp > XB_SPIN_CAP) { atomicAdd(&(bar)[XB_TMO], 1u); break; } } } } while (0)
struct XcdBarrier { unsigned* bar; unsigned x; volatile LAS unsigned* st; };
__device__ __forceinline__ XcdBarrier xcd_barrier_post(unsigned* bar, volatile LAS unsigned* st) {
    XcdBarrier b; b.bar = bar; b.x = xb_xcc_id(); b.st = st;
    if (threadIdx.x == 0) (void)xb_add(&bar[XB_XCNT(b.x)], 1u);
    return b;
}
__device__ __forceinline__ void xcd_barrier_complete(unsigned* bar, unsigned x, unsigned& nloc, unsigned& nx) {
    const unsigned G = gridDim.x * gridDim.y * gridDim.z;
    unsigned sum, cnt, mine, sp = 0u;
    for (;;) {
        sum = 0u; cnt = 0u; mine = 0u;
#pragma unroll
        for (unsigned j = 0; j < 16; ++j) { const unsigned c = xb_ld(&bar[XB_XCNT(j)]); sum += c; cnt += (c > 0u) ? 1u : 0u; mine = (j == x) ? c : mine; }
        if (sum == G) break;
        __builtin_amdgcn_s_sleep(1);
        if ((++sp & 255u) == 0u) { if (xb_ld(&bar[XB_TMO])) break; if (sp > XB_SPIN_CAP) { atomicAdd(&bar[XB_TMO], 1u); break; } }
    }
    nloc = mine > 0u ? mine : 1u; nx = cnt > 0u ? cnt : 1u;
}
__device__ __forceinline__ void xcd_barrier(const XcdBarrier& b) {
    asm volatile("s_waitcnt vmcnt(0)" ::: "memory");
    __syncthreads();
    if (threadIdx.x == 0) {
        unsigned* bar = b.bar;
        __builtin_amdgcn_s_waitcnt(0);
        unsigned nloc = b.st[0], nx = b.st[1];
        if (nloc == 0u) { xcd_barrier_complete(bar, b.x, nloc, nx); b.st[0] = nloc; b.st[1] = nx; }
        const unsigned old = xb_add(&bar[XB_XSUB(b.x)], 1u);
        const unsigned gen = old / nloc;
        if (old + 1u == (gen + 1u) * nloc) {
            __builtin_amdgcn_fence(__ATOMIC_RELEASE, "agent");
            asm volatile("s_waitcnt vmcnt(0)" ::: "memory");
            const unsigned og = xb_add(&bar[XB_TOP], 1u);
            const unsigned tg = og / nx;
            if (og + 1u == (tg + 1u) * nx) xb_add(&bar[XB_TOPGEN], 1u);
            else XB_SPIN(xb_ld(&bar[XB_TOPGEN]) == tg, bar);
            __builtin_amdgcn_fence(__ATOMIC_ACQUIRE, "agent");
            xb_add(&bar[XB_XGEN(b.x)], 1u);
            asm volatile("s_waitcnt vmcnt(0)" ::: "memory");
        } else {
            XB_SPIN(xb_ld(&bar[XB_XGEN(b.x)]) == gen, bar);
            __builtin_amdgcn_fence(__ATOMIC_ACQUIRE, "agent");
            asm volatile("s_waitcnt vmcnt(0)" ::: "memory");
        }
    }
    __syncthreads();
}

struct Args { const float* in[26]; float* out; unsigned char* ws; int ph_lo, ph_hi, probe, pad; };
struct Frame {
    LAS unsigned char* lds; unsigned char* ws; unsigned* ctl;
    int tid, lane, wave, G, bid;
    const float* const* in;
    float* out;
};
#define WSP(type, off) ((type*)(F.ws + (off)))
enum { I_X = 0, I_MEM, I_NMIXG, I_WIN, I_GGW, I_GGB, I_GNG, I_GOW, I_CW, I_CBIAS, I_COW, I_MXW, I_NXG, I_NMG, I_XQ, I_XK, I_XV, I_XO, I_NMOEG, I_RW, I_RB, I_GUW, I_GUB, I_DNW, I_DNB, I_NFG };

constexpr int BM = 256, BK = 64, HALF = 128, HTB = HALF * BK * 2, NXCD = 8, WGM = 4;
__device__ __forceinline__ int lds_byte(int r, int c) { const int st = (r >> 4) * 2 + (c >> 5), rr = r & 15, cc = c & 31, ob = rr * 64 + cc * 2; return st * 1024 + (ob ^ (((ob >> 9) & 1) << 5)); }
__device__ __forceinline__ void stage_rc(int b, int& R, int& C) { const int st = b / 1024, sb = b % 1024, swz = sb ^ (((sb >> 9) & 1) << 5); R = (st >> 1) * 16 + swz / 64; C = (st & 1) * 32 + (swz % 64) / 2; }
__device__ __forceinline__ int g8(int rr) { return ((rr >> 3) & 1) * 4 + ((rr >> 1) & 1); }
__device__ __forceinline__ int lds_byte8(int r, int c) { return (r >> 4) * 2048 + (r & 15) * 128 + ((c ^ g8(r & 15)) << 4); }
__device__ __forceinline__ void stage_rc8(int b, int& R, int& C) { const int s = b >> 4, rr = (s >> 3) & 15; R = (s >> 7) * 16 + rr; C = 8 * ((s & 7) ^ g8(rr)); }
__device__ __forceinline__ int perm32(int rho) { const int n = rho >> 4, i = rho & 15; return 8 * (i >> 2) + 4 * n + (i & 3); }

struct Unit { int pm, pn, e; };
__device__ __forceinline__ bool static_next(int i, int G, int c, int nM, int nN, Unit& u) {
    const int nwg = nM * nN; const long L = (long)i * G + c; if (L >= nwg) return false;
    int wgid = (int)L; { const int q = nwg / NXCD, r = nwg % NXCD, xcd = wgid % NXCD, off = wgid / NXCD; wgid = (xcd < r ? xcd * (q + 1) : r * (q + 1) + (xcd - r) * q) + off; }
    const int nig = WGM * nN, gid = wgid / nig, fm = gid * WGM, gsz = (nM - fm) < WGM ? (nM - fm) : WGM;
    u.pm = fm + ((wgid % nig) % gsz); u.pn = (wgid % nig) / gsz; u.e = 0; return true;
}
struct DenseSched {
    const char* A; const char* Bt; int K, nM, nN, G, c, i0, ni, pair;
    __device__ __forceinline__ void init(const void* A_, const void* Bt_, int M, int N, int K_, int G_, int c_, int i0_ = 0, int ni_ = 1 << 30, int pair_ = 0) { A = (const char*)A_; Bt = (const char*)Bt_; K = K_; nM = M / BM; nN = N / BM; G = G_; c = c_; i0 = i0_; ni = ni_; pair = pair_; }
    __device__ __forceinline__ bool next(int i, Unit& u) const { if (pair) { if (i >= 2 * ni) return false; return static_next(i0 + (i >> 1), G, c - (i & 1) * pair, nM, nN, u); } if (i >= ni) return false; if (!static_next(i0 + i, G, c, nM, nN, u)) return false; if (ks) { u.e = u.pn / (nN >> 1); u.pn -= u.e * (nN >> 1); } return true; }
    int ks = 0;
    __device__ __forceinline__ const char* a_base() const { return A; }
    __device__ __forceinline__ size_t a_off(const Unit& u) const { return ks ? (size_t)u.e * K : 0; }
    __device__ __forceinline__ const char* b_base(const Unit& u) const { return Bt + (size_t)u.pn * BM * K * 2 + (ks ? (size_t)u.e * K : 0); }
    __device__ __forceinline__ unsigned a_src_row(const Unit& u, int r) const { return (unsigned)(u.pm * BM + r); }
    __device__ __forceinline__ int koff(const Unit& u, int nt) const { return 0; }
    __device__ __forceinline__ int nkt(int bk) const { return (ks ? K / 2 : K) / bk; }
};
constexpr int LAY_OFF = 131072, LAY_CNT = 64, LAY_TILE = 128;
__device__ __forceinline__ void moe_layout(LAS unsigned char* lds, const unsigned* cnt) {
    LAS int* lay = (LAS int*)(lds + LAY_OFF);
    __syncthreads();
    if (threadIdx.x < NE) lay[LAY_CNT + threadIdx.x] = (int)__hip_atomic_load(cnt + 64 * threadIdx.x, RLX_AGENT);
    __syncthreads();
    if (threadIdx.x == 0) { int o = 0; for (int e = 0; e < NE; ++e) { lay[e] = o; o += (lay[LAY_CNT + e] + 255) / 256 * 256; } lay[NE] = o; }
    __syncthreads();
    for (int tl = threadIdx.x; tl < lay[NE] / 256; tl += NTHR) { int e = 0; for (int q = 1; q < NE; ++q) e = (tl * 256 >= lay[q]) ? q : e; lay[LAY_TILE + tl] = e; }
    __syncthreads();
}
struct GroupSched {
    const char* A; const char* Bt; int K, N, nM, nN, G, c, eb; const LAS int* lay; const int* rte;
    __device__ __forceinline__ void init(const void* A_, const void* Bt_, int ntiles, int N_, int K_, int G_, int c_, const LAS int* lay_, const int* rte_, int eb_ = 2) { A = (const char*)A_; Bt = (const char*)Bt_; eb = eb_; K = K_; N = N_; nM = ntiles; nN = N_ / BM; G = G_; c = c_; lay = lay_; rte = rte_; }
    __device__ __forceinline__ bool next(int i, Unit& u) const { if (!static_next(i, G, c, nM, nN, u)) return false; u.e = __builtin_amdgcn_readfirstlane(lay[LAY_TILE + u.pm]); return true; }
    __device__ __forceinline__ const char* a_base() const { return A; }
    __device__ __forceinline__ const char* b_base(const Unit& u) const { return eb == 1 ? Bt + ((size_t)u.e * nN + (size_t)u.pn) * (size_t)(K / 128) * 32768 : Bt + ((size_t)u.e * N + (size_t)u.pn * BM) * K * eb; }
    __device__ __forceinline__ int koff(const Unit& u, int nt) const { return 0; }
    __device__ __forceinline__ size_t a_off(const Unit& u) const { return 0; }
    __device__ __forceinline__ int nkt(int bk) const { return K / bk; }
    __device__ __forceinline__ unsigned a_src_row(const Unit& u, int r) const { if (!rte) return (unsigned)(u.pm * BM + r); const int pos = u.pm * BM + r - lay[u.e]; return pos < lay[LAY_CNT + u.e] ? (unsigned)ld_agent_i(rte + (size_t)u.e * T + pos) : (unsigned)T; }
};

template <class Epi, class Sched>
__device__ __forceinline__ void gemm_ref(LAS unsigned char* lds, const Sched& S, const Epi& E) {
    const int tid = threadIdx.x, tx = tid & 15, ty = tid >> 4, K = S.K;
    LAS float* As = (LAS float*)lds; LAS float* Bs = As + 16 * 260;
    const int lr = tid >> 1, kh = tid & 1;
    for (int i = 0;; ++i) {
        Unit u; if (!S.next(i, u)) break;
        float acc[8][16];
#pragma unroll
        for (int j = 0; j < 8; ++j)
#pragma unroll
            for (int q = 0; q < 16; ++q) acc[j][q] = 0.f;
        const char* Ab = S.a_base() + S.a_off(u) + ((size_t)S.a_src_row(u, lr) * K + 8 * kh) * 2;
        const char* Bb = S.b_base(u) + ((size_t)lr * K + 8 * kh) * 2;
        for (int k0 = 0; k0 < 16 * S.nkt(16); k0 += 16) {
            const bf16x8 av = *(const bf16x8*)(Ab + (size_t)k0 * 2), bv = *(const bf16x8*)(Bb + (size_t)k0 * 2);
            __syncthreads();
#pragma unroll
            for (int j = 0; j < 8; ++j) { As[(8 * kh + j) * 260 + lr] = bf2f((unsigned short)av[j]); Bs[(8 * kh + j) * 260 + lr] = bf2f((unsigned short)bv[j]); }
            __syncthreads();
#pragma unroll 4
            for (int kk = 0; kk < 16; ++kk) {
                float a[8], b[16];
#pragma unroll
                for (int j = 0; j < 8; ++j) a[j] = As[kk * 260 + ty + 32 * j];
                const f32x4 b0 = *(const LAS f32x4*)(Bs + kk * 260 + 8 * tx), b1 = *(const LAS f32x4*)(Bs + kk * 260 + 8 * tx + 4);
                const f32x4 b2 = *(const LAS f32x4*)(Bs + kk * 260 + 128 + 8 * tx), b3 = *(const LAS f32x4*)(Bs + kk * 260 + 128 + 8 * tx + 4);
#pragma unroll
                for (int q = 0; q < 4; ++q) { b[q] = b0[q]; b[4 + q] = b1[q]; b[8 + q] = b2[q]; b[12 + q] = b3[q]; }
#pragma unroll
                for (int j = 0; j < 8; ++j)
#pragma unroll
                    for (int q = 0; q < 16; ++q) acc[j][q] += a[j] * b[q];
            }
        }
#pragma unroll 8
        for (int j = 0; j < 8; ++j) {
            const f32x4 a0 = {acc[j][0], acc[j][1], acc[j][2], acc[j][3]}, a1 = {acc[j][4], acc[j][5], acc[j][6], acc[j][7]};
            const f32x4 b0 = {acc[j][8], acc[j][9], acc[j][10], acc[j][11]}, b1 = {acc[j][12], acc[j][13], acc[j][14], acc[j][15]};
            typename Epi::Ctx cx; E.load(u.pm * BM + ty + 32 * j, u, 8 * tx, cx); E.template fin<false>(u.pm * BM + ty + 32 * j, u, 8 * tx, cx, a0, a1, b0, b1);
        }
    }
    __syncthreads();
}

__device__ __forceinline__ void glds16s(const void* sbase, unsigned voff, unsigned lds_dst) {
    asm volatile("s_mov_b32 m0, %2\n\ts_nop 0\n\tglobal_load_lds_dwordx4 %1, %0" :: "s"(sbase), "v"(voff), "s"(lds_dst) : "memory", "m0");
}
typedef int i32x8 __attribute__((ext_vector_type(8)));
typedef int i32x4_t __attribute__((ext_vector_type(4)));
template <class Epi, class Sched, bool FP8 = false>
__device__ __forceinline__ void gemm_mfma(LAS unsigned char* lds, const Sched& S, const Epi& E, const bool do_epi = true) {
    const int tid = threadIdx.x, wid = __builtin_amdgcn_readfirstlane(tid >> 6), lane = tid & 63, wr = wid >> 2, wc = wid & 3, fr = lane & 15, fq = lane >> 4;
    const int K = S.K, nt = S.nkt(FP8 ? 128 : BK); const unsigned rowb = (unsigned)K * (FP8 ? 1u : 2u), rowbB = FP8 ? 128u : rowb;
    unsigned voffB[2];
#pragma unroll
    for (int i = 0; i < 2; ++i) { int R_, C_; if constexpr (FP8) stage_rc8(tid * 16 + i * 8192, R_, C_); else stage_rc(tid * 16 + i * 8192, R_, C_); const int Rb = (R_ & ~31) + perm32(R_ & 31); voffB[i] = (unsigned)Rb * rowbB + (unsigned)C_ * 2u; }
    const size_t kstep = (size_t)(BK * 2);
    const size_t kstepB = FP8 ? (size_t)32768 : kstep, hstep = (size_t)HALF * rowbB;
    const unsigned ldsw = (unsigned)wid * 1024u, lds0 = (unsigned)(uintptr_t)lds;
    const int aoff = FP8 ? lds_byte8(wr * 64 + fr, 2 * fq) : lds_byte(wr * 64 + fr, fq * 8), boff = FP8 ? lds_byte8(wc * 32 + fr, 2 * fq) : lds_byte(wc * 32 + fr, fq * 8);
    const int aoff1 = FP8 ? lds_byte8(wr * 64 + fr, 2 * fq + 1) : 0, boff1 = FP8 ? lds_byte8(wc * 32 + fr, 2 * fq + 1) : 0;

#define PG8_SA(b, h) (((b) * 2 + (h)) * HTB)
#define PG8_SB(b, h) ((4 + (b) * 2 + (h)) * HTB)
#define PG8_STAGE(bufoff, gbase, voff) do { _Pragma("unroll") for (int _i = 0; _i < 2; ++_i) \
        glds16s((const void*)(gbase), (voff)[_i], (unsigned)__builtin_amdgcn_readfirstlane((int)(lds0 + (unsigned)(bufoff) + ldsw + (unsigned)_i * 8192u))); } while (0)
#define PG8_LDA(dst, b, h) do { _Pragma("unroll") for (int m = 0; m < 4; ++m) { if constexpr (FP8) { const LAS unsigned char* _p = lds + PG8_SA(b, h) + m * 2048; \
            dst##8[m] = __builtin_shufflevector(*(const LAS i32x4_t*)(_p + aoff), *(const LAS i32x4_t*)(_p + aoff1), 0, 1, 2, 3, 4, 5, 6, 7); } \
        else { _Pragma("unroll") for (int k = 0; k < 2; ++k) dst[m][k] = *(const LAS bf16x8*)(lds + PG8_SA(b, h) + aoff + m * 2048 + k * 1024); } } } while (0)
#define PG8_LDB(dst, b, h) do { _Pragma("unroll") for (int n = 0; n < 2; ++n) { if constexpr (FP8) { const LAS unsigned char* _p = lds + PG8_SB(b, h) + n * 2048; \
            dst##8[n] = __builtin_shufflevector(*(const LAS i32x4_t*)(_p + boff), *(const LAS i32x4_t*)(_p + boff1), 0, 1, 2, 3, 4, 5, 6, 7); } \
        else { _Pragma("unroll") for (int k = 0; k < 2; ++k) dst[n][k] = *(const LAS bf16x8*)(lds + PG8_SB(b, h) + boff + n * 2048 + k * 1024); } } } while (0)
#define PG8_MMA(ai, bj, At, Bt) do { __builtin_amdgcn_s_setprio(1); _Pragma("unroll") for (int m = 0; m < 4; ++m) _Pragma("unroll") for (int n = 0; n < 2; ++n) { \
        if constexpr (FP8) { asm volatile("v_mfma_f32_16x16x128_f8f6f4 %0, %1, %2, %0" : "+v"(acc[ai][bj][m][n]) : "v"(Bt##8[n]), "v"(At##8[m])); } \
        else { _Pragma("unroll") for (int k = 0; k < 2; ++k) acc[ai][bj][m][n] = __builtin_amdgcn_mfma_f32_16x16x32_bf16(Bt[n][k], At[m][k], acc[ai][bj][m][n], 0, 0, 0); } } \
        __builtin_amdgcn_s_setprio(0); } while (0)
#define PG8_WAIT_V(n) asm volatile("s_waitcnt vmcnt(" #n ")" ::: "memory")
#define PG8_WAIT_L(n) asm volatile("s_waitcnt lgkmcnt(" #n ")" ::: "memory")
#define PG8_BAR __builtin_amdgcn_s_barrier()
#define PG8_SCHED __builtin_amdgcn_sched_barrier(0)
#define PG8_AOFF(dst, uu) do { _Pragma("unroll") for (int _i = 0; _i < 2; ++_i) { int _R, _C; if constexpr (FP8) stage_rc8(tid * 16 + _i * 8192, _R, _C); else stage_rc(tid * 16 + _i * 8192, _R, _C); _Pragma("unroll") for (int _h = 0; _h < 2; ++_h) dst[_h][_i] = S.a_src_row(uu, _h * HALF + _R) * rowb + (unsigned)_C * 2u; } } while (0)
    Unit cur, nxt; int ui = 0;
    if (!S.next(0, cur)) return;
    f32x4 acc[2][2][4][2];
#pragma unroll
    for (int a = 0; a < 2; ++a)
#pragma unroll
        for (int b = 0; b < 2; ++b)
#pragma unroll
            for (int m = 0; m < 4; ++m)
#pragma unroll
                for (int n = 0; n < 2; ++n) acc[a][b][m][n] = (f32x4){0.f, 0.f, 0.f, 0.f};
    bf16x8 At[4][2], B0[2][2], B1[2][2]; i32x8 At8[4], B08[2], B18[2];
    unsigned coff[2][2], noff[2][2];
    PG8_AOFF(coff, cur);
    const char* cA = S.a_base() + S.a_off(cur); const char* cB = S.b_base(cur);
    int ck = S.koff(cur, nt), nk = 0;
    PG8_STAGE(PG8_SB(0, 0), cB + ck * kstepB, voffB); PG8_STAGE(PG8_SB(0, 1), cB + hstep + ck * kstepB, voffB); PG8_STAGE(PG8_SA(0, 0), cA + ck * kstep, coff[0]); PG8_STAGE(PG8_SA(0, 1), cA + ck * kstep, coff[1]);
    if (wr == 1) PG8_BAR;
    PG8_WAIT_V(2); PG8_BAR;
    PG8_STAGE(PG8_SB(1, 0), cB + (ck + 1) * kstepB, voffB); PG8_STAGE(PG8_SA(1, 0), cA + (ck + 1) * kstep, coff[0]); PG8_STAGE(PG8_SB(1, 1), cB + hstep + (ck + 1) * kstepB, voffB);
    PG8_WAIT_V(6); PG8_BAR;
    for (;;) {
        const bool has_next = S.next(ui + 1, nxt);
        const char* nB = cB; const char* nA = cA;
#pragma unroll
        for (int _h = 0; _h < 2; ++_h)
#pragma unroll
            for (int _i = 0; _i < 2; ++_i) noff[_h][_i] = coff[_h][_i];
        nk = ck;
        if (has_next) { nB = S.b_base(nxt); nA = S.a_base() + S.a_off(nxt); PG8_AOFF(noff, nxt); nk = S.koff(nxt, nt); }
        for (int t = 0; t < nt; t += 2) {
            const bool last = (t == nt - 2);
            const int k1 = (t + 1 + ck) & (nt - 1), k2 = last ? nk : ((t + 2 + ck) & (nt - 1));
            const char* a1 = cA + (size_t)k1 * kstep;
            const char* a2 = (last ? nA : cA) + (size_t)k2 * kstep; const char* b2 = (last ? nB : cB) + (size_t)k2 * kstepB;
            const char* a3 = a2 + kstep; const char* b3 = b2 + kstepB;
            unsigned o2[2][2];
#pragma unroll
            for (int _h = 0; _h < 2; ++_h)
#pragma unroll
                for (int _i = 0; _i < 2; ++_i) o2[_h][_i] = last ? noff[_h][_i] : coff[_h][_i];
            PG8_LDB(B0, 0, 0); PG8_LDB(B1, 0, 1); PG8_SCHED; PG8_LDA(At, 0, 0); PG8_STAGE(PG8_SA(1, 1), a1, coff[1]);
            PG8_WAIT_V(8); PG8_WAIT_L(0); PG8_BAR; PG8_MMA(0, 0, At, B0); PG8_MMA(0, 1, At, B1); PG8_BAR; PG8_SCHED;
            PG8_LDA(At, 0, 1); PG8_STAGE(PG8_SB(0, 0), b2, voffB); PG8_STAGE(PG8_SB(0, 1), b2 + hstep, voffB); PG8_STAGE(PG8_SA(0, 0), a2, o2[0]);
            PG8_WAIT_V(8); PG8_WAIT_L(0); PG8_BAR; PG8_MMA(1, 0, At, B0); PG8_MMA(1, 1, At, B1); PG8_BAR; PG8_SCHED;
            PG8_LDB(B0, 1, 0); PG8_LDB(B1, 1, 1); PG8_SCHED; PG8_LDA(At, 1, 0); PG8_STAGE(PG8_SA(0, 1), a2, o2[1]);
            PG8_WAIT_V(8); PG8_WAIT_L(0); PG8_BAR; PG8_MMA(0, 0, At, B0); PG8_MMA(0, 1, At, B1); PG8_BAR; PG8_SCHED;
            PG8_LDA(At, 1, 1); PG8_STAGE(PG8_SB(1, 0), b3, voffB); PG8_STAGE(PG8_SB(1, 1), b3 + hstep, voffB); PG8_STAGE(PG8_SA(1, 0), a3, o2[0]);
            PG8_WAIT_V(8); PG8_WAIT_L(0); PG8_BAR; PG8_MMA(1, 0, At, B0); PG8_MMA(1, 1, At, B1); PG8_BAR; PG8_SCHED;
        }
#ifndef ALIGN_EPI
#define ALIGN_EPI 1
#endif
        if (ALIGN_EPI && wr == 0) PG8_BAR;
        if constexpr (FP8) asm volatile("s_nop 15\n\ts_nop 15" ::: "memory");
        if (do_epi) {
            constexpr int NB = Epi::NB, NBUF = (NB < 8) ? 2 : 1; const int rbase = cur.pm * BM + wr * 64 + fr, c0 = wc * 32 + 8 * fq;
            typename Epi::Ctx cx[NBUF][NB];
#pragma unroll
            for (int i = 0; i < NB; ++i) E.load(rbase + (i >> 2) * HALF + (i & 3) * 16, cur, c0, cx[0][i]);
#pragma unroll
            for (int g0 = 0; g0 < 8; g0 += NB) {
                const int bsel = (NBUF == 2) ? ((g0 / NB) & 1) : 0;
                if (NBUF == 2 && g0 + NB < 8) {
#pragma unroll
                    for (int i = 0; i < NB; ++i) E.load(rbase + ((g0 + NB + i) >> 2) * HALF + ((g0 + NB + i) & 3) * 16, cur, c0, cx[bsel ^ 1][i]); }
#pragma unroll
                for (int i = 0; i < NB; ++i) { const int ai = (g0 + i) >> 2, m = (g0 + i) & 3;
                    E.template fin<true>(rbase + ai * HALF + m * 16, cur, c0, cx[bsel][i], acc[ai][0][m][0], acc[ai][0][m][1], acc[ai][1][m][0], acc[ai][1][m][1]); }
            }
        }
        if (!has_next) break;
#pragma unroll
        for (int a = 0; a < 2; ++a)
#pragma unroll
            for (int b = 0; b < 2; ++b)
#pragma unroll
                for (int m = 0; m < 4; ++m)
#pragma unroll
                    for (int n = 0; n < 2; ++n) acc[a][b][m][n] = (f32x4){0.f, 0.f, 0.f, 0.f};
        cur = nxt; cB = nB; cA = nA; ck = nk;
#pragma unroll
        for (int _h = 0; _h < 2; ++_h)
#pragma unroll
            for (int _i = 0; _i < 2; ++_i) coff[_h][_i] = noff[_h][_i];
        ++ui;
        if (ALIGN_EPI && wr == 1) PG8_BAR;
    }
    PG8_WAIT_V(0);
    if (!ALIGN_EPI && wr == 0) PG8_BAR;
    PG8_BAR;
#undef PG8_SA
#undef PG8_SB
#undef PG8_STAGE
#undef PG8_LDA
#undef PG8_LDB
#undef PG8_MMA
#undef PG8_WAIT_V
#undef PG8_WAIT_L
#undef PG8_BAR
#undef PG8_SCHED
#undef PG8_AOFF
}
#ifndef SKEW_TICKS
#define SKEW_TICKS 0
#endif
__device__ __forceinline__ void phase_skew(int bid) {
    if (SKEW_TICKS > 0 && (bid & 1)) { const unsigned long long t0 = __builtin_amdgcn_s_memrealtime(); while (__builtin_amdgcn_s_memrealtime() - t0 < (unsigned long long)SKEW_TICKS) __builtin_amdgcn_s_sleep(8); }
}
template <class Epi, class Sched, bool FP8 = false>
__device__ __forceinline__ void gemm_any(LAS unsigned char* lds, const Sched& S, const Epi& E, const bool do_epi = true) {
#if OPT_GEMM
    gemm_mfma<Epi, Sched, FP8>(lds, S, E, do_epi);
#else
    gemm_ref<Epi, Sched>(lds, S, E);
#endif
}

__device__ __forceinline__ void st_bf8(bf16* p, f32x4 a, f32x4 b) { *(u32x4*)p = pack8(a, b); }
__device__ __forceinline__ void ld_bf8(const bf16* p, f32x4& a, f32x4& b) { unpack8(*(const u32x4*)p, a, b); }
constexpr float W8_SCALE = 128.0f, H8_SCALE = 8.0f, A8_SCALE = 4.0f;

struct EpiInProj {
    static constexpr int NB = 1; struct Ctx { int dummy; };
    bf16 *Q, *Kk, *V, *SR, *CB, *U, *SGA, *SGB;
    __device__ __forceinline__ void load(int row, const Unit& u, int c0, Ctx& c) const {}
    template <bool MF> __device__ __forceinline__ void fin(int row, const Unit& u, int c0, const Ctx& c, f32x4 a0, f32x4 a1, f32x4 b0, f32x4 b1) const {
        const int pn = u.pn;
        if (pn >= TN_U && pn < TN_GA) { st_bf8(U + (size_t)row * D + (pn - TN_U) * 128 + c0, a0 * b0, a1 * b1); return; }
        bf16* base; int ld, ct, mode = 0; float sc = 1.0f;
        if (pn < TN_K) { base = Q; ld = QK; ct = pn - TN_Q; sc = 0.0625f; }
        else if (pn < TN_V) { base = Kk; ld = QK; ct = pn - TN_K; }
        else if (pn < TN_R) { base = V; ld = VD; ct = pn - TN_V; }
        else if (pn < TN_CB) { base = SR; ld = VD; ct = pn - TN_R; mode = 1; }
        else if (pn < TN_U) { base = CB; ld = D; ct = pn - TN_CB; }
        else if (pn < TN_GB) { base = SGA; ld = D; ct = pn - TN_GA; mode = 2; }
        else { base = SGB; ld = D; ct = pn - TN_GB; mode = 2; }
        if (mode) {
#pragma unroll
            for (int j = 0; j < 4; ++j) { const float s0 = sigmoidf_(a0[j]), s1 = sigmoidf_(a1[j]), s2 = sigmoidf_(b0[j]), s3 = sigmoidf_(b1[j]);
                a0[j] = (mode == 1) ? a0[j] * s0 : s0; a1[j] = (mode == 1) ? a1[j] * s1 : s1; b0[j] = (mode == 1) ? b0[j] * s2 : s2; b1[j] = (mode == 1) ? b1[j] * s3 : s3; }
        } else { a0 *= sc; a1 *= sc; b0 *= sc; b1 *= sc; }
        bf16* p = base + (size_t)row * ld + ct * 256 + c0; st_bf8(p, a0, a1); st_bf8(p + 128, b0, b1);
    }
};
struct EpiGateA {
    static constexpr int NB = 2; struct Ctx { u32x4 s0, s1; };
    bf16* T1; const bf16* SGA;
    __device__ __forceinline__ void load(int row, const Unit& u, int c0, Ctx& c) const { const size_t o = (size_t)row * D + u.pn * 256 + c0; c.s0 = *(const u32x4*)(SGA + o); c.s1 = *(const u32x4*)(SGA + o + 128); }
    template <bool MF> __device__ __forceinline__ void fin(int row, const Unit& u, int c0, const Ctx& c, f32x4 a0, f32x4 a1, f32x4 b0, f32x4 b1) const {
        const size_t o = (size_t)row * D + u.pn * 256 + c0; f32x4 g0, g1, g2, g3; unpack8(c.s0, g0, g1); unpack8(c.s1, g2, g3);
        st_bf8(T1 + o, a0 * g0, a1 * g1); st_bf8(T1 + o + 128, b0 * g2, b1 * g3);
    }
};
struct EpiGateB {
    static constexpr int NB = 2; struct Ctx { u32x4 s0, s1, t0, t1; };
    const bf16* T1; const bf16* SGB; bf16* MG;
    __device__ __forceinline__ void load(int row, const Unit& u, int c0, Ctx& c) const { const size_t o = (size_t)row * D + u.pn * 256 + c0; c.s0 = *(const u32x4*)(SGB + o); c.s1 = *(const u32x4*)(SGB + o + 128); c.t0 = *(const u32x4*)(T1 + o); c.t1 = *(const u32x4*)(T1 + o + 128); }
    template <bool MF> __device__ __forceinline__ void fin(int row, const Unit& u, int c0, const Ctx& c, f32x4 a0, f32x4 a1, f32x4 b0, f32x4 b1) const {
        const size_t o = (size_t)row * D + u.pn * 256 + c0; f32x4 g0, g1, g2, g3, t0, t1, t2, t3; unpack8(c.s0, g0, g1); unpack8(c.s1, g2, g3); unpack8(c.t0, t0, t1); unpack8(c.t1, t2, t3);
        st_bf8(MG + o, t0 + a0 * g0, t1 + a1 * g1); st_bf8(MG + o + 128, t2 + b0 * g2, t3 + b1 * g3);
    }
};
#if OPT_GEMM
constexpr int SSP_N = 32;
#else
constexpr int SSP_N = 128;
#endif
struct EpiResid1 {
    static constexpr int NB = 2; struct Ctx { f32x4 x0, x1, x2, x3; };
    const float* X; bf16* XB; float* SSP;
    __device__ __forceinline__ void load(int row, const Unit& u, int c0, Ctx& c) const { const size_t o = (size_t)row * D + u.pn * 256 + c0; c.x0 = *(const f32x4*)(X + o); c.x1 = *(const f32x4*)(X + o + 4); c.x2 = *(const f32x4*)(X + o + 128); c.x3 = *(const f32x4*)(X + o + 132); }
    template <bool MF> __device__ __forceinline__ void fin(int row, const Unit& u, int c0, const Ctx& c, f32x4 a0, f32x4 a1, f32x4 b0, f32x4 b1) const {
        const size_t o = (size_t)row * D + u.pn * 256 + c0;
        a0 += c.x0; a1 += c.x1; b0 += c.x2; b1 += c.x3;
        st_bf8(XB + o, a0, a1); st_bf8(XB + o + 128, b0, b1);
        float s = 0.f;
#pragma unroll
        for (int j = 0; j < 4; ++j) s += a0[j] * a0[j] + a1[j] * a1[j] + b0[j] * b0[j] + b1[j] * b1[j];
        if (MF) { s += __shfl_xor(s, 16); s += __shfl_xor(s, 32); if ((threadIdx.x & 63) < 16) SSP[(size_t)row * SSP_N + 4 * u.pn + (c0 >> 5)] = s; }
        else SSP[(size_t)row * SSP_N + 16 * u.pn + (c0 >> 3)] = s;
    }
};
constexpr ptrdiff_t QX_HALF = ((ptrdiff_t)WS_O32 - (ptrdiff_t)WS_QX) / 2;
struct EpiXQ {
    static constexpr int NB = 8; struct Ctx { float r; };
    bf16* QX; const float* SSP;
    __device__ __forceinline__ void load(int row, const Unit& u, int c0, Ctx& c) const {
        const float* sp = SSP + (size_t)row * SSP_N; f32x4 t = *(const f32x4*)sp;
#pragma unroll
        for (int j = 1; j < SSP_N / 4; ++j) t += *(const f32x4*)(sp + 4 * j);
        c.r = rsqrtf(((t[0] + t[1]) + (t[2] + t[3])) * (1.0f / D) + EPS);
    }
    template <bool MF> __device__ __forceinline__ void fin(int row, const Unit& u, int c0, const Ctx& c, f32x4 a0, f32x4 a1, f32x4 b0, f32x4 b1) const {
        bf16* p = QX + (ptrdiff_t)u.e * QX_HALF + (size_t)row * XA + u.pn * 256 + c0; st_bf8(p, a0 * c.r, a1 * c.r); st_bf8(p + 128, b0 * c.r, b1 * c.r);
    }
};
struct EpiResid2 {
    static constexpr int NB = 8; struct Ctx { u32x4 x0, x1; };
    bf16* XB;
    __device__ __forceinline__ void load(int row, const Unit& u, int c0, Ctx& c) const { const bf16* p = XB + (size_t)row * D + u.pn * 256 + c0; c.x0 = *(const u32x4*)p; c.x1 = *(const u32x4*)(p + 128); }
    template <bool MF> __device__ __forceinline__ void fin(int row, const Unit& u, int c0, const Ctx& c, f32x4 a0, f32x4 a1, f32x4 b0, f32x4 b1) const {
        bf16* p = XB + (size_t)row * D + u.pn * 256 + c0; f32x4 x0, x1, x2, x3; unpack8(c.x0, x0, x1); unpack8(c.x1, x2, x3);
        st_bf8(p, x0 + a0, x1 + a1); st_bf8(p + 128, x2 + b0, x3 + b1);
    }
};
struct EpiGU8 {
    static constexpr int NB = 8; struct Ctx { f32x4 g0, g1, u0, u1; };
    unsigned char* ACT8; const float* gub;
    __device__ __forceinline__ void load(int row, const Unit& u, int c0, Ctx& c) const { const float* bg = gub + (size_t)u.e * (2 * FF) + u.pn * 128 + c0; c.g0 = *(const f32x4*)bg; c.g1 = *(const f32x4*)(bg + 4); c.u0 = *(const f32x4*)(bg + FF); c.u1 = *(const f32x4*)(bg + FF + 4); }
    template <bool MF> __device__ __forceinline__ void fin(int row, const Unit& u, int c0, const Ctx& c, f32x4 a0, f32x4 a1, f32x4 b0, f32x4 b1) const {
        const int f = u.pn * 128 + c0; const float is = 1.0f / (W8_SCALE * H8_SCALE);
        f32x4 r0, r1;
        constexpr float KK = -1.702f * 1.4426950408889634f, C1 = A8_SCALE / KK; const float isk = is * KK;
#pragma unroll
        for (int j = 0; j < 4; ++j) {
            float gp = fmaxf(fmaf(a0[j], isk, c.g0[j] * KK), 7.0f * KK), up = fminf(fmaxf(fmaf(b0[j], is, c.u0[j]), -7.0f), 7.0f);
            r0[j] = fmaf(up, C1, C1) * gp * __builtin_amdgcn_rcpf(1.0f + __builtin_amdgcn_exp2f(gp));
            gp = fmaxf(fmaf(a1[j], isk, c.g1[j] * KK), 7.0f * KK); up = fminf(fmaxf(fmaf(b1[j], is, c.u1[j]), -7.0f), 7.0f);
            r1[j] = fmaf(up, C1, C1) * gp * __builtin_amdgcn_rcpf(1.0f + __builtin_amdgcn_exp2f(gp));
        }
        u32x2 o; o.x = pk4_fp8(r0[0], r0[1], r0[2], r0[3]); o.y = pk4_fp8(r1[0], r1[1], r1[2], r1[3]);
        *(u32x2*)(ACT8 + (size_t)row * FF + f) = o;
    }
};
constexpr float Y8_SCALE = 16.0f;
constexpr bool DN_PERM = (OPT_GEMM != 0);
struct EpiDown8 {
    static constexpr int NB = 8; struct Ctx { f32x4 b0, b1, b2, b3; };
    unsigned char* YS; const float* dnb;
    __device__ __forceinline__ static int col0(int c0) { return DN_PERM ? ((c0 >> 5) << 6) + (((c0 >> 3) & 3) << 4) : c0; }
    __device__ __forceinline__ void load(int row, const Unit& u, int c0, Ctx& c) const { const float* bb = dnb + (size_t)u.e * D + u.pn * 256 + col0(c0); constexpr int o2 = DN_PERM ? 8 : 128;
        c.b0 = *(const f32x4*)bb; c.b1 = *(const f32x4*)(bb + 4); c.b2 = *(const f32x4*)(bb + o2); c.b3 = *(const f32x4*)(bb + o2 + 4); }
    template <bool MF> __device__ __forceinline__ void fin(int row, const Unit& u, int c0, const Ctx& c, f32x4 a0, f32x4 a1, f32x4 b0, f32x4 b1) const {
        unsigned char* p = YS + (size_t)row * D + u.pn * 256 + col0(c0); const float is = Y8_SCALE / (W8_SCALE * A8_SCALE);
        a0 = a0 * is + c.b0 * Y8_SCALE; a1 = a1 * is + c.b1 * Y8_SCALE; b0 = b0 * is + c.b2 * Y8_SCALE; b1 = b1 * is + c.b3 * Y8_SCALE;
        if (DN_PERM) { u32x4 o; o.x = pk4_fp8(a0[0], a0[1], a0[2], a0[3]); o.y = pk4_fp8(a1[0], a1[1], a1[2], a1[3]); o.z = pk4_fp8(b0[0], b0[1], b0[2], b0[3]); o.w = pk4_fp8(b1[0], b1[1], b1[2], b1[3]); *(u32x4*)p = o; }
        else { u32x2 o; o.x = pk4_fp8(a0[0], a0[1], a0[2], a0[3]); o.y = pk4_fp8(a1[0], a1[1], a1[2], a1[3]); *(u32x2*)p = o;
            o.x = pk4_fp8(b0[0], b0[1], b0[2], b0[3]); o.y = pk4_fp8(b1[0], b1[1], b1[2], b1[3]); *(u32x2*)(p + 128) = o; }
    }
};

__device__ __forceinline__ void tr_item_fp8(const float* W, int ldw, int K, int srccol0, unsigned char* WT, int dstrow0, LAS float* scr, int kb, int lane) {
    const int k0 = 128 * kb;
#pragma unroll 8
    for (int i = 0; i < 64; ++i) { const int kk = 2 * i + (lane >> 5); scr[kk * 33 + (lane & 31)] = W[(size_t)(k0 + kk) * ldw + srccol0 + (lane & 31)] * W8_SCALE; }
    LDS_WAIT(); asm volatile("" ::: "memory");
    const int c = lane & 7;
#pragma unroll
    for (int j = 0; j < 4; ++j) { const int n = (lane >> 3) + 8 * j; const LAS float* s = scr + (16 * c) * 33 + n;
        u32x4 o; o.x = pk4_fp8(s[0 * 33], s[1 * 33], s[2 * 33], s[3 * 33]); o.y = pk4_fp8(s[4 * 33], s[5 * 33], s[6 * 33], s[7 * 33]);
        o.z = pk4_fp8(s[8 * 33], s[9 * 33], s[10 * 33], s[11 * 33]); o.w = pk4_fp8(s[12 * 33], s[13 * 33], s[14 * 33], s[15 * 33]);
        *(u32x4*)(WT + (size_t)(dstrow0 + n) * K + k0 + 16 * c) = o; }
    LDS_WAIT(); asm volatile("" ::: "memory");
}
__device__ __forceinline__ void tr_item(const float* W, int ldw, int K, int srccol0, bf16* WT, int dstrow0, const float* ksc, LAS float* scr, int kb, int lane) {
    const int k0 = 64 * kb;
    float v[32];
#pragma unroll
    for (int i = 0; i < 32; ++i) v[i] = __builtin_nontemporal_load(W + (size_t)(k0 + 2 * i + (lane >> 5)) * ldw + srccol0 + (lane & 31));
#pragma unroll
    for (int i = 0; i < 32; ++i) { const int kk = 2 * i + (lane >> 5); scr[kk * 33 + (lane & 31)] = ksc ? v[i] * ksc[k0 + kk] : v[i]; }
    LDS_WAIT(); asm volatile("" ::: "memory");
    const int c = lane & 7;
#pragma unroll
    for (int j = 0; j < 4; ++j) { const int n = (lane >> 3) + 8 * j; const LAS float* s = scr + (8 * c) * 33 + n;
        u32x4 o; o.x = pk2(s[0 * 33], s[1 * 33]); o.y = pk2(s[2 * 33], s[3 * 33]); o.z = pk2(s[4 * 33], s[5 * 33]); o.w = pk2(s[6 * 33], s[7 * 33]);
        *(u32x4*)(WT + (size_t)(dstrow0 + n) * K + k0 + 8 * c) = o; }
    LDS_WAIT(); asm volatile("" ::: "memory");
}
__device__ __forceinline__ void tr8_load(const float* W, int ldw, int srccol0, int kb32, int lane, f32x4 (&v)[8]) {
    const char* base = (const char*)(W + (size_t)(32 * kb32) * ldw + srccol0);
    const unsigned voff = (unsigned)((lane >> 4) * ldw + 4 * (lane & 15)) * 4u;
#pragma unroll
    for (int i = 0; i < 8; ++i) v[i] = __builtin_nontemporal_load((const f32x4*)(base + (size_t)(4 * i) * ldw * 4 + voff));
}
__device__ __forceinline__ void tr8_quarter(const f32x4 (&v)[8], LAS float* scr, int lane, u32x4 (&o)[2]) {
    LAS float* w = scr + (lane >> 4) * 68 + 4 * (lane & 15);
#pragma unroll
    for (int i = 0; i < 8; ++i) *(LAS f32x4*)(w + 4 * i * 68) = v[i] * W8_SCALE;
    LDS_WAIT(); asm volatile("" ::: "memory");
    const LAS float* s = scr + lane;
    o[0].x = pk4_fp8(s[0 * 68], s[1 * 68], s[2 * 68], s[3 * 68]); o[0].y = pk4_fp8(s[4 * 68], s[5 * 68], s[6 * 68], s[7 * 68]);
    o[0].z = pk4_fp8(s[8 * 68], s[9 * 68], s[10 * 68], s[11 * 68]); o[0].w = pk4_fp8(s[12 * 68], s[13 * 68], s[14 * 68], s[15 * 68]);
    o[1].x = pk4_fp8(s[16 * 68], s[17 * 68], s[18 * 68], s[19 * 68]); o[1].y = pk4_fp8(s[20 * 68], s[21 * 68], s[22 * 68], s[23 * 68]);
    o[1].z = pk4_fp8(s[24 * 68], s[25 * 68], s[26 * 68], s[27 * 68]); o[1].w = pk4_fp8(s[28 * 68], s[29 * 68], s[30 * 68], s[31 * 68]);
    LDS_WAIT(); asm volatile("" ::: "memory");
}
__device__ __forceinline__ void tr8_store(const u32x4 (&pc)[4][2], unsigned char* WT, int K, int dstrow0, int kb, LAS float* scr, int lane, const bool perm = false) {
    LAS unsigned* t = (LAS unsigned*)scr;
    LAS unsigned* wl = t + lane * 33;
#pragma unroll
    for (int q = 0; q < 4; ++q)
#pragma unroll
        for (int j = 0; j < 2; ++j) { LAS unsigned* d = wl + 8 * q + 4 * j; const u32x4 x = pc[q][j]; d[0] = x.x; d[1] = x.y; d[2] = x.z; d[3] = x.w; }
    LDS_WAIT(); asm volatile("" ::: "memory");
    const LAS unsigned* rl = t + (lane >> 3) * 33 + 4 * (lane & 7);
    unsigned char* gb = WT + ((size_t)((dstrow0 >> 8) * (K >> 7) + kb) * 256 + (dstrow0 & 255)) * 128;
    const unsigned gvo = (unsigned)((lane >> 3) * 128 + 16 * (lane & 7));
    unsigned char* tb = WT + ((size_t)((dstrow0 >> 8) * (K >> 7) + kb) * 256 + ((dstrow0 & 255) >> 6) * 32) * 128;
#pragma unroll
    for (int j = 0; j < 8; ++j) { const LAS unsigned* sdw = rl + 8 * 33 * j;
        const u32x4 x = {sdw[0], sdw[1], sdw[2], sdw[3]};
        __builtin_nontemporal_store(x, (u32x4*)((perm ? tb + ((j & 1) * 128 + (j >> 1) * 8) * 128 : gb + 1024 * j) + gvo)); }
    LDS_WAIT(); asm volatile("" ::: "memory");
}
__device__ __forceinline__ void ex8_decode(const Frame& F, int sup, const float*& W, int& ldw, int& src, unsigned char*& WT, int& K, int& dst, int& kb) {
    if (sup < NE * 1024) { const int e = sup / 1024, r = sup % 1024, nb = r % 64, p = nb >> 2, w = (nb & 3) * 64; kb = r / 64;
        W = F.in[I_GUW] + (size_t)e * D * (2 * FF); ldw = 2 * FF; src = (w < 128) ? 128 * p + w : FF + 128 * p + (w - 128); WT = WSP(unsigned char, WS_WGU) + (size_t)e * (2 * FF) * D; K = D; dst = 64 * nb; }
    else { const int s2 = sup - NE * 1024, e = s2 / 512, r = s2 % 512, nb = r % 32; kb = r / 32;
        W = F.in[I_DNW] + (size_t)e * FF * D; ldw = D; src = 64 * nb; WT = WSP(unsigned char, WS_WDN) + (size_t)e * D * FF; K = FF; dst = 64 * nb; }
}
__device__ __forceinline__ void rms_row_to_bf16(const float* xrow, const float* g, bf16* orow, int lane) {
    f32x4 v[8]; float s = 0.f;
#pragma unroll
    for (int j = 0; j < 8; ++j) { v[j] = *(const f32x4*)(xrow + 4 * lane + 256 * j); s += (v[j][0] * v[j][0] + v[j][1] * v[j][1]) + (v[j][2] * v[j][2] + v[j][3] * v[j][3]); }
    const float r = rsqrtf(wave_sum(s) * (1.0f / D) + EPS);
#pragma unroll
    for (int j = 0; j < 8; ++j) { const f32x4 gg = *(const f32x4*)(g + 4 * lane + 256 * j); u32x2 o; o.x = pk2(v[j][0] * r * gg[0], v[j][1] * r * gg[1]); o.y = pk2(v[j][2] * r * gg[2], v[j][3] * r * gg[3]); *(u32x2*)(orow + 4 * lane + 256 * j) = o; }
}
__device__ __forceinline__ void p0_prologue(Frame& F, const int part, const int cb, const int CNG) {
    LAS float* scr = (LAS float*)(F.lds + F.wave * 16896);
    const int gw = cb * NWAVES + F.wave, NGW = CNG * NWAVES, lane = F.lane, gt = cb * NTHR + F.tid, NGT = CNG * NTHR;
    const float* Win = F.in[I_WIN];
    bf16* WIN = WSP(bf16, WS_WIN);
    if (part == 0) {
    for (int it = gw; it < 512 * 32; it += NGW) {
        const int nb = it % 512, kb = it / 512, n0 = 32 * nb;
        int src;
        if (n0 < TN_CB * 256) src = n0;
        else if (n0 < TN_U * 256) src = SRC_CB + (n0 - TN_CB * 256);
        else if (n0 < TN_GA * 256) { const int rel = n0 - TN_U * 256, p = rel >> 8, w = rel & 255; src = (w < 128) ? SRC_CC + 128 * p + w : SRC_CHH + 128 * p + (w - 128); }
        else if (n0 < TN_GB * 256) src = SRC_GA + (n0 - TN_GA * 256);
        else src = SRC_GB + (n0 - TN_GB * 256);
        tr_item(Win, NIN_SRC, D, src, WIN, n0, nullptr, scr, kb, lane);
    }
    for (int it = gw; it < 32; it += NGW) tr_item(Win, NIN_SRC, D, SRC_ALOW, WSP(bf16, WS_WAL), 0, nullptr, scr, it, lane);
    { const float* GW = F.in[I_GGW]; bf16* WGW = WSP(bf16, WS_WGW); for (int i = gt; i < QK * 32; i += NGT) { const int n = i >> 5, k = i & 31; WGW[i] = (k < 16) ? (bf16)f2bf(GW[k * QK + n]) : (bf16)0; } }
    }
    if (part == 0) {
    for (int it = gw; it < 3 * 2048; it += NGW) { const int w = it / 2048, r = it % 2048, nb = r % 64, kb = r / 64;
        const float* W = F.in[w == 0 ? I_GOW : (w == 1 ? I_COW : I_MXW)]; bf16* WT = WSP(bf16, w == 0 ? WS_WGO : (w == 1 ? WS_WCO : WS_WMX));
        tr_item(W, D, D, 32 * nb, WT, 32 * nb, nullptr, scr, kb, lane); }
    for (int it = gw; it < 3 * 512; it += NGW) { const int w = it / 512, r = it % 512, nb = r % 16, kb = r / 16;
        if (w == 0) tr_item(F.in[I_XQ], XA, D, 32 * nb, WSP(bf16, WS_WXQ), 32 * nb, F.in[I_NXG], scr, kb, lane);
        else tr_item(F.in[w == 1 ? I_XK : I_XV], XA, D, 32 * nb, WSP(bf16, WS_WXKV), (w - 1) * XA + 32 * nb, nullptr, scr, kb, lane); }
    for (int it = gw; it < 512; it += NGW) { const int nb = it % 64, kb = it / 64; tr_item(F.in[I_XO], D, XA, 32 * nb, WSP(bf16, WS_WXO), 32 * nb, nullptr, scr, kb, lane); }
    }
    if (part == 1) {
#if MOE_FP8
    { LAS float* scr8 = (LAS float*)(F.lds + F.wave * 16896);
      constexpr int NSUP = NE * 1024 + NE * 512;
      f32x4 va[8], vb[8]; u32x4 pc[4][2];
      const float* W; int ldw, src, K, dst, kb; unsigned char* WT;
      if (gw < NSUP) { ex8_decode(F, gw, W, ldw, src, WT, K, dst, kb); tr8_load(W, ldw, src, 4 * kb + 0, lane, va); }
      for (int sup = gw; sup < NSUP; sup += NGW) {
          tr8_load(W, ldw, src, 4 * kb + 1, lane, vb); tr8_quarter(va, scr8, lane, pc[0]);
          tr8_load(W, ldw, src, 4 * kb + 2, lane, va); tr8_quarter(vb, scr8, lane, pc[1]);
          tr8_load(W, ldw, src, 4 * kb + 3, lane, vb); tr8_quarter(va, scr8, lane, pc[2]);
          const float* W1 = W; int ldw1 = ldw, src1 = src, K1 = K, dst1 = dst, kb1 = kb; unsigned char* WT1 = WT;
          if (sup + NGW < NSUP) { ex8_decode(F, sup + NGW, W1, ldw1, src1, WT1, K1, dst1, kb1); tr8_load(W1, ldw1, src1, 4 * kb1 + 0, lane, va); }
          tr8_quarter(vb, scr8, lane, pc[3]);
          tr8_store(pc, WT, K, dst, kb, scr8, lane, DN_PERM && sup >= NE * 1024);
          W = W1; ldw = ldw1; src = src1; K = K1; dst = dst1; kb = kb1; WT = WT1;
      } }
#endif
    { const float* rw = F.in[I_RW]; const float* g = F.in[I_NMOEG]; float* WR = WSP(float, WS_WR);
      for (int i = gt; i < NE * D; i += NGT) { const int e = i / D, k = i % D; WR[i] = rw[k * NE + e] * g[k]; } }
    }
    if (part == 0) {
    for (int m = gw; m < T; m += 2 * NGW) {
        const float* x0 = F.in[I_X] + (size_t)m * D; const bool two = (m + NGW < T); const float* x1 = F.in[I_X] + (size_t)(two ? m + NGW : m) * D; const float* gmix = F.in[I_NMIXG];
        f32x4 v0[8], v1[8]; float s0 = 0.f, s1 = 0.f;
#pragma unroll
        for (int j = 0; j < 8; ++j) { v0[j] = *(const f32x4*)(x0 + 4 * lane + 256 * j); v1[j] = *(const f32x4*)(x1 + 4 * lane + 256 * j); }
#pragma unroll
        for (int j = 0; j < 8; ++j) { s0 += (v0[j][0] * v0[j][0] + v0[j][1] * v0[j][1]) + (v0[j][2] * v0[j][2] + v0[j][3] * v0[j][3]); s1 += (v1[j][0] * v1[j][0] + v1[j][1] * v1[j][1]) + (v1[j][2] * v1[j][2] + v1[j][3] * v1[j][3]); }
        const float r0 = rsqrtf(wave_sum(s0) * (1.0f / D) + EPS), r1 = rsqrtf(wave_sum(s1) * (1.0f / D) + EPS);
        bf16* o0 = WSP(bf16, WS_XN) + (size_t)m * D; bf16* o1 = WSP(bf16, WS_XN) + (size_t)(m + NGW) * D;
#pragma unroll
        for (int j = 0; j < 8; ++j) { const f32x4 gg = *(const f32x4*)(gmix + 4 * lane + 256 * j);
            u32x2 a; a.x = pk2(v0[j][0] * r0 * gg[0], v0[j][1] * r0 * gg[1]); a.y = pk2(v0[j][2] * r0 * gg[2], v0[j][3] * r0 * gg[3]); *(u32x2*)(o0 + 4 * lane + 256 * j) = a;
            if (two) { u32x2 b; b.x = pk2(v1[j][0] * r1 * gg[0], v1[j][1] * r1 * gg[1]); b.y = pk2(v1[j][2] * r1 * gg[2], v1[j][3] * r1 * gg[3]); *(u32x2*)(o1 + 4 * lane + 256 * j) = b; } }
    }
    }
    if (part == 0) { for (int m = gw; m < MEM; m += NGW) rms_row_to_bf16(F.in[I_MEM] + (size_t)m * D, F.in[I_NMG], WSP(bf16, WS_MEMN) + (size_t)m * D, lane); }
    if (part == 1) {
    { u32x4* z = (u32x4*)(WSP(bf16, WS_H3) + (size_t)T * D); u32x4* z8 = (u32x4*)(WSP(unsigned char, WS_H3) + (size_t)T * D); for (int i = gt; i < 256; i += NGT) { z[i] = (u32x4){0u, 0u, 0u, 0u}; z8[i] = (u32x4){0u, 0u, 0u, 0u}; } }
    }
}

constexpr int CW_MKV = 20480;
__device__ __forceinline__ void p_memkv(Frame& F) {
    const bf16* A = WSP(bf16, WS_MEMN); const bf16* B = WSP(bf16, WS_WXKV); bf16* KM = WSP(bf16, WS_KM); bf16* VMT = WSP(bf16, WS_VMT);
    LAS f32x4* red = (LAS f32x4*)F.lds;
    LAS int* box = (LAS int*)(F.lds + 8 * 4 * 64 * 16);
    const int lane = F.lane, w = F.wave, lr = lane & 15, lg = lane >> 4;
    for (;;) {
        __syncthreads();
        if (F.tid == 0) box[0] = (int)__hip_atomic_fetch_add(F.ctl + CW_MKV, 1u, RLX_AGENT);
        __syncthreads();
        const int unit = __builtin_amdgcn_readfirstlane(box[0]);
        if (unit >= (MEM / 16) * (2 * XA / 64)) break;
        const int mt = unit & 15, nt = unit >> 4; const bool isk = nt < 8;
        const bf16* ap = A + (size_t)(16 * mt + lr) * D + 256 * w + 8 * lg; const bf16* bp = B + (size_t)(64 * nt + lr) * D + 256 * w + 8 * lg;
        bf16x8 af[8], bf[4][8];
#pragma unroll
        for (int s = 0; s < 8; ++s) { af[s] = *(const bf16x8*)(ap + 32 * s);
#pragma unroll
            for (int j = 0; j < 4; ++j) bf[j][s] = *(const bf16x8*)(bp + (size_t)(16 * j) * D + 32 * s); }
        f32x4 acc[4];
#pragma unroll
        for (int j = 0; j < 4; ++j) { acc[j] = (f32x4){0.f, 0.f, 0.f, 0.f};
#pragma unroll
            for (int s = 0; s < 8; ++s) acc[j] = isk ? MFMA16(bf[j][s], af[s], acc[j]) : MFMA16(af[s], bf[j][s], acc[j]); }
        __syncthreads();
#pragma unroll
        for (int j = 0; j < 4; ++j) red[(w * 4 + j) * 64 + lane] = acc[j];
        __syncthreads();
        if (w < 4) { f32x4 t = red[w * 64 + lane];
#pragma unroll
            for (int ww = 1; ww < 8; ++ww) t += red[(ww * 4 + w) * 64 + lane];
            u32x2 o; o.x = pk2(t[0], t[1]); o.y = pk2(t[2], t[3]);
            if (isk) *(u32x2*)(KM + (size_t)(16 * mt + lr) * XA + 64 * nt + 16 * w + 4 * lg) = o;
            else *(u32x2*)(VMT + (size_t)(64 * nt - XA + 16 * w + lr) * MEM + 16 * mt + 4 * lg) = o;
        }
    }
    __syncthreads();
}

__device__ __forceinline__ void p_alow(Frame& F) {
    const bf16* XN = WSP(bf16, WS_XN); const bf16* WAL = WSP(bf16, WS_WAL); const bf16* WGW = WSP(bf16, WS_WGW); const float* GB = F.in[I_GGB]; float* LA = WSP(float, WS_LA);
    LAS f32x4* red = (LAS f32x4*)F.lds;
    const int lane = F.lane, lr = lane & 15, lg = lane >> 4, tk = F.wave >> 1, kh = F.wave & 1;
    for (int t4 = F.bid; t4 < T / 64; t4 += F.G) {
        const int task = 4 * t4 + tk;
        const bf16* ap = WAL + (size_t)lr * D + 1024 * kh + 8 * lg; const bf16* bp = XN + (size_t)(16 * task + lr) * D + 1024 * kh + 8 * lg;
        f32x4 acc = {0.f, 0.f, 0.f, 0.f};
#pragma unroll 16
        for (int s = 0; s < 32; ++s) acc = MFMA16(*(const bf16x8*)(ap + 32 * s), *(const bf16x8*)(bp + 32 * s), acc);
        __syncthreads();
        red[(tk * 2 + kh) * 64 + lane] = acc;
        __syncthreads();
#if OPT_GLA
        if (kh == 0) *(f32x4*)(WSP(float, WS_ALOW) + (size_t)(16 * task + lr) * 16 + 4 * lg) = red[(tk * 2) * 64 + lane] + red[(tk * 2 + 1) * 64 + lane];
        continue;
#endif
        u32x4 bw = {0u, 0u, 0u, 0u};
        if (lg < 2) { const f32x4 x0 = red[(tk * 2) * 64 + lr + 32 * lg] + red[(tk * 2 + 1) * 64 + lr + 32 * lg], x1 = red[(tk * 2) * 64 + lr + 32 * lg + 16] + red[(tk * 2 + 1) * 64 + lr + 32 * lg + 16];
            bw = (u32x4){pk2(x0[0], x0[1]), pk2(x0[2], x0[3]), pk2(x1[0], x1[1]), pk2(x1[2], x1[3])}; }
        const bf16x8 bfr = as_bf8(bw);
#pragma unroll 4
        for (int q = 0; q < 32; ++q) { const int nt = 32 * kh + q;
            const bf16x8 afr = *(const bf16x8*)(WGW + (size_t)(16 * nt + lr) * 32 + 8 * lg);
            f32x4 z = MFMA16(afr, bfr, ((f32x4){0.f, 0.f, 0.f, 0.f}));
            const f32x4 gb = *(const f32x4*)(GB + 16 * nt + 4 * lg);
#pragma unroll
            for (int r = 0; r < 4; ++r) z[r] = logsigmoidf_(z[r] + gb[r]) * 0.0625f;
            *(f32x4*)(LA + (size_t)(16 * task + lr) * QK + 16 * nt + 4 * lg) = z; }
    }
    __syncthreads();
}

__device__ __forceinline__ void p_conv(Frame& F) {
    const bf16* U = WSP(bf16, WS_U); const bf16* CB = WSP(bf16, WS_CB); bf16* Z = WSP(bf16, WS_Z);
    const float* cw = F.in[I_CW]; const float* cb = F.in[I_CBIAS];
    for (int task = F.bid * NTHR + F.tid; task < (T / 32) * (D / 8); task += F.G * NTHR) {
        const int cg = task & 255, tb = task >> 8, c = 8 * cg, t0 = 32 * tb;
        f32x4 w0a = *(const f32x4*)(cw + c), w0b = *(const f32x4*)(cw + c + 4), w1a = *(const f32x4*)(cw + D + c), w1b = *(const f32x4*)(cw + D + c + 4);
        f32x4 w2a = *(const f32x4*)(cw + 2 * D + c), w2b = *(const f32x4*)(cw + 2 * D + c + 4), ba = *(const f32x4*)(cb + c), bb = *(const f32x4*)(cb + c + 4);
        f32x4 p2a = {0.f, 0.f, 0.f, 0.f}, p2b = p2a, p1a = p2a, p1b = p2a;
        if (t0 >= 2) { ld_bf8(U + (size_t)(t0 - 2) * D + c, p2a, p2b); ld_bf8(U + (size_t)(t0 - 1) * D + c, p1a, p1b); }
        for (int tq = t0; tq < t0 + 32; tq += 8) {
            u32x4 ur[8], cr[8];
#pragma unroll
            for (int i = 0; i < 8; ++i) { ur[i] = *(const u32x4*)(U + (size_t)(tq + i) * D + c); cr[i] = *(const u32x4*)(CB + (size_t)(tq + i) * D + c); }
#pragma unroll
            for (int i = 0; i < 8; ++i) {
                f32x4 ua, ub, ca, cbv; unpack8(ur[i], ua, ub); unpack8(cr[i], ca, cbv);
                const f32x4 ya = ca * (w0a * p2a + w1a * p1a + w2a * ua + ba), yb = cbv * (w0b * p2b + w1b * p1b + w2b * ub + bb);
                st_bf8(Z + (size_t)(tq + i) * D + c, ya, yb);
                p2a = p1a; p2b = p1b; p1a = ua; p1b = ub;
            }
        }
    }
}
__device__ __forceinline__ void p_glaprep(Frame& F) {
    const bf16* Q = WSP(bf16, WS_Q); const bf16* Kk = WSP(bf16, WS_K); const float* ALOW = WSP(float, WS_ALOW); const float* GW = F.in[I_GGW]; const float* GB = F.in[I_GGB];
    bf16* QT = WSP(bf16, WS_QT); bf16* KH = WSP(bf16, WS_KH); bf16* KHT = WSP(bf16, WS_KHT); bf16* QG = WSP(bf16, WS_QG);
    float* DL = WSP(float, WS_DL); float* DG = WSP(float, WS_DG);
    LAS float* part = (LAS float*)F.lds;
    LAS float* sal = part + 512;
    const int col = F.tid & 63, sub = F.tid >> 6;
    for (int unit0 = F.bid; unit0 < NG * 16; unit0 += F.G) {
        const int unit = (F.G == NG * 16) ? ((((unit0 & 7) + 8 * (unit0 >> 5)) << 2) | ((unit0 >> 3) & 3)) : unit0;
        const int g = unit >> 4, cs = unit & 15, gc = cs * 64 + col, h = gc >> 8, kc = gc & 255;
        float gw[16];
#pragma unroll
        for (int r = 0; r < 16; ++r) gw[r] = GW[r * QK + gc];
        const float gbv = GB[gc];
        float carry = 0.f;
        bf16 qr[8], kr[8]; f32x4 av = {0.f, 0.f, 0.f, 0.f};
#define PREP_LOAD(chunk_) do { const int _t0 = (chunk_) * CH + 8 * sub; \
        _Pragma("unroll") for (int j = 0; j < 8; ++j) { qr[j] = Q[(size_t)(_t0 + j) * QK + gc]; kr[j] = Kk[(size_t)(_t0 + j) * QK + gc]; } \
        if (F.tid < 256) av = *(const f32x4*)(ALOW + (size_t)(chunk_) * CH * 16 + 4 * F.tid); } while (0)
        PREP_LOAD(g * GC);
        for (int c = 0; c < GC; ++c) {
            const int chunk = g * GC + c, t0 = chunk * CH + 8 * sub;
            float la[8], qv[8], kv[8];
#pragma unroll
            for (int j = 0; j < 8; ++j) { qv[j] = bf2f(qr[j]); kv[j] = bf2f(kr[j]); }
            if (F.tid < 256) *(LAS f32x4*)(sal + 4 * F.tid) = av;
            __syncthreads();
            if (c + 1 < GC) PREP_LOAD(chunk + 1);
#pragma unroll
            for (int j = 0; j < 8; ++j) { const LAS f32x4* ar = (const LAS f32x4*)(sal + (8 * sub + j) * 16); const f32x4 a0 = ar[0], a1 = ar[1], a2 = ar[2], a3 = ar[3];
                float z = gbv;
#pragma unroll
                for (int r = 0; r < 4; ++r) z += a0[r] * gw[r];
#pragma unroll
                for (int r = 0; r < 4; ++r) z += a1[r] * gw[4 + r];
#pragma unroll
                for (int r = 0; r < 4; ++r) z += a2[r] * gw[8 + r];
#pragma unroll
                for (int r = 0; r < 4; ++r) z += a3[r] * gw[12 + r];
                la[j] = logsigmoidf_(z) * 0.0625f; }
#pragma unroll
            for (int j = 1; j < 8; ++j) la[j] += la[j - 1];
            part[sub * 64 + col] = la[7];
            __syncthreads();
            float off = 0.f, tot = 0.f;
#pragma unroll
            for (int s = 0; s < 8; ++s) { const float p = part[s * 64 + col]; off += (s < sub) ? p : 0.f; tot += p; }
            unsigned kt[4];
#pragma unroll
            for (int j = 0; j < 8; ++j) { const float b = off + la[j], eb = __expf(b), enb = __expf(-b), eg = __expf(carry + b);
                QT[(size_t)(t0 + j) * QK + gc] = (bf16)f2bf(qv[j] * eb); const unsigned khv = f2bf(kv[j] * enb); KH[(size_t)(t0 + j) * QK + gc] = (bf16)khv;
                QG[(size_t)(t0 + j) * QK + gc] = (bf16)f2bf(qv[j] * eg);
                if (j & 1) kt[j >> 1] |= khv << 16; else kt[j >> 1] = khv; }
            *(u32x4*)(KHT + ((size_t)(chunk * GH + h) * DK + kc) * CH + 8 * sub) = (u32x4){kt[0], kt[1], kt[2], kt[3]};
            if (sub == 0) DL[(size_t)chunk * QK + gc] = __expf(tot);
            carry += tot;
        }
#undef PREP_LOAD
        if (sub == 0) DG[(size_t)g * QK + gc] = __expf(carry);
    }
}

__device__ __forceinline__ void p_gla_ref(Frame& F) {
    const bf16* Q = WSP(bf16, WS_Q); const bf16* Kk = WSP(bf16, WS_K); const bf16* V = WSP(bf16, WS_V); const float* LA = WSP(float, WS_LA); float* O32 = WSP(float, WS_O32);
    LAS float* red = (LAS float*)F.lds;
    const int k = F.tid & 255, vh = F.tid >> 8;
    for (int unit = F.bid; unit < GH * 64; unit += F.G) {
        const int h = unit >> 6, vb = unit & 63, vcol = h * DV + vb * 8 + vh * 4;
        float s0 = 0.f, s1 = 0.f, s2 = 0.f, s3 = 0.f;
        for (int tb = 0; tb < T; tb += 8) {
            LAS float* rb = red + ((tb >> 3) & 1) * 256;
#pragma unroll
            for (int j = 0; j < 8; ++j) {
                const int t = tb + j; const float a = __expf(LA[(size_t)t * QK + h * DK + k]), kk = bf2f(Kk[(size_t)t * QK + h * DK + k]), qq = bf2f(Q[(size_t)t * QK + h * DK + k]);
                const u32x2 vv = *(const u32x2*)(V + (size_t)t * VD + vcol);
                const float v0 = __uint_as_float(vv.x << 16), v1 = __uint_as_float(vv.x & 0xffff0000u), v2 = __uint_as_float(vv.y << 16), v3 = __uint_as_float(vv.y & 0xffff0000u);
                s0 = a * s0 + kk * v0; s1 = a * s1 + kk * v1; s2 = a * s2 + kk * v2; s3 = a * s3 + kk * v3;
                const float p0 = wave_sum(qq * s0), p1 = wave_sum(qq * s1), p2 = wave_sum(qq * s2), p3 = wave_sum(qq * s3);
                if (F.lane == 0) *(LAS f32x4*)(rb + (j * 8 + F.wave) * 4) = (f32x4){p0, p1, p2, p3};
            }
            __syncthreads();
            if (F.tid < 64) { const int j = F.tid >> 3, vhh = (F.tid >> 2) & 1, q = F.tid & 3; float s = 0.f;
#pragma unroll
                for (int w = 0; w < 4; ++w) s += rb[(j * 8 + vhh * 4 + w) * 4 + q];
                O32[(size_t)(tb + j) * VD + h * DV + vb * 8 + vhh * 4 + q] = s; }
        }
        __syncthreads();
    }
}
__device__ __forceinline__ void p_gla_norm_ref(Frame& F) {
    const float* O32 = WSP(float, WS_O32); const bf16* SR = WSP(bf16, WS_SR); bf16* OA = WSP(bf16, WS_OA); const float* g = F.in[I_GNG];
    const int gw = F.bid * NWAVES + F.wave, NGW = F.G * NWAVES;
    for (int it = gw; it < T * GH; it += NGW) {
        const size_t o = (size_t)it * DV + 8 * F.lane;
        const f32x4 a = *(const f32x4*)(O32 + o), b = *(const f32x4*)(O32 + o + 4);
        float s = 0.f;
#pragma unroll
        for (int j = 0; j < 4; ++j) s += a[j] * a[j] + b[j] * b[j];
        const float r = rsqrtf(wave_sum(s) * (1.0f / DV) + EPS);
        f32x4 s0, s1; ld_bf8(SR + o, s0, s1);
        const f32x4 g0 = *(const f32x4*)(g + 8 * F.lane), g1 = *(const f32x4*)(g + 8 * F.lane + 4);
        st_bf8(OA + o, a * r * g0 * s0, b * r * g1 * s1);
    }
}

__device__ __forceinline__ void p_gla_a(Frame& F) {
    const bf16* QT = WSP(bf16, WS_QT); const bf16* KH = WSP(bf16, WS_KH); const bf16* KHT = WSP(bf16, WS_KHT); const bf16* V = WSP(bf16, WS_V); const float* DL = WSP(float, WS_DL);
    bf16* OL = WSP(bf16, WS_OL); float* SLOC = WSP(float, WS_SLOC);
    constexpr int QS = 528, KQ = 544, KS = 160;
    LAS unsigned char* sQ = F.lds; LAS unsigned char* sK = sQ + 64 * QS; LAS unsigned char* sKT = sK + 64 * KQ; LAS unsigned char* sVT = sKT + 256 * KS; LAS unsigned char* sP = sVT + 128 * KS;
    LAS float* sDL = (LAS float*)(sP + 64 * KS);
    static_assert(64 * QS + 64 * KQ + 256 * KS + 128 * KS + 64 * KS + 1024 <= MISC_OFF, "gla lds");
    const int tid = F.tid, lane = F.lane, w = F.wave, lr = lane & 15, lg = lane >> 4;
    for (int unit0 = F.bid; unit0 < NG * GH * 4; unit0 += F.G) {
        const int unit = (F.G == NG * GH * 4) ? ((((unit0 & 7) + 8 * (unit0 >> 5)) << 2) | ((unit0 >> 3) & 3)) : unit0;
        const int g = unit >> 4, h = (unit >> 2) & 3, vs = unit & 3;
        f32x4 S[16];
#pragma unroll
        for (int kt = 0; kt < 16; ++kt) S[kt] = (f32x4){0.f, 0.f, 0.f, 0.f};
        u32x4 rq[4], rk[4], rt[4], rv[2], rd = {0u, 0u, 0u, 0u};
#define GLA_LOAD(chunk_) do { const int _t0 = (chunk_) * CH; \
        _Pragma("unroll") for (int q = 0; q < 4; ++q) { const int p = tid + 512 * q, row = p >> 5, c16 = p & 31; \
            rq[q] = *(const u32x4*)(QT + (size_t)(_t0 + row) * QK + h * DK + c16 * 8); rk[q] = *(const u32x4*)(KH + (size_t)(_t0 + row) * QK + h * DK + c16 * 8); \
            rt[q] = *(const u32x4*)(KHT + (size_t)((chunk_) * GH + h) * DK * CH + (size_t)p * 8); } \
        _Pragma("unroll") for (int q = 0; q < 2; ++q) rv[q] = *(const u32x4*)(V + (size_t)(_t0 + lane) * VD + h * DV + vs * 128 + 8 * (2 * w + q)); \
        if (tid < 64) rd = *(const u32x4*)(DL + (size_t)(chunk_) * QK + h * DK + 4 * tid); } while (0)
        GLA_LOAD(g * GC);
        for (int c = 0; c < GC; ++c) {
            const int chunk = g * GC + c, t0 = chunk * CH;
#pragma unroll
            for (int q = 0; q < 4; ++q) { const int p = tid + 512 * q; *(LAS u32x4*)(sQ + (p >> 5) * QS + (p & 31) * 16) = rq[q]; *(LAS u32x4*)(sK + (p >> 5) * KQ + (p & 31) * 16) = rk[q]; *(LAS u32x4*)(sKT + (p >> 3) * KS + (p & 7) * 16) = rt[q]; }
#pragma unroll
            for (int q = 0; q < 2; ++q) { LAS unsigned char* vp = sVT + (8 * (2 * w + q)) * KS + 2 * lane;
                *(LAS unsigned short*)(vp) = (unsigned short)rv[q].x; *(LAS unsigned short*)(vp + KS) = (unsigned short)(rv[q].x >> 16); *(LAS unsigned short*)(vp + 2 * KS) = (unsigned short)rv[q].y; *(LAS unsigned short*)(vp + 3 * KS) = (unsigned short)(rv[q].y >> 16);
                *(LAS unsigned short*)(vp + 4 * KS) = (unsigned short)rv[q].z; *(LAS unsigned short*)(vp + 5 * KS) = (unsigned short)(rv[q].z >> 16); *(LAS unsigned short*)(vp + 6 * KS) = (unsigned short)rv[q].w; *(LAS unsigned short*)(vp + 7 * KS) = (unsigned short)(rv[q].w >> 16); }
            if (tid < 64) *(LAS u32x4*)(sDL + 4 * tid) = rd;
            __syncthreads();
            if (c + 1 < GC) GLA_LOAD(chunk + 1);
            { const int ti = w >> 1;
#pragma unroll
              for (int jj = 0; jj < 2; ++jj) { const int tj = 2 * (w & 1) + jj; f32x4 pa = {0.f, 0.f, 0.f, 0.f};
                if (tj <= ti) {
#pragma unroll
                    for (int s = 0; s < 8; ++s) { const bf16x8 a = *(const LAS bf16x8*)(sK + (16 * tj + lr) * KQ + (32 * s + 8 * lg) * 2), b = *(const LAS bf16x8*)(sQ + (16 * ti + lr) * QS + (32 * s + 8 * lg) * 2); pa = MFMA16(a, b, pa); }
                    const int i = 16 * ti + lr, j0 = 16 * tj + 4 * lg;
#pragma unroll
                    for (int r = 0; r < 4; ++r) pa[r] = (j0 + r <= i) ? pa[r] : 0.f;
                }
                u32x2 pw; pw.x = pk2(pa[0], pa[1]); pw.y = pk2(pa[2], pa[3]);
                *(LAS u32x2*)(sP + (16 * ti + lr) * KS + (16 * tj + 4 * lg) * 2) = pw; } }
            f32x4 oacc[4];
#pragma unroll
            for (int ti = 0; ti < 4; ++ti) oacc[ti] = (f32x4){0.f, 0.f, 0.f, 0.f};
#pragma unroll
            for (int s = 0; s < 8; ++s) {
                u32x4 sw; sw.x = pk2(S[2 * s][0], S[2 * s][1]); sw.y = pk2(S[2 * s][2], S[2 * s][3]); sw.z = pk2(S[2 * s + 1][0], S[2 * s + 1][1]); sw.w = pk2(S[2 * s + 1][2], S[2 * s + 1][3]);
                const bf16x8 a = as_bf8(sw);
#pragma unroll
                for (int ti = 0; ti < 4; ++ti) { const LAS unsigned char* qp = sQ + (16 * ti + lr) * QS + (32 * s + 4 * lg) * 2; const u32x2 lo = *(const LAS u32x2*)qp, hi = *(const LAS u32x2*)(qp + 32);
                    oacc[ti] = MFMA16(a, as_bf8((u32x4){lo.x, lo.y, hi.x, hi.y}), oacc[ti]); }
            }
            __syncthreads();
            bf16x8 vf[2];
#pragma unroll
            for (int s2 = 0; s2 < 2; ++s2) vf[s2] = *(const LAS bf16x8*)(sVT + (16 * w + lr) * KS + (32 * s2 + 8 * lg) * 2);
#pragma unroll
            for (int s2 = 0; s2 < 2; ++s2)
#pragma unroll
                for (int ti = 0; ti < 4; ++ti) { const bf16x8 b = *(const LAS bf16x8*)(sP + (16 * ti + lr) * KS + (32 * s2 + 8 * lg) * 2); oacc[ti] = MFMA16(vf[s2], b, oacc[ti]); }
#pragma unroll
            for (int ti = 0; ti < 4; ++ti) { u32x2 ow; ow.x = pk2(oacc[ti][0], oacc[ti][1]); ow.y = pk2(oacc[ti][2], oacc[ti][3]);
                *(u32x2*)(OL + (size_t)(t0 + 16 * ti + lr) * VD + h * DV + vs * 128 + 16 * w + 4 * lg) = ow; }
#pragma unroll
            for (int kt = 0; kt < 16; ++kt) {
#pragma unroll
                for (int s2 = 0; s2 < 2; ++s2) { const bf16x8 a = *(const LAS bf16x8*)(sKT + (16 * kt + lr) * KS + (32 * s2 + 8 * lg) * 2); S[kt] = MFMA16(a, vf[s2], S[kt]); }
                S[kt] *= *(const LAS f32x4*)(sDL + 16 * kt + 4 * lg);
            }
            __syncthreads();
        }
#undef GLA_LOAD
#pragma unroll
        for (int kt = 0; kt < 16; ++kt)
#pragma unroll
            for (int r = 0; r < 4; ++r) SLOC[((size_t)(g * GH + h) * DK + 16 * kt + 4 * lg + r) * DV + vs * 128 + 16 * w + lr] = S[kt][r];
    }
}
__device__ __forceinline__ void p_gla_b(Frame& F) {
    const float* SLOC = WSP(float, WS_SLOC); const float* DG = WSP(float, WS_DG); bf16* SG0 = WSP(bf16, WS_SG0);
    for (int idx = F.bid * NTHR + F.tid; idx < GH * DV * (DK / 4); idx += F.G * NTHR) {
        const int v = idx & 511, k4 = (idx >> 9) & 63, h = idx >> 15;
        float x[NG - 1][4]; f32x4 d[NG - 1];
#pragma unroll
        for (int g = 0; g < NG - 1; ++g) { d[g] = *(const f32x4*)(DG + (size_t)g * QK + h * DK + 4 * k4);
#pragma unroll
            for (int j = 0; j < 4; ++j) x[g][j] = SLOC[((size_t)(g * GH + h) * DK + 4 * k4 + j) * DV + v]; }
        float s[4] = {0.f, 0.f, 0.f, 0.f};
#pragma unroll
        for (int g = 0; g < NG; ++g) {
            *(u32x2*)(SG0 + ((size_t)(g * GH + h) * DV + v) * DK + 4 * k4) = (u32x2){pk2(s[0], s[1]), pk2(s[2], s[3])};
            if (g < NG - 1) {
#pragma unroll
                for (int j = 0; j < 4; ++j) s[j] = d[g][j] * s[j] + x[g][j]; }
        }
    }
}
__device__ __forceinline__ void p_gla_c(Frame& F) {
    const bf16* QG = WSP(bf16, WS_QG); const bf16* SG0 = WSP(bf16, WS_SG0); const bf16* OL = WSP(bf16, WS_OL); const bf16* SR = WSP(bf16, WS_SR); bf16* OA = WSP(bf16, WS_OA); const float* gn = F.in[I_GNG];
    LAS float* red = (LAS float*)F.lds;
    const int lane = F.lane, w = F.wave, lr = lane & 15, lg = lane >> 4;
    for (int unit = F.bid; unit < (T / 128) * GH; unit += F.G) {
        const int gh = (F.G == 256) ? (F.bid & 7) + 8 * (F.bid >> 6) + 32 * (unit >> 8) : (unit >> 5), blk = (F.G == 256) ? ((F.bid >> 3) & 7) : ((unit >> 2) & 7);
        const int h = (F.G == 256) ? (gh & 3) : (unit & 3), g = (F.G == 256) ? (gh >> 2) : (unit >> 5), rt = 8 * g + blk, row0 = rt * 128;
        f32x4 o[8][4];
#pragma unroll
        for (int it = 0; it < 8; ++it)
#pragma unroll
            for (int vt = 0; vt < 4; ++vt) o[it][vt] = (f32x4){0.f, 0.f, 0.f, 0.f};
        if (g > 0) {
            const bf16* sg = SG0 + ((size_t)(g * GH + h) * DV + 64 * w + 8 * (lr >> 2) + (lr & 3)) * DK + 8 * lg; const bf16* qg = QG + (size_t)(row0 + lr) * QK + h * DK + 8 * lg;
            bf16x8 a0[4], b0[8], a1[4], b1[8];
#define GLC_LOAD(A_, B_, s_) do { _Pragma("unroll") for (int vt = 0; vt < 4; ++vt) A_[vt] = *(const bf16x8*)(sg + (size_t)(32 * (vt >> 1) + 4 * (vt & 1)) * DK + 32 * (s_)); \
            _Pragma("unroll") for (int it = 0; it < 8; ++it) B_[it] = *(const bf16x8*)(qg + (size_t)(16 * it) * QK + 32 * (s_)); } while (0)
#define GLC_MMA(A_, B_) do { _Pragma("unroll") for (int it = 0; it < 8; ++it) _Pragma("unroll") for (int vt = 0; vt < 4; ++vt) o[it][vt] = MFMA16(A_[vt], B_[it], o[it][vt]); } while (0)
            GLC_LOAD(a0, b0, 0);
#pragma unroll
            for (int s = 0; s < 8; s += 2) {
                GLC_LOAD(a1, b1, s + 1);
                GLC_MMA(a0, b0);
                if (s + 2 < 8) GLC_LOAD(a0, b0, s + 2);
                GLC_MMA(a1, b1);
            }
#undef GLC_LOAD
#undef GLC_MMA
        }
        asm volatile("" ::: "memory");
        const size_t ob = (size_t)(row0 + lr) * VD + h * DV + 64 * w + 8 * lg;
        float ss[8];
#pragma unroll
        for (int it = 0; it < 8; ++it) { ss[it] = 0.f;
#pragma unroll
            for (int p = 0; p < 2; ++p) { const u32x4 ol4 = *(const u32x4*)(OL + ob + (size_t)(16 * it) * VD + 32 * p);
#pragma unroll
              for (int q = 0; q < 2; ++q) { const int vt = 2 * p + q; u32x2 ol; ol.x = q ? ol4.z : ol4.x; ol.y = q ? ol4.w : ol4.y;
                o[it][vt][0] += __uint_as_float(ol.x << 16); o[it][vt][1] += __uint_as_float(ol.x & 0xffff0000u); o[it][vt][2] += __uint_as_float(ol.y << 16); o[it][vt][3] += __uint_as_float(ol.y & 0xffff0000u);
                ss[it] += (o[it][vt][0] * o[it][vt][0] + o[it][vt][1] * o[it][vt][1]) + (o[it][vt][2] * o[it][vt][2] + o[it][vt][3] * o[it][vt][3]); } }
            ss[it] += __shfl_xor(ss[it], 16); ss[it] += __shfl_xor(ss[it], 32); }
        __syncthreads();
        if (lg == 0) {
#pragma unroll
            for (int it = 0; it < 8; ++it) red[w * 128 + 16 * it + lr] = ss[it]; }
        __syncthreads();
#pragma unroll
        for (int it = 0; it < 8; ++it) { float t = 0.f;
#pragma unroll
            for (int ww = 0; ww < 8; ++ww) t += red[ww * 128 + 16 * it + lr];
            const float r = rsqrtf(t * (1.0f / DV) + EPS);
#pragma unroll
            for (int p = 0; p < 2; ++p) { const size_t oo = ob + (size_t)(16 * it) * VD + 32 * p; const u32x4 sr4 = *(const u32x4*)(SR + oo); u32x4 ow4;
#pragma unroll
              for (int q = 0; q < 2; ++q) { const int vt = 2 * p + q; u32x2 sr; sr.x = q ? sr4.z : sr4.x; sr.y = q ? sr4.w : sr4.y; const f32x4 gg = *(const f32x4*)(gn + 64 * w + 32 * p + 8 * lg + 4 * q);
                u32x2 ow; ow.x = pk2(o[it][vt][0] * r * gg[0] * __uint_as_float(sr.x << 16), o[it][vt][1] * r * gg[1] * __uint_as_float(sr.x & 0xffff0000u));
                ow.y = pk2(o[it][vt][2] * r * gg[2] * __uint_as_float(sr.y << 16), o[it][vt][3] * r * gg[3] * __uint_as_float(sr.y & 0xffff0000u));
                if (q) { ow4.z = ow.x; ow4.w = ow.y; } else { ow4.x = ow.x; ow4.y = ow.y; } }
              *(u32x4*)(OA + oo) = ow4; } }
    }
    __syncthreads();
}

__device__ __forceinline__ void p_attn_ref(Frame& F) {
    const bf16* QX = WSP(bf16, WS_QX); const bf16* KM = WSP(bf16, WS_KM); const bf16* VMT = WSP(bf16, WS_VMT); bf16* OX = WSP(bf16, WS_OX);
    LAS float* pbuf = (LAS float*)F.lds + F.wave * 256;
    const int gw = F.bid * NWAVES + F.wave, NGW = F.G * NWAVES, lane = F.lane;
    for (int it = gw; it < T * XH; it += NGW) {
        const int t = it >> 2, h = it & 3; const bf16* q = QX + (size_t)t * XA + h * XD;
        float s[4] = {0.f, 0.f, 0.f, 0.f};
        for (int d = 0; d < XD; d += 8) { f32x4 q0, q1, q2, q3; ld_bf8(q + d, q0, q1); ld_bf8(q + d + QX_HALF, q2, q3); q0 += q2; q1 += q3;
#pragma unroll
            for (int c = 0; c < 4; ++c) { f32x4 k0, k1; ld_bf8(KM + (size_t)(lane + 64 * c) * XA + h * XD + d, k0, k1);
#pragma unroll
                for (int j = 0; j < 4; ++j) s[c] += q0[j] * k0[j] + q1[j] * k1[j]; } }
        const float sc = 0.08838834764831845f;
        float mx = fmaxf(fmaxf(s[0], s[1]), fmaxf(s[2], s[3])) * sc; mx = wave_max(mx);
        float e[4], sum = 0.f;
#pragma unroll
        for (int c = 0; c < 4; ++c) { e[c] = __expf(s[c] * sc - mx); sum += e[c]; }
        sum = wave_sum(sum); const float inv = 1.0f / sum;
#pragma unroll
        for (int c = 0; c < 4; ++c) pbuf[lane + 64 * c] = bf2f((unsigned short)f2bf(e[c] * inv));
        LDS_WAIT(); asm volatile("" ::: "memory");
        float o0 = 0.f, o1 = 0.f; const bf16* v0 = VMT + (size_t)(h * XD + 2 * lane) * MEM; const bf16* v1 = v0 + MEM;
        for (int m = 0; m < MEM; m += 8) { f32x4 a0, a1, b0, b1; ld_bf8(v0 + m, a0, a1); ld_bf8(v1 + m, b0, b1); const f32x4 p0 = *(const LAS f32x4*)(pbuf + m), p1 = *(const LAS f32x4*)(pbuf + m + 4);
#pragma unroll
            for (int j = 0; j < 4; ++j) { o0 += p0[j] * a0[j] + p1[j] * a1[j]; o1 += p0[j] * b0[j] + p1[j] * b1[j]; } }
        *(unsigned*)(OX + (size_t)t * XA + h * XD + 2 * lane) = pk2(o0, o1);
        LDS_WAIT(); asm volatile("" ::: "memory");
    }
}

__device__ __forceinline__ void p_attn(Frame& F) {
    const bf16* QX = WSP(bf16, WS_QX); const bf16* KM = WSP(bf16, WS_KM); const bf16* VMT = WSP(bf16, WS_VMT); bf16* OX = WSP(bf16, WS_OX);
    constexpr int KSt = 288, VSt = 528;
    LAS unsigned char* sK = F.lds; LAS unsigned char* sV = sK + 256 * KSt;
    static_assert(256 * KSt + 128 * VSt <= MISC_OFF, "attn lds");
    const int tid = F.tid, lane = F.lane, w = F.wave, lr = lane & 15, lg = lane >> 4;
    int curh = -1;
    for (int unit = F.bid; unit < (T / 128) * XH; unit += F.G) {
        const int h = unit & 3, rt = unit >> 2;
        if (h != curh) {
            __syncthreads();
#pragma unroll
            for (int q = 0; q < 8; ++q) { const int p = tid + 512 * q;
                *(LAS u32x4*)(sK + (p >> 4) * KSt + (p & 15) * 16) = *(const u32x4*)(KM + (size_t)(p >> 4) * XA + h * XD + (p & 15) * 8);
                *(LAS u32x4*)(sV + (p >> 5) * VSt + (p & 31) * 16) = *(const u32x4*)(VMT + (size_t)(h * XD + (p >> 5)) * MEM + (p & 31) * 8); }
            __syncthreads();
            curh = h;
        }
        const int row = rt * 128 + 16 * w + lr;
        bf16x8 qf[4];
#pragma unroll
        for (int s = 0; s < 4; ++s) { const bf16* qp = QX + (size_t)row * XA + h * XD + 32 * s + 8 * lg;
            f32x4 a0, a1, b0, b1; unpack8(*(const u32x4*)qp, a0, a1); unpack8(*(const u32x4*)(qp + QX_HALF), b0, b1); qf[s] = as_bf8(pack8(a0 + b0, a1 + b1)); }
        f32x4 sc[16];
#pragma unroll
        for (int kt = 0; kt < 16; ++kt) { sc[kt] = (f32x4){0.f, 0.f, 0.f, 0.f};
#pragma unroll
            for (int s = 0; s < 4; ++s) { const bf16x8 a = *(const LAS bf16x8*)(sK + (16 * kt + lr) * KSt + (32 * s + 8 * lg) * 2); sc[kt] = MFMA16(a, qf[s], sc[kt]); } }
        float m = -3.0e38f;
#pragma unroll
        for (int kt = 0; kt < 16; ++kt) m = fmaxf(m, fmaxf(fmaxf(sc[kt][0], sc[kt][1]), fmaxf(sc[kt][2], sc[kt][3])));
        m = fmaxf(m, __shfl_xor(m, 16)); m = fmaxf(m, __shfl_xor(m, 32));
        const float c = 0.08838834764831845f * 1.4426950408889634f;
        float sum = 0.f;
#pragma unroll
        for (int kt = 0; kt < 16; ++kt)
#pragma unroll
            for (int r = 0; r < 4; ++r) { const float p = exp2f((sc[kt][r] - m) * c); sc[kt][r] = p; sum += p; }
        sum += __shfl_xor(sum, 16); sum += __shfl_xor(sum, 32);
        const float inv = 1.0f / sum;
        f32x4 oa[8];
#pragma unroll
        for (int dt = 0; dt < 8; ++dt) oa[dt] = (f32x4){0.f, 0.f, 0.f, 0.f};
#pragma unroll
        for (int s = 0; s < 8; ++s) {
            u32x4 pw; pw.x = pk2(sc[2 * s][0], sc[2 * s][1]); pw.y = pk2(sc[2 * s][2], sc[2 * s][3]); pw.z = pk2(sc[2 * s + 1][0], sc[2 * s + 1][1]); pw.w = pk2(sc[2 * s + 1][2], sc[2 * s + 1][3]);
            const bf16x8 b = as_bf8(pw);
#pragma unroll
            for (int dt = 0; dt < 8; ++dt) { const LAS unsigned char* vp = sV + (16 * dt + lr) * VSt + (32 * s + 4 * lg) * 2; const u32x2 lo = *(const LAS u32x2*)vp, hi = *(const LAS u32x2*)(vp + 32);
                oa[dt] = MFMA16(as_bf8((u32x4){lo.x, lo.y, hi.x, hi.y}), b, oa[dt]); }
        }
#pragma unroll
        for (int dt = 0; dt < 8; ++dt) { u32x2 ow; ow.x = pk2(oa[dt][0] * inv, oa[dt][1] * inv); ow.y = pk2(oa[dt][2] * inv, oa[dt][3] * inv);
            *(u32x2*)(OX + (size_t)row * XA + h * XD + 16 * dt + 4 * lg) = ow; }
    }
    __syncthreads();
}

typedef float f32x16 __attribute__((ext_vector_type(16)));
__device__ __forceinline__ void p_router(Frame& F) {
    const bf16* X2 = WSP(bf16, WS_X1B); bf16* H3 = WSP(bf16, WS_H3); const float* WR = WSP(float, WS_WR); const float* g = F.in[I_NMOEG]; const float* rb = F.in[I_RB];
    int* TKE = WSP(int, WS_TKE); int* TKP = WSP(int, WS_TKP); float* TKW = WSP(float, WS_TKW); unsigned* cnt = F.ctl + CW_CNT; int* RTE = WSP(int, WS_RTE);
    LAS unsigned* lcnt = (LAS unsigned*)F.lds;
    LAS int* le = (LAS int*)(F.lds + 256);
    LAS int* lp = (LAS int*)(F.lds + 256 + 1024);
    LAS float* P = (LAS float*)(F.lds + 4096);
    LAS float* SSQ = (LAS float*)(F.lds + 4096 + 8 * 32 * 33 * 4);
    const int lane = F.lane, th = F.wave & 1, kq = F.wave >> 1, li = lane & 31, hh = lane >> 5;
    for (int blk = F.bid; blk < T / 64; blk += F.G) {
        __syncthreads();
        if (F.tid < 64) lcnt[F.tid] = 0u;
        const bf16* xr = X2 + (size_t)(blk * 64 + th * 32 + li) * D + kq * 512 + 8 * hh;
        const float* wr = WR + (size_t)li * D + kq * 512 + 8 * hh;
        f32x16 acc;
#pragma unroll
        for (int r = 0; r < 16; ++r) acc[r] = 0.f;
        float ss = 0.f;
#pragma unroll 8
        for (int q = 0; q < 32; ++q) {
            const u32x4 aw = *(const u32x4*)(xr + 16 * q); const f32x4 b0 = *(const f32x4*)(wr + 16 * q), b1 = *(const f32x4*)(wr + 16 * q + 4);
            const f32x4 a0 = {__uint_as_float(aw.x << 16), __uint_as_float(aw.x & 0xffff0000u), __uint_as_float(aw.y << 16), __uint_as_float(aw.y & 0xffff0000u)};
            const f32x4 a1 = {__uint_as_float(aw.z << 16), __uint_as_float(aw.z & 0xffff0000u), __uint_as_float(aw.w << 16), __uint_as_float(aw.w & 0xffff0000u)};
            ss += ((a0[0] * a0[0] + a0[1] * a0[1]) + (a0[2] * a0[2] + a0[3] * a0[3])) + ((a1[0] * a1[0] + a1[1] * a1[1]) + (a1[2] * a1[2] + a1[3] * a1[3]));
#pragma unroll
            for (int s = 0; s < 4; ++s) acc = __builtin_amdgcn_mfma_f32_32x32x2f32(a0[s], b0[s], acc, 0, 0, 0);
#pragma unroll
            for (int s = 0; s < 4; ++s) acc = __builtin_amdgcn_mfma_f32_32x32x2f32(a1[s], b1[s], acc, 0, 0, 0);
        }
        ss += __shfl_xor(ss, 32);
#pragma unroll
        for (int r = 0; r < 16; ++r) P[(F.wave * 32 + (r & 3) + 8 * (r >> 2) + 4 * hh) * 33 + li] = acc[r];
        if (lane < 32) SSQ[F.wave * 32 + lane] = ss;
        __syncthreads();
        if (F.tid < 64) {
            const int tl = F.tid, th2 = tl >> 5, ti = tl & 31, t = blk * 64 + tl;
            float ssq = 0.f;
#pragma unroll
            for (int k4 = 0; k4 < 4; ++k4) ssq += SSQ[(k4 * 2 + th2) * 32 + ti];
            const float r = rsqrtf(ssq * (1.0f / D) + EPS);
            float v0 = -3.0e38f, v1 = -3.0e38f, v2 = -3.0e38f, v3 = -3.0e38f; int i0 = 0, i1 = 0, i2 = 0, i3 = 0;
            for (int e = 0; e < NE; ++e) {
                float x = 0.f;
#pragma unroll
                for (int k4 = 0; k4 < 4; ++k4) x += P[((k4 * 2 + th2) * 32 + ti) * 33 + e];
                x = x * r + rb[e];
                if (x > v3) {
                    if (x > v2) { v3 = v2; i3 = i2;
                        if (x > v1) { v2 = v1; i2 = i1;
                            if (x > v0) { v1 = v0; i1 = i0; v0 = x; i0 = e; } else { v1 = x; i1 = e; } }
                        else { v2 = x; i2 = e; } }
                    else { v3 = x; i3 = e; } }
            }
            const float e1 = __expf(v1 - v0), e2 = __expf(v2 - v0), e3 = __expf(v3 - v0), inv = 1.0f / (1.0f + e1 + e2 + e3);
            const unsigned p0 = __hip_atomic_fetch_add(lcnt + i0, 1u, __ATOMIC_RELAXED, __HIP_MEMORY_SCOPE_WORKGROUP);
            const unsigned p1 = __hip_atomic_fetch_add(lcnt + i1, 1u, __ATOMIC_RELAXED, __HIP_MEMORY_SCOPE_WORKGROUP);
            const unsigned p2 = __hip_atomic_fetch_add(lcnt + i2, 1u, __ATOMIC_RELAXED, __HIP_MEMORY_SCOPE_WORKGROUP);
            const unsigned p3 = __hip_atomic_fetch_add(lcnt + i3, 1u, __ATOMIC_RELAXED, __HIP_MEMORY_SCOPE_WORKGROUP);
            le[tl * 4 + 0] = i0; le[tl * 4 + 1] = i1; le[tl * 4 + 2] = i2; le[tl * 4 + 3] = i3;
            lp[tl * 4 + 0] = (int)p0; lp[tl * 4 + 1] = (int)p1; lp[tl * 4 + 2] = (int)p2; lp[tl * 4 + 3] = (int)p3;
            *(int4*)(TKE + t * 4) = make_int4(i0, i1, i2, i3);
            *(f32x4*)(TKW + t * 4) = (f32x4){inv, e1 * inv, e2 * inv, e3 * inv};
        }
        __syncthreads();
        if (F.tid < NE) lcnt[32 + F.tid] = __hip_atomic_fetch_add(cnt + 64 * F.tid, lcnt[F.tid], RLX_AGENT);
        __syncthreads();
        if (F.tid < 256) { const int tl = F.tid >> 2, k = F.tid & 3, ee = le[tl * 4 + k], pos = lp[tl * 4 + k] + (int)lcnt[32 + ee]; TKP[(blk * 64 + tl) * 4 + k] = pos; RTE[(size_t)ee * T + pos] = blk * 64 + tl; }
#if MOE_FP8
        for (int tq = 0; tq < 8; tq += 4) {
            u32x2 xw[4][8];
#pragma unroll
            for (int u = 0; u < 4; ++u)
#pragma unroll
                for (int j = 0; j < 8; ++j) xw[u][j] = *(const u32x2*)(X2 + (size_t)(blk * 64 + F.wave * 8 + tq + u) * D + 4 * lane + 256 * j);
#pragma unroll
            for (int u = 0; u < 4; ++u) { unsigned char* o8 = (unsigned char*)H3 + (size_t)(blk * 64 + F.wave * 8 + tq + u) * D;
                f32x4 v[8]; float s2 = 0.f;
#pragma unroll
                for (int j = 0; j < 8; ++j) { v[j] = (f32x4){__uint_as_float(xw[u][j].x << 16), __uint_as_float(xw[u][j].x & 0xffff0000u), __uint_as_float(xw[u][j].y << 16), __uint_as_float(xw[u][j].y & 0xffff0000u)}; s2 += (v[j][0] * v[j][0] + v[j][1] * v[j][1]) + (v[j][2] * v[j][2] + v[j][3] * v[j][3]); }
                const float r2 = rsqrtf(wave_sum(s2) * (1.0f / D) + EPS) * H8_SCALE;
#pragma unroll
                for (int j = 0; j < 8; ++j) { const f32x4 gg = *(const f32x4*)(g + 4 * lane + 256 * j); *(unsigned*)(o8 + 4 * lane + 256 * j) = pk4_fp8(v[j][0] * r2 * gg[0], v[j][1] * r2 * gg[1], v[j][2] * r2 * gg[2], v[j][3] * r2 * gg[3]); } } }
#else
        for (int tt = 0; tt < 8; ++tt) { const int t = blk * 64 + F.wave * 8 + tt; rms_row_to_bf16(X2 + (size_t)t * D, g, H3 + (size_t)t * D, lane); }
#endif
    }
}
__device__ __forceinline__ void p_lists(Frame& F) {
    unsigned* cnt = F.ctl + CW_CNT; int* TKE = WSP(int, WS_TKE); int* TKP = WSP(int, WS_TKP); int* ROWTOK = WSP(int, WS_ROWTOK); int* TILE = WSP(int, WS_TILE);
    LAS int* poff = (LAS int*)F.lds;
    LAS int* lc = (LAS int*)(F.lds + 256);
    __syncthreads();
    if (F.tid < NE) lc[F.tid] = (int)__hip_atomic_load(cnt + 64 * F.tid, RLX_AGENT);
    __syncthreads();
    if (F.tid == 0) { int o = 0; for (int e = 0; e < NE; ++e) { poff[e] = o; o += (lc[e] + 255) / 256 * 256; } poff[NE] = o; }
    __syncthreads();
    for (int i = F.bid * NTHR + F.tid; i < T * TOPK; i += F.G * NTHR) { const int e = TKE[i], slot = poff[e] + TKP[i]; TKP[i] = slot; ROWTOK[slot] = i >> 2; }
    if (F.bid == 0) {
        for (int e = 0; e < NE; ++e) for (int s = poff[e] + lc[e] + F.tid; s < poff[e + 1]; s += NTHR) ROWTOK[s] = T;
        for (int e = 0; e < NE; ++e) for (int tl = poff[e] / 256 + F.tid; tl < poff[e + 1] / 256; tl += NTHR) TILE[tl] = e;
        if (F.tid == 0) TILE[512] = poff[NE] / 256;
    }
    __syncthreads();
}
__device__ __forceinline__ void p_combine(Frame& F) {
    const bf16* X2 = WSP(bf16, WS_X1B); const unsigned char* YS = WSP(unsigned char, WS_YS); const int* TKP = WSP(int, WS_TKP); const float* TKW = WSP(float, WS_TKW); const float* g = F.in[I_NFG];
    const int gw = F.bid * NWAVES + F.wave, NGW = F.G * NWAVES, lane = F.lane;
    moe_layout(F.lds, F.ctl + CW_CNT); const LAS int* lay = (const LAS int*)(F.lds + LAY_OFF); const int* TKE = WSP(int, WS_TKE);
    int sl[4]; float w[4];
    if (gw < T) {
#pragma unroll
        for (int k = 0; k < 4; ++k) { sl[k] = lay[TKE[gw * 4 + k]] + TKP[gw * 4 + k]; w[k] = TKW[gw * 4 + k] * (1.0f / Y8_SCALE); } }
    for (int t = gw; t < T; t += NGW) {
        int sn[4] = {0, 0, 0, 0}; float wn[4] = {0.f, 0.f, 0.f, 0.f};
        if (t + NGW < T) {
#pragma unroll
            for (int k = 0; k < 4; ++k) { sn[k] = lay[TKE[(t + NGW) * 4 + k]] + TKP[(t + NGW) * 4 + k]; wn[k] = TKW[(t + NGW) * 4 + k] * (1.0f / Y8_SCALE); } }
        f32x4 v[8]; float s = 0.f;
#pragma unroll
        for (int j = 0; j < 8; ++j) { { const u32x2 xw = *(const u32x2*)(X2 + (size_t)t * D + 4 * lane + 256 * j); v[j] = (f32x4){__uint_as_float(xw.x << 16), __uint_as_float(xw.x & 0xffff0000u), __uint_as_float(xw.y << 16), __uint_as_float(xw.y & 0xffff0000u)}; }
#pragma unroll
            for (int k = 0; k < 4; ++k) { const int y = __builtin_nontemporal_load((const int*)(YS + (size_t)sl[k] * D + 4 * lane + 256 * j)); const f32x2 y01 = __builtin_amdgcn_cvt_pk_f32_fp8(y, false), y23 = __builtin_amdgcn_cvt_pk_f32_fp8(y, true);
                v[j][0] += w[k] * y01[0]; v[j][1] += w[k] * y01[1]; v[j][2] += w[k] * y23[0]; v[j][3] += w[k] * y23[1]; }
            s += (v[j][0] * v[j][0] + v[j][1] * v[j][1]) + (v[j][2] * v[j][2] + v[j][3] * v[j][3]); }
        const float r = rsqrtf(wave_sum(s) * (1.0f / D) + EPS);
#pragma unroll
        for (int j = 0; j < 8; ++j) { const f32x4 gg = *(const f32x4*)(g + 4 * lane + 256 * j); __builtin_nontemporal_store(v[j] * r * gg, (f32x4*)(F.out + (size_t)t * D + 4 * lane + 256 * j)); }
#pragma unroll
        for (int k = 0; k < 4; ++k) { sl[k] = sn[k]; w[k] = wn[k]; }
    }
}

constexpr int NPHASE = 16;
__global__ void __launch_bounds__(NTHR, 2) hybrid_fwd(Args args) {
    extern __shared__ __attribute__((aligned(16))) unsigned char lds_raw[];
    Frame F;
    F.lds = (LAS unsigned char*)lds_raw; F.ws = args.ws; F.ctl = (unsigned*)(args.ws + WS_CTL);
    F.tid = threadIdx.x; F.lane = F.tid & 63; F.wave = __builtin_amdgcn_readfirstlane(F.tid >> 6); F.G = gridDim.x; F.bid = blockIdx.x;
    F.in = args.in; F.out = args.out;
    volatile LAS unsigned* MISC = (volatile LAS unsigned*)(F.lds + MISC_OFF);
    if (F.tid < 32) MISC[F.tid] = 0u;
    __syncthreads();
#if MK_ONE_LAUNCH
    XcdBarrier bar = xcd_barrier_post(F.ctl + CW_BAR, MISC + 8);
#define GRID_BAR() xcd_barrier(bar)
#else
#define GRID_BAR() do {} while (0)
#endif
    const int lo = args.ph_lo, hi = args.ph_hi;
#ifndef ONLY_PHASE
#define ONLY_PHASE -1
#endif
#define IN(k) (lo <= (k) && (k) < hi && (ONLY_PHASE < 0 || ONLY_PHASE == (k)))
#define SEAM(k) do { if (IN(k) && IN((k) + 1)) GRID_BAR(); } while (0)

#ifndef DUP_PHASE
#define DUP_PHASE -1
#endif
#ifndef DUP_NOEPI
#define DUP_NOEPI 0
#endif
    bool do_epi = true, do_epi_flag = true;
#define PHASE_NS(k, ...) do { if (IN(k)) { __VA_ARGS__ if (DUP_PHASE == (k)) { GRID_BAR(); do_epi = (DUP_NOEPI == 1) ? (args.probe != 0) : true; do_epi_flag = false; __VA_ARGS__ do_epi = true; do_epi_flag = true; } } } while (0)
#define PHASE(k, ...) do { if (IN(k)) { __VA_ARGS__ if (DUP_PHASE == (k)) { GRID_BAR(); do_epi = (DUP_NOEPI == 1) ? (args.probe != 0) : true; do_epi_flag = false; __VA_ARGS__ do_epi = true; do_epi_flag = true; } } SEAM(k); } while (0)
    constexpr int MAIN_ROUNDS = 4;
    const bool split = (F.G == 256);
    const int sgrp = F.bid >> 3;
    const bool conv_role = !split || (sgrp & 3) == 0;
    PHASE(0, p0_prologue(F, 0, F.bid, F.G););
    PHASE_NS(12,
        if (conv_role) { p0_prologue(F, 1, split ? ((sgrp >> 2) * 8 + (F.bid & 7)) : F.bid, split ? 64 : F.G); }
        else { const int j = (sgrp - (sgrp >> 2) - 1) * 8 + (F.bid & 7);
          DenseSched S; S.init(WSP(bf16, WS_XN), WSP(bf16, WS_WIN), T, NIN, D, 192, MAIN_ROUNDS * 256 + j);
          EpiInProj E{WSP(bf16, WS_Q), WSP(bf16, WS_K), WSP(bf16, WS_V), WSP(bf16, WS_SR), WSP(bf16, WS_CB), WSP(bf16, WS_U), WSP(bf16, WS_SGA), WSP(bf16, WS_SGB)};
          gemm_any(F.lds, S, E, do_epi); }
        VM_WAIT(); __syncthreads(););
    PHASE(1,
        { DenseSched S; S.init(WSP(bf16, WS_XN), WSP(bf16, WS_WIN), T, NIN, D, F.G, F.bid, 0, split ? MAIN_ROUNDS : (1 << 30));
          EpiInProj E{WSP(bf16, WS_Q), WSP(bf16, WS_K), WSP(bf16, WS_V), WSP(bf16, WS_SR), WSP(bf16, WS_CB), WSP(bf16, WS_U), WSP(bf16, WS_SGA), WSP(bf16, WS_SGB)};
          gemm_any(F.lds, S, E, do_epi); }
        p_alow(F); p_memkv(F););
    PHASE(2, p_conv(F); p_glaprep(F););
#if OPT_GLA
    PHASE(3, p_gla_a(F););
    PHASE(4, p_gla_b(F););
    PHASE(5, p_gla_c(F););
#else
    PHASE(3, p_gla_ref(F););
    PHASE(4, ;);
    PHASE(5, p_gla_norm_ref(F););
#endif
    PHASE(6,
        { DenseSched S; S.init(WSP(bf16, WS_OA), WSP(bf16, WS_WGO), T, D, D, F.G, F.bid); EpiGateA E{WSP(bf16, WS_T1), WSP(bf16, WS_SGA)}; gemm_any(F.lds, S, E, do_epi); }
        VM_WAIT(); __syncthreads();
        { DenseSched S; S.init(WSP(bf16, WS_Z), WSP(bf16, WS_WCO), T, D, D, F.G, F.bid); EpiGateB E{WSP(bf16, WS_T1), WSP(bf16, WS_SGB), WSP(bf16, WS_MG)}; gemm_any(F.lds, S, E, do_epi); });
    PHASE(7, { DenseSched S; S.init(WSP(bf16, WS_MG), WSP(bf16, WS_WMX), T, D, D, F.G, F.bid); EpiResid1 E{F.in[I_X], WSP(bf16, WS_X1B), WSP(float, WS_SSP)}; gemm_any(F.lds, S, E, do_epi); });
    PHASE(8, { DenseSched S; S.init(WSP(bf16, WS_X1B), WSP(bf16, WS_WXQ), T, 2 * XA, D, F.G, F.bid); S.ks = 1; EpiXQ E{WSP(bf16, WS_QX), WSP(float, WS_SSP)}; gemm_any(F.lds, S, E, do_epi); });
#if OPT_ATT
    PHASE(9, p_attn(F););
#else
    PHASE(9, p_attn_ref(F););
#endif
    PHASE(10, { DenseSched S; S.init(WSP(bf16, WS_OX), WSP(bf16, WS_WXO), T, D, XA, F.G, F.bid); EpiResid2 E{WSP(bf16, WS_X1B)}; gemm_any(F.lds, S, E, do_epi); });
    PHASE(11, p_router(F););
#if MOE_FP8
    PHASE(13, { moe_layout(F.lds, F.ctl + CW_CNT); const LAS int* lay = (const LAS int*)(F.lds + LAY_OFF); const int ntiles = __builtin_amdgcn_readfirstlane(lay[NE]) / 256;
        GroupSched S; S.init(WSP(unsigned char, WS_H3), WSP(unsigned char, WS_WGU), ntiles, 2 * FF, D, F.G, F.bid, lay, WSP(int, WS_RTE), 1); EpiGU8 E{WSP(unsigned char, WS_ACT), F.in[I_GUB]};
        gemm_any<EpiGU8, GroupSched, true>(F.lds, S, E, do_epi); });
    PHASE(14, { if (!IN(13)) moe_layout(F.lds, F.ctl + CW_CNT);
        const LAS int* lay = (const LAS int*)(F.lds + LAY_OFF); const int ntiles = __builtin_amdgcn_readfirstlane(lay[NE]) / 256;
        GroupSched S; S.init(WSP(unsigned char, WS_ACT), WSP(unsigned char, WS_WDN), ntiles, D, FF, F.G, F.bid, lay, nullptr, 1); EpiDown8 E{WSP(unsigned char, WS_YS), F.in[I_DNB]};
        gemm_any<EpiDown8, GroupSched, true>(F.lds, S, E, do_epi); });
#endif
    PHASE(15, p_combine(F););
#undef PHASE
#undef IN
#undef SEAM
}

extern "C" void kernel_launch(void* const* d_in, const int* in_sizes, int n_in, void* d_out, int out_size, void* d_ws, size_t ws_size, hipStream_t stream) {
    static int grid = 0;
    if (grid == 0) {
        if (n_in != 26 || out_size != T * D || ws_size < WS_END) { fprintf(stderr, "kernel_launch: unexpected problem (n_in %d, out %d, ws %zu < %zu)\n", n_in, out_size, ws_size, (size_t)WS_END); grid = -1; return; }
        int dev = 0, cus = 0, per_cu = 0;
        if (hipGetDevice(&dev) != hipSuccess || hipDeviceGetAttribute(&cus, hipDeviceAttributeMultiprocessorCount, dev) != hipSuccess) { grid = -1; return; }
        if (hipFuncSetAttribute((const void*)hybrid_fwd, hipFuncAttributeMaxDynamicSharedMemorySize, LDS_BYTES) != hipSuccess) { fprintf(stderr, "kernel_launch: hipFuncSetAttribute failed\n"); grid = -1; return; }
        if (hipOccupancyMaxActiveBlocksPerMultiprocessor(&per_cu, (const void*)hybrid_fwd, NTHR, LDS_BYTES) != hipSuccess || per_cu < 1) fprintf(stderr, "kernel_launch: occupancy query says %d\n", per_cu);
        (void)hipGetLastError();
        grid = cus;
    }
    if (grid < 0) return;
    (void)hipMemsetAsync((char*)d_ws + WS_CTL, 0, CTL_ZERO_BYTES, stream);
    Args a{};
    for (int i = 0; i < 26; ++i) a.in[i] = (const float*)d_in[i];
    a.out = (float*)d_out; a.ws = (unsigned char*)d_ws;
#if MK_ONE_LAUNCH
    a.ph_lo = 0; a.ph_hi = NPHASE;
    hipLaunchKernelGGL(hybrid_fwd, dim3(grid), dim3(NTHR), LDS_BYTES, stream, a);
#else
    for (int p = 0; p < NPHASE; ++p) { a.ph_lo = p; a.ph_hi = p + 1; hipLaunchKernelGGL(hybrid_fwd, dim3(grid), dim3(NTHR), LDS_BYTES, stream, a); }
#endif
}
```
